# Optimizing an MI355X kernel written in HIP

```python
import math
import jax, jax.numpy as jnp
from jax import lax
import numpy as np

D_MODEL = 2048
BATCH = 4
SEQ = 2048
DEPTH = 1
DEC_BATCH = 128
DEC_SEQ = 1
PAST_LEN = 16384
PAGE_SIZE = 128

D_MIX = D_MODEL
D_S5 = D_MIX // 2
D_LRU = D_MIX - D_S5
S5_CH = 16
S5_GROUPS = D_S5 // S5_CH
S5_STATE = 64
LRU_HEADS = 4
LRU_BLOCK = D_LRU // LRU_HEADS
CONV_W = 4
LRU_C = 8.0
D_FF = 4 * D_MODEL
D_PLE = 256
EPS = 1e-6
F32 = jnp.float32

kernel_name = "hymba_s5_rglru_hybrid_step"


def rmsnorm(x, g):
    xf = x.astype(F32)
    out = xf * lax.rsqrt(jnp.mean(xf * xf, axis=-1, keepdims=True) + EPS) * g.astype(F32)
    return out.astype(x.dtype)


def _complex_affine_combine(e1, e2):
    a1r, a1i, b1r, b1i = e1
    a2r, a2i, b2r, b2i = e2
    return (a2r * a1r - a2i * a1i,
            a2r * a1i + a2i * a1r,
            a2r * b1r - a2i * b1i + b2r,
            a2r * b1i + a2i * b1r + b2i)


def _real_affine_combine(e1, e2):
    a1, b1 = e1
    a2, b2 = e2
    return (a1 * a2, a2 * b1 + b2)


def s5_mixer(u, h0_re, h0_im, lam_re, lam_im, log_step, b_re, b_im, c_re, c_im, d_skip, w_glu, b_glu):
    n, t, _ = u.shape
    uf = u.astype(F32).reshape(n, t, S5_GROUPS, S5_CH)
    step = jnp.exp(log_step.astype(F32))[:, None]
    lr = lam_re.astype(F32)
    li = lam_im.astype(F32)
    mag = jnp.exp(lr * step)
    ar = mag * jnp.cos(li * step)
    ai = mag * jnp.sin(li * step)
    nr, ni = ar - 1.0, ai
    den = lr * lr + li * li
    cr = (nr * lr + ni * li) / den
    ci = (ni * lr - nr * li) / den
    br = b_re.astype(F32)
    bi = b_im.astype(F32)
    bbr = cr[..., None] * br - ci[..., None] * bi
    bbi = cr[..., None] * bi + ci[..., None] * br
    bu_re = jnp.einsum('ntgc,gpc->ntgp', uf, bbr)
    bu_im = jnp.einsum('ntgc,gpc->ntgp', uf, bbi)
    h0r = h0_re.astype(F32)
    h0i = h0_im.astype(F32)
    bu_re = bu_re.at[:, 0].add(ar * h0r - ai * h0i)
    bu_im = bu_im.at[:, 0].add(ar * h0i + ai * h0r)
    a_re = jnp.broadcast_to(ar, bu_re.shape)
    a_im = jnp.broadcast_to(ai, bu_im.shape)
    _, _, h_re, h_im = lax.associative_scan(_complex_affine_combine, (a_re, a_im, bu_re, bu_im), axis=1)
    y = (jnp.einsum('ntgp,gcp->ntgc', h_re, c_re.astype(F32))
         - jnp.einsum('ntgp,gcp->ntgc', h_im, c_im.astype(F32))
         + d_skip.astype(F32).reshape(S5_GROUPS, S5_CH) * uf)
    y = jax.nn.gelu(y.reshape(n, t, D_S5))
    y = y * jax.nn.sigmoid(y @ w_glu.astype(F32) + b_glu.astype(F32))
    return y.astype(u.dtype), h_re[:, -1], h_im[:, -1]


def rglru_mixer(xb, gb, h0, conv0, conv_w, conv_b, w_a, b_a, w_i, b_i, lam):
    n, t, _ = xb.shape
    xpad = jnp.concatenate([conv0.astype(F32), xb.astype(F32)], axis=1)
    cw = conv_w.astype(F32)
    xc = conv_b.astype(F32) + sum(xpad[:, k:k + t] * cw[k] for k in range(CONV_W))
    new_conv = xpad[:, -(CONV_W - 1):]
    xh = xc.reshape(n, t, LRU_HEADS, LRU_BLOCK)
    r = jax.nn.sigmoid(jnp.einsum('nthi,hij->nthj', xh, w_a.astype(F32)).reshape(n, t, D_LRU) + b_a.astype(F32))
    ig = jax.nn.sigmoid(jnp.einsum('nthi,hij->nthj', xh, w_i.astype(F32)).reshape(n, t, D_LRU) + b_i.astype(F32))
    log_a = -LRU_C * r * jax.nn.softplus(-lam.astype(F32))
    a = jnp.exp(log_a)
    mult = jnp.sqrt(-jnp.expm1(2.0 * log_a))
    bterm = mult * (ig * xc)
    bterm = bterm.at[:, 0].add(a[:, 0] * h0.astype(F32))
    _, h = lax.associative_scan(_real_affine_combine, (a, bterm), axis=1)
    out = h * jax.nn.gelu(gb.astype(F32))
    return out.astype(xb.dtype), h[:, -1], new_conv


def decoder_layer(x, p, s5_re, s5_im, lru_h, conv_buf, lw):
    h = rmsnorm(x, lw['g_mix'])
    z = h @ lw['w_in']
    u = z[..., :D_S5]
    xb = z[..., D_S5:D_S5 + D_LRU]
    gb = z[..., D_S5 + D_LRU:]
    ya, s5r, s5i = s5_mixer(u, s5_re, s5_im, lw['s5_lam_re'], lw['s5_lam_im'], lw['s5_log_step'],
                            lw['s5_b_re'], lw['s5_b_im'], lw['s5_c_re'], lw['s5_c_im'], lw['s5_d'],
                            lw['s5_w_glu'], lw['s5_b_glu'])
    yb, lh, cb = rglru_mixer(xb, gb, lru_h, conv_buf, lw['conv_w'], lw['conv_b'], lw['lru_w_a'],
                             lw['lru_b_a'], lw['lru_w_i'], lw['lru_b_i'], lw['lru_lam'])
    merged = jnp.concatenate([rmsnorm(ya, lw['g_merge_a']), rmsnorm(yb, lw['g_merge_b'])], axis=-1)
    x = x + merged @ lw['w_out']
    h2 = rmsnorm(x, lw['g_mlp'])
    x = x + jnp.square(jax.nn.relu(h2 @ lw['w_up'])) @ lw['w_down']
    gate = jax.nn.sigmoid(rmsnorm(x, lw['g_ple']) @ lw['w_ple_gate'])
    x = x + (p.astype(x.dtype) @ lw['w_ple']) * gate
    return x, s5r, s5i, lh, cb


def setup_inputs(seed: int = 0) -> dict:
    key = jax.random.key(seed)
    ks = iter(jax.random.split(key, 48))
    nrm = lambda shape, s: jax.random.normal(next(ks), shape, F32) * s
    uni = lambda shape, lo, hi: jax.random.uniform(next(ks), shape, F32, lo, hi)
    L = DEPTH
    n_idx = jnp.arange(S5_STATE, dtype=F32)
    lam_re = -0.5 + nrm((L, S5_GROUPS, S5_STATE), 0.01)
    lam_im = math.pi * n_idx + nrm((L, S5_GROUPS, S5_STATE), 0.01)
    a0 = uni((L, D_LRU), 0.9, 0.999) ** (1.0 / LRU_C)
    lru_lam = jnp.log(a0) - jnp.log1p(-a0)
    return {
        'x_prompt': nrm((BATCH, SEQ, D_MODEL), 1.0),
        'x_sample': nrm((DEC_BATCH, DEC_SEQ, D_MODEL), 1.0),
        'state_s5_re': nrm((L, DEC_BATCH, S5_GROUPS, S5_STATE), 0.5),
        'state_s5_im': nrm((L, DEC_BATCH, S5_GROUPS, S5_STATE), 0.5),
        'state_lru': nrm((L, DEC_BATCH, D_LRU), 0.5),
        'state_conv': nrm((L, DEC_BATCH, CONV_W - 1, D_LRU), 1.0),
        'p_prompt': nrm((L, BATCH, SEQ, D_PLE), 1.0),
        'p_sample': nrm((L, DEC_BATCH, DEC_SEQ, D_PLE), 1.0),
        'g_mix': 1.0 + nrm((L, D_MODEL), 0.02),
        'w_in': nrm((L, D_MODEL, D_S5 + 2 * D_LRU), D_MODEL ** -0.5),
        's5_lam_re': lam_re,
        's5_lam_im': lam_im,
        's5_log_step': uni((L, S5_GROUPS), math.log(1e-3), math.log(1e-1)),
        's5_b_re': nrm((L, S5_GROUPS, S5_STATE, S5_CH), (2 * S5_CH) ** -0.5),
        's5_b_im': nrm((L, S5_GROUPS, S5_STATE, S5_CH), (2 * S5_CH) ** -0.5),
        's5_c_re': nrm((L, S5_GROUPS, S5_CH, S5_STATE), (2 * S5_STATE) ** -0.5),
        's5_c_im': nrm((L, S5_GROUPS, S5_CH, S5_STATE), (2 * S5_STATE) ** -0.5),
        's5_d': nrm((L, D_S5), 1.0),
        's5_w_glu': nrm((L, D_S5, D_S5), D_S5 ** -0.5),
        's5_b_glu': nrm((L, D_S5), 0.01),
        'conv_w': nrm((L, CONV_W, D_LRU), CONV_W ** -0.5),
        'conv_b': nrm((L, D_LRU), 0.01),
        'lru_w_a': nrm((L, LRU_HEADS, LRU_BLOCK, LRU_BLOCK), LRU_BLOCK ** -0.5),
        'lru_b_a': nrm((L, D_LRU), 0.01),
        'lru_w_i': nrm((L, LRU_HEADS, LRU_BLOCK, LRU_BLOCK), LRU_BLOCK ** -0.5),
        'lru_b_i': nrm((L, D_LRU), 0.01),
        'lru_lam': lru_lam,
        'g_merge_a': 1.0 + nrm((L, D_S5), 0.02),
        'g_merge_b': 1.0 + nrm((L, D_LRU), 0.02),
        'w_out': nrm((L, D_MIX, D_MODEL), D_MIX ** -0.5),
        'g_mlp': 1.0 + nrm((L, D_MODEL), 0.02),
        'w_up': nrm((L, D_MODEL, D_FF), D_MODEL ** -0.5),
        'w_down': nrm((L, D_FF, D_MODEL), D_FF ** -0.5),
        'g_ple': 1.0 + nrm((L, D_MODEL), 0.02),
        'w_ple_gate': nrm((L, D_MODEL, D_MODEL), D_MODEL ** -0.5),
        'w_ple': nrm((L, D_PLE, D_MODEL), D_PLE ** -0.5),
        'g_final': 1.0 + nrm((D_MODEL,), 0.02),
    }


def reference(x_prompt, x_sample, state_s5_re, state_s5_im, state_lru, state_conv, p_prompt, p_sample,
              g_mix, w_in, s5_lam_re, s5_lam_im, s5_log_step, s5_b_re, s5_b_im, s5_c_re, s5_c_im, s5_d,
              s5_w_glu, s5_b_glu, conv_w, conv_b, lru_w_a, lru_b_a, lru_w_i, lru_b_i, lru_lam,
              g_merge_a, g_merge_b, w_out, g_mlp, w_up, w_down, g_ple, w_ple_gate, w_ple, g_final):
    nb = x_prompt.shape[0]
    xp, xs = x_prompt, x_sample
    s5r_p, s5i_p, lru_p, conv_p = [], [], [], []
    s5r_s, s5i_s, lru_s, conv_s = [], [], [], []
    for i in range(DEPTH):
        lw = dict(g_mix=g_mix[i], w_in=w_in[i], s5_lam_re=s5_lam_re[i], s5_lam_im=s5_lam_im[i],
                  s5_log_step=s5_log_step[i], s5_b_re=s5_b_re[i], s5_b_im=s5_b_im[i],
                  s5_c_re=s5_c_re[i], s5_c_im=s5_c_im[i], s5_d=s5_d[i], s5_w_glu=s5_w_glu[i],
                  s5_b_glu=s5_b_glu[i], conv_w=conv_w[i], conv_b=conv_b[i], lru_w_a=lru_w_a[i],
                  lru_b_a=lru_b_a[i], lru_w_i=lru_w_i[i], lru_b_i=lru_b_i[i], lru_lam=lru_lam[i],
                  g_merge_a=g_merge_a[i], g_merge_b=g_merge_b[i], w_out=w_out[i], g_mlp=g_mlp[i],
                  w_up=w_up[i], w_down=w_down[i], g_ple=g_ple[i], w_ple_gate=w_ple_gate[i],
                  w_ple=w_ple[i])
        z_s5 = jnp.zeros((nb, S5_GROUPS, S5_STATE), F32)
        xp, a, b, c, d = decoder_layer(xp, p_prompt[i], z_s5, z_s5, jnp.zeros((nb, D_LRU), F32),
                                       jnp.zeros((nb, CONV_W - 1, D_LRU), F32), lw)
        s5r_p.append(a); s5i_p.append(b); lru_p.append(c); conv_p.append(d)
        xs, a, b, c, d = decoder_layer(xs, p_sample[i], state_s5_re[i], state_s5_im[i], state_lru[i],
                                       state_conv[i], lw)
        s5r_s.append(a); s5i_s.append(b); lru_s.append(c); conv_s.append(d)
    y_prompt = rmsnorm(xp, g_final)
    y_sample = rmsnorm(xs, g_final)
    return (y_prompt, y_sample,
            jnp.stack(s5r_p), jnp.stack(s5i_p), jnp.stack(lru_p), jnp.stack(conv_p),
            jnp.stack(s5r_s), jnp.stack(s5i_s), jnp.stack(lru_s), jnp.stack(conv_s))
```

```cpp
#include <hip/hip_runtime.h>
#include <hip/hip_cooperative_groups.h>
#include <cstdio>
#include <cstdint>
namespace cg = cooperative_groups;

#ifndef MK_LAUNCHES
#define MK_LAUNCHES 1
#endif

#define LAS __attribute__((address_space(3)))
typedef unsigned short bf16_t;
typedef short bf16x8 __attribute__((ext_vector_type(8)));
typedef float f32x4 __attribute__((ext_vector_type(4)));
typedef unsigned u32x4 __attribute__((ext_vector_type(4)));
typedef unsigned u32x2 __attribute__((ext_vector_type(2)));

constexpr int DM = 2048, SEQ = 2048, NB = 4, MP = 8192, MS = 128, MT = 8320;
constexpr int NZ = 3072, DFF = 8192, DPLE = 256, DH = 1024;
constexpr float EPS = 1e-6f;
constexpr int NPHASE = 10;

constexpr size_t MiB = 1u << 20;
constexpr size_t WS_CTL = 0, CTL_ZERO_BYTES = 1 * MiB;
constexpr int SS_STRIDE = 8448;
constexpr int SS_A = 0, SS_B = 1, SS_1 = 2, SS_2 = 3, SS_3 = 4;
constexpr int CW_BAR = 65536;
constexpr size_t WS_SMALL = 1 * MiB;
constexpr size_t SM_RS0 = 0, SM_AR = 65536, SM_AI = SM_AR + 16384, SM_A64R = SM_AI + 16384, SM_A64I = SM_A64R + 16384,
                 SM_BBB = SM_A64I + 16384  , SM_CMB = SM_BBB + 262144  , SM_SPL = SM_CMB + 262144  , SM_RAT = 663552  , SM_RSB = SM_RAT + 34816  ;
constexpr size_t WS_WUP = 2 * MiB, WS_WDOWN = 34 * MiB, WS_WGATE = 66 * MiB, WS_WPLE = 74 * MiB, WS_PB = 75 * MiB, WS_AB = 80 * MiB;
constexpr size_t WS_E = 113 * MiB;
constexpr size_t WS_HUP = WS_E, WS_PW = WS_E;
constexpr size_t WS_WIN = 113 * MiB, WS_WGLU = 125 * MiB, WS_WOUT = 127 * MiB, WS_WLRU = 135 * MiB, WS_Z = 136 * MiB,
                 WS_YG = 185 * MiB, WS_MERGED = 202 * MiB, WS_XC = 235 * MiB, WS_S5SUM = 251 * MiB, WS_END = 255 * MiB;
static_assert(WS_HUP + (size_t)MT * DFF * 2 <= 256 * MiB, "hup fits");
static_assert(WS_Z + (size_t)MT * NZ * 2 <= WS_YG && WS_YG + (size_t)MT * DH * 2 <= WS_MERGED && WS_MERGED + (size_t)MT * DM * 2 <= WS_XC, "map");
static_assert(WS_AB + (size_t)MT * DM * 2 <= WS_E && WS_PB + (size_t)MT * DPLE * 2 <= WS_AB, "map2");

constexpr size_t O_Y = 0, O_S5RP = 17039360, O_S5IP = 17055744, O_LRUP = 17072128, O_CONVP = 17076224,
                 O_S5RS = 17088512, O_S5IS = 17612800, O_LRUS = 18137088, O_CONVS = 18268160;

constexpr int RING_BYTES = 131072, MISC_OFF = RING_BYTES + 320, LDS_BYTES = 147456;

__device__ __forceinline__ unsigned cvt_pk_bf16(float lo, float hi) { unsigned r; asm("v_cvt_pk_bf16_f32 %0, %1, %2" : "=v"(r) : "v"(lo), "v"(hi)); return r; }
__device__ __forceinline__ float bf_lo(unsigned u) { return __uint_as_float(u << 16); }
__device__ __forceinline__ float bf_hi(unsigned u) { return __uint_as_float(u & 0xffff0000u); }
__device__ __forceinline__ float bf1(bf16_t u) { return __uint_as_float(((unsigned)u) << 16); }
__device__ __forceinline__ float sigm(float x) { return __builtin_amdgcn_rcpf(1.f + __expf(-x)); }
__device__ __forceinline__ float gelu_t(float x) { const float u = 1.5957691216057308f * (x + 0.044715f * x * x * x); return x * __builtin_amdgcn_rcpf(1.f + __expf(-u)); }
__device__ __forceinline__ float wave_sum(float v) {
#pragma unroll
    for (int o = 1; o < 64; o <<= 1) v += __shfl_xor(v, o);
    return v;
}
#define LDS_WAIT() asm volatile("s_waitcnt lgkmcnt(0)" ::: "memory")

namespace pg8 {
constexpr int BM = 256, BK = 64, HALF = 128, HTB = HALF * BK * 2, STAGE_BYTES = 8 * HTB, NXCD = 8, WGM = 8;
__host__ __device__ __forceinline__ int lds_byte(int r, int c) { const int st = (r >> 4) * 2 + (c >> 5), rr = r & 15, cc = c & 31, ob = rr * 64 + cc * 2; return st * 1024 + (ob ^ (((ob >> 9) & 1) << 5)); }
__host__ __device__ __forceinline__ void stage_rc(int b, int& R, int& C) { const int st = b / 1024, sb = b % 1024, swz = sb ^ (((sb >> 9) & 1) << 5); R = (st >> 1) * 16 + swz / 64; C = (st & 1) * 32 + (swz % 64) / 2; }
struct Unit { int pm, pn; };
struct Gemm { const bf16_t* A; const bf16_t* Bt; int lda, ldb, K, akmode; };
struct StaticOrder {
    int nM, nN, nwg, G, c;
    __device__ __forceinline__ void init(int nM_, int nN_, int G_, int c_) { nM = nM_; nN = nN_; nwg = nM * nN; G = G_; c = c_; }
    __device__ __forceinline__ bool next(int i, Unit& u) const {
        const long L = (long)i * G + c; if (L >= nwg) return false;
        int wgid = (int)L; { const int q = nwg / NXCD, r = nwg % NXCD, xcd = wgid % NXCD, off = wgid / NXCD; wgid = (xcd < r ? xcd * (q + 1) : r * (q + 1) + (xcd - r) * q) + off; }
        const int nig = WGM * nN, gid = wgid / nig, fm = gid * WGM, gsz = (nM - fm) < WGM ? (nM - fm) : WGM;
        u.pm = fm + ((wgid % nig) % gsz); u.pn = (wgid % nig) / gsz; return true;
    }
};

template <class Epi, bool ALIGN_EPI>
__device__ __forceinline__ void gemm_phase(LAS unsigned char* lds, const Gemm g, const StaticOrder& S, const Epi& E) {
    const int tid = threadIdx.x, wid = __builtin_amdgcn_readfirstlane(tid >> 6), lane = tid & 63, wr = wid >> 2, wc = wid & 3, fr = lane & 15, fq = lane >> 4;
    int K = g.K; asm volatile("" : "+s"(K));
    const int nt = K / BK;
    unsigned voffA[2], voffB[2];
#pragma unroll
    for (int i = 0; i < 2; ++i) { int R, C; stage_rc(tid * 16 + i * 8192, R, C);
        voffA[i] = (unsigned)(R * g.lda + C) * 2u; voffB[i] = (unsigned)(R * g.ldb + C) * 2u; }
    const size_t kstep = (size_t)(BK * 2);
    const size_t hstepA = (size_t)HALF * g.lda * 2, hstepB = (size_t)HALF * g.ldb * 2;
    const size_t tstepA = 2 * hstepA, tstepB = 2 * hstepB;
    const unsigned ldsw = (unsigned)wid * 1024u;
    const int aoff = lds_byte(wr * 64 + fr, fq * 8), boff = lds_byte(wc * 32 + fr, fq * 8);
#define PG8_SA(b, h) (((b) * 2 + (h)) * HTB)
#define PG8_SB(b, h) ((4 + (b) * 2 + (h)) * HTB)
#define PG8_STAGE(bufoff, gbase, voff) do { _Pragma("unroll") for (int _i = 0; _i < 2; ++_i) \
        __builtin_amdgcn_global_load_lds((const unsigned*)((const char*)(gbase) + (voff)[_i]), (LAS unsigned*)(lds + (bufoff) + ldsw + _i * 8192), 16, 0, 0); } while (0)
#define PG8_LDA(dst, b, h) do { _Pragma("unroll") for (int m = 0; m < 4; ++m) _Pragma("unroll") for (int k = 0; k < 2; ++k) dst[m][k] = *(const LAS bf16x8*)(lds + PG8_SA(b, h) + aoff + m * 2048 + k * 1024); } while (0)
#define PG8_LDB(dst, b, h) do { _Pragma("unroll") for (int n = 0; n < 2; ++n) _Pragma("unroll") for (int k = 0; k < 2; ++k) dst[n][k] = *(const LAS bf16x8*)(lds + PG8_SB(b, h) + boff + n * 2048 + k * 1024); } while (0)
#define PG8_MMA(ai, bj, At, Bt) do { __builtin_amdgcn_s_setprio(1); _Pragma("unroll") for (int m = 0; m < 4; ++m) _Pragma("unroll") for (int n = 0; n < 2; ++n) _Pragma("unroll") for (int k = 0; k < 2; ++k) \
        acc[ai][bj][m][n] = __builtin_amdgcn_mfma_f32_16x16x32_bf16(Bt[n][k], At[m][k], acc[ai][bj][m][n], 0, 0, 0); __builtin_amdgcn_s_setprio(0); } while (0)
#define PG8_WAIT_V(n) asm volatile("s_waitcnt vmcnt(" #n ")" ::: "memory")
#define PG8_WAIT_L(n) asm volatile("s_waitcnt lgkmcnt(" #n ")" ::: "memory")
#define PG8_BAR __builtin_amdgcn_s_barrier()
#define PG8_SCHED __builtin_amdgcn_sched_barrier(0)
    Unit cur, nxt; int ui = 0;
    if (!S.next(0, cur)) return;
    f32x4 acc[2][2][4][2];
#pragma unroll
    for (int a = 0; a < 2; ++a)
#pragma unroll
        for (int b = 0; b < 2; ++b)
#pragma unroll
            for (int m = 0; m < 4; ++m)
#pragma unroll
                for (int n = 0; n < 2; ++n) acc[a][b][m][n] = (f32x4){0.f, 0.f, 0.f, 0.f};
    bf16x8 At[4][2], B0[2][2], B1[2][2];
    const char* cA = (const char*)g.A + (size_t)cur.pm * tstepA + (g.akmode ? (size_t)(cur.pn >> 1) * 512 : 0);
    const char* cB = (const char*)g.Bt + (size_t)cur.pn * tstepB;
    PG8_STAGE(PG8_SB(0, 0), cB, voffB); PG8_STAGE(PG8_SB(0, 1), cB + hstepB, voffB); PG8_STAGE(PG8_SA(0, 0), cA, voffA); PG8_STAGE(PG8_SA(0, 1), cA + hstepA, voffA);
    if (wr == 1) PG8_BAR;
    PG8_WAIT_V(2); PG8_BAR;
    PG8_STAGE(PG8_SB(1, 0), cB + kstep, voffB); PG8_STAGE(PG8_SA(1, 0), cA + kstep, voffA); PG8_STAGE(PG8_SB(1, 1), cB + hstepB + kstep, voffB);
    PG8_WAIT_V(6); PG8_BAR;
    for (;;) {
        const bool has_next = S.next(ui + 1, nxt);
        const char* nA = has_next ? (const char*)g.A + (size_t)nxt.pm * tstepA + (g.akmode ? (size_t)(nxt.pn >> 1) * 512 : 0) : cA;
        const char* nB = has_next ? (const char*)g.Bt + (size_t)nxt.pn * tstepB : cB;
        for (int t = 0; t < nt; t += 2) {
            const bool last = (t == nt - 2);
            const char* a1 = cA + (size_t)(t + 1) * kstep;
            const char* a2 = last ? nA : cA + (size_t)(t + 2) * kstep; const char* b2 = last ? nB : cB + (size_t)(t + 2) * kstep;
            const char* a3 = a2 + kstep; const char* b3 = b2 + kstep;
            if constexpr (Epi::MID) { if (t == (nt >> 1)) E.mid(acc, cur, wr, fr); }
            PG8_LDB(B0, 0, 0); PG8_LDB(B1, 0, 1); PG8_SCHED; PG8_LDA(At, 0, 0); PG8_STAGE(PG8_SA(1, 1), a1 + hstepA, voffA);
            PG8_WAIT_V(8); PG8_WAIT_L(0); PG8_BAR; PG8_MMA(0, 0, At, B0); PG8_MMA(0, 1, At, B1); PG8_BAR; PG8_SCHED;
            PG8_LDA(At, 0, 1); PG8_STAGE(PG8_SB(0, 0), b2, voffB); PG8_STAGE(PG8_SB(0, 1), b2 + hstepB, voffB); PG8_STAGE(PG8_SA(0, 0), a2, voffA);
            PG8_WAIT_V(8); PG8_WAIT_L(0); PG8_BAR; PG8_MMA(1, 0, At, B0); PG8_MMA(1, 1, At, B1); PG8_BAR; PG8_SCHED;
            PG8_LDB(B0, 1, 0); PG8_LDB(B1, 1, 1); PG8_SCHED; PG8_LDA(At, 1, 0); PG8_STAGE(PG8_SA(0, 1), a2 + hstepA, voffA);
            PG8_WAIT_V(8); PG8_WAIT_L(0); PG8_BAR; PG8_MMA(0, 0, At, B0); PG8_MMA(0, 1, At, B1); PG8_BAR; PG8_SCHED;
            PG8_LDA(At, 1, 1); PG8_STAGE(PG8_SB(1, 0), b3, voffB); PG8_STAGE(PG8_SB(1, 1), b3 + hstepB, voffB); PG8_STAGE(PG8_SA(1, 0), a3, voffA);
            PG8_WAIT_V(8); PG8_WAIT_L(0); PG8_BAR; PG8_MMA(1, 0, At, B0); PG8_MMA(1, 1, At, B1); PG8_BAR; PG8_SCHED;
        }
        if constexpr (ALIGN_EPI) { if (wr == 0) PG8_BAR; }
        E(acc, cur, wr, wc, fr, fq);
        if (!has_next) break;
#pragma unroll
        for (int a = 0; a < 2; ++a)
#pragma unroll
            for (int b = 0; b < 2; ++b)
#pragma unroll
                for (int m = 0; m < 4; ++m)
#pragma unroll
                    for (int n = 0; n < 2; ++n) acc[a][b][m][n] = (f32x4){0.f, 0.f, 0.f, 0.f};
        cur = nxt; cA = nA; cB = nB; ++ui;
        if constexpr (ALIGN_EPI) { if (wr == 1) PG8_BAR; }
    }
    PG8_WAIT_V(0);
    if constexpr (!ALIGN_EPI) { if (wr == 0) PG8_BAR; }
    PG8_BAR;
#undef PG8_SA
#undef PG8_SB
#undef PG8_STAGE
#undef PG8_LDA
#undef PG8_LDB
#undef PG8_MMA
#undef PG8_WAIT_V
#undef PG8_WAIT_L
#undef PG8_BAR
#undef PG8_SCHED
}
}

template <class E> struct EpiWrap {
    E e; static constexpr bool MID = E::MID;
    __device__ __forceinline__ void operator()(const f32x4 (&acc)[2][2][4][2], const pg8::Unit& u, int wr, int wc, int fr, int fq) const {
#pragma unroll
        for (int ai = 0; ai < 2; ++ai)
#pragma unroll
            for (int m = 0; m < 4; ++m) {
                const int row = u.pm * 256 + ai * 128 + wr * 64 + m * 16 + fr; const float rv = e.rowval(row); float s = 0.f;
#pragma unroll
                for (int bj = 0; bj < 2; ++bj)
#pragma unroll
                    for (int n = 0; n < 2; ++n) s += e.apply(row, u.pn * 256 + bj * 128 + wc * 32 + n * 16 + 4 * fq, acc[ai][bj][m][n], rv);
                if constexpr (E::HAS_SS) { s += __shfl_xor(s, 16); s += __shfl_xor(s, 32); if (fq == 0) atomicAdd(e.ss + row, s); }
                asm volatile("" ::: "memory");
            }
    }
    __device__ __forceinline__ void mid(f32x4 (&acc)[2][2][4][2], const pg8::Unit& u, int wr, int fr) const {
#pragma unroll
        for (int ai = 0; ai < 2; ++ai)
#pragma unroll
            for (int m = 0; m < 4; ++m) { const float r = e.kscale(u.pm * 256 + ai * 128 + wr * 64 + m * 16 + fr, 0);
#pragma unroll
                for (int bj = 0; bj < 2; ++bj)
#pragma unroll
                    for (int n = 0; n < 2; ++n) acc[ai][bj][m][n] = acc[ai][bj][m][n] * r; }
    }
};
__device__ __forceinline__ u32x2 pk4(f32x4 v) { u32x2 w; w.x = cvt_pk_bf16(v[0], v[1]); w.y = cvt_pk_bf16(v[2], v[3]); return w; }
__device__ __forceinline__ f32x4 up4(u32x2 w) { return (f32x4){bf_lo(w.x), bf_hi(w.x), bf_lo(w.y), bf_hi(w.y)}; }
__device__ __forceinline__ float ssq4(f32x4 v) { return (v[0] * v[0] + v[1] * v[1]) + (v[2] * v[2] + v[3] * v[3]); }

struct EIn {
    static constexpr bool MID = false, HAS_SS = false; float* ss; const float* rs0; bf16_t* Z;
    __device__ __forceinline__ float rowval(int row) const { return rs0[row]; }
    __device__ __forceinline__ float kscale(int, int) const { return 1.f; }
    __device__ __forceinline__ float apply(int row, int col, f32x4 v, float rv) const { *(u32x2*)(Z + (size_t)row * NZ + col) = pk4(v * rv); return 0.f; }
};
struct EGlu {
    static constexpr bool MID = false, HAS_SS = true; float* ss; const float* bglu; const bf16_t* YG; bf16_t* MG;
    __device__ __forceinline__ float rowval(int) const { return 0.f; }
    __device__ __forceinline__ float kscale(int, int) const { return 1.f; }
    __device__ __forceinline__ float apply(int row, int col, f32x4 v, float) const {
        const f32x4 b = *(const f32x4*)(bglu + col); const f32x4 yg = up4(*(const u32x2*)(YG + (size_t)row * DH + col)); f32x4 o;
#pragma unroll
        for (int j = 0; j < 4; ++j) o[j] = yg[j] * sigm(v[j] + b[j]);
        *(u32x2*)(MG + (size_t)row * DM + col) = pk4(o); return ssq4(o);
    }
};
struct EOut {
    static constexpr bool MID = true, HAS_SS = true; float* ss; const float* rat; const float* rsb; const float* xp; const float* xs; float* XO; bf16_t* AB;
    __device__ __forceinline__ float rowval(int row) const { return rsb[row]; }
    __device__ __forceinline__ float kscale(int row, int w) const { return w < 4 ? rat[row] : 1.f; }
    __device__ __forceinline__ float apply(int row, int col, f32x4 v, float rv) const {
        const float* xr = row < MP ? xp + (size_t)row * DM : xs + (size_t)(row - MP) * DM;
        const f32x4 o = *(const f32x4*)(xr + col) + v * rv;
        *(f32x4*)(XO + (size_t)row * DM + col) = o; *(u32x2*)(AB + (size_t)row * DM + col) = pk4(o); return ssq4(o);
    }
};
struct EUp {
    static constexpr bool MID = false, HAS_SS = false; float* ss; const float* ss1; bf16_t* HUP;
    __device__ __forceinline__ float rowval(int row) const { return rsqrtf(ss1[row] * (1.f / DM) + EPS); }
    __device__ __forceinline__ float kscale(int, int) const { return 1.f; }
    __device__ __forceinline__ float apply(int row, int col, f32x4 v, float rv) const { f32x4 o;
#pragma unroll
        for (int j = 0; j < 4; ++j) { const float r = fmaxf(v[j] * rv, 0.f); o[j] = r * r; }
        *(u32x2*)(HUP + (size_t)row * DFF + col) = pk4(o); return 0.f; }
};
struct EDown {
    static constexpr bool MID = false, HAS_SS = true; float* ss; float* XO; bf16_t* AB;
    __device__ __forceinline__ float rowval(int) const { return 0.f; }
    __device__ __forceinline__ float kscale(int, int) const { return 1.f; }
    __device__ __forceinline__ float apply(int row, int col, f32x4 v, float) const {
        float* p = XO + (size_t)row * DM + col; const f32x4 o = *(const f32x4*)p + v; *(f32x4*)p = o; *(u32x2*)(AB + (size_t)row * DM + col) = pk4(o); return ssq4(o); }
};
struct EPw {
    static constexpr bool MID = false, HAS_SS = false; float* ss; bf16_t* PW;
    __device__ __forceinline__ float rowval(int) const { return 0.f; }
    __device__ __forceinline__ float kscale(int, int) const { return 1.f; }
    __device__ __forceinline__ float apply(int row, int col, f32x4 v, float) const { *(u32x2*)(PW + (size_t)row * DM + col) = pk4(v); return 0.f; }
};
struct EGate {
    static constexpr bool MID = false, HAS_SS = true; float* ss; const float* ss2; const bf16_t* PW; float* XO;
    __device__ __forceinline__ float rowval(int row) const { return rsqrtf(ss2[row] * (1.f / DM) + EPS); }
    __device__ __forceinline__ float kscale(int, int) const { return 1.f; }
    __device__ __forceinline__ float apply(int row, int col, f32x4 v, float rv) const {
        float* p = XO + (size_t)row * DM + col; f32x4 o = *(const f32x4*)p; const f32x4 pw = up4(*(const u32x2*)(PW + (size_t)row * DM + col));
#pragma unroll
        for (int j = 0; j < 4; ++j) o[j] += pw[j] * sigm(v[j] * rv);
        *(f32x4*)p = o; return ssq4(o); }
};
__device__ __forceinline__ float em1(float x) {
    float p = x * (1.f + x * (0.5f + x * (0.16666667f + x * (0.041666668f + x * (0.0083333338f + x * (0.0013888889f + x * 0.0001984127f))))));
    if (__builtin_expect(__any(fabsf(x) >= 0.5f), 0)) p = fabsf(x) < 0.5f ? p : __expf(x) - 1.f;
    return p;
}
struct ELru {
    static constexpr bool MID = false; const bf16_t* XC; const float* ba; const float* bi; const float* spl; float* Ao; float* Bo;
    __device__ __forceinline__ void mid(f32x4 (&)[2][2][4][2], const pg8::Unit&, int, int) const {}
    __device__ __forceinline__ void operator()(const f32x4 (&acc)[2][2][4][2], const pg8::Unit& u, int wr, int wc, int fr, int fq) const {
#pragma unroll
        for (int n = 0; n < 2; ++n) {
            const int ch = (u.pn >> 1) * 256 + (u.pn & 1) * 128 + wc * 32 + n * 16 + 4 * fq;
            const f32x4 bav = *(const f32x4*)(ba + ch), biv = *(const f32x4*)(bi + ch), sp = *(const f32x4*)(spl + ch);
#pragma unroll
            for (int ai = 0; ai < 2; ++ai)
#pragma unroll
                for (int m = 0; m < 4; ++m) {
                    const int row = u.pm * 256 + ai * 128 + wr * 64 + m * 16 + fr;
                    const f32x4 xc = up4(*(const u32x2*)(XC + (size_t)row * DH + ch)); f32x4 av, bv;
#pragma unroll
                    for (int j = 0; j < 4; ++j) { const float r = sigm(acc[ai][0][m][n][j] + bav[j]), ig = sigm(acc[ai][1][m][n][j] + biv[j]);
                        const float la = r * sp[j]; av[j] = 1.f + em1(la); bv[j] = __builtin_amdgcn_sqrtf(fmaxf(-em1(2.f * la), 0.f)) * ig * xc[j]; }
                    *(f32x4*)(Ao + (size_t)row * DH + ch) = av; *(f32x4*)(Bo + (size_t)row * DH + ch) = bv;
                    asm volatile("" ::: "memory");
                }
        }
    }
};

template <class E, int MT = 8, int NG = 1>
__device__ __forceinline__ void skinny_gemm(LAS unsigned char* lds, const bf16_t* A, int lda, const bf16_t* Bt, int ldb, int N, int K, const E& e, int nb = 0) {
    const int tid = threadIdx.x, wid = __builtin_amdgcn_readfirstlane(tid >> 6), lane = tid & 63, fr = lane & 15, fq = lane >> 4;
    LAS f32x4* red = (LAS f32x4*)lds;
    constexpr int NH = 8 / MT;
    const int kw = K >> 3, k0w = wid * kw, nks = kw >> 5, nit = ((N >> 4) / NG) * NH, G = gridDim.x, NBk = nb ? nb : G;
    for (int iti = G - 1 - (int)blockIdx.x; iti < nit && (G - 1 - (int)blockIdx.x) < NBk; iti += NBk) {
        const int n0 = (iti / NH) * (16 * NG), r0 = (iti % NH) * (MT * 16);
        f32x4 acc[NG][MT];
#pragma unroll
        for (int q = 0; q < NG; ++q)
#pragma unroll
            for (int m = 0; m < MT; ++m) acc[q][m] = (f32x4){0.f, 0.f, 0.f, 0.f};
        const bf16_t* bp = Bt + (size_t)(n0 + fr) * ldb + k0w + 8 * fq;
        const bf16_t* ap = A + (size_t)(r0 + fr) * lda + k0w + 8 * fq;
        {
            bf16x8 bc[NG], ac[MT];
#pragma unroll
            for (int q = 0; q < NG; ++q) bc[q] = *(const bf16x8*)(bp + (size_t)(16 * q) * ldb);
#pragma unroll
            for (int m = 0; m < MT; ++m) ac[m] = *(const bf16x8*)(ap + (size_t)(16 * m) * lda);
            for (int ks = 0; ks < nks; ++ks) {
                const int kn = ks + 1 < nks ? ks + 1 : ks;
                bf16x8 bn[NG], an[MT];
#pragma unroll
                for (int q = 0; q < NG; ++q) bn[q] = *(const bf16x8*)(bp + (size_t)(16 * q) * ldb + 32 * kn);
#pragma unroll
                for (int m = 0; m < MT; ++m) an[m] = *(const bf16x8*)(ap + (size_t)(16 * m) * lda + 32 * kn);
#pragma unroll
                for (int q = 0; q < NG; ++q)
#pragma unroll
                    for (int m = 0; m < MT; ++m) acc[q][m] = __builtin_amdgcn_mfma_f32_16x16x32_bf16(bc[q], ac[m], acc[q][m], 0, 0, 0);
#pragma unroll
                for (int q = 0; q < NG; ++q) bc[q] = bn[q];
#pragma unroll
                for (int m = 0; m < MT; ++m) ac[m] = an[m];
            }
        }
#pragma unroll
        for (int q = 0; q < NG; ++q)
#pragma unroll
            for (int m = 0; m < MT; ++m) red[((wid * NG + q) * MT + m) * 64 + lane] = acc[q][m];
        __syncthreads();
        if (wid < MT) {
            const int row = MP + r0 + 16 * wid + fr; const float rv = e.rowval(row);
#pragma unroll
            for (int q = 0; q < NG; ++q) {
                f32x4 v = (f32x4){0.f, 0.f, 0.f, 0.f};
#pragma unroll
                for (int w = 0; w < 8; ++w) { f32x4 p = red[((w * NG + q) * MT + wid) * 64 + lane]; if constexpr (E::MID) p = p * e.kscale(row, w); v += p; }
                float s = e.apply(row, n0 + 16 * q + 4 * fq, v, rv);
                if constexpr (E::HAS_SS) { s += __shfl_xor(s, 16); s += __shfl_xor(s, 32); if (fq == 0) atomicAdd(e.ss + row, s); }
            }
        }
        __syncthreads();
    }
}

struct Args { const float* in[37]; float* out; unsigned char* ws; int ph_lo, ph_hi; };
enum { I_XP = 0, I_XS, I_S5RE, I_S5IM, I_LRUH, I_CONV, I_PP, I_PS, I_GMIX, I_WIN, I_LAMRE, I_LAMIM, I_LOGSTEP, I_BRE, I_BIM, I_CRE, I_CIM, I_S5D,
       I_WGLU, I_BGLU, I_CONVW, I_CONVB, I_WA, I_BA, I_WI, I_BI, I_LAM, I_GMA, I_GMB, I_WOUT, I_GMLP, I_WUP, I_WDOWN, I_GPLE, I_WGATE, I_WPLE, I_GFIN };

__device__ __forceinline__ void tr_item(const float* W, int K, int N, bf16_t* WT, int rbase, int lru, const float* g1, const float* g2, int gsplit,
                                        LAS float* scr, int item, int lane) {
    const int nblk = N / 32, kb = item / nblk, nb = item % nblk, k0 = 64 * kb, n0 = 32 * nb;
    f32x4 wv[8];
#pragma unroll
    for (int i = 0; i < 8; ++i) wv[i] = *(const f32x4*)(W + (size_t)(k0 + 8 * i + (lane >> 3)) * N + n0 + 4 * (lane & 7));
#pragma unroll
    for (int i = 0; i < 8; ++i) { const int kk = 8 * i + (lane >> 3), k = k0 + kk; const float gv = g1 ? (k < gsplit ? g1[k] : g2[k - gsplit]) : 1.f;
        LAS float* d = scr + kk * 33 + 4 * (lane & 7); d[0] = wv[i][0] * gv; d[1] = wv[i][1] * gv; d[2] = wv[i][2] * gv; d[3] = wv[i][3] * gv; }
    LDS_WAIT();
    const int c = lane & 7;
#pragma unroll
    for (int j = 0; j < 4; ++j) { const int n = (lane >> 3) + 8 * j, nn = n0 + n; const int drow = lru ? rbase + (nn >> 7) * 256 + (nn & 127) : rbase + nn;
        const LAS float* s = scr + (8 * c) * 33 + n;
        u32x4 o; o.x = cvt_pk_bf16(s[0 * 33], s[1 * 33]); o.y = cvt_pk_bf16(s[2 * 33], s[3 * 33]); o.z = cvt_pk_bf16(s[4 * 33], s[5 * 33]); o.w = cvt_pk_bf16(s[6 * 33], s[7 * 33]);
        *(u32x4*)(WT + (size_t)drow * K + k0 + 8 * c) = o; }
    LDS_WAIT();
}

__device__ __forceinline__ void phase0(const Args& a, LAS unsigned char* lds) {
    const int tid = threadIdx.x, wave = __builtin_amdgcn_readfirstlane(tid >> 6), lane = tid & 63, G = gridDim.x;
    unsigned char* ws = a.ws;
    LAS float* scr = (LAS float*)(lds + wave * 16384);
    const int gw = blockIdx.x * 8 + wave, NGW = G * 8;
    constexpr int I_IN = 32 * 96, I_GLU = 16 * 32, I_OUT = 32 * 64, I_UP = 32 * 256, I_DOWN = 128 * 64, I_GATE = 32 * 64, I_PLE = 4 * 64, I_LRU = 8 * 32;
    constexpr int NITEMS = I_IN + I_GLU + I_OUT + I_UP + I_DOWN + I_GATE + I_PLE + I_LRU;
    for (int it = gw; it < NITEMS; it += NGW) {
        int r = it;
        if (r < I_UP) { tr_item(a.in[I_WUP], DM, DFF, (bf16_t*)(ws + WS_WUP), 0, 0, a.in[I_GMLP], a.in[I_GMLP], 1 << 30, scr, r, lane); continue; } r -= I_UP;
        if (r < I_DOWN) { tr_item(a.in[I_WDOWN], DFF, DM, (bf16_t*)(ws + WS_WDOWN), 0, 0, nullptr, nullptr, 0, scr, r, lane); continue; } r -= I_DOWN;
        if (r < I_IN) { tr_item(a.in[I_WIN], DM, NZ, (bf16_t*)(ws + WS_WIN), 0, 0, a.in[I_GMIX], a.in[I_GMIX], 1 << 30, scr, r, lane); continue; } r -= I_IN;
        if (r < I_OUT) { tr_item(a.in[I_WOUT], DM, DM, (bf16_t*)(ws + WS_WOUT), 0, 0, a.in[I_GMA], a.in[I_GMB], DH, scr, r, lane); continue; } r -= I_OUT;
        if (r < I_GATE) { tr_item(a.in[I_WGATE], DM, DM, (bf16_t*)(ws + WS_WGATE), 0, 0, a.in[I_GPLE], a.in[I_GPLE], 1 << 30, scr, r, lane); continue; } r -= I_GATE;
        if (r < I_GLU) { tr_item(a.in[I_WGLU], DH, DH, (bf16_t*)(ws + WS_WGLU), 0, 0, nullptr, nullptr, 0, scr, r, lane); continue; } r -= I_GLU;
        if (r < I_PLE) { tr_item(a.in[I_WPLE], DPLE, DM, (bf16_t*)(ws + WS_WPLE), 0, 0, nullptr, nullptr, 0, scr, r, lane); continue; } r -= I_PLE;
        { const int mat = r >> 5, h = mat >> 1, bj = mat & 1;
          tr_item((bj ? a.in[I_WI] : a.in[I_WA]) + (size_t)h * 65536, 256, 256, (bf16_t*)(ws + WS_WLRU), h * 512 + bj * 128, 1, nullptr, nullptr, 0, scr, r & 31, lane); }
    }
    float* rs0 = (float*)(ws + WS_SMALL + SM_RS0); bf16_t* XB = (bf16_t*)(ws + WS_AB); bf16_t* PB = (bf16_t*)(ws + WS_PB);
    for (int row = gw; row < MT; row += NGW) {
        const float* xr = row < MP ? a.in[I_XP] + (size_t)row * DM : a.in[I_XS] + (size_t)(row - MP) * DM;
        f32x4 v[8]; float s = 0.f;
#pragma unroll
        for (int j = 0; j < 8; ++j) { v[j] = ((const f32x4*)xr)[lane + 64 * j]; s += ssq4(v[j]); }
        s = wave_sum(s); if (lane == 0) rs0[row] = rsqrtf(s * (1.f / DM) + EPS);
#pragma unroll
        for (int j = 0; j < 8; ++j) ((u32x2*)(XB + (size_t)row * DM))[lane + 64 * j] = pk4(v[j]);
        const float* pr = row < MP ? a.in[I_PP] + (size_t)row * DPLE : a.in[I_PS] + (size_t)(row - MP) * DPLE;
        ((u32x2*)(PB + (size_t)row * DPLE))[lane] = pk4(((const f32x4*)pr)[lane]);
    }
    { float* SPL = (float*)(ws + WS_SMALL + SM_SPL);
      for (int i = blockIdx.x * 512 + tid; i < DH; i += G * 512) { const float xl = -a.in[I_LAM][i]; SPL[i] = -8.f * (fmaxf(xl, 0.f) + log1pf(expf(-fabsf(xl)))); } }
    float* AR = (float*)(ws + WS_SMALL + SM_AR); float* AI = (float*)(ws + WS_SMALL + SM_AI); float* A64R = (float*)(ws + WS_SMALL + SM_A64R); float* A64I = (float*)(ws + WS_SMALL + SM_A64I);
    bf16_t* BBB = (bf16_t*)(ws + WS_SMALL + SM_BBB); bf16_t* CMB = (bf16_t*)(ws + WS_SMALL + SM_CMB);
    for (int i = blockIdx.x * 512 + tid; i < 4096; i += G * 512) {
        const int g = i >> 6, p = i & 63;
        const float step = expf(a.in[I_LOGSTEP][g]), lr = a.in[I_LAMRE][i], li = a.in[I_LAMIM][i];
        const float mag = expf(lr * step); float sn, cs; sincosf(li * step, &sn, &cs);
        const float ar = mag * cs, ai = mag * sn, nr = ar - 1.f, ni = ai, den = lr * lr + li * li;
        const float cr = (nr * lr + ni * li) / den, ci = (ni * lr - nr * li) / den;
        AR[i] = ar; AI[i] = ai;
        float pr_ = ar, pi_ = ai;
#pragma unroll
        for (int q = 0; q < 6; ++q) { const float t0 = pr_ * pr_ - pi_ * pi_, t1 = 2.f * pr_ * pi_; pr_ = t0; pi_ = t1; }
        A64R[i] = pr_; A64I[i] = pi_;
        for (int c = 0; c < 16; ++c) {
            const float br = a.in[I_BRE][(size_t)i * 16 + c], bi = a.in[I_BIM][(size_t)i * 16 + c];
            BBB[((size_t)g * 128 + p) * 16 + c] = (bf16_t)(cvt_pk_bf16(cr * br - ci * bi, 0.f) & 0xffffu);
            BBB[((size_t)g * 128 + 64 + p) * 16 + c] = (bf16_t)(cvt_pk_bf16(cr * bi + ci * br, 0.f) & 0xffffu);
            CMB[((size_t)g * 16 + c) * 128 + p] = (bf16_t)(cvt_pk_bf16(a.in[I_CRE][((size_t)g * 16 + c) * 64 + p], 0.f) & 0xffffu);
            CMB[((size_t)g * 16 + c) * 128 + 64 + p] = (bf16_t)(cvt_pk_bf16(-a.in[I_CIM][((size_t)g * 16 + c) * 64 + p], 0.f) & 0xffffu);
        }
    }
}

__device__ __forceinline__ void s5_unit(const Args& a, LAS unsigned char* wl, int lane, int mode, int n, int g, int j) {
    unsigned char* ws = a.ws;
    const int fr = lane & 15, fq = lane >> 4;
    const float* AR = (const float*)(ws + WS_SMALL + SM_AR); const float* AI = (const float*)(ws + WS_SMALL + SM_AI);
    const bf16_t* BBB = (const bf16_t*)(ws + WS_SMALL + SM_BBB); const bf16_t* CMB = (const bf16_t*)(ws + WS_SMALL + SM_CMB);
    const bf16_t* Z = (const bf16_t*)(ws + WS_Z); bf16_t* YG = (bf16_t*)(ws + WS_YG); float* SUM = (float*)(ws + WS_S5SUM);
    LAS float* BuS = (LAS float*)wl; LAS bf16_t* Hs = (LAS bf16_t*)(wl + 8448);
    const float ar = AR[g * 64 + lane], ai = AI[g * 64 + lane];
    const bf16x8 zero8 = (bf16x8){0, 0, 0, 0, 0, 0, 0, 0};
    bf16x8 bb[8];
#pragma unroll
    for (int t = 0; t < 8; ++t) bb[t] = fq < 2 ? *(const bf16x8*)(BBB + ((size_t)g * 128 + 16 * t + fr) * 16 + 8 * fq) : zero8;
    bf16x8 cm[4];
#pragma unroll
    for (int kk = 0; kk < 4; ++kk) cm[kk] = *(const bf16x8*)(CMB + ((size_t)g * 16 + fr) * 128 + 32 * kk + 8 * fq);
    const f32x4 dsk = *(const f32x4*)(a.in[I_S5D] + 16 * g + 4 * fq);
    float hr = 0.f, hi = 0.f;
    if (mode == 1 && j > 0) {
        const float pr = ((const float*)(ws + WS_SMALL + SM_A64R))[g * 64 + lane], pi = ((const float*)(ws + WS_SMALL + SM_A64I))[g * 64 + lane];
        const float* sp = SUM + ((size_t)(n * 64 + g) * 32) * 128;
        for (int i = 0; i < j; ++i) { const float sr = sp[i * 128 + lane], si = sp[i * 128 + 64 + lane];
            const float t0 = pr * hr - pi * hi + sr, t1 = pr * hi + pi * hr + si; hr = t0; hi = t1; }
    }
    if (mode == 4 && j > 0) {
        float pr = ((const float*)(ws + WS_SMALL + SM_A64R))[g * 64 + lane], pi = ((const float*)(ws + WS_SMALL + SM_A64I))[g * 64 + lane];
#pragma unroll
        for (int q = 0; q < 2; ++q) { const float t0 = pr * pr - pi * pi, t1 = 2.f * pr * pi; pr = t0; pi = t1; }
        for (int v = 0; v < j; ++v) { const LAS float* ps = (const LAS float*)(wl + (v - j) * 16384 + 12800); const float sr = ps[lane], si = ps[64 + lane];
            const float t0 = pr * hr - pi * hi + sr, t1 = pr * hi + pi * hr + si; hr = t0; hi = t1; }
    }
    const int row0 = mode == 2 ? MP + 16 * j : ((mode == 3 || mode == 4) ? n * SEQ + 256 * j : n * SEQ + 64 * j);
    const int nblk = mode == 2 ? 1 : ((mode == 3 || mode == 1 || mode == 4) ? 16 : 4);
    for (int blk = 0; blk < nblk; ++blk) {
        const int r0 = row0 + 16 * blk;
        const bf16x8 ua = fq < 2 ? *(const bf16x8*)(Z + (size_t)(r0 + fr) * NZ + 16 * g + 8 * fq) : zero8;
        u32x2 u4raw = (u32x2){0u, 0u}; if (mode == 1 || mode == 2 || mode == 4) u4raw = *(const u32x2*)(Z + (size_t)(r0 + fr) * NZ + 16 * g + 4 * fq);
#pragma unroll
        for (int t = 0; t < 8; ++t) {
            const f32x4 c = __builtin_amdgcn_mfma_f32_16x16x32_bf16(ua, bb[t], (f32x4){0.f, 0.f, 0.f, 0.f}, 0, 0, 0);
#pragma unroll
            for (int jj = 0; jj < 4; ++jj) BuS[(4 * fq + jj) * 132 + 16 * t + fr] = c[jj];
        }
        LDS_WAIT();
        float burv[16], buiv[16];
#pragma unroll
        for (int t = 0; t < 16; ++t) { burv[t] = BuS[t * 132 + lane]; buiv[t] = BuS[t * 132 + 64 + lane]; }
#pragma unroll
        for (int t = 0; t < 16; ++t) {
            const float bur = burv[t], bui = buiv[t];
            if (mode == 2) { const size_t si = ((size_t)(r0 - MP + t) * 64 + g) * 64 + lane; hr = a.in[I_S5RE][si]; hi = a.in[I_S5IM][si]; }
            const float t0 = ar * hr - ai * hi + bur, t1 = ar * hi + ai * hr + bui; hr = t0; hi = t1;
            if (mode == 2) { const size_t si = ((size_t)(r0 - MP + t) * 64 + g) * 64 + lane; a.out[O_S5RS + si] = hr; a.out[O_S5IS + si] = hi; }
            if (mode == 1 || mode == 2 || mode == 4) { const unsigned w = cvt_pk_bf16(hr, hi); Hs[t * 136 + lane] = (bf16_t)(w & 0xffffu); Hs[t * 136 + 64 + lane] = (bf16_t)(w >> 16); }
        }
        if (mode == 1 || mode == 2 || mode == 4) {
            LDS_WAIT();
            f32x4 y = (f32x4){0.f, 0.f, 0.f, 0.f};
#pragma unroll
            for (int kk = 0; kk < 4; ++kk) { const bf16x8 hb = *(const LAS bf16x8*)(Hs + fr * 136 + 32 * kk + 8 * fq);
                y = __builtin_amdgcn_mfma_f32_16x16x32_bf16(cm[kk], hb, y, 0, 0, 0); }
            const f32x4 u4 = up4(u4raw); f32x4 o;
#pragma unroll
            for (int jj = 0; jj < 4; ++jj) o[jj] = gelu_t(y[jj] + dsk[jj] * u4[jj]);
            *(u32x2*)(YG + (size_t)(r0 + fr) * DH + 16 * g + 4 * fq) = pk4(o);
            LDS_WAIT();
        }
    }
    if (mode == 0) { float* sp = SUM + ((size_t)(n * 64 + g) * 32 + j) * 128; sp[lane] = hr; sp[64 + lane] = hi; }
    if (mode == 3) { LAS float* ps = (LAS float*)(wl + 12800); ps[lane] = hr; ps[64 + lane] = hi; }
    if (mode == 4 && j == 7) { a.out[O_S5RP + (size_t)(n * 64 + g) * 64 + lane] = hr; a.out[O_S5IP + (size_t)(n * 64 + g) * 64 + lane] = hi; }
}

__device__ __forceinline__ void conv_prompt(const Args& a) {
    unsigned char* ws = a.ws; const bf16_t* Z = (const bf16_t*)(ws + WS_Z); bf16_t* XC = (bf16_t*)(ws + WS_XC);
    const float* cw = a.in[I_CONVW]; const float* cb = a.in[I_CONVB];
    const int G = gridDim.x;
    for (int it = blockIdx.x * 512 + threadIdx.x; it < MP * 128; it += G * 512) {
        const int row = it >> 7, c = (it & 127) * 8, t = row & (SEQ - 1);
        float acc[8];
#pragma unroll
        for (int q = 0; q < 8; ++q) acc[q] = cb[c + q];
#pragma unroll
        for (int k = 0; k < 4; ++k) {
            if (t - 3 + k >= 0) {
                const u32x4 z = *(const u32x4*)(Z + (size_t)(row - 3 + k) * NZ + DH + c);
                const float x[8] = {bf_lo(z.x), bf_hi(z.x), bf_lo(z.y), bf_hi(z.y), bf_lo(z.z), bf_hi(z.z), bf_lo(z.w), bf_hi(z.w)};
#pragma unroll
                for (int q = 0; q < 8; ++q) acc[q] += cw[k * DH + c + q] * x[q];
                if (k == 3 && t >= SEQ - 3) {
                    float* o = a.out + O_CONVP + ((size_t)(row >> 11) * 3 + (t - (SEQ - 3))) * DH + c;
#pragma unroll
                    for (int q = 0; q < 8; ++q) o[q] = x[q];
                }
            }
        }
        u32x4 o; o.x = cvt_pk_bf16(acc[0], acc[1]); o.y = cvt_pk_bf16(acc[2], acc[3]); o.z = cvt_pk_bf16(acc[4], acc[5]); o.w = cvt_pk_bf16(acc[6], acc[7]);
        *(u32x4*)(XC + (size_t)row * DH + c) = o;
    }
}

__device__ __forceinline__ void conv_tile(const Args& a, int pm, int h) {
    unsigned char* ws = a.ws; const bf16_t* Z = (const bf16_t*)(ws + WS_Z); bf16_t* XC = (bf16_t*)(ws + WS_XC);
    const int tid = threadIdx.x, c = h * 256 + (tid & 31) * 8;
    float cwv[4][8], cbv[8];
#pragma unroll
    for (int q = 0; q < 8; ++q) { cbv[q] = a.in[I_CONVB][c + q];
#pragma unroll
        for (int k = 0; k < 4; ++k) cwv[k][q] = a.in[I_CONVW][k * DH + c + q]; }
#pragma unroll 1
    for (int r4 = 0; r4 < 16; r4 += 4) {
        u32x4 z[4][4];
#pragma unroll
        for (int rr = 0; rr < 4; ++rr) { const int row = pm * 256 + (tid >> 5) + 16 * (r4 + rr), t = row & (SEQ - 1);
#pragma unroll
            for (int k = 0; k < 4; ++k) z[rr][k] = (t - 3 + k >= 0) ? *(const u32x4*)(Z + (size_t)(row - 3 + k) * NZ + DH + c) : (u32x4){0u, 0u, 0u, 0u}; }
#pragma unroll
        for (int rr = 0; rr < 4; ++rr) { const int row = pm * 256 + (tid >> 5) + 16 * (r4 + rr), t = row & (SEQ - 1);
            float acc[8];
#pragma unroll
            for (int q = 0; q < 8; ++q) acc[q] = cbv[q];
#pragma unroll
            for (int k = 0; k < 4; ++k) { const u32x4 zz = z[rr][k];
                const float x[8] = {bf_lo(zz.x), bf_hi(zz.x), bf_lo(zz.y), bf_hi(zz.y), bf_lo(zz.z), bf_hi(zz.z), bf_lo(zz.w), bf_hi(zz.w)};
#pragma unroll
                for (int q = 0; q < 8; ++q) acc[q] += cwv[k][q] * x[q];
                if (k == 3 && t >= SEQ - 3) { float* o = a.out + O_CONVP + ((size_t)(row >> 11) * 3 + (t - (SEQ - 3))) * DH + c;
#pragma unroll
                    for (int q = 0; q < 8; ++q) o[q] = x[q]; } }
            u32x4 o; o.x = cvt_pk_bf16(acc[0], acc[1]); o.y = cvt_pk_bf16(acc[2], acc[3]); o.z = cvt_pk_bf16(acc[4], acc[5]); o.w = cvt_pk_bf16(acc[6], acc[7]);
            *(u32x4*)(XC + (size_t)row * DH + c) = o; }
    }
}

__device__ __forceinline__ void lru_sample(const Args& a, LAS unsigned char* lds, int unit) {
    unsigned char* ws = a.ws; const bf16_t* Z = (const bf16_t*)(ws + WS_Z); bf16_t* MG = (bf16_t*)(ws + WS_MERGED); float* ssB = (float*)(ws + WS_CTL) + SS_B * SS_STRIDE;
    LAS float* sxc = (LAS float*)lds;
    const int tid = threadIdx.x, s = unit >> 1, half = unit & 1, row = MP + s;
    const float* cw = a.in[I_CONVW]; const float* cs = a.in[I_CONV] + (size_t)s * 3 * DH;
    for (int c = tid; c < DH; c += 512) {
        const float xb = bf1(Z[(size_t)row * NZ + DH + c]);
        sxc[c] = a.in[I_CONVB][c] + cw[c] * cs[c] + cw[DH + c] * cs[DH + c] + cw[2 * DH + c] * cs[2 * DH + c] + cw[3 * DH + c] * xb;
        if ((c >> 9) == half) { float* o = a.out + O_CONVS + (size_t)s * 3 * DH; o[c] = cs[DH + c]; o[DH + c] = cs[2 * DH + c]; o[2 * DH + c] = xb; }
    }
    __syncthreads();
    float sq = 0.f;
    {
        const int c = half * 512 + tid, h = c >> 8, jj = c & 255;
        const float* wa = a.in[I_WA] + (size_t)h * 65536 + jj; const float* wi = a.in[I_WI] + (size_t)h * 65536 + jj;
        float ra = a.in[I_BA][c], ri = a.in[I_BI][c];
#pragma unroll 1
        for (int k0 = 0; k0 < 256; k0 += 32) {
            float wav[32], wiv[32];
#pragma unroll
            for (int q = 0; q < 32; ++q) { wav[q] = wa[(size_t)(k0 + q) * 256]; wiv[q] = wi[(size_t)(k0 + q) * 256]; }
#pragma unroll
            for (int q = 0; q < 32; ++q) { const float x = sxc[h * 256 + k0 + q]; ra += x * wav[q]; ri += x * wiv[q]; }
        }
        const float r = sigm(ra), ig = sigm(ri); const float xl = -a.in[I_LAM][c]; const float sp = fmaxf(xl, 0.f) + log1pf(expf(-fabsf(xl)));
        const float la = -8.f * r * sp, av = expf(la), bv = sqrtf(-expm1f(2.f * la)) * ig * sxc[c];
        const float hn = av * a.in[I_LRUH][(size_t)s * DH + c] + bv;
        a.out[O_LRUS + (size_t)s * DH + c] = hn;
        const float o = hn * gelu_t(bf1(Z[(size_t)row * NZ + 2 * DH + c]));
        MG[(size_t)row * DM + DH + c] = (bf16_t)(cvt_pk_bf16(o, 0.f) & 0xffffu);
        sq = o * o;
    }
    sq = wave_sum(sq);
    if ((tid & 63) == 0) atomicAdd(ssB + row, sq);
    __syncthreads();
}

__device__ __forceinline__ void lru_scan_unit(const Args& a, LAS unsigned char* lds, int unit) {
    unsigned char* ws = a.ws; const bf16_t* Z = (const bf16_t*)(ws + WS_Z); bf16_t* MG = (bf16_t*)(ws + WS_MERGED); float* ssB = (float*)(ws + WS_CTL) + SS_B * SS_STRIDE;
    const float* Ao = a.out; const float* Bo = a.out + (size_t)MP * DH;
    LAS float* sP = (LAS float*)lds; LAS float* sH = sP + 512; LAS float* rsum = sH + 512;
    const int tid = threadIdx.x, n = unit >> 6, ch = (unit & 63) * 16 + (tid & 15), j = tid >> 4;
    const size_t r0 = (size_t)n * SEQ + 64 * j;
    float P = 1.f, h = 0.f;
#pragma unroll 1
    for (int tb = 0; tb < 64; tb += 16) {
        float av[16], bv[16];
#pragma unroll
        for (int q = 0; q < 16; ++q) { av[q] = Ao[(r0 + tb + q) * DH + ch]; bv[q] = Bo[(r0 + tb + q) * DH + ch]; }
#pragma unroll
        for (int q = 0; q < 16; ++q) { h = av[q] * h + bv[q]; P *= av[q]; }
    }
    sP[tid] = P; sH[tid] = h;
    __syncthreads();
    float H = 0.f;
    for (int i = 0; i < j; ++i) H = sP[i * 16 + (tid & 15)] * H + sH[i * 16 + (tid & 15)];
    h = H;
#pragma unroll 1
    for (int tb = 0; tb < 64; tb += 16) {
        float av[16], bv[16]; bf16_t gz[16];
#pragma unroll
        for (int q = 0; q < 16; ++q) { const size_t row = r0 + tb + q; av[q] = Ao[row * DH + ch]; bv[q] = Bo[row * DH + ch]; gz[q] = Z[row * NZ + 2 * DH + ch]; }
#pragma unroll
        for (int q = 0; q < 16; ++q) {
            const size_t row = r0 + tb + q;
            h = av[q] * h + bv[q];
            const float o = h * gelu_t(bf1(gz[q]));
            MG[row * DM + DH + ch] = (bf16_t)(cvt_pk_bf16(o, 0.f) & 0xffffu);
            float s = o * o; s += __shfl_xor(s, 1); s += __shfl_xor(s, 2); s += __shfl_xor(s, 4); s += __shfl_xor(s, 8);
            if ((tid & 15) == 0) rsum[64 * j + tb + q] = s;
        }
    }
    __syncthreads();
    for (int r = tid; r < SEQ; r += 512) atomicAdd(ssB + (size_t)n * SEQ + r, rsum[r]);
    if (j == 31) a.out[O_LRUP + (size_t)n * DH + ch] = h;
    __syncthreads();
}

#define XB_TMO      128
#define XB_XCNT(j)  (256  + 64 * (j))
#define XB_XSUB(j)  (1280 + 64 * (j))
#define XB_XGEN(j)  (2304 + 64 * (j))
#define XB_TOP      3328
#define XB_TOPGEN   3392
#define XB_SPIN_CAP (1u << 18)
__device__ __forceinline__ unsigned xb_ld(unsigned* p)              { return __hip_atomic_load(p, __ATOMIC_RELAXED, __HIP_MEMORY_SCOPE_AGENT); }
__device__ __forceinline__ unsigned xb_add(unsigned* p, unsigned v) { return __hip_atomic_fetch_add(p, v, __ATOMIC_RELAXED, __HIP_MEMORY_SCOPE_AGENT); }
__device__ __forceinline__ unsigned xb_xcc_id() { return (unsigned)__builtin_amdgcn_s_getreg((3 << 11) | 20) & 0xFu; }
#define XB_SPIN(cond, bar) do { unsigned _sp = 0; while (cond) { __builtin_amdgcn_s_sleep(1); \
    if ((++_sp & 255u) == 0u) { if (xb_ld(&(bar)[XB_TMO])) break; if (_sp > XB_SPIN_CAP) { atomicAdd(&(bar)[XB_TMO], 1u); break; } } } } while (0)
struct XcdBarrier { unsigned* bar; unsigned x; volatile LAS unsigned* st; };
__device__ __forceinline__ XcdBarrier xcd_barrier_post(unsigned* bar, volatile LAS unsigned* st) {
    XcdBarrier b; b.bar = bar; b.x = xb_xcc_id(); b.st = st;
    if (threadIdx.x == 0) (void)xb_add(&bar[XB_XCNT(b.x)], 1u);
    return b;
}
__device__ __forceinline__ void xcd_barrier_complete(unsigned* bar, unsigned x, unsigned& nloc, unsigned& nx) {
    const unsigned G = gridDim.x * gridDim.y * gridDim.z;
    unsigned sum, cnt, mine, sp = 0u;
    for (;;) {
        sum = 0u; cnt = 0u; mine = 0u;
#pragma unroll
        for (unsigned j = 0; j < 16; ++j) { const unsigned c = xb_ld(&bar[XB_XCNT(j)]); sum += c; cnt += (c > 0u) ? 1u : 0u; mine = (j == x) ? c : mine; }
        if (sum == G) break;
        __builtin_amdgcn_s_sleep(1);
        if ((++sp & 255u) == 0u) { if (xb_ld(&bar[XB_TMO])) break; if (sp > XB_SPIN_CAP) { atomicAdd(&bar[XB_TMO], 1u); break; } }
    }
    nloc = mine > 0u ? mine : 1u; nx = cnt > 0u ? cnt : 1u;
}
__device__ __forceinline__ void xcd_barrier(const XcdBarrier& b) {
    asm volatile("s_waitcnt vmcnt(0)" ::: "memory");
    __syncthreads();
    if (threadIdx.x == 0) {
        unsigned* bar = b.bar;
        __builtin_amdgcn_s_waitcnt(0);
        unsigned nloc = b.st[0], nx = b.st[1];
        if (nloc == 0u) { xcd_barrier_complete(bar, b.x, nloc, nx); b.st[0] = nloc; b.st[1] = nx; }
        const unsigned old = xb_add(&bar[XB_XSUB(b.x)], 1u);
        const unsigned gen = old / nloc;
        if (old + 1u == (gen + 1u) * nloc) {
            __builtin_amdgcn_fence(__ATOMIC_RELEASE, "agent");
            asm volatile("s_waitcnt vmcnt(0)" ::: "memory");
            const unsigned og = xb_add(&bar[XB_TOP], 1u);
            const unsigned tg = og / nx;
            if (og + 1u == (tg + 1u) * nx) xb_add(&bar[XB_TOPGEN], 1u);
            else XB_SPIN(xb_ld(&bar[XB_TOPGEN]) == tg, bar);
            __builtin_amdgcn_fence(__ATOMIC_ACQUIRE, "agent");
            xb_add(&bar[XB_XGEN(b.x)], 1u);
            asm volatile("s_waitcnt vmcnt(0)" ::: "memory");
        } else {
            XB_SPIN(xb_ld(&bar[XB_XGEN(b.x)]) == gen, bar);
            __builtin_amdgcn_fence(__ATOMIC_ACQUIRE, "agent");
            asm volatile("s_waitcnt vmcnt(0)" ::: "memory");
        }
    }
    __syncthreads();
}

__global__ void __launch_bounds__(512, 2) fwd_kernel(Args a) {
    extern __shared__ __attribute__((aligned(16))) unsigned char lds_raw[];
    LAS unsigned char* lds = (LAS unsigned char*)lds_raw;
    const int tid = threadIdx.x, wave = __builtin_amdgcn_readfirstlane(tid >> 6), lane = tid & 63, G = gridDim.x;
    unsigned char* ws = a.ws;
    const int lo = a.ph_lo, hi = a.ph_hi;
    volatile LAS unsigned* MISC = (volatile LAS unsigned*)(lds + MISC_OFF);
    for (int u = tid; u < (LDS_BYTES - RING_BYTES) / 4; u += 512) ((LAS unsigned*)(lds + RING_BYTES))[u] = 0u;
    __syncthreads();
#if MK_LAUNCHES == 1
    XcdBarrier bar = xcd_barrier_post((unsigned*)(ws + WS_CTL) + CW_BAR, MISC + 8);
#define GRID_BAR() xcd_barrier(bar)
#else
#define GRID_BAR() do {} while (0)
#endif
#define IN(k) (lo <= (k) && (k) < hi)
#define BOTH(k) (IN(k) && IN((k) + 1))
#define ssb ((float*)(ws + WS_CTL))
#define AB ((bf16_t*)(ws + WS_AB))
#define Z ((bf16_t*)(ws + WS_Z))
#define YG ((bf16_t*)(ws + WS_YG))
#define MG ((bf16_t*)(ws + WS_MERGED))
#define HUP ((bf16_t*)(ws + WS_HUP))
#define PW ((bf16_t*)(ws + WS_PW))
#define PB ((bf16_t*)(ws + WS_PB))
#define XO (a.out + O_Y)

    if (IN(0)) { phase0(a, lds); if (BOTH(0)) GRID_BAR(); }

    if (IN(1)) {
        pg8::Gemm g{AB, (const bf16_t*)(ws + WS_WIN), DM, DM, DM, 0}; pg8::StaticOrder S; S.init(MP / 256, NZ / 256, G, (int)blockIdx.x);
        EpiWrap<EIn> E{{nullptr, (const float*)(ws + WS_SMALL + SM_RS0), Z}};
        pg8::gemm_phase<EpiWrap<EIn>, true>(lds, g, S, E);
        skinny_gemm<EIn, 8, 2>(lds, AB + (size_t)MP * DM, DM, (const bf16_t*)(ws + WS_WIN), DM, NZ, DM, E.e, G / 2);
        if (BOTH(1)) GRID_BAR();
    }

    if (IN(3)) {
        pg8::Gemm g{(const bf16_t*)(ws + WS_XC), (const bf16_t*)(ws + WS_WLRU), DH, 256, 256, 1}; pg8::StaticOrder S; S.init(MP / 256, 8, G, (int)blockIdx.x);
        { pg8::Unit cu; for (int i = 0; S.next(i, cu); ++i) conv_tile(a, cu.pm, cu.pn >> 1); }
        asm volatile("s_waitcnt vmcnt(0)" ::: "memory"); __syncthreads();
        ELru E{(const bf16_t*)(ws + WS_XC), a.in[I_BA], a.in[I_BI], (const float*)(ws + WS_SMALL + SM_SPL), a.out, a.out + (size_t)MP * DH};
        pg8::gemm_phase<ELru, true>(lds, g, S, E);
        for (int s = G - 1 - (int)blockIdx.x; s < 2 * MS; s += G) lru_sample(a, lds, s);
        for (int u = blockIdx.x; u < NB * 64; u += G) {
            const int n = u >> 6, g2 = u & 63;
            s5_unit(a, lds + wave * 16384, lane, 3, n, g2, wave);
            __syncthreads();
            s5_unit(a, lds + wave * 16384, lane, 4, n, g2, wave);
            __syncthreads();
        }
        for (int u = blockIdx.x * 8 + wave; u < 512; u += G * 8) s5_unit(a, lds + wave * 16384, lane, 2, 0, u >> 3, u & 7);
        if (BOTH(3)) GRID_BAR();
    }

    if (IN(4)) {
        pg8::Gemm g{YG, (const bf16_t*)(ws + WS_WGLU), DH, DH, DH, 0}; pg8::StaticOrder S; S.init(MP / 256, DH / 256, G, (int)blockIdx.x);
        EpiWrap<EGlu> E{{ssb + SS_A * SS_STRIDE, a.in[I_BGLU], YG, MG}};
        pg8::gemm_phase<EpiWrap<EGlu>, true>(lds, g, S, E);
        skinny_gemm<EGlu, 4>(lds, YG + (size_t)MP * DH, DH, (const bf16_t*)(ws + WS_WGLU), DH, DH, DH, E.e);
        for (int u = G - 1 - (int)blockIdx.x; u < NB * 64; u += G) lru_scan_unit(a, lds, u);
        if (BOTH(4)) GRID_BAR();
    }

    if (IN(5)) {
        pg8::Gemm g{MG, (const bf16_t*)(ws + WS_WOUT), DM, DM, DM, 0}; pg8::StaticOrder S; S.init(MP / 256, DM / 256, G, (int)blockIdx.x);
        { float* RAT = (float*)(ws + WS_SMALL + SM_RAT); float* RSB = (float*)(ws + WS_SMALL + SM_RSB);
          pg8::Unit cu;
          for (int ui = -1; ui < 0 || S.next(ui, cu); ++ui)
              for (int i = tid; i < (ui < 0 ? MS : 256); i += 512) { const int row = ui < 0 ? MP + i : cu.pm * 256 + i;
                  const float va = ssb[SS_A * SS_STRIDE + row] * (1.f / DH) + EPS, vb = ssb[SS_B * SS_STRIDE + row] * (1.f / DH) + EPS; RAT[row] = sqrtf(vb / va); RSB[row] = rsqrtf(vb); }
          asm volatile("s_waitcnt vmcnt(0)" ::: "memory"); __syncthreads(); }
        EpiWrap<EOut> E{{ssb + SS_1 * SS_STRIDE, (const float*)(ws + WS_SMALL + SM_RAT), (const float*)(ws + WS_SMALL + SM_RSB), a.in[I_XP], a.in[I_XS], XO, AB}};
        pg8::gemm_phase<EpiWrap<EOut>, true>(lds, g, S, E);
        skinny_gemm<EOut, 4>(lds, MG + (size_t)MP * DM, DM, (const bf16_t*)(ws + WS_WOUT), DM, DM, DM, E.e);
        if (BOTH(5)) GRID_BAR();
    }

    if (IN(6)) {
        pg8::Gemm g{AB, (const bf16_t*)(ws + WS_WUP), DM, DM, DM, 0}; pg8::StaticOrder S; S.init(MP / 256, DFF / 256, G, (int)blockIdx.x);
        EpiWrap<EUp> E{{nullptr, ssb + SS_1 * SS_STRIDE, HUP}};
        pg8::gemm_phase<EpiWrap<EUp>, true>(lds, g, S, E);
        skinny_gemm<EUp, 8, 2>(lds, AB + (size_t)MP * DM, DM, (const bf16_t*)(ws + WS_WUP), DM, DFF, DM, E.e);
        if (BOTH(6)) GRID_BAR();
    }

    if (IN(7)) {
        pg8::Gemm g{HUP, (const bf16_t*)(ws + WS_WDOWN), DFF, DFF, DFF, 0}; pg8::StaticOrder S; S.init(MP / 256, DM / 256, G, (int)blockIdx.x);
        EpiWrap<EDown> E{{ssb + SS_2 * SS_STRIDE, XO, AB}};
        pg8::gemm_phase<EpiWrap<EDown>, true>(lds, g, S, E);
        skinny_gemm<EDown, 4>(lds, HUP + (size_t)MP * DFF, DFF, (const bf16_t*)(ws + WS_WDOWN), DFF, DM, DFF, E.e);
        if (BOTH(7)) GRID_BAR();
    }

    if (IN(8)) {
        { pg8::Gemm g{PB, (const bf16_t*)(ws + WS_WPLE), DPLE, DPLE, DPLE, 0}; pg8::StaticOrder S; S.init(MP / 256, DM / 256, G, (int)blockIdx.x);
          EpiWrap<EPw> E{{nullptr, PW}};
          pg8::gemm_phase<EpiWrap<EPw>, true>(lds, g, S, E);
          skinny_gemm<EPw, 4>(lds, PB + (size_t)MP * DPLE, DPLE, (const bf16_t*)(ws + WS_WPLE), DPLE, DM, DPLE, E.e); }
        asm volatile("s_waitcnt vmcnt(0)" ::: "memory"); __syncthreads();
        { pg8::Gemm g{AB, (const bf16_t*)(ws + WS_WGATE), DM, DM, DM, 0}; pg8::StaticOrder S; S.init(MP / 256, DM / 256, G, (int)blockIdx.x);
          EpiWrap<EGate> E{{ssb + SS_3 * SS_STRIDE, ssb + SS_2 * SS_STRIDE, PW, XO}};
          pg8::gemm_phase<EpiWrap<EGate>, true>(lds, g, S, E);
          skinny_gemm<EGate, 4>(lds, AB + (size_t)MP * DM, DM, (const bf16_t*)(ws + WS_WGATE), DM, DM, DM, E.e); }
        if (BOTH(8)) GRID_BAR();
    }

    if (IN(9)) {
        const float* ss3 = ssb + SS_3 * SS_STRIDE; const float* gf = a.in[I_GFIN];
        f32x4 gv[8];
#pragma unroll
        for (int j = 0; j < 8; ++j) gv[j] = ((const f32x4*)gf)[lane + 64 * j];
        for (int row = blockIdx.x * 8 + wave; row < MT; row += 2 * G * 8) {
            const int row2 = row + G * 8; const bool has2 = row2 < MT; const int r2 = has2 ? row2 : row;
            f32x4* xa = (f32x4*)(XO + (size_t)row * DM); f32x4* xb2 = (f32x4*)(XO + (size_t)r2 * DM);
            f32x4 va[8], vb[8];
#pragma unroll
            for (int j = 0; j < 8; ++j) { va[j] = xa[lane + 64 * j]; vb[j] = xb2[lane + 64 * j]; }
            const float rsa = rsqrtf(ss3[row] * (1.f / DM) + EPS), rsb2 = rsqrtf(ss3[r2] * (1.f / DM) + EPS);
#pragma unroll
            for (int j = 0; j < 8; ++j) xa[lane + 64 * j] = va[j] * rsa * gv[j];
            if (has2) {
#pragma unroll
                for (int j = 0; j < 8; ++j) xb2[lane + 64 * j] = vb[j] * rsb2 * gv[j];
            }
        }
    }
#if MK_LAUNCHES == 1
    if (lo > hi) cg::this_grid().sync();
#endif
}

#undef ssb
#undef AB
#undef Z
#undef YG
#undef MG
#undef HUP
#undef PW
#undef PB
#undef XO
extern "C" void kernel_launch(void* const* d_in, const int* in_sizes, int n_in, void* d_out, int out_size, void* d_ws, size_t ws_size, hipStream_t stream) {
    static int grid = 0;
    if (grid == 0) {
        int dev = 0, cus = 0;
        if (n_in != 37 || ws_size < WS_END) { fprintf(stderr, "kernel_launch: unexpected inputs (n_in %d, ws %zu)\n", n_in, ws_size); grid = -1; return; }
        if (hipGetDevice(&dev) != hipSuccess || hipDeviceGetAttribute(&cus, hipDeviceAttributeMultiprocessorCount, dev) != hipSuccess) { grid = -1; return; }
        if (hipFuncSetAttribute((const void*)fwd_kernel, hipFuncAttributeMaxDynamicSharedMemorySize, LDS_BYTES) != hipSuccess) { fprintf(stderr, "kernel_launch: hipFuncSetAttribute failed\n"); grid = -1; return; }
        int per_cu = 0;
        if (hipOccupancyMaxActiveBlocksPerMultiprocessor(&per_cu, (const void*)fwd_kernel, 512, LDS_BYTES) != hipSuccess || per_cu < 1) { fprintf(stderr, "kernel_launch: occupancy query %d\n", per_cu); }
        (void)hipGetLastError();
        grid = cus;
    }
    if (grid < 0) return;
    (void)hipMemsetAsync((char*)d_ws + WS_CTL, 0, CTL_ZERO_BYTES, stream);
    Args a{};
    for (int i = 0; i < 37; ++i) a.in[i] = (const float*)d_in[i];
    a.out = (float*)d_out; a.ws = (unsigned char*)d_ws;
#if MK_LAUNCHES == 1
    a.ph_lo = 0; a.ph_hi = NPHASE;
    void* args[] = {&a};
    hipError_t e = hipLaunchCooperativeKernel((const void*)fwd_kernel, dim3(grid), dim3(512), args, LDS_BYTES, stream);
    if (e != hipSuccess) fprintf(stderr, "cooperative launch failed: %s (grid %d)\n", hipGetErrorString(e), grid);
#else
    for (int ph = 0; ph < NPHASE; ++ph) {
        a.ph_lo = ph; a.ph_hi = ph + 1;
        hipLaunchKernelGGL(fwd_kernel, dim3(grid), dim3(512), LDS_BYTES, stream, a);
    }
#endif
}
```

```cpp
#include <hip/hip_runtime.h>
#include <hip/hip_cooperative_groups.h>
#include <cstdio>
#include <cstdint>
namespace cg = cooperative_groups;

#ifndef MK_LAUNCHES
#define MK_LAUNCHES 1
#endif

#define LAS __attribute__((address_space(3)))
typedef unsigned short bf16_t;
typedef short bf16x8 __attribute__((ext_vector_type(8)));
typedef float f32x4 __attribute__((ext_vector_type(4)));
typedef unsigned u32x4 __attribute__((ext_vector_type(4)));
typedef unsigned u32x2 __attribute__((ext_vector_type(2)));

constexpr int DM = 2048, SEQ = 2048, NB = 4, MP = 8192, MS = 128, MT = 8320;
constexpr int NZ = 3072, DFF = 8192, DPLE = 256, DH = 1024;
constexpr float EPS = 1e-6f;
constexpr int NPHASE = 10;

constexpr size_t MiB = 1u << 20;
constexpr size_t WS_CTL = 0, CTL_ZERO_BYTES = 1 * MiB;
constexpr int SS_STRIDE = 8448;
constexpr int SS_A = 0, SS_B = 1, SS_1 = 2, SS_2 = 3, SS_3 = 4;
constexpr int CW_BAR = 65536;
constexpr size_t WS_SMALL = 1 * MiB;
constexpr size_t SM_RS0 = 0, SM_AR = 65536, SM_AI = SM_AR + 16384, SM_A64R = SM_AI + 16384, SM_A64I = SM_A64R + 16384,
                 SM_BBB = SM_A64I + 16384  , SM_CMB = SM_BBB + 262144  , SM_SPL = SM_CMB + 262144  , SM_RAT = 663552  , SM_RSB = SM_RAT + 34816  ;
constexpr size_t WS_WUP = 2 * MiB, WS_WDOWN = 34 * MiB, WS_WGATE = 66 * MiB, WS_WPLE = 74 * MiB, WS_PB = 75 * MiB, WS_AB = 80 * MiB;
constexpr size_t WS_E = 113 * MiB;
constexpr size_t WS_HUP = WS_E, WS_PW = WS_E;
constexpr size_t WS_WIN = 113 * MiB, WS_WGLU = 125 * MiB, WS_WOUT = 127 * MiB, WS_WLRU = 135 * MiB, WS_Z = 136 * MiB,
                 WS_YG = 185 * MiB, WS_MERGED = 202 * MiB, WS_XC = 235 * MiB, WS_S5SUM = 251 * MiB, WS_END = 255 * MiB;
static_assert(WS_HUP + (size_t)MT * DFF * 2 <= 256 * MiB, "hup fits");
static_assert(WS_Z + (size_t)MT * NZ * 2 <= WS_YG && WS_YG + (size_t)MT * DH * 2 <= WS_MERGED && WS_MERGED + (size_t)MT * DM * 2 <= WS_XC, "map");
static_assert(WS_AB + (size_t)MT * DM * 2 <= WS_E && WS_PB + (size_t)MT * DPLE * 2 <= WS_AB, "map2");

constexpr size_t O_Y = 0, O_S5RP = 17039360, O_S5IP = 17055744, O_LRUP = 17072128, O_CONVP = 17076224,
                 O_S5RS = 17088512, O_S5IS = 17612800, O_LRUS = 18137088, O_CONVS = 18268160;

constexpr int RING_BYTES = 131072, MISC_OFF = RING_BYTES + 320, LDS_BYTES = 147456;

__device__ __forceinline__ unsigned cvt_pk_bf16(float lo, float hi) { unsigned r; asm("v_cvt_pk_bf16_f32 %0, %1, %2" : "=v"(r) : "v"(lo), "v"(hi)); return r; }
__device__ __forceinline__ float bf_lo(unsigned u) { return __uint_as_float(u << 16); }
__device__ __forceinline__ float bf_hi(unsigned u) { return __uint_as_float(u & 0xffff0000u); }
__device__ __forceinline__ float bf1(bf16_t u) { return __uint_as_float(((unsigned)u) << 16); }
__device__ __forceinline__ float sigm(float x) { return __builtin_amdgcn_rcpf(1.f + __expf(-x)); }
__device__ __forceinline__ float gelu_t(float x) { const float u = 1.5957691216057308f * (x + 0.044715f * x * x * x); return x * __builtin_amdgcn_rcpf(1.f + __expf(-u)); }
__device__ __forceinline__ float wave_sum(float v) {
#pragma unroll
    for (int o = 1; o < 64; o <<= 1) v += __shfl_xor(v, o);
    return v;
}
#define LDS_WAIT() asm volatile("s_waitcnt lgkmcnt(0)" ::: "memory")

namespace pg8 {
constexpr int BM = 256, BK = 64, HALF = 128, HTB = HALF * BK * 2, STAGE_BYTES = 8 * HTB, NXCD = 8, WGM = 8;
__host__ __device__ __forceinline__ int lds_byte(int r, int c) { const int st = (r >> 4) * 2 + (c >> 5), rr = r & 15, cc = c & 31, ob = rr * 64 + cc * 2; return st * 1024 + (ob ^ (((ob >> 9) & 1) << 5)); }
__host__ __device__ __forceinline__ void stage_rc(int b, int& R, int& C) { const int st = b / 1024, sb = b % 1024, swz = sb ^ (((sb >> 9) & 1) << 5); R = (st >> 1) * 16 + swz / 64; C = (st & 1) * 32 + (swz % 64) / 2; }
struct Unit { int pm, pn; };
struct Gemm { const bf16_t* A; const bf16_t* Bt; int lda, ldb, K, akmode; };
struct StaticOrder {
    int nM, nN, nwg, G, c;
    __device__ __forceinline__ void init(int nM_, int nN_, int G_, int c_) { nM = nM_; nN = nN_; nwg = nM * nN; G = G_; c = c_; }
    __device__ __forceinline__ bool next(int i, Unit& u) const {
        const long L = (long)i * G + c; if (L >= nwg) return false;
        int wgid = (int)L; { const int q = nwg / NXCD, r = nwg % NXCD, xcd = wgid % NXCD, off = wgid / NXCD; wgid = (xcd < r ? xcd * (q + 1) : r * (q + 1) + (xcd - r) * q) + off; }
        const int nig = WGM * nN, gid = wgid / nig, fm = gid * WGM, gsz = (nM - fm) < WGM ? (nM - fm) : WGM;
        u.pm = fm + ((wgid % nig) % gsz); u.pn = (wgid % nig) / gsz; return true;
    }
};

template <class Epi, bool ALIGN_EPI>
__device__ __forceinline__ void gemm_phase(LAS unsigned char* lds, const Gemm g, const StaticOrder& S, const Epi& E) {
    const int tid = threadIdx.x, wid = __builtin_amdgcn_readfirstlane(tid >> 6), lane = tid & 63, wr = wid >> 2, wc = wid & 3, fr = lane & 15, fq = lane >> 4;
    int K = g.K; asm volatile("" : "+s"(K));
    const int nt = K / BK;
    unsigned voffA[2], voffB[2];
#pragma unroll
    for (int i = 0; i < 2; ++i) { int R, C; stage_rc(tid * 16 + i * 8192, R, C);
        voffA[i] = (unsigned)(R * g.lda + C) * 2u; voffB[i] = (unsigned)(R * g.ldb + C) * 2u; }
    const size_t kstep = (size_t)(BK * 2);
    const size_t hstepA = (size_t)HALF * g.lda * 2, hstepB = (size_t)HALF * g.ldb * 2;
    const size_t tstepA = 2 * hstepA, tstepB = 2 * hstepB;
    const unsigned ldsw = (unsigned)wid * 1024u;
    const int aoff = lds_byte(wr * 64 + fr, fq * 8), boff = lds_byte(wc * 32 + fr, fq * 8);
#define PG8_SA(b, h) (((b) * 2 + (h)) * HTB)
#define PG8_SB(b, h) ((4 + (b) * 2 + (h)) * HTB)
#define PG8_STAGE(bufoff, gbase, voff) do { _Pragma("unroll") for (int _i = 0; _i < 2; ++_i) \
        __builtin_amdgcn_global_load_lds((const unsigned*)((const char*)(gbase) + (voff)[_i]), (LAS unsigned*)(lds + (bufoff) + ldsw + _i * 8192), 16, 0, 0); } while (0)
#define PG8_LDA(dst, b, h) do { _Pragma("unroll") for (int m = 0; m < 4; ++m) _Pragma("unroll") for (int k = 0; k < 2; ++k) dst[m][k] = *(const LAS bf16x8*)(lds + PG8_SA(b, h) + aoff + m * 2048 + k * 1024); } while (0)
#define PG8_LDB(dst, b, h) do { _Pragma("unroll") for (int n = 0; n < 2; ++n) _Pragma("unroll") for (int k = 0; k < 2; ++k) dst[n][k] = *(const LAS bf16x8*)(lds + PG8_SB(b, h) + boff + n * 2048 + k * 1024); } while (0)
#define PG8_MMA(ai, bj, At, Bt) do { __builtin_amdgcn_s_setprio(1); _Pragma("unroll") for (int m = 0; m < 4; ++m) _Pragma("unroll") for (int n = 0; n < 2; ++n) _Pragma("unroll") for (int k = 0; k < 2; ++k) \
        acc[ai][bj][m][n] = __builtin_amdgcn_mfma_f32_16x16x32_bf16(Bt[n][k], At[m][k], acc[ai][bj][m][n], 0, 0, 0); __builtin_amdgcn_s_setprio(0); } while (0)
#define PG8_WAIT_V(n) asm volatile("s_waitcnt vmcnt(" #n ")" ::: "memory")
#define PG8_WAIT_L(n) asm volatile("s_waitcnt lgkmcnt(" #n ")" ::: "memory")
#define PG8_BAR __builtin_amdgcn_s_barrier()
#define PG8_SCHED __builtin_amdgcn_sched_barrier(0)
    Unit cur, nxt; int ui = 0;
    if (!S.next(0, cur)) return;
    f32x4 acc[2][2][4][2];
#pragma unroll
    for (int a = 0; a < 2; ++a)
#pragma unroll
        for (int b = 0; b < 2; ++b)
#pragma unroll
            for (int m = 0; m < 4; ++m)
#pragma unroll
                for (int n = 0; n < 2; ++n) acc[a][b][m][n] = (f32x4){0.f, 0.f, 0.f, 0.f};
    bf16x8 At[4][2], B0[2][2], B1[2][2];
    const char* cA = (const char*)g.A + (size_t)cur.pm * tstepA + (g.akmode ? (size_t)(cur.pn >> 1) * 512 : 0);
    const char* cB = (const char*)g.Bt + (size_t)cur.pn * tstepB;
    PG8_STAGE(PG8_SB(0, 0), cB, voffB); PG8_STAGE(PG8_SB(0, 1), cB + hstepB, voffB); PG8_STAGE(PG8_SA(0, 0), cA, voffA); PG8_STAGE(PG8_SA(0, 1), cA + hstepA, voffA);
    if (wr == 1) PG8_BAR;
    PG8_WAIT_V(2); PG8_BAR;
    PG8_STAGE(PG8_SB(1, 0), cB + kstep, voffB); PG8_STAGE(PG8_SA(1, 0), cA + kstep, voffA); PG8_STAGE(PG8_SB(1, 1), cB + hstepB + kstep, voffB);
    PG8_WAIT_V(6); PG8_BAR;
    for (;;) {
        const bool has_next = S.next(ui + 1, nxt);
        const char* nA = has_next ? (const char*)g.A + (size_t)nxt.pm * tstepA + (g.akmode ? (size_t)(nxt.pn >> 1) * 512 : 0) : cA;
        const char* nB = has_next ? (const char*)g.Bt + (size_t)nxt.pn * tstepB : cB;
        for (int t = 0; t < nt; t += 2) {
            const bool last = (t == nt - 2);
            const char* a1 = cA + (size_t)(t + 1) * kstep;
            const char* a2 = last ? nA : cA + (size_t)(t + 2) * kstep; const char* b2 = last ? nB : cB + (size_t)(t + 2) * kstep;
            const char* a3 = a2 + kstep; const char* b3 = b2 + kstep;
            if constexpr (Epi::MID) { if (t == (nt >> 1)) E.mid(acc, cur, wr, fr); }
            PG8_LDB(B0, 0, 0); PG8_LDB(B1, 0, 1); PG8_SCHED; PG8_LDA(At, 0, 0); PG8_STAGE(PG8_SA(1, 1), a1 + hstepA, voffA);
            PG8_WAIT_V(8); PG8_WAIT_L(0); PG8_BAR; PG8_MMA(0, 0, At, B0); PG8_MMA(0, 1, At, B1); PG8_BAR; PG8_SCHED;
            PG8_LDA(At, 0, 1); PG8_STAGE(PG8_SB(0, 0), b2, voffB); PG8_STAGE(PG8_SB(0, 1), b2 + hstepB, voffB); PG8_STAGE(PG8_SA(0, 0), a2, voffA);
            PG8_WAIT_V(8); PG8_WAIT_L(0); PG8_BAR; PG8_MMA(1, 0, At, B0); PG8_MMA(1, 1, At, B1); PG8_BAR; PG8_SCHED;
            PG8_LDB(B0, 1, 0); PG8_LDB(B1, 1, 1); PG8_SCHED; PG8_LDA(At, 1, 0); PG8_STAGE(PG8_SA(0, 1), a2 + hstepA, voffA);
            PG8_WAIT_V(8); PG8_WAIT_L(0); PG8_BAR; PG8_MMA(0, 0, At, B0); PG8_MMA(0, 1, At, B1); PG8_BAR; PG8_SCHED;
            PG8_LDA(At, 1, 1); PG8_STAGE(PG8_SB(1, 0), b3, voffB); PG8_STAGE(PG8_SB(1, 1), b3 + hstepB, voffB); PG8_STAGE(PG8_SA(1, 0), a3, voffA);
            PG8_WAIT_V(8); PG8_WAIT_L(0); PG8_BAR; PG8_MMA(1, 0, At, B0); PG8_MMA(1, 1, At, B1); PG8_BAR; PG8_SCHED;
        }
        if constexpr (ALIGN_EPI) { if (wr == 0) PG8_BAR; }
        E(acc, cur, wr, wc, fr, fq);
        if (!has_next) break;
#pragma unroll
        for (int a = 0; a < 2; ++a)
#pragma unroll
            for (int b = 0; b < 2; ++b)
#pragma unroll
                for (int m = 0; m < 4; ++m)
#pragma unroll
                    for (int n = 0; n < 2; ++n) acc[a][b][m][n] = (f32x4){0.f, 0.f, 0.f, 0.f};
        cur = nxt; cA = nA; cB = nB; ++ui;
        if constexpr (ALIGN_EPI) { if (wr == 1) PG8_BAR; }
    }
    PG8_WAIT_V(0);
    if constexpr (!ALIGN_EPI) { if (wr == 0) PG8_BAR; }
    PG8_BAR;
#undef PG8_SA
#undef PG8_SB
#undef PG8_STAGE
#undef PG8_LDA
#undef PG8_LDB
#undef PG8_MMA
#undef PG8_WAIT_V
#undef PG8_WAIT_L
#undef PG8_BAR
#undef PG8_SCHED
}
}

template <class E> struct EpiWrap {
    E e; static constexpr bool MID = E::MID;
    __device__ __forceinline__ void operator()(const f32x4 (&acc)[2][2][4][2], const pg8::Unit& u, int wr, int wc, int fr, int fq) const {
        if constexpr (E::HAS_RES) {
            f32x4 rc[2][2], rn[2][2];
            { const int row = u.pm * 256 + wr * 64 + fr;
#pragma unroll
              for (int bj = 0; bj < 2; ++bj)
#pragma unroll
                  for (int n = 0; n < 2; ++n) rc[bj][n] = e.res(row, u.pn * 256 + bj * 128 + wc * 32 + n * 16 + 4 * fq); }
#pragma unroll
            for (int idx = 0; idx < 8; ++idx) {
                const int ai = idx >> 2, m = idx & 3;
                const int row = u.pm * 256 + ai * 128 + wr * 64 + m * 16 + fr; const float rv = e.rowval(row); float s = 0.f;
                if (idx < 7) { const int rown = u.pm * 256 + ((idx + 1) >> 2) * 128 + wr * 64 + ((idx + 1) & 3) * 16 + fr;
#pragma unroll
                    for (int bj = 0; bj < 2; ++bj)
#pragma unroll
                        for (int n = 0; n < 2; ++n) rn[bj][n] = e.res(rown, u.pn * 256 + bj * 128 + wc * 32 + n * 16 + 4 * fq); }
#pragma unroll
                for (int bj = 0; bj < 2; ++bj)
#pragma unroll
                    for (int n = 0; n < 2; ++n) s += e.applyr(row, u.pn * 256 + bj * 128 + wc * 32 + n * 16 + 4 * fq, acc[ai][bj][m][n], rv, rc[bj][n]);
                if constexpr (E::HAS_SS) { s += __shfl_xor(s, 16); s += __shfl_xor(s, 32); if (fq == 0) atomicAdd(e.ss + row, s); }
                asm volatile("" ::: "memory");
#pragma unroll
                for (int bj = 0; bj < 2; ++bj)
#pragma unroll
                    for (int n = 0; n < 2; ++n) rc[bj][n] = rn[bj][n];
            }
            return;
        }
#pragma unroll
        for (int ai = 0; ai < 2; ++ai)
#pragma unroll
            for (int m = 0; m < 4; ++m) {
                const int row = u.pm * 256 + ai * 128 + wr * 64 + m * 16 + fr; const float rv = e.rowval(row); float s = 0.f;
#pragma unroll
                for (int bj = 0; bj < 2; ++bj)
#pragma unroll
                    for (int n = 0; n < 2; ++n) s += e.apply(row, u.pn * 256 + bj * 128 + wc * 32 + n * 16 + 4 * fq, acc[ai][bj][m][n], rv);
                if constexpr (E::HAS_SS) { s += __shfl_xor(s, 16); s += __shfl_xor(s, 32); if (fq == 0) atomicAdd(e.ss + row, s); }
                asm volatile("" ::: "memory");
            }
    }
    __device__ __forceinline__ void mid(f32x4 (&acc)[2][2][4][2], const pg8::Unit& u, int wr, int fr) const {
#pragma unroll
        for (int ai = 0; ai < 2; ++ai)
#pragma unroll
            for (int m = 0; m < 4; ++m) { const float r = e.kscale(u.pm * 256 + ai * 128 + wr * 64 + m * 16 + fr, 0);
#pragma unroll
                for (int bj = 0; bj < 2; ++bj)
#pragma unroll
                    for (int n = 0; n < 2; ++n) acc[ai][bj][m][n] = acc[ai][bj][m][n] * r; }
    }
};
__device__ __forceinline__ u32x2 pk4(f32x4 v) { u32x2 w; w.x = cvt_pk_bf16(v[0], v[1]); w.y = cvt_pk_bf16(v[2], v[3]); return w; }
__device__ __forceinline__ f32x4 up4(u32x2 w) { return (f32x4){bf_lo(w.x), bf_hi(w.x), bf_lo(w.y), bf_hi(w.y)}; }
__device__ __forceinline__ float ssq4(f32x4 v) { return (v[0] * v[0] + v[1] * v[1]) + (v[2] * v[2] + v[3] * v[3]); }

struct EIn {
    static constexpr bool HAS_RES = false; static constexpr bool MID = false, HAS_SS = false; float* ss; const float* rs0; bf16_t* Z;
    __device__ __forceinline__ float rowval(int row) const { return rs0[row]; }
    __device__ __forceinline__ float kscale(int, int) const { return 1.f; }
    __device__ __forceinline__ float apply(int row, int col, f32x4 v, float rv) const { *(u32x2*)(Z + (size_t)row * NZ + col) = pk4(v * rv); return 0.f; }
};
struct EGlu {
    static constexpr bool HAS_RES = false; static constexpr bool MID = false, HAS_SS = true; float* ss; const float* bglu; const bf16_t* YG; bf16_t* MG;
    __device__ __forceinline__ float rowval(int) const { return 0.f; }
    __device__ __forceinline__ float kscale(int, int) const { return 1.f; }
    __device__ __forceinline__ float apply(int row, int col, f32x4 v, float) const {
        const f32x4 b = *(const f32x4*)(bglu + col); const f32x4 yg = up4(*(const u32x2*)(YG + (size_t)row * DH + col)); f32x4 o;
#pragma unroll
        for (int j = 0; j < 4; ++j) o[j] = yg[j] * sigm(v[j] + b[j]);
        *(u32x2*)(MG + (size_t)row * DM + col) = pk4(o); return ssq4(o);
    }
};
struct EOut {
    static constexpr bool MID = true, HAS_SS = true; float* ss; const float* rat; const float* rsb; const float* xp; const float* xs; float* XO; bf16_t* AB;
    __device__ __forceinline__ float rowval(int row) const { return rsb[row]; }
    __device__ __forceinline__ float kscale(int row, int w) const { return w < 4 ? rat[row] : 1.f; }
    static constexpr bool HAS_RES = true;
    __device__ __forceinline__ f32x4 res(int row, int col) const { return *(const f32x4*)(xp + (size_t)row * DM + col); }
    __device__ __forceinline__ float applyr(int row, int col, f32x4 v, float rv, f32x4 r) const {
        const f32x4 o = r + v * rv;
        *(f32x4*)(XO + (size_t)row * DM + col) = o; *(u32x2*)(AB + (size_t)row * DM + col) = pk4(o); return ssq4(o); }
    __device__ __forceinline__ float apply(int row, int col, f32x4 v, float rv) const {
        const float* xr = row < MP ? xp + (size_t)row * DM : xs + (size_t)(row - MP) * DM;
        const f32x4 o = *(const f32x4*)(xr + col) + v * rv;
        *(f32x4*)(XO + (size_t)row * DM + col) = o; *(u32x2*)(AB + (size_t)row * DM + col) = pk4(o); return ssq4(o);
    }
};
struct EUp {
    static constexpr bool HAS_RES = false; static constexpr bool MID = false, HAS_SS = false; float* ss; const float* ss1; bf16_t* HUP;
    __device__ __forceinline__ float rowval(int row) const { return rsqrtf(ss1[row] * (1.f / DM) + EPS); }
    __device__ __forceinline__ float kscale(int, int) const { return 1.f; }
    __device__ __forceinline__ float apply(int row, int col, f32x4 v, float rv) const { f32x4 o;
#pragma unroll
        for (int j = 0; j < 4; ++j) { const float r = fmaxf(v[j] * rv, 0.f); o[j] = r * r; }
        *(u32x2*)(HUP + (size_t)row * DFF + col) = pk4(o); return 0.f; }
};
struct EDown {
    static constexpr bool MID = false, HAS_SS = true; float* ss; float* XO; bf16_t* AB;
    __device__ __forceinline__ float rowval(int) const { return 0.f; }
    __device__ __forceinline__ float kscale(int, int) const { return 1.f; }
    static constexpr bool HAS_RES = true;
    __device__ __forceinline__ f32x4 res(int row, int col) const { return *(const f32x4*)(XO + (size_t)row * DM + col); }
    __device__ __forceinline__ float applyr(int row, int col, f32x4 v, float, f32x4 r) const {
        const f32x4 o = r + v; *(f32x4*)(XO + (size_t)row * DM + col) = o; *(u32x2*)(AB + (size_t)row * DM + col) = pk4(o); return ssq4(o); }
    __device__ __forceinline__ float apply(int row, int col, f32x4 v, float) const {
        float* p = XO + (size_t)row * DM + col; const f32x4 o = *(const f32x4*)p + v; *(f32x4*)p = o; *(u32x2*)(AB + (size_t)row * DM + col) = pk4(o); return ssq4(o); }
};
struct EPw {
    static constexpr bool HAS_RES = false; static constexpr bool MID = false, HAS_SS = false; float* ss; bf16_t* PW;
    __device__ __forceinline__ float rowval(int) const { return 0.f; }
    __device__ __forceinline__ float kscale(int, int) const { return 1.f; }
    __device__ __forceinline__ float apply(int row, int col, f32x4 v, float) const { *(u32x2*)(PW + (size_t)row * DM + col) = pk4(v); return 0.f; }
};
struct EGate {
    static constexpr bool MID = false, HAS_SS = true; float* ss; const float* ss2; const bf16_t* PW; float* XO;
    __device__ __forceinline__ float rowval(int row) const { return rsqrtf(ss2[row] * (1.f / DM) + EPS); }
    __device__ __forceinline__ float kscale(int, int) const { return 1.f; }
    static constexpr bool HAS_RES = true;
    __device__ __forceinline__ f32x4 res(int row, int col) const { return *(const f32x4*)(XO + (size_t)row * DM + col); }
    __device__ __forceinline__ float applyr(int row, int col, f32x4 v, float rv, f32x4 r) const {
        f32x4 o = r; const f32x4 pw = up4(*(const u32x2*)(PW + (size_t)row * DM + col));
#pragma unroll
        for (int j = 0; j < 4; ++j) o[j] += pw[j] * sigm(v[j] * rv);
        *(f32x4*)(XO + (size_t)row * DM + col) = o; return ssq4(o); }
    __device__ __forceinline__ float apply(int row, int col, f32x4 v, float rv) const {
        float* p = XO + (size_t)row * DM + col; f32x4 o = *(const f32x4*)p; const f32x4 pw = up4(*(const u32x2*)(PW + (size_t)row * DM + col));
#pragma unroll
        for (int j = 0; j < 4; ++j) o[j] += pw[j] * sigm(v[j] * rv);
        *(f32x4*)p = o; return ssq4(o); }
};
__device__ __forceinline__ float em1(float x) {
    float p = x * (1.f + x * (0.5f + x * (0.16666667f + x * (0.041666668f + x * (0.0083333338f + x * (0.0013888889f + x * 0.0001984127f))))));
    if (__builtin_expect(__any(fabsf(x) >= 0.5f), 0)) p = fabsf(x) < 0.5f ? p : __expf(x) - 1.f;
    return p;
}
struct ELru {
    static constexpr bool MID = false; const bf16_t* XC; const float* ba; const float* bi; const float* spl; float* Ao; float* Bo;
    __device__ __forceinline__ void mid(f32x4 (&)[2][2][4][2], const pg8::Unit&, int, int) const {}
    __device__ __forceinline__ void operator()(const f32x4 (&acc)[2][2][4][2], const pg8::Unit& u, int wr, int wc, int fr, int fq) const {
#pragma unroll
        for (int n = 0; n < 2; ++n) {
            const int ch = (u.pn >> 1) * 256 + (u.pn & 1) * 128 + wc * 32 + n * 16 + 4 * fq;
            const f32x4 bav = *(const f32x4*)(ba + ch), biv = *(const f32x4*)(bi + ch), sp = *(const f32x4*)(spl + ch);
#pragma unroll
            for (int ai = 0; ai < 2; ++ai)
#pragma unroll
                for (int m = 0; m < 4; ++m) {
                    const int row = u.pm * 256 + ai * 128 + wr * 64 + m * 16 + fr;
                    const f32x4 xc = up4(*(const u32x2*)(XC + (size_t)row * DH + ch)); f32x4 av, bv;
#pragma unroll
                    for (int j = 0; j < 4; ++j) { const float r = sigm(acc[ai][0][m][n][j] + bav[j]), ig = sigm(acc[ai][1][m][n][j] + biv[j]);
                        const float la = r * sp[j]; av[j] = 1.f + em1(la); bv[j] = __builtin_amdgcn_sqrtf(fmaxf(-em1(2.f * la), 0.f)) * ig * xc[j]; }
                    *(f32x4*)(Ao + (size_t)row * DH + ch) = av; *(f32x4*)(Bo + (size_t)row * DH + ch) = bv;
                    asm volatile("" ::: "memory");
                }
        }
    }
};

template <class E, int MT = 8, int NG = 1>
__device__ __forceinline__ void skinny_gemm(LAS unsigned char* lds, const bf16_t* A, int lda, const bf16_t* Bt, int ldb, int N, int K, const E& e, int nb = 0) {
    const int tid = threadIdx.x, wid = __builtin_amdgcn_readfirstlane(tid >> 6), lane = tid & 63, fr = lane & 15, fq = lane >> 4;
    LAS f32x4* red = (LAS f32x4*)lds;
    constexpr int NH = 8 / MT;
    const int kw = K >> 3, k0w = wid * kw, nks = kw >> 5, nit = ((N >> 4) / NG) * NH, G = gridDim.x, NBk = nb ? nb : G;
    for (int iti = G - 1 - (int)blockIdx.x; iti < nit && (G - 1 - (int)blockIdx.x) < NBk; iti += NBk) {
        const int n0 = (iti / NH) * (16 * NG), r0 = (iti % NH) * (MT * 16);
        f32x4 acc[NG][MT];
#pragma unroll
        for (int q = 0; q < NG; ++q)
#pragma unroll
            for (int m = 0; m < MT; ++m) acc[q][m] = (f32x4){0.f, 0.f, 0.f, 0.f};
        const bf16_t* bp = Bt + (size_t)(n0 + fr) * ldb + k0w + 8 * fq;
        const bf16_t* ap = A + (size_t)(r0 + fr) * lda + k0w + 8 * fq;
        {
            bf16x8 bc[NG], ac[MT];
#pragma unroll
            for (int q = 0; q < NG; ++q) bc[q] = *(const bf16x8*)(bp + (size_t)(16 * q) * ldb);
#pragma unroll
            for (int m = 0; m < MT; ++m) ac[m] = *(const bf16x8*)(ap + (size_t)(16 * m) * lda);
            for (int ks = 0; ks < nks; ++ks) {
                const int kn = ks + 1 < nks ? ks + 1 : ks;
                bf16x8 bn[NG], an[MT];
#pragma unroll
                for (int q = 0; q < NG; ++q) bn[q] = *(const bf16x8*)(bp + (size_t)(16 * q) * ldb + 32 * kn);
#pragma unroll
                for (int m = 0; m < MT; ++m) an[m] = *(const bf16x8*)(ap + (size_t)(16 * m) * lda + 32 * kn);
#pragma unroll
                for (int q = 0; q < NG; ++q)
#pragma unroll
                    for (int m = 0; m < MT; ++m) acc[q][m] = __builtin_amdgcn_mfma_f32_16x16x32_bf16(bc[q], ac[m], acc[q][m], 0, 0, 0);
#pragma unroll
                for (int q = 0; q < NG; ++q) bc[q] = bn[q];
#pragma unroll
                for (int m = 0; m < MT; ++m) ac[m] = an[m];
            }
        }
#pragma unroll
        for (int q = 0; q < NG; ++q)
#pragma unroll
            for (int m = 0; m < MT; ++m) red[((wid * NG + q) * MT + m) * 64 + lane] = acc[q][m];
        __syncthreads();
        if (wid < MT) {
            const int row = MP + r0 + 16 * wid + fr; const float rv = e.rowval(row);
#pragma unroll
            for (int q = 0; q < NG; ++q) {
                f32x4 v = (f32x4){0.f, 0.f, 0.f, 0.f};
#pragma unroll
                for (int w = 0; w < 8; ++w) { f32x4 p = red[((w * NG + q) * MT + wid) * 64 + lane]; if constexpr (E::MID) p = p * e.kscale(row, w); v += p; }
                float s = e.apply(row, n0 + 16 * q + 4 * fq, v, rv);
                if constexpr (E::HAS_SS) { s += __shfl_xor(s, 16); s += __shfl_xor(s, 32); if (fq == 0) atomicAdd(e.ss + row, s); }
            }
        }
        __syncthreads();
    }
}

struct Args { const float* in[37]; float* out; unsigned char* ws; int ph_lo, ph_hi; };
enum { I_XP = 0, I_XS, I_S5RE, I_S5IM, I_LRUH, I_CONV, I_PP, I_PS, I_GMIX, I_WIN, I_LAMRE, I_LAMIM, I_LOGSTEP, I_BRE, I_BIM, I_CRE, I_CIM, I_S5D,
       I_WGLU, I_BGLU, I_CONVW, I_CONVB, I_WA, I_BA, I_WI, I_BI, I_LAM, I_GMA, I_GMB, I_WOUT, I_GMLP, I_WUP, I_WDOWN, I_GPLE, I_WGATE, I_WPLE, I_GFIN };

__device__ __forceinline__ void tr_item(const float* W, int K, int N, bf16_t* WT, int rbase, int lru, const float* g1, const float* g2, int gsplit,
                                        LAS float* scr, int item, int lane) {
    const int nblk = N / 32, kb = item / nblk, nb = item % nblk, k0 = 64 * kb, n0 = 32 * nb;
    f32x4 wv[8];
#pragma unroll
    for (int i = 0; i < 8; ++i) wv[i] = *(const f32x4*)(W + (size_t)(k0 + 8 * i + (lane >> 3)) * N + n0 + 4 * (lane & 7));
#pragma unroll
    for (int i = 0; i < 8; ++i) { const int kk = 8 * i + (lane >> 3), k = k0 + kk; const float gv = g1 ? (k < gsplit ? g1[k] : g2[k - gsplit]) : 1.f;
        LAS float* d = scr + kk * 33 + 4 * (lane & 7); d[0] = wv[i][0] * gv; d[1] = wv[i][1] * gv; d[2] = wv[i][2] * gv; d[3] = wv[i][3] * gv; }
    LDS_WAIT();
    const int c = lane & 7;
#pragma unroll
    for (int j = 0; j < 4; ++j) { const int n = (lane >> 3) + 8 * j, nn = n0 + n; const int drow = lru ? rbase + (nn >> 7) * 256 + (nn & 127) : rbase + nn;
        const LAS float* s = scr + (8 * c) * 33 + n;
        u32x4 o; o.x = cvt_pk_bf16(s[0 * 33], s[1 * 33]); o.y = cvt_pk_bf16(s[2 * 33], s[3 * 33]); o.z = cvt_pk_bf16(s[4 * 33], s[5 * 33]); o.w = cvt_pk_bf16(s[6 * 33], s[7 * 33]);
        *(u32x4*)(WT + (size_t)drow * K + k0 + 8 * c) = o; }
    LDS_WAIT();
}

__device__ __forceinline__ void phase0(const Args& a, LAS unsigned char* lds) {
    const int tid = threadIdx.x, wave = __builtin_amdgcn_readfirstlane(tid >> 6), lane = tid & 63, G = gridDim.x;
    unsigned char* ws = a.ws;
    LAS float* scr = (LAS float*)(lds + wave * 16384);
    const int gw = blockIdx.x * 8 + wave, NGW = G * 8;
    constexpr int I_IN = 32 * 96, I_GLU = 16 * 32, I_OUT = 32 * 64, I_UP = 32 * 256, I_DOWN = 128 * 64, I_GATE = 32 * 64, I_PLE = 4 * 64, I_LRU = 8 * 32;
    constexpr int NITEMS = I_IN + I_GLU + I_OUT + I_UP + I_DOWN + I_GATE + I_PLE + I_LRU;
    for (int it = gw; it < NITEMS; it += NGW) {
        int r = it;
        if (r < I_UP) { tr_item(a.in[I_WUP], DM, DFF, (bf16_t*)(ws + WS_WUP), 0, 0, a.in[I_GMLP], a.in[I_GMLP], 1 << 30, scr, r, lane); continue; } r -= I_UP;
        if (r < I_DOWN) { tr_item(a.in[I_WDOWN], DFF, DM, (bf16_t*)(ws + WS_WDOWN), 0, 0, nullptr, nullptr, 0, scr, r, lane); continue; } r -= I_DOWN;
        if (r < I_IN) { tr_item(a.in[I_WIN], DM, NZ, (bf16_t*)(ws + WS_WIN), 0, 0, a.in[I_GMIX], a.in[I_GMIX], 1 << 30, scr, r, lane); continue; } r -= I_IN;
        if (r < I_OUT) { tr_item(a.in[I_WOUT], DM, DM, (bf16_t*)(ws + WS_WOUT), 0, 0, a.in[I_GMA], a.in[I_GMB], DH, scr, r, lane); continue; } r -= I_OUT;
        if (r < I_GATE) { tr_item(a.in[I_WGATE], DM, DM, (bf16_t*)(ws + WS_WGATE), 0, 0, a.in[I_GPLE], a.in[I_GPLE], 1 << 30, scr, r, lane); continue; } r -= I_GATE;
        if (r < I_GLU) { tr_item(a.in[I_WGLU], DH, DH, (bf16_t*)(ws + WS_WGLU), 0, 0, nullptr, nullptr, 0, scr, r, lane); continue; } r -= I_GLU;
        if (r < I_PLE) { tr_item(a.in[I_WPLE], DPLE, DM, (bf16_t*)(ws + WS_WPLE), 0, 0, nullptr, nullptr, 0, scr, r, lane); continue; } r -= I_PLE;
        { const int mat = r >> 5, h = mat >> 1, bj = mat & 1;
          tr_item((bj ? a.in[I_WI] : a.in[I_WA]) + (size_t)h * 65536, 256, 256, (bf16_t*)(ws + WS_WLRU), h * 512 + bj * 128, 1, nullptr, nullptr, 0, scr, r & 31, lane); }
    }
    float* rs0 = (float*)(ws + WS_SMALL + SM_RS0); bf16_t* XB = (bf16_t*)(ws + WS_AB); bf16_t* PB = (bf16_t*)(ws + WS_PB);
    for (int row = gw; row < MT; row += NGW) {
        const float* xr = row < MP ? a.in[I_XP] + (size_t)row * DM : a.in[I_XS] + (size_t)(row - MP) * DM;
        f32x4 v[8]; float s = 0.f;
#pragma unroll
        for (int j = 0; j < 8; ++j) { v[j] = ((const f32x4*)xr)[lane + 64 * j]; s += ssq4(v[j]); }
        s = wave_sum(s); if (lane == 0) rs0[row] = rsqrtf(s * (1.f / DM) + EPS);
#pragma unroll
        for (int j = 0; j < 8; ++j) ((u32x2*)(XB + (size_t)row * DM))[lane + 64 * j] = pk4(v[j]);
        const float* pr = row < MP ? a.in[I_PP] + (size_t)row * DPLE : a.in[I_PS] + (size_t)(row - MP) * DPLE;
        ((u32x2*)(PB + (size_t)row * DPLE))[lane] = pk4(((const f32x4*)pr)[lane]);
    }
    { float* SPL = (float*)(ws + WS_SMALL + SM_SPL);
      for (int i = blockIdx.x * 512 + tid; i < DH; i += G * 512) { const float xl = -a.in[I_LAM][i]; SPL[i] = -8.f * (fmaxf(xl, 0.f) + log1pf(expf(-fabsf(xl)))); } }
    float* AR = (float*)(ws + WS_SMALL + SM_AR); float* AI = (float*)(ws + WS_SMALL + SM_AI); float* A64R = (float*)(ws + WS_SMALL + SM_A64R); float* A64I = (float*)(ws + WS_SMALL + SM_A64I);
    bf16_t* BBB = (bf16_t*)(ws + WS_SMALL + SM_BBB); bf16_t* CMB = (bf16_t*)(ws + WS_SMALL + SM_CMB);
    for (int i = blockIdx.x * 512 + tid; i < 4096; i += G * 512) {
        const int g = i >> 6, p = i & 63;
        const float step = expf(a.in[I_LOGSTEP][g]), lr = a.in[I_LAMRE][i], li = a.in[I_LAMIM][i];
        const float mag = expf(lr * step); float sn, cs; sincosf(li * step, &sn, &cs);
        const float ar = mag * cs, ai = mag * sn, nr = ar - 1.f, ni = ai, den = lr * lr + li * li;
        const float cr = (nr * lr + ni * li) / den, ci = (ni * lr - nr * li) / den;
        AR[i] = ar; AI[i] = ai;
        float pr_ = ar, pi_ = ai;
#pragma unroll
        for (int q = 0; q < 6; ++q) { const float t0 = pr_ * pr_ - pi_ * pi_, t1 = 2.f * pr_ * pi_; pr_ = t0; pi_ = t1; }
        A64R[i] = pr_; A64I[i] = pi_;
        for (int c = 0; c < 16; ++c) {
            const float br = a.in[I_BRE][(size_t)i * 16 + c], bi = a.in[I_BIM][(size_t)i * 16 + c];
            BBB[((size_t)g * 128 + p) * 16 + c] = (bf16_t)(cvt_pk_bf16(cr * br - ci * bi, 0.f) & 0xffffu);
            BBB[((size_t)g * 128 + 64 + p) * 16 + c] = (bf16_t)(cvt_pk_bf16(cr * bi + ci * br, 0.f) & 0xffffu);
            CMB[((size_t)g * 16 + c) * 128 + p] = (bf16_t)(cvt_pk_bf16(a.in[I_CRE][((size_t)g * 16 + c) * 64 + p], 0.f) & 0xffffu);
            CMB[((size_t)g * 16 + c) * 128 + 64 + p] = (bf16_t)(cvt_pk_bf16(-a.in[I_CIM][((size_t)g * 16 + c) * 64 + p], 0.f) & 0xffffu);
        }
    }
}

__device__ __forceinline__ void s5_unit(const Args& a, LAS unsigned char* wl, int lane, int mode, int n, int g, int j) {
    unsigned char* ws = a.ws;
    const int fr = lane & 15, fq = lane >> 4;
    const float* AR = (const float*)(ws + WS_SMALL + SM_AR); const float* AI = (const float*)(ws + WS_SMALL + SM_AI);
    const bf16_t* BBB = (const bf16_t*)(ws + WS_SMALL + SM_BBB); const bf16_t* CMB = (const bf16_t*)(ws + WS_SMALL + SM_CMB);
    const bf16_t* Z = (const bf16_t*)(ws + WS_Z); bf16_t* YG = (bf16_t*)(ws + WS_YG); float* SUM = (float*)(ws + WS_S5SUM);
    LAS float* BuS = (LAS float*)wl; LAS bf16_t* Hs = (LAS bf16_t*)(wl + 8448);
    const float ar = AR[g * 64 + lane], ai = AI[g * 64 + lane];
    const bf16x8 zero8 = (bf16x8){0, 0, 0, 0, 0, 0, 0, 0};
    bf16x8 bb[8];
#pragma unroll
    for (int t = 0; t < 8; ++t) bb[t] = fq < 2 ? *(const bf16x8*)(BBB + ((size_t)g * 128 + 16 * t + fr) * 16 + 8 * fq) : zero8;
    bf16x8 cm[4];
#pragma unroll
    for (int kk = 0; kk < 4; ++kk) cm[kk] = *(const bf16x8*)(CMB + ((size_t)g * 16 + fr) * 128 + 32 * kk + 8 * fq);
    const f32x4 dsk = *(const f32x4*)(a.in[I_S5D] + 16 * g + 4 * fq);
    float hr = 0.f, hi = 0.f;
    if (mode == 1 && j > 0) {
        const float pr = ((const float*)(ws + WS_SMALL + SM_A64R))[g * 64 + lane], pi = ((const float*)(ws + WS_SMALL + SM_A64I))[g * 64 + lane];
        const float* sp = SUM + ((size_t)(n * 64 + g) * 32) * 128;
        for (int i = 0; i < j; ++i) { const float sr = sp[i * 128 + lane], si = sp[i * 128 + 64 + lane];
            const float t0 = pr * hr - pi * hi + sr, t1 = pr * hi + pi * hr + si; hr = t0; hi = t1; }
    }
    if (mode == 4 && j > 0) {
        float pr = ((const float*)(ws + WS_SMALL + SM_A64R))[g * 64 + lane], pi = ((const float*)(ws + WS_SMALL + SM_A64I))[g * 64 + lane];
#pragma unroll
        for (int q = 0; q < 2; ++q) { const float t0 = pr * pr - pi * pi, t1 = 2.f * pr * pi; pr = t0; pi = t1; }
        for (int v = 0; v < j; ++v) { const LAS float* ps = (const LAS float*)(wl + (v - j) * 16384 + 12800); const float sr = ps[lane], si = ps[64 + lane];
            const float t0 = pr * hr - pi * hi + sr, t1 = pr * hi + pi * hr + si; hr = t0; hi = t1; }
    }
    const int row0 = mode == 2 ? MP + 16 * j : ((mode == 3 || mode == 4) ? n * SEQ + 256 * j : n * SEQ + 64 * j);
    const int nblk = mode == 2 ? 1 : ((mode == 3 || mode == 1 || mode == 4) ? 16 : 4);
    for (int blk = 0; blk < nblk; ++blk) {
        const int r0 = row0 + 16 * blk;
        const bf16x8 ua = fq < 2 ? *(const bf16x8*)(Z + (size_t)(r0 + fr) * NZ + 16 * g + 8 * fq) : zero8;
        u32x2 u4raw = (u32x2){0u, 0u}; if (mode == 1 || mode == 2 || mode == 4) u4raw = *(const u32x2*)(Z + (size_t)(r0 + fr) * NZ + 16 * g + 4 * fq);
#pragma unroll
        for (int t = 0; t < 8; ++t) {
            const f32x4 c = __builtin_amdgcn_mfma_f32_16x16x32_bf16(ua, bb[t], (f32x4){0.f, 0.f, 0.f, 0.f}, 0, 0, 0);
#pragma unroll
            for (int jj = 0; jj < 4; ++jj) BuS[(4 * fq + jj) * 132 + 16 * t + fr] = c[jj];
        }
        LDS_WAIT();
        float burv[16], buiv[16];
#pragma unroll
        for (int t = 0; t < 16; ++t) { burv[t] = BuS[t * 132 + lane]; buiv[t] = BuS[t * 132 + 64 + lane]; }
#pragma unroll
        for (int t = 0; t < 16; ++t) {
            const float bur = burv[t], bui = buiv[t];
            if (mode == 2) { const size_t si = ((size_t)(r0 - MP + t) * 64 + g) * 64 + lane; hr = a.in[I_S5RE][si]; hi = a.in[I_S5IM][si]; }
            const float t0 = ar * hr - ai * hi + bur, t1 = ar * hi + ai * hr + bui; hr = t0; hi = t1;
            if (mode == 2) { const size_t si = ((size_t)(r0 - MP + t) * 64 + g) * 64 + lane; a.out[O_S5RS + si] = hr; a.out[O_S5IS + si] = hi; }
            if (mode == 1 || mode == 2 || mode == 4) { const unsigned w = cvt_pk_bf16(hr, hi); Hs[t * 136 + lane] = (bf16_t)(w & 0xffffu); Hs[t * 136 + 64 + lane] = (bf16_t)(w >> 16); }
        }
        if (mode == 1 || mode == 2 || mode == 4) {
            LDS_WAIT();
            f32x4 y = (f32x4){0.f, 0.f, 0.f, 0.f};
#pragma unroll
            for (int kk = 0; kk < 4; ++kk) { const bf16x8 hb = *(const LAS bf16x8*)(Hs + fr * 136 + 32 * kk + 8 * fq);
                y = __builtin_amdgcn_mfma_f32_16x16x32_bf16(cm[kk], hb, y, 0, 0, 0); }
            const f32x4 u4 = up4(u4raw); f32x4 o;
#pragma unroll
            for (int jj = 0; jj < 4; ++jj) o[jj] = gelu_t(y[jj] + dsk[jj] * u4[jj]);
            *(u32x2*)(YG + (size_t)(r0 + fr) * DH + 16 * g + 4 * fq) = pk4(o);
            LDS_WAIT();
        }
    }
    if (mode == 0) { float* sp = SUM + ((size_t)(n * 64 + g) * 32 + j) * 128; sp[lane] = hr; sp[64 + lane] = hi; }
    if (mode == 3) { LAS float* ps = (LAS float*)(wl + 12800); ps[lane] = hr; ps[64 + lane] = hi; }
    if (mode == 4 && j == 7) { a.out[O_S5RP + (size_t)(n * 64 + g) * 64 + lane] = hr; a.out[O_S5IP + (size_t)(n * 64 + g) * 64 + lane] = hi; }
}

__device__ __forceinline__ void conv_prompt(const Args& a) {
    unsigned char* ws = a.ws; const bf16_t* Z = (const bf16_t*)(ws + WS_Z); bf16_t* XC = (bf16_t*)(ws + WS_XC);
    const float* cw = a.in[I_CONVW]; const float* cb = a.in[I_CONVB];
    const int G = gridDim.x;
    for (int it = blockIdx.x * 512 + threadIdx.x; it < MP * 128; it += G * 512) {
        const int row = it >> 7, c = (it & 127) * 8, t = row & (SEQ - 1);
        float acc[8];
#pragma unroll
        for (int q = 0; q < 8; ++q) acc[q] = cb[c + q];
#pragma unroll
        for (int k = 0; k < 4; ++k) {
            if (t - 3 + k >= 0) {
                const u32x4 z = *(const u32x4*)(Z + (size_t)(row - 3 + k) * NZ + DH + c);
                const float x[8] = {bf_lo(z.x), bf_hi(z.x), bf_lo(z.y), bf_hi(z.y), bf_lo(z.z), bf_hi(z.z), bf_lo(z.w), bf_hi(z.w)};
#pragma unroll
                for (int q = 0; q < 8; ++q) acc[q] += cw[k * DH + c + q] * x[q];
                if (k == 3 && t >= SEQ - 3) {
                    float* o = a.out + O_CONVP + ((size_t)(row >> 11) * 3 + (t - (SEQ - 3))) * DH + c;
#pragma unroll
                    for (int q = 0; q < 8; ++q) o[q] = x[q];
                }
            }
        }
        u32x4 o; o.x = cvt_pk_bf16(acc[0], acc[1]); o.y = cvt_pk_bf16(acc[2], acc[3]); o.z = cvt_pk_bf16(acc[4], acc[5]); o.w = cvt_pk_bf16(acc[6], acc[7]);
        *(u32x4*)(XC + (size_t)row * DH + c) = o;
    }
}

__device__ __forceinline__ void conv_tile(const Args& a, int pm, int h) {
    unsigned char* ws = a.ws; const bf16_t* Z = (const bf16_t*)(ws + WS_Z); bf16_t* XC = (bf16_t*)(ws + WS_XC);
    const int tid = threadIdx.x, c = h * 256 + (tid & 31) * 8;
    float cwv[4][8], cbv[8];
#pragma unroll
    for (int q = 0; q < 8; ++q) { cbv[q] = a.in[I_CONVB][c + q];
#pragma unroll
        for (int k = 0; k < 4; ++k) cwv[k][q] = a.in[I_CONVW][k * DH + c + q]; }
#pragma unroll 1
    for (int r4 = 0; r4 < 16; r4 += 4) {
        u32x4 z[4][4];
#pragma unroll
        for (int rr = 0; rr < 4; ++rr) { const int row = pm * 256 + (tid >> 5) + 16 * (r4 + rr), t = row & (SEQ - 1);
#pragma unroll
            for (int k = 0; k < 4; ++k) z[rr][k] = (t - 3 + k >= 0) ? *(const u32x4*)(Z + (size_t)(row - 3 + k) * NZ + DH + c) : (u32x4){0u, 0u, 0u, 0u}; }
#pragma unroll
        for (int rr = 0; rr < 4; ++rr) { const int row = pm * 256 + (tid >> 5) + 16 * (r4 + rr), t = row & (SEQ - 1);
            float acc[8];
#pragma unroll
            for (int q = 0; q < 8; ++q) acc[q] = cbv[q];
#pragma unroll
            for (int k = 0; k < 4; ++k) { const u32x4 zz = z[rr][k];
                const float x[8] = {bf_lo(zz.x), bf_hi(zz.x), bf_lo(zz.y), bf_hi(zz.y), bf_lo(zz.z), bf_hi(zz.z), bf_lo(zz.w), bf_hi(zz.w)};
#pragma unroll
                for (int q = 0; q < 8; ++q) acc[q] += cwv[k][q] * x[q];
                if (k == 3 && t >= SEQ - 3) { float* o = a.out + O_CONVP + ((size_t)(row >> 11) * 3 + (t - (SEQ - 3))) * DH + c;
#pragma unroll
                    for (int q = 0; q < 8; ++q) o[q] = x[q]; } }
            u32x4 o; o.x = cvt_pk_bf16(acc[0], acc[1]); o.y = cvt_pk_bf16(acc[2], acc[3]); o.z = cvt_pk_bf16(acc[4], acc[5]); o.w = cvt_pk_bf16(acc[6], acc[7]);
            *(u32x4*)(XC + (size_t)row * DH + c) = o; }
    }
}

__device__ __forceinline__ void lru_sample(const Args& a, LAS unsigned char* lds, int unit) {
    unsigned char* ws = a.ws; const bf16_t* Z = (const bf16_t*)(ws + WS_Z); bf16_t* MG = (bf16_t*)(ws + WS_MERGED); float* ssB = (float*)(ws + WS_CTL) + SS_B * SS_STRIDE;
    LAS float* sxc = (LAS float*)lds;
    const int tid = threadIdx.x, s = unit >> 1, half = unit & 1, row = MP + s;
    const float* cw = a.in[I_CONVW]; const float* cs = a.in[I_CONV] + (size_t)s * 3 * DH;
    for (int c = tid; c < DH; c += 512) {
        const float xb = bf1(Z[(size_t)row * NZ + DH + c]);
        sxc[c] = a.in[I_CONVB][c] + cw[c] * cs[c] + cw[DH + c] * cs[DH + c] + cw[2 * DH + c] * cs[2 * DH + c] + cw[3 * DH + c] * xb;
        if ((c >> 9) == half) { float* o = a.out + O_CONVS + (size_t)s * 3 * DH; o[c] = cs[DH + c]; o[DH + c] = cs[2 * DH + c]; o[2 * DH + c] = xb; }
    }
    __syncthreads();
    float sq = 0.f;
    {
        const int c = half * 512 + tid, h = c >> 8, jj = c & 255;
        const float* wa = a.in[I_WA] + (size_t)h * 65536 + jj; const float* wi = a.in[I_WI] + (size_t)h * 65536 + jj;
        float ra = a.in[I_BA][c], ri = a.in[I_BI][c];
#pragma unroll 1
        for (int k0 = 0; k0 < 256; k0 += 32) {
            float wav[32], wiv[32];
#pragma unroll
            for (int q = 0; q < 32; ++q) { wav[q] = wa[(size_t)(k0 + q) * 256]; wiv[q] = wi[(size_t)(k0 + q) * 256]; }
#pragma unroll
            for (int q = 0; q < 32; ++q) { const float x = sxc[h * 256 + k0 + q]; ra += x * wav[q]; ri += x * wiv[q]; }
        }
        const float r = sigm(ra), ig = sigm(ri); const float xl = -a.in[I_LAM][c]; const float sp = fmaxf(xl, 0.f) + log1pf(expf(-fabsf(xl)));
        const float la = -8.f * r * sp, av = expf(la), bv = sqrtf(-expm1f(2.f * la)) * ig * sxc[c];
        const float hn = av * a.in[I_LRUH][(size_t)s * DH + c] + bv;
        a.out[O_LRUS + (size_t)s * DH + c] = hn;
        const float o = hn * gelu_t(bf1(Z[(size_t)row * NZ + 2 * DH + c]));
        MG[(size_t)row * DM + DH + c] = (bf16_t)(cvt_pk_bf16(o, 0.f) & 0xffffu);
        sq = o * o;
    }
    sq = wave_sum(sq);
    if ((tid & 63) == 0) atomicAdd(ssB + row, sq);
    __syncthreads();
}

__device__ __forceinline__ void lru_scan_unit(const Args& a, LAS unsigned char* lds, int unit) {
    unsigned char* ws = a.ws; const bf16_t* Z = (const bf16_t*)(ws + WS_Z); bf16_t* MG = (bf16_t*)(ws + WS_MERGED); float* ssB = (float*)(ws + WS_CTL) + SS_B * SS_STRIDE;
    const float* Ao = a.out; const float* Bo = a.out + (size_t)MP * DH;
    LAS float* sP = (LAS float*)lds; LAS float* sH = sP + 512; LAS float* rsum = sH + 512;
    const int tid = threadIdx.x, n = unit >> 6, ch = (unit & 63) * 16 + (tid & 15), j = tid >> 4;
    const size_t r0 = (size_t)n * SEQ + 64 * j;
    float P = 1.f, h = 0.f;
#pragma unroll 1
    for (int tb = 0; tb < 64; tb += 16) {
        float av[16], bv[16];
#pragma unroll
        for (int q = 0; q < 16; ++q) { av[q] = Ao[(r0 + tb + q) * DH + ch]; bv[q] = Bo[(r0 + tb + q) * DH + ch]; }
#pragma unroll
        for (int q = 0; q < 16; ++q) { h = av[q] * h + bv[q]; P *= av[q]; }
    }
    sP[tid] = P; sH[tid] = h;
    __syncthreads();
    float H = 0.f;
    for (int i = 0; i < j; ++i) H = sP[i * 16 + (tid & 15)] * H + sH[i * 16 + (tid & 15)];
    h = H;
#pragma unroll 1
    for (int tb = 0; tb < 64; tb += 16) {
        float av[16], bv[16]; bf16_t gz[16];
#pragma unroll
        for (int q = 0; q < 16; ++q) { const size_t row = r0 + tb + q; av[q] = Ao[row * DH + ch]; bv[q] = Bo[row * DH + ch]; gz[q] = Z[row * NZ + 2 * DH + ch]; }
#pragma unroll
        for (int q = 0; q < 16; ++q) {
            const size_t row = r0 + tb + q;
            h = av[q] * h + bv[q];
            const float o = h * gelu_t(bf1(gz[q]));
            MG[row * DM + DH + ch] = (bf16_t)(cvt_pk_bf16(o, 0.f) & 0xffffu);
            float s = o * o; s += __shfl_xor(s, 1); s += __shfl_xor(s, 2); s += __shfl_xor(s, 4); s += __shfl_xor(s, 8);
            if ((tid & 15) == 0) rsum[64 * j + tb + q] = s;
        }
    }
    __syncthreads();
    for (int r = tid; r < SEQ; r += 512) atomicAdd(ssB + (size_t)n * SEQ + r, rsum[r]);
    if (j == 31) a.out[O_LRUP + (size_t)n * DH + ch] = h;
    __syncthreads();
}

#define XB_TMO      128
#define XB_XCNT(j)  (256  + 64 * (j))
#define XB_XSUB(j)  (1280 + 64 * (j))
#define XB_XGEN(j)  (2304 + 64 * (j))
#define XB_TOP      3328
#define XB_TOPGEN   3392
#define XB_SPIN_CAP (1u << 18)
__device__ __forceinline__ unsigned xb_ld(unsigned* p)              { return __hip_atomic_load(p, __ATOMIC_RELAXED, __HIP_MEMORY_SCOPE_AGENT); }
__device__ __forceinline__ unsigned xb_add(unsigned* p, unsigned v) { return __hip_atomic_fetch_add(p, v, __ATOMIC_RELAXED, __HIP_MEMORY_SCOPE_AGENT); }
__device__ __forceinline__ unsigned xb_xcc_id() { return (unsigned)__builtin_amdgcn_s_getreg((3 << 11) | 20) & 0xFu; }
#define XB_SPIN(cond, bar) do { unsigned _sp = 0; while (cond) { __builtin_amdgcn_s_sleep(1); \
    if ((++_sp & 255u) == 0u) { if (xb_ld(&(bar)[XB_TMO])) break; if (_sp > XB_SPIN_CAP) { atomicAdd(&(bar)[XB_TMO], 1u); break; } } } } while (0)
struct XcdBarrier { unsigned* bar; unsigned x; volatile LAS unsigned* st; };
__device__ __forceinline__ XcdBarrier xcd_barrier_post(unsigned* bar, volatile LAS unsigned* st) {
    XcdBarrier b; b.bar = bar; b.x = xb_xcc_id(); b.st = st;
    if (threadIdx.x == 0) (void)xb_add(&bar[XB_XCNT(b.x)], 1u);
    return b;
}
__device__ __forceinline__ void xcd_barrier_complete(unsigned* bar, unsigned x, unsigned& nloc, unsigned& nx) {
    const unsigned G = gridDim.x * gridDim.y * gridDim.z;
    unsigned sum, cnt, mine, sp = 0u;
    for (;;) {
        sum = 0u; cnt = 0u; mine = 0u;
#pragma unroll
        for (unsigned j = 0; j < 16; ++j) { const unsigned c = xb_ld(&bar[XB_XCNT(j)]); sum += c; cnt += (c > 0u) ? 1u : 0u; mine = (j == x) ? c : mine; }
        if (sum == G) break;
        __builtin_amdgcn_s_sleep(1);
        if ((++sp & 255u) == 0u) { if (xb_ld(&bar[XB_TMO])) break; if (sp > XB_SPIN_CAP) { atomicAdd(&bar[XB_TMO], 1u); break; } }
    }
    nloc = mine > 0u ? mine : 1u; nx = cnt > 0u ? cnt : 1u;
}
__device__ __forceinline__ void xcd_barrier(const XcdBarrier& b) {
    asm volatile("s_waitcnt vmcnt(0)" ::: "memory");
    __syncthreads();
    if (threadIdx.x == 0) {
        unsigned* bar = b.bar;
        __builtin_amdgcn_s_waitcnt(0);
        unsigned nloc = b.st[0], nx = b.st[1];
        if (nloc == 0u) { xcd_barrier_complete(bar, b.x, nloc, nx); b.st[0] = nloc; b.st[1] = nx; }
        const unsigned old = xb_add(&bar[XB_XSUB(b.x)], 1u);
        const unsigned gen = old / nloc;
        if (old + 1u == (gen + 1u) * nloc) {
            __builtin_amdgcn_fence(__ATOMIC_RELEASE, "agent");
            asm volatile("s_waitcnt vmcnt(0)" ::: "memory");
            const unsigned og = xb_add(&bar[XB_TOP], 1u);
            const unsigned tg = og / nx;
            if (og + 1u == (tg + 1u) * nx) xb_add(&bar[XB_TOPGEN], 1u);
            else XB_SPIN(xb_ld(&bar[XB_TOPGEN]) == tg, bar);
            __builtin_amdgcn_fence(__ATOMIC_ACQUIRE, "agent");
            xb_add(&bar[XB_XGEN(b.x)], 1u);
            asm volatile("s_waitcnt vmcnt(0)" ::: "memory");
        } else {
            XB_SPIN(xb_ld(&bar[XB_XGEN(b.x)]) == gen, bar);
            __builtin_amdgcn_fence(__ATOMIC_ACQUIRE, "agent");
            asm volatile("s_waitcnt vmcnt(0)" ::: "memory");
        }
    }
    __syncthreads();
}

__global__ void __launch_bounds__(512, 2) fwd_kernel(Args a) {
    extern __shared__ __attribute__((aligned(16))) unsigned char lds_raw[];
    LAS unsigned char* lds = (LAS unsigned char*)lds_raw;
    const int tid = threadIdx.x, wave = __builtin_amdgcn_readfirstlane(tid >> 6), lane = tid & 63, G = gridDim.x;
    unsigned char* ws = a.ws;
    const int lo = a.ph_lo, hi = a.ph_hi;
    volatile LAS unsigned* MISC = (volatile LAS unsigned*)(lds + MISC_OFF);
    for (int u = tid; u < (LDS_BYTES - RING_BYTES) / 4; u += 512) ((LAS unsigned*)(lds + RING_BYTES))[u] = 0u;
    __syncthreads();
#if MK_LAUNCHES == 1
    XcdBarrier bar = xcd_barrier_post((unsigned*)(ws + WS_CTL) + CW_BAR, MISC + 8);
#define GRID_BAR() xcd_barrier(bar)
#else
#define GRID_BAR() do {} while (0)
#endif
#define IN(k) (lo <= (k) && (k) < hi)
#define BOTH(k) (IN(k) && IN((k) + 1))
#define ssb ((float*)(ws + WS_CTL))
#define AB ((bf16_t*)(ws + WS_AB))
#define Z ((bf16_t*)(ws + WS_Z))
#define YG ((bf16_t*)(ws + WS_YG))
#define MG ((bf16_t*)(ws + WS_MERGED))
#define HUP ((bf16_t*)(ws + WS_HUP))
#define PW ((bf16_t*)(ws + WS_PW))
#define PB ((bf16_t*)(ws + WS_PB))
#define XO (a.out + O_Y)

    if (IN(0)) { phase0(a, lds); if (BOTH(0)) GRID_BAR(); }

    if (IN(1)) {
        pg8::Gemm g{AB, (const bf16_t*)(ws + WS_WIN), DM, DM, DM, 0}; pg8::StaticOrder S; S.init(MP / 256, NZ / 256, G, (int)blockIdx.x);
        EpiWrap<EIn> E{{nullptr, (const float*)(ws + WS_SMALL + SM_RS0), Z}};
        pg8::gemm_phase<EpiWrap<EIn>, true>(lds, g, S, E);
        skinny_gemm<EIn, 8, 2>(lds, AB + (size_t)MP * DM, DM, (const bf16_t*)(ws + WS_WIN), DM, NZ, DM, E.e, G / 2);
        if (BOTH(1)) GRID_BAR();
    }

    if (IN(3)) {
        pg8::Gemm g{(const bf16_t*)(ws + WS_XC), (const bf16_t*)(ws + WS_WLRU), DH, 256, 256, 1}; pg8::StaticOrder S; S.init(MP / 256, 8, G, (int)blockIdx.x);
        { pg8::Unit cu; for (int i = 0; S.next(i, cu); ++i) conv_tile(a, cu.pm, cu.pn >> 1); }
        asm volatile("s_waitcnt vmcnt(0)" ::: "memory"); __syncthreads();
        ELru E{(const bf16_t*)(ws + WS_XC), a.in[I_BA], a.in[I_BI], (const float*)(ws + WS_SMALL + SM_SPL), a.out, a.out + (size_t)MP * DH};
        pg8::gemm_phase<ELru, true>(lds, g, S, E);
        for (int s = G - 1 - (int)blockIdx.x; s < 2 * MS; s += G) lru_sample(a, lds, s);
        for (int u = blockIdx.x; u < NB * 64; u += G) {
            const int n = u >> 6, g2 = u & 63;
            s5_unit(a, lds + wave * 16384, lane, 3, n, g2, wave);
            __syncthreads();
            s5_unit(a, lds + wave * 16384, lane, 4, n, g2, wave);
            __syncthreads();
        }
        for (int u = blockIdx.x * 8 + wave; u < 512; u += G * 8) s5_unit(a, lds + wave * 16384, lane, 2, 0, u >> 3, u & 7);
        if (BOTH(3)) GRID_BAR();
    }

    if (IN(4)) {
        pg8::Gemm g{YG, (const bf16_t*)(ws + WS_WGLU), DH, DH, DH, 0}; pg8::StaticOrder S; S.init(MP / 256, DH / 256, G, (int)blockIdx.x);
        EpiWrap<EGlu> E{{ssb + SS_A * SS_STRIDE, a.in[I_BGLU], YG, MG}};
        pg8::gemm_phase<EpiWrap<EGlu>, true>(lds, g, S, E);
        skinny_gemm<EGlu, 4>(lds, YG + (size_t)MP * DH, DH, (const bf16_t*)(ws + WS_WGLU), DH, DH, DH, E.e);
        for (int u = G - 1 - (int)blockIdx.x; u < NB * 64; u += G) lru_scan_unit(a, lds, u);
        if (BOTH(4)) GRID_BAR();
    }

    if (IN(5)) {
        pg8::Gemm g{MG, (const bf16_t*)(ws + WS_WOUT), DM, DM, DM, 0}; pg8::StaticOrder S; S.init(MP / 256, DM / 256, G, (int)blockIdx.x);
        { float* RAT = (float*)(ws + WS_SMALL + SM_RAT); float* RSB = (float*)(ws + WS_SMALL + SM_RSB);
          pg8::Unit cu;
          for (int ui = -1; ui < 0 || S.next(ui, cu); ++ui)
              for (int i = tid; i < (ui < 0 ? MS : 256); i += 512) { const int row = ui < 0 ? MP + i : cu.pm * 256 + i;
                  const float va = ssb[SS_A * SS_STRIDE + row] * (1.f / DH) + EPS, vb = ssb[SS_B * SS_STRIDE + row] * (1.f / DH) + EPS; RAT[row] = sqrtf(vb / va); RSB[row] = rsqrtf(vb); }
          asm volatile("s_waitcnt vmcnt(0)" ::: "memory"); __syncthreads(); }
        EpiWrap<EOut> E{{ssb + SS_1 * SS_STRIDE, (const float*)(ws + WS_SMALL + SM_RAT), (const float*)(ws + WS_SMALL + SM_RSB), a.in[I_XP], a.in[I_XS], XO, AB}};
        pg8::gemm_phase<EpiWrap<EOut>, true>(lds, g, S, E);
        skinny_gemm<EOut, 4>(lds, MG + (size_t)MP * DM, DM, (const bf16_t*)(ws + WS_WOUT), DM, DM, DM, E.e);
        if (BOTH(5)) GRID_BAR();
    }

    if (IN(6)) {
        pg8::Gemm g{AB, (const bf16_t*)(ws + WS_WUP), DM, DM, DM, 0}; pg8::StaticOrder S; S.init(MP / 256, DFF / 256, G, (int)blockIdx.x);
        EpiWrap<EUp> E{{nullptr, ssb + SS_1 * SS_STRIDE, HUP}};
        pg8::gemm_phase<EpiWrap<EUp>, true>(lds, g, S, E);
        skinny_gemm<EUp, 8, 2>(lds, AB + (size_t)MP * DM, DM, (const bf16_t*)(ws + WS_WUP), DM, DFF, DM, E.e);
        if (BOTH(6)) GRID_BAR();
    }

    if (IN(7)) {
        pg8::Gemm g{HUP, (const bf16_t*)(ws + WS_WDOWN), DFF, DFF, DFF, 0}; pg8::StaticOrder S; S.init(MP / 256, DM / 256, G, (int)blockIdx.x);
        EpiWrap<EDown> E{{ssb + SS_2 * SS_STRIDE, XO, AB}};
        pg8::gemm_phase<EpiWrap<EDown>, true>(lds, g, S, E);
        skinny_gemm<EDown, 4>(lds, HUP + (size_t)MP * DFF, DFF, (const bf16_t*)(ws + WS_WDOWN), DFF, DM, DFF, E.e);
        if (BOTH(7)) GRID_BAR();
    }

    if (IN(8)) {
        { pg8::Gemm g{PB, (const bf16_t*)(ws + WS_WPLE), DPLE, DPLE, DPLE, 0}; pg8::StaticOrder S; S.init(MP / 256, DM / 256, G, (int)blockIdx.x);
          EpiWrap<EPw> E{{nullptr, PW}};
          pg8::gemm_phase<EpiWrap<EPw>, true>(lds, g, S, E);
          skinny_gemm<EPw, 4>(lds, PB + (size_t)MP * DPLE, DPLE, (const bf16_t*)(ws + WS_WPLE), DPLE, DM, DPLE, E.e); }
        asm volatile("s_waitcnt vmcnt(0)" ::: "memory"); __syncthreads();
        { pg8::Gemm g{AB, (const bf16_t*)(ws + WS_WGATE), DM, DM, DM, 0}; pg8::StaticOrder S; S.init(MP / 256, DM / 256, G, (int)blockIdx.x);
          EpiWrap<EGate> E{{ssb + SS_3 * SS_STRIDE, ssb + SS_2 * SS_STRIDE, PW, XO}};
          pg8::gemm_phase<EpiWrap<EGate>, true>(lds, g, S, E);
          skinny_gemm<EGate, 4>(lds, AB + (size_t)MP * DM, DM, (const bf16_t*)(ws + WS_WGATE), DM, DM, DM, E.e); }
        if (BOTH(8)) GRID_BAR();
    }

    if (IN(9)) {
        const float* ss3 = ssb + SS_3 * SS_STRIDE; const float* gf = a.in[I_GFIN];
        f32x4 gv[8];
#pragma unroll
        for (int j = 0; j < 8; ++j) gv[j] = ((const f32x4*)gf)[lane + 64 * j];
        for (int row = blockIdx.x * 8 + wave; row < MT; row += 2 * G * 8) {
            const int row2 = row + G * 8; const bool has2 = row2 < MT; const int r2 = has2 ? row2 : row;
            f32x4* xa = (f32x4*)(XO + (size_t)row * DM); f32x4* xb2 = (f32x4*)(XO + (size_t)r2 * DM);
            f32x4 va[8], vb[8];
#pragma unroll
            for (int j = 0; j < 8; ++j) { va[j] = xa[lane + 64 * j]; vb[j] = xb2[lane + 64 * j]; }
            const float rsa = rsqrtf(ss3[row] * (1.f / DM) + EPS), rsb2 = rsqrtf(ss3[r2] * (1.f / DM) + EPS);
#pragma unroll
            for (int j = 0; j < 8; ++j) xa[lane + 64 * j] = va[j] * rsa * gv[j];
            if (has2) {
#pragma unroll
                for (int j = 0; j < 8; ++j) xb2[lane + 64 * j] = vb[j] * rsb2 * gv[j];
            }
        }
    }
#if MK_LAUNCHES == 1
    if (lo > hi) cg::this_grid().sync();
#endif
}

#undef ssb
#undef AB
#undef Z
#undef YG
#undef MG
#undef HUP
#undef PW
#undef PB
#undef XO
extern "C" void kernel_launch(void* const* d_in, const int* in_sizes, int n_in, void* d_out, int out_size, void* d_ws, size_t ws_size, hipStream_t stream) {
    static int grid = 0;
    if (grid == 0) {
        int dev = 0, cus = 0;
        if (n_in != 37 || ws_size < WS_END) { fprintf(stderr, "kernel_launch: unexpected inputs (n_in %d, ws %zu)\n", n_in, ws_size); grid = -1; return; }
        if (hipGetDevice(&dev) != hipSuccess || hipDeviceGetAttribute(&cus, hipDeviceAttributeMultiprocessorCount, dev) != hipSuccess) { grid = -1; return; }
        if (hipFuncSetAttribute((const void*)fwd_kernel, hipFuncAttributeMaxDynamicSharedMemorySize, LDS_BYTES) != hipSuccess) { fprintf(stderr, "kernel_launch: hipFuncSetAttribute failed\n"); grid = -1; return; }
        int per_cu = 0;
        if (hipOccupancyMaxActiveBlocksPerMultiprocessor(&per_cu, (const void*)fwd_kernel, 512, LDS_BYTES) != hipSuccess || per_cu < 1) { fprintf(stderr, "kernel_launch: occupancy query %d\n", per_cu); }
        (void)hipGetLastError();
        grid = cus;
    }
    if (grid < 0) return;
    (void)hipMemsetAsync((char*)d_ws + WS_CTL, 0, CTL_ZERO_BYTES, stream);
    Args a{};
    for (int i = 0; i < 37; ++i) a.in[i] = (const float*)d_in[i];
    a.out = (float*)d_out; a.ws = (unsigned char*)d_ws;
#if MK_LAUNCHES == 1
    a.ph_lo = 0; a.ph_hi = NPHASE;
    void* args[] = {&a};
    hipError_t e = hipLaunchCooperativeKernel((const void*)fwd_kernel, dim3(grid), dim3(512), args, LDS_BYTES, stream);
    if (e != hipSuccess) fprintf(stderr, "cooperative launch failed: %s (grid %d)\n", hipGetErrorString(e), grid);
#else
    for (int ph = 0; ph < NPHASE; ++ph) {
        a.ph_lo = ph; a.ph_hi = ph + 1;
        hipLaunchKernelGGL(fwd_kernel, dim3(grid), dim3(512), LDS_BYTES, stream, a);
    }
#endif
}
```

```cpp
#include <hip/hip_runtime.h>
#include <hip/hip_cooperative_groups.h>
#include <cstdio>
#include <cstdint>
namespace cg = cooperative_groups;

#ifndef MK_LAUNCHES
#define MK_LAUNCHES 1
#endif

#define LAS __attribute__((address_space(3)))
typedef unsigned short bf16_t;
typedef short bf16x8 __attribute__((ext_vector_type(8)));
typedef float f32x4 __attribute__((ext_vector_type(4)));
typedef unsigned u32x4 __attribute__((ext_vector_type(4)));
typedef unsigned u32x2 __attribute__((ext_vector_type(2)));

constexpr int DM = 2048, SEQ = 2048, NB = 4, MP = 8192, MS = 128, MT = 8320;
constexpr int NZ = 3072, DFF = 8192, DPLE = 256, DH = 1024;
constexpr float EPS = 1e-6f;
constexpr int NPHASE = 10;

constexpr size_t MiB = 1u << 20;
constexpr size_t WS_CTL = 0, CTL_ZERO_BYTES = 1 * MiB;
constexpr int SS_STRIDE = 8448;
constexpr int SS_A = 0, SS_B = 1, SS_1 = 2, SS_2 = 3, SS_3 = 4;
constexpr int CW_BAR = 65536;
constexpr size_t WS_SMALL = 1 * MiB;
constexpr size_t SM_RS0 = 0, SM_AR = 65536, SM_AI = SM_AR + 16384, SM_A64R = SM_AI + 16384, SM_A64I = SM_A64R + 16384,
                 SM_BBB = SM_A64I + 16384  , SM_CMB = SM_BBB + 262144  , SM_SPL = SM_CMB + 262144  , SM_RAT = 663552  , SM_RSB = SM_RAT + 34816  ;
constexpr size_t WS_WUP = 2 * MiB, WS_WDOWN = 34 * MiB, WS_WGATE = 66 * MiB, WS_WPLE = 74 * MiB, WS_PB = 75 * MiB, WS_AB = 80 * MiB;
constexpr size_t WS_E = 113 * MiB;
constexpr size_t WS_HUP = WS_E, WS_PW = WS_E;
constexpr size_t WS_WIN = 113 * MiB, WS_WGLU = 125 * MiB, WS_WOUT = 127 * MiB, WS_WLRU = 135 * MiB, WS_Z = 136 * MiB,
                 WS_YG = 185 * MiB, WS_MERGED = 202 * MiB, WS_XC = 235 * MiB, WS_S5SUM = 251 * MiB, WS_END = 255 * MiB;
static_assert(WS_HUP + (size_t)MT * DFF * 2 <= 256 * MiB, "hup fits");
static_assert(WS_Z + (size_t)MT * NZ * 2 <= WS_YG && WS_YG + (size_t)MT * DH * 2 <= WS_MERGED && WS_MERGED + (size_t)MT * DM * 2 <= WS_XC, "map");
static_assert(WS_AB + (size_t)MT * DM * 2 <= WS_E && WS_PB + (size_t)MT * DPLE * 2 <= WS_AB, "map2");

constexpr size_t O_Y = 0, O_S5RP = 17039360, O_S5IP = 17055744, O_LRUP = 17072128, O_CONVP = 17076224,
                 O_S5RS = 17088512, O_S5IS = 17612800, O_LRUS = 18137088, O_CONVS = 18268160;

constexpr int RING_BYTES = 131072, MISC_OFF = RING_BYTES + 320, LDS_BYTES = 147456;

__device__ __forceinline__ unsigned cvt_pk_bf16(float lo, float hi) { unsigned r; asm("v_cvt_pk_bf16_f32 %0, %1, %2" : "=v"(r) : "v"(lo), "v"(hi)); return r; }
__device__ __forceinline__ float bf_lo(unsigned u) { return __uint_as_float(u << 16); }
__device__ __forceinline__ float bf_hi(unsigned u) { return __uint_as_float(u & 0xffff0000u); }
__device__ __forceinline__ float bf1(bf16_t u) { return __uint_as_float(((unsigned)u) << 16); }
__device__ __forceinline__ float sigm(float x) { return __builtin_amdgcn_rcpf(1.f + __expf(-x)); }
__device__ __forceinline__ float gelu_t(float x) { const float u = 1.5957691216057308f * (x + 0.044715f * x * x * x); return x * __builtin_amdgcn_rcpf(1.f + __expf(-u)); }
__device__ __forceinline__ float wave_sum(float v) {
#pragma unroll
    for (int o = 1; o < 64; o <<= 1) v += __shfl_xor(v, o);
    return v;
}
#define LDS_WAIT() asm volatile("s_waitcnt lgkmcnt(0)" ::: "memory")

namespace pg8 {
constexpr int BM = 256, BK = 64, HALF = 128, HTB = HALF * BK * 2, STAGE_BYTES = 8 * HTB, NXCD = 8, WGM = 8;
__host__ __device__ __forceinline__ int lds_byte(int r, int c) { const int st = (r >> 4) * 2 + (c >> 5), rr = r & 15, cc = c & 31, ob = rr * 64 + cc * 2; return st * 1024 + (ob ^ (((ob >> 9) & 1) << 5)); }
__host__ __device__ __forceinline__ void stage_rc(int b, int& R, int& C) { const int st = b / 1024, sb = b % 1024, swz = sb ^ (((sb >> 9) & 1) << 5); R = (st >> 1) * 16 + swz / 64; C = (st & 1) * 32 + (swz % 64) / 2; }
__host__ __device__ __forceinline__ int perm32(int rho) { const int n = rho >> 4, i = rho & 15; return 8 * (i >> 2) + 4 * n + (i & 3); }
struct Unit { int pm, pn; };
struct Gemm { const bf16_t* A; const bf16_t* Bt; int lda, ldb, K, akmode; };
struct StaticOrder {
    int nM, nN, nwg, G, c;
    __device__ __forceinline__ void init(int nM_, int nN_, int G_, int c_) { nM = nM_; nN = nN_; nwg = nM * nN; G = G_; c = c_; }
    __device__ __forceinline__ bool next(int i, Unit& u) const {
        const long L = (long)i * G + c; if (L >= nwg) return false;
        int wgid = (int)L; { const int q = nwg / NXCD, r = nwg % NXCD, xcd = wgid % NXCD, off = wgid / NXCD; wgid = (xcd < r ? xcd * (q + 1) : r * (q + 1) + (xcd - r) * q) + off; }
        const int nig = WGM * nN, gid = wgid / nig, fm = gid * WGM, gsz = (nM - fm) < WGM ? (nM - fm) : WGM;
        u.pm = fm + ((wgid % nig) % gsz); u.pn = (wgid % nig) / gsz; return true;
    }
};

template <class Epi, bool ALIGN_EPI>
__device__ __forceinline__ void gemm_phase(LAS unsigned char* lds, const Gemm g, const StaticOrder& S, const Epi& E) {
    const int tid = threadIdx.x, wid = __builtin_amdgcn_readfirstlane(tid >> 6), lane = tid & 63, wr = wid >> 2, wc = wid & 3, fr = lane & 15, fq = lane >> 4;
    int K = g.K; asm volatile("" : "+s"(K));
    const int nt = K / BK;
    unsigned voffA[2], voffB[2];
#pragma unroll
    for (int i = 0; i < 2; ++i) { int R, C; stage_rc(tid * 16 + i * 8192, R, C);
        const int Rb = Epi::PERM ? ((R & ~31) + perm32(R & 31)) : R;
        voffA[i] = (unsigned)(R * g.lda + C) * 2u; voffB[i] = (unsigned)(Rb * g.ldb + C) * 2u; }
    const size_t kstep = (size_t)(BK * 2);
    const size_t hstepA = (size_t)HALF * g.lda * 2, hstepB = (size_t)HALF * g.ldb * 2;
    const size_t tstepA = 2 * hstepA, tstepB = 2 * hstepB;
    const unsigned ldsw = (unsigned)wid * 1024u;
    const int aoff = lds_byte(wr * 64 + fr, fq * 8), boff = lds_byte(wc * 32 + fr, fq * 8);
#define PG8_SA(b, h) (((b) * 2 + (h)) * HTB)
#define PG8_SB(b, h) ((4 + (b) * 2 + (h)) * HTB)
#define PG8_STAGE(bufoff, gbase, voff) do { _Pragma("unroll") for (int _i = 0; _i < 2; ++_i) \
        __builtin_amdgcn_global_load_lds((const unsigned*)((const char*)(gbase) + (voff)[_i]), (LAS unsigned*)(lds + (bufoff) + ldsw + _i * 8192), 16, 0, 0); } while (0)
#define PG8_LDA(dst, b, h) do { _Pragma("unroll") for (int m = 0; m < 4; ++m) _Pragma("unroll") for (int k = 0; k < 2; ++k) dst[m][k] = *(const LAS bf16x8*)(lds + PG8_SA(b, h) + aoff + m * 2048 + k * 1024); } while (0)
#define PG8_LDB(dst, b, h) do { _Pragma("unroll") for (int n = 0; n < 2; ++n) _Pragma("unroll") for (int k = 0; k < 2; ++k) dst[n][k] = *(const LAS bf16x8*)(lds + PG8_SB(b, h) + boff + n * 2048 + k * 1024); } while (0)
#define PG8_MMA(ai, bj, At, Bt) do { __builtin_amdgcn_s_setprio(1); _Pragma("unroll") for (int m = 0; m < 4; ++m) _Pragma("unroll") for (int n = 0; n < 2; ++n) _Pragma("unroll") for (int k = 0; k < 2; ++k) \
        acc[ai][bj][m][n] = __builtin_amdgcn_mfma_f32_16x16x32_bf16(Bt[n][k], At[m][k], acc[ai][bj][m][n], 0, 0, 0); __builtin_amdgcn_s_setprio(0); } while (0)
#define PG8_WAIT_V(n) asm volatile("s_waitcnt vmcnt(" #n ")" ::: "memory")
#define PG8_WAIT_L(n) asm volatile("s_waitcnt lgkmcnt(" #n ")" ::: "memory")
#define PG8_BAR __builtin_amdgcn_s_barrier()
#define PG8_SCHED __builtin_amdgcn_sched_barrier(0)
    Unit cur, nxt; int ui = 0;
    if (!S.next(0, cur)) return;
    f32x4 acc[2][2][4][2];
#pragma unroll
    for (int a = 0; a < 2; ++a)
#pragma unroll
        for (int b = 0; b < 2; ++b)
#pragma unroll
            for (int m = 0; m < 4; ++m)
#pragma unroll
                for (int n = 0; n < 2; ++n) acc[a][b][m][n] = (f32x4){0.f, 0.f, 0.f, 0.f};
    bf16x8 At[4][2], B0[2][2], B1[2][2];
    const char* cA = (const char*)g.A + (size_t)cur.pm * tstepA + (g.akmode ? (size_t)(cur.pn >> 1) * 512 : 0);
    const char* cB = (const char*)g.Bt + (size_t)cur.pn * tstepB;
    PG8_STAGE(PG8_SB(0, 0), cB, voffB); PG8_STAGE(PG8_SB(0, 1), cB + hstepB, voffB); PG8_STAGE(PG8_SA(0, 0), cA, voffA); PG8_STAGE(PG8_SA(0, 1), cA + hstepA, voffA);
    if (wr == 1) PG8_BAR;
    PG8_WAIT_V(2); PG8_BAR;
    PG8_STAGE(PG8_SB(1, 0), cB + kstep, voffB); PG8_STAGE(PG8_SA(1, 0), cA + kstep, voffA); PG8_STAGE(PG8_SB(1, 1), cB + hstepB + kstep, voffB);
    PG8_WAIT_V(6); PG8_BAR;
    for (;;) {
        const bool has_next = S.next(ui + 1, nxt);
        const char* nA = has_next ? (const char*)g.A + (size_t)nxt.pm * tstepA + (g.akmode ? (size_t)(nxt.pn >> 1) * 512 : 0) : cA;
        const char* nB = has_next ? (const char*)g.Bt + (size_t)nxt.pn * tstepB : cB;
        for (int t = 0; t < nt; t += 2) {
            const bool last = (t == nt - 2);
            const char* a1 = cA + (size_t)(t + 1) * kstep;
            const char* a2 = last ? nA : cA + (size_t)(t + 2) * kstep; const char* b2 = last ? nB : cB + (size_t)(t + 2) * kstep;
            const char* a3 = a2 + kstep; const char* b3 = b2 + kstep;
            if constexpr (Epi::MID) { if (t == (nt >> 1)) E.mid(acc, cur, wr, fr); }
            PG8_LDB(B0, 0, 0); PG8_LDB(B1, 0, 1); PG8_SCHED; PG8_LDA(At, 0, 0); PG8_STAGE(PG8_SA(1, 1), a1 + hstepA, voffA);
            PG8_WAIT_V(8); PG8_WAIT_L(0); PG8_BAR; PG8_MMA(0, 0, At, B0); PG8_MMA(0, 1, At, B1); PG8_BAR; PG8_SCHED;
            PG8_LDA(At, 0, 1); PG8_STAGE(PG8_SB(0, 0), b2, voffB); PG8_STAGE(PG8_SB(0, 1), b2 + hstepB, voffB); PG8_STAGE(PG8_SA(0, 0), a2, voffA);
            PG8_WAIT_V(8); PG8_WAIT_L(0); PG8_BAR; PG8_MMA(1, 0, At, B0); PG8_MMA(1, 1, At, B1); PG8_BAR; PG8_SCHED;
            PG8_LDB(B0, 1, 0); PG8_LDB(B1, 1, 1); PG8_SCHED; PG8_LDA(At, 1, 0); PG8_STAGE(PG8_SA(0, 1), a2 + hstepA, voffA);
            PG8_WAIT_V(8); PG8_WAIT_L(0); PG8_BAR; PG8_MMA(0, 0, At, B0); PG8_MMA(0, 1, At, B1); PG8_BAR; PG8_SCHED;
            PG8_LDA(At, 1, 1); PG8_STAGE(PG8_SB(1, 0), b3, voffB); PG8_STAGE(PG8_SB(1, 1), b3 + hstepB, voffB); PG8_STAGE(PG8_SA(1, 0), a3, voffA);
            PG8_WAIT_V(8); PG8_WAIT_L(0); PG8_BAR; PG8_MMA(1, 0, At, B0); PG8_MMA(1, 1, At, B1); PG8_BAR; PG8_SCHED;
        }
        if constexpr (ALIGN_EPI) { if (wr == 0) PG8_BAR; }
        E(acc, cur, wr, wc, fr, fq);
        if (!has_next) break;
#pragma unroll
        for (int a = 0; a < 2; ++a)
#pragma unroll
            for (int b = 0; b < 2; ++b)
#pragma unroll
                for (int m = 0; m < 4; ++m)
#pragma unroll
                    for (int n = 0; n < 2; ++n) acc[a][b][m][n] = (f32x4){0.f, 0.f, 0.f, 0.f};
        cur = nxt; cA = nA; cB = nB; ++ui;
        if constexpr (ALIGN_EPI) { if (wr == 1) PG8_BAR; }
    }
    PG8_WAIT_V(0);
    if constexpr (!ALIGN_EPI) { if (wr == 0) PG8_BAR; }
    PG8_BAR;
#undef PG8_SA
#undef PG8_SB
#undef PG8_STAGE
#undef PG8_LDA
#undef PG8_LDB
#undef PG8_MMA
#undef PG8_WAIT_V
#undef PG8_WAIT_L
#undef PG8_BAR
#undef PG8_SCHED
}
}

template <class E> struct EpiWrap {
    E e; static constexpr bool MID = E::MID, PERM = E::PERM;
    __device__ __forceinline__ void operator()(const f32x4 (&acc)[2][2][4][2], const pg8::Unit& u, int wr, int wc, int fr, int fq) const {
        if constexpr (E::PERM) {
#pragma unroll
            for (int ai = 0; ai < 2; ++ai)
#pragma unroll
                for (int m = 0; m < 4; ++m) {
                    const int row = u.pm * 256 + ai * 128 + wr * 64 + m * 16 + fr; const float rv = e.rowval(row); float s = 0.f;
#pragma unroll
                    for (int bj = 0; bj < 2; ++bj) s += e.apply8(row, u.pn * 256 + bj * 128 + wc * 32 + 8 * fq, acc[ai][bj][m][0], acc[ai][bj][m][1], rv);
                    if constexpr (E::HAS_SS) { s += __shfl_xor(s, 16); s += __shfl_xor(s, 32); if (fq == 0) atomicAdd(e.ss + row, s); }
                    asm volatile("" ::: "memory");
                }
            return;
        }
        if constexpr (E::HAS_RES) {
            f32x4 rc[2][2], rn[2][2];
            { const int row = u.pm * 256 + wr * 64 + fr;
#pragma unroll
              for (int bj = 0; bj < 2; ++bj)
#pragma unroll
                  for (int n = 0; n < 2; ++n) rc[bj][n] = e.res(row, u.pn * 256 + bj * 128 + wc * 32 + n * 16 + 4 * fq); }
#pragma unroll
            for (int idx = 0; idx < 8; ++idx) {
                const int ai = idx >> 2, m = idx & 3;
                const int row = u.pm * 256 + ai * 128 + wr * 64 + m * 16 + fr; const float rv = e.rowval(row); float s = 0.f;
                if (idx < 7) { const int rown = u.pm * 256 + ((idx + 1) >> 2) * 128 + wr * 64 + ((idx + 1) & 3) * 16 + fr;
#pragma unroll
                    for (int bj = 0; bj < 2; ++bj)
#pragma unroll
                        for (int n = 0; n < 2; ++n) rn[bj][n] = e.res(rown, u.pn * 256 + bj * 128 + wc * 32 + n * 16 + 4 * fq); }
#pragma unroll
                for (int bj = 0; bj < 2; ++bj)
#pragma unroll
                    for (int n = 0; n < 2; ++n) s += e.applyr(row, u.pn * 256 + bj * 128 + wc * 32 + n * 16 + 4 * fq, acc[ai][bj][m][n], rv, rc[bj][n]);
                if constexpr (E::HAS_SS) { s += __shfl_xor(s, 16); s += __shfl_xor(s, 32); if (fq == 0) atomicAdd(e.ss + row, s); }
                asm volatile("" ::: "memory");
#pragma unroll
                for (int bj = 0; bj < 2; ++bj)
#pragma unroll
                    for (int n = 0; n < 2; ++n) rc[bj][n] = rn[bj][n];
            }
            return;
        }
#pragma unroll
        for (int ai = 0; ai < 2; ++ai)
#pragma unroll
            for (int m = 0; m < 4; ++m) {
                const int row = u.pm * 256 + ai * 128 + wr * 64 + m * 16 + fr; const float rv = e.rowval(row); float s = 0.f;
#pragma unroll
                for (int bj = 0; bj < 2; ++bj)
#pragma unroll
                    for (int n = 0; n < 2; ++n) s += e.apply(row, u.pn * 256 + bj * 128 + wc * 32 + n * 16 + 4 * fq, acc[ai][bj][m][n], rv);
                if constexpr (E::HAS_SS) { s += __shfl_xor(s, 16); s += __shfl_xor(s, 32); if (fq == 0) atomicAdd(e.ss + row, s); }
                asm volatile("" ::: "memory");
            }
    }
    __device__ __forceinline__ void mid(f32x4 (&acc)[2][2][4][2], const pg8::Unit& u, int wr, int fr) const {
#pragma unroll
        for (int ai = 0; ai < 2; ++ai)
#pragma unroll
            for (int m = 0; m < 4; ++m) { const float r = e.kscale(u.pm * 256 + ai * 128 + wr * 64 + m * 16 + fr, 0);
#pragma unroll
                for (int bj = 0; bj < 2; ++bj)
#pragma unroll
                    for (int n = 0; n < 2; ++n) acc[ai][bj][m][n] = acc[ai][bj][m][n] * r; }
    }
};
__device__ __forceinline__ u32x2 pk4(f32x4 v) { u32x2 w; w.x = cvt_pk_bf16(v[0], v[1]); w.y = cvt_pk_bf16(v[2], v[3]); return w; }
__device__ __forceinline__ f32x4 up4(u32x2 w) { return (f32x4){bf_lo(w.x), bf_hi(w.x), bf_lo(w.y), bf_hi(w.y)}; }
__device__ __forceinline__ float ssq4(f32x4 v) { return (v[0] * v[0] + v[1] * v[1]) + (v[2] * v[2] + v[3] * v[3]); }

struct EIn {
    static constexpr bool HAS_RES = false, PERM = true; static constexpr bool MID = false, HAS_SS = false; float* ss; const float* rs0; bf16_t* Z;
    __device__ __forceinline__ float rowval(int row) const { return rs0[row]; }
    __device__ __forceinline__ float kscale(int, int) const { return 1.f; }
    __device__ __forceinline__ float apply(int row, int col, f32x4 v, float rv) const { *(u32x2*)(Z + (size_t)row * NZ + col) = pk4(v * rv); return 0.f; }
    __device__ __forceinline__ float apply8(int row, int col, f32x4 v0, f32x4 v1, float rv) const { u32x4 w; { const u32x2 a0 = pk4(v0 * rv), a1 = pk4(v1 * rv); w.x = a0.x; w.y = a0.y; w.z = a1.x; w.w = a1.y; } *(u32x4*)(Z + (size_t)row * NZ + col) = w; return 0.f; }
};
struct EGlu {
    static constexpr bool HAS_RES = false, PERM = true; static constexpr bool MID = false, HAS_SS = true; float* ss; const float* bglu; const bf16_t* YG; bf16_t* MG;
    __device__ __forceinline__ float rowval(int) const { return 0.f; }
    __device__ __forceinline__ float kscale(int, int) const { return 1.f; }
    __device__ __forceinline__ float apply(int row, int col, f32x4 v, float) const {
        const f32x4 b = *(const f32x4*)(bglu + col); const f32x4 yg = up4(*(const u32x2*)(YG + (size_t)row * DH + col)); f32x4 o;
#pragma unroll
        for (int j = 0; j < 4; ++j) o[j] = yg[j] * sigm(v[j] + b[j]);
        *(u32x2*)(MG + (size_t)row * DM + col) = pk4(o); return ssq4(o);
    }
    __device__ __forceinline__ float apply8(int row, int col, f32x4 v0, f32x4 v1, float) const {
        const f32x4 b0 = *(const f32x4*)(bglu + col), b1 = *(const f32x4*)(bglu + col + 4); const u32x4 yr = *(const u32x4*)(YG + (size_t)row * DH + col);
        const f32x4 y0 = up4((u32x2){yr.x, yr.y}), y1 = up4((u32x2){yr.z, yr.w}); f32x4 o0, o1;
#pragma unroll
        for (int j = 0; j < 4; ++j) { o0[j] = y0[j] * sigm(v0[j] + b0[j]); o1[j] = y1[j] * sigm(v1[j] + b1[j]); }
        u32x4 w; { const u32x2 a0 = pk4(o0), a1 = pk4(o1); w.x = a0.x; w.y = a0.y; w.z = a1.x; w.w = a1.y; } *(u32x4*)(MG + (size_t)row * DM + col) = w; return ssq4(o0) + ssq4(o1);
    }
};
struct EOut {
    static constexpr bool MID = true, HAS_SS = true; float* ss; const float* rat; const float* rsb; const float* xp; const float* xs; float* XO; bf16_t* AB;
    __device__ __forceinline__ float rowval(int row) const { return rsb[row]; }
    __device__ __forceinline__ float kscale(int row, int w) const { return w < 4 ? rat[row] : 1.f; }
    static constexpr bool HAS_RES = true, PERM = false;
    __device__ __forceinline__ f32x4 res(int row, int col) const { return *(const f32x4*)(xp + (size_t)row * DM + col); }
    __device__ __forceinline__ float applyr(int row, int col, f32x4 v, float rv, f32x4 r) const {
        const f32x4 o = r + v * rv;
        *(f32x4*)(XO + (size_t)row * DM + col) = o; *(u32x2*)(AB + (size_t)row * DM + col) = pk4(o); return ssq4(o); }
    __device__ __forceinline__ float apply(int row, int col, f32x4 v, float rv) const {
        const float* xr = row < MP ? xp + (size_t)row * DM : xs + (size_t)(row - MP) * DM;
        const f32x4 o = *(const f32x4*)(xr + col) + v * rv;
        *(f32x4*)(XO + (size_t)row * DM + col) = o; *(u32x2*)(AB + (size_t)row * DM + col) = pk4(o); return ssq4(o);
    }
};
struct EUp {
    static constexpr bool HAS_RES = false, PERM = true; static constexpr bool MID = false, HAS_SS = false; float* ss; const float* ss1; bf16_t* HUP;
    __device__ __forceinline__ float rowval(int row) const { return rsqrtf(ss1[row] * (1.f / DM) + EPS); }
    __device__ __forceinline__ float kscale(int, int) const { return 1.f; }
    __device__ __forceinline__ float apply(int row, int col, f32x4 v, float rv) const { f32x4 o;
#pragma unroll
        for (int j = 0; j < 4; ++j) { const float r = fmaxf(v[j] * rv, 0.f); o[j] = r * r; }
        *(u32x2*)(HUP + (size_t)row * DFF + col) = pk4(o); return 0.f; }
    __device__ __forceinline__ float apply8(int row, int col, f32x4 v0, f32x4 v1, float rv) const { f32x4 o0, o1;
#pragma unroll
        for (int j = 0; j < 4; ++j) { const float r0 = fmaxf(v0[j] * rv, 0.f), r1 = fmaxf(v1[j] * rv, 0.f); o0[j] = r0 * r0; o1[j] = r1 * r1; }
        u32x4 w; { const u32x2 a0 = pk4(o0), a1 = pk4(o1); w.x = a0.x; w.y = a0.y; w.z = a1.x; w.w = a1.y; } *(u32x4*)(HUP + (size_t)row * DFF + col) = w; return 0.f; }
};
struct EDown {
    static constexpr bool MID = false, HAS_SS = true; float* ss; float* XO; bf16_t* AB;
    __device__ __forceinline__ float rowval(int) const { return 0.f; }
    __device__ __forceinline__ float kscale(int, int) const { return 1.f; }
    static constexpr bool HAS_RES = true, PERM = false;
    __device__ __forceinline__ f32x4 res(int row, int col) const { return *(const f32x4*)(XO + (size_t)row * DM + col); }
    __device__ __forceinline__ float applyr(int row, int col, f32x4 v, float, f32x4 r) const {
        const f32x4 o = r + v; *(f32x4*)(XO + (size_t)row * DM + col) = o; *(u32x2*)(AB + (size_t)row * DM + col) = pk4(o); return ssq4(o); }
    __device__ __forceinline__ float apply(int row, int col, f32x4 v, float) const {
        float* p = XO + (size_t)row * DM + col; const f32x4 o = *(const f32x4*)p + v; *(f32x4*)p = o; *(u32x2*)(AB + (size_t)row * DM + col) = pk4(o); return ssq4(o); }
};
struct EPw {
    static constexpr bool HAS_RES = false, PERM = true; static constexpr bool MID = false, HAS_SS = false; float* ss; bf16_t* PW;
    __device__ __forceinline__ float rowval(int) const { return 0.f; }
    __device__ __forceinline__ float kscale(int, int) const { return 1.f; }
    __device__ __forceinline__ float apply(int row, int col, f32x4 v, float) const { *(u32x2*)(PW + (size_t)row * DM + col) = pk4(v); return 0.f; }
    __device__ __forceinline__ float apply8(int row, int col, f32x4 v0, f32x4 v1, float) const { u32x4 w; { const u32x2 a0 = pk4(v0), a1 = pk4(v1); w.x = a0.x; w.y = a0.y; w.z = a1.x; w.w = a1.y; } *(u32x4*)(PW + (size_t)row * DM + col) = w; return 0.f; }
};
struct EGate {
    static constexpr bool MID = false, HAS_SS = true; float* ss; const float* ss2; const bf16_t* PW; float* XO;
    __device__ __forceinline__ float rowval(int row) const { return rsqrtf(ss2[row] * (1.f / DM) + EPS); }
    __device__ __forceinline__ float kscale(int, int) const { return 1.f; }
    static constexpr bool HAS_RES = true, PERM = false;
    __device__ __forceinline__ f32x4 res(int row, int col) const { return *(const f32x4*)(XO + (size_t)row * DM + col); }
    __device__ __forceinline__ float applyr(int row, int col, f32x4 v, float rv, f32x4 r) const {
        f32x4 o = r; const f32x4 pw = up4(*(const u32x2*)(PW + (size_t)row * DM + col));
#pragma unroll
        for (int j = 0; j < 4; ++j) o[j] += pw[j] * sigm(v[j] * rv);
        *(f32x4*)(XO + (size_t)row * DM + col) = o; return ssq4(o); }
    __device__ __forceinline__ float apply(int row, int col, f32x4 v, float rv) const {
        float* p = XO + (size_t)row * DM + col; f32x4 o = *(const f32x4*)p; const f32x4 pw = up4(*(const u32x2*)(PW + (size_t)row * DM + col));
#pragma unroll
        for (int j = 0; j < 4; ++j) o[j] += pw[j] * sigm(v[j] * rv);
        *(f32x4*)p = o; return ssq4(o); }
};
__device__ __forceinline__ float em1(float x) {
    float p = x * (1.f + x * (0.5f + x * (0.16666667f + x * (0.041666668f + x * (0.0083333338f + x * (0.0013888889f + x * 0.0001984127f))))));
    if (__builtin_expect(__any(fabsf(x) >= 0.5f), 0)) p = fabsf(x) < 0.5f ? p : __expf(x) - 1.f;
    return p;
}
struct ELru {
    static constexpr bool MID = false, PERM = false; const bf16_t* XC; const float* ba; const float* bi; const float* spl; float* Ao; float* Bo;
    __device__ __forceinline__ void mid(f32x4 (&)[2][2][4][2], const pg8::Unit&, int, int) const {}
    __device__ __forceinline__ void operator()(const f32x4 (&acc)[2][2][4][2], const pg8::Unit& u, int wr, int wc, int fr, int fq) const {
#pragma unroll
        for (int n = 0; n < 2; ++n) {
            const int ch = (u.pn >> 1) * 256 + (u.pn & 1) * 128 + wc * 32 + n * 16 + 4 * fq;
            const f32x4 bav = *(const f32x4*)(ba + ch), biv = *(const f32x4*)(bi + ch), sp = *(const f32x4*)(spl + ch);
#pragma unroll
            for (int ai = 0; ai < 2; ++ai)
#pragma unroll
                for (int m = 0; m < 4; ++m) {
                    const int row = u.pm * 256 + ai * 128 + wr * 64 + m * 16 + fr;
                    const f32x4 xc = up4(*(const u32x2*)(XC + (size_t)row * DH + ch)); f32x4 av, bv;
#pragma unroll
                    for (int j = 0; j < 4; ++j) { const float r = sigm(acc[ai][0][m][n][j] + bav[j]), ig = sigm(acc[ai][1][m][n][j] + biv[j]);
                        const float la = r * sp[j]; av[j] = 1.f + em1(la); bv[j] = __builtin_amdgcn_sqrtf(fmaxf(-em1(2.f * la), 0.f)) * ig * xc[j]; }
                    *(f32x4*)(Ao + (size_t)row * DH + ch) = av; *(f32x4*)(Bo + (size_t)row * DH + ch) = bv;
                    asm volatile("" ::: "memory");
                }
        }
    }
};

template <class E, int MT = 8, int NG = 1>
__device__ __forceinline__ void skinny_gemm(LAS unsigned char* lds, const bf16_t* A, int lda, const bf16_t* Bt, int ldb, int N, int K, const E& e, int nb = 0) {
    const int tid = threadIdx.x, wid = __builtin_amdgcn_readfirstlane(tid >> 6), lane = tid & 63, fr = lane & 15, fq = lane >> 4;
    LAS f32x4* red = (LAS f32x4*)lds;
    constexpr int NH = 8 / MT;
    const int kw = K >> 3, k0w = wid * kw, nks = kw >> 5, nit = ((N >> 4) / NG) * NH, G = gridDim.x, NBk = nb ? nb : G;
    for (int iti = G - 1 - (int)blockIdx.x; iti < nit && (G - 1 - (int)blockIdx.x) < NBk; iti += NBk) {
        const int n0 = (iti / NH) * (16 * NG), r0 = (iti % NH) * (MT * 16);
        f32x4 acc[NG][MT];
#pragma unroll
        for (int q = 0; q < NG; ++q)
#pragma unroll
            for (int m = 0; m < MT; ++m) acc[q][m] = (f32x4){0.f, 0.f, 0.f, 0.f};
        const bf16_t* bp = Bt + (size_t)(n0 + fr) * ldb + k0w + 8 * fq;
        const bf16_t* ap = A + (size_t)(r0 + fr) * lda + k0w + 8 * fq;
        {
            bf16x8 bc[NG], ac[MT];
#pragma unroll
            for (int q = 0; q < NG; ++q) bc[q] = *(const bf16x8*)(bp + (size_t)(16 * q) * ldb);
#pragma unroll
            for (int m = 0; m < MT; ++m) ac[m] = *(const bf16x8*)(ap + (size_t)(16 * m) * lda);
            for (int ks = 0; ks < nks; ++ks) {
                const int kn = ks + 1 < nks ? ks + 1 : ks;
                bf16x8 bn[NG], an[MT];
#pragma unroll
                for (int q = 0; q < NG; ++q) bn[q] = *(const bf16x8*)(bp + (size_t)(16 * q) * ldb + 32 * kn);
#pragma unroll
                for (int m = 0; m < MT; ++m) an[m] = *(const bf16x8*)(ap + (size_t)(16 * m) * lda + 32 * kn);
#pragma unroll
                for (int q = 0; q < NG; ++q)
#pragma unroll
                    for (int m = 0; m < MT; ++m) acc[q][m] = __builtin_amdgcn_mfma_f32_16x16x32_bf16(bc[q], ac[m], acc[q][m], 0, 0, 0);
#pragma unroll
                for (int q = 0; q < NG; ++q) bc[q] = bn[q];
#pragma unroll
                for (int m = 0; m < MT; ++m) ac[m] = an[m];
            }
        }
#pragma unroll
        for (int q = 0; q < NG; ++q)
#pragma unroll
            for (int m = 0; m < MT; ++m) red[((wid * NG + q) * MT + m) * 64 + lane] = acc[q][m];
        __syncthreads();
        if (wid < MT) {
            const int row = MP + r0 + 16 * wid + fr; const float rv = e.rowval(row);
#pragma unroll
            for (int q = 0; q < NG; ++q) {
                f32x4 v = (f32x4){0.f, 0.f, 0.f, 0.f};
#pragma unroll
                for (int w = 0; w < 8; ++w) { f32x4 p = red[((w * NG + q) * MT + wid) * 64 + lane]; if constexpr (E::MID) p = p * e.kscale(row, w); v += p; }
                float s = e.apply(row, n0 + 16 * q + 4 * fq, v, rv);
                if constexpr (E::HAS_SS) { s += __shfl_xor(s, 16); s += __shfl_xor(s, 32); if (fq == 0) atomicAdd(e.ss + row, s); }
            }
        }
        __syncthreads();
    }
}

struct Args { const float* in[37]; float* out; unsigned char* ws; int ph_lo, ph_hi; };
enum { I_XP = 0, I_XS, I_S5RE, I_S5IM, I_LRUH, I_CONV, I_PP, I_PS, I_GMIX, I_WIN, I_LAMRE, I_LAMIM, I_LOGSTEP, I_BRE, I_BIM, I_CRE, I_CIM, I_S5D,
       I_WGLU, I_BGLU, I_CONVW, I_CONVB, I_WA, I_BA, I_WI, I_BI, I_LAM, I_GMA, I_GMB, I_WOUT, I_GMLP, I_WUP, I_WDOWN, I_GPLE, I_WGATE, I_WPLE, I_GFIN };

__device__ __forceinline__ void tr_item(const float* W, int K, int N, bf16_t* WT, int rbase, int lru, const float* g1, const float* g2, int gsplit,
                                        LAS float* scr, int item, int lane) {
    const int nblk = N / 32, kb = item / nblk, nb = item % nblk, k0 = 64 * kb, n0 = 32 * nb;
    f32x4 wv[8];
#pragma unroll
    for (int i = 0; i < 8; ++i) wv[i] = *(const f32x4*)(W + (size_t)(k0 + 8 * i + (lane >> 3)) * N + n0 + 4 * (lane & 7));
#pragma unroll
    for (int i = 0; i < 8; ++i) { const int kk = 8 * i + (lane >> 3), k = k0 + kk; const float gv = g1 ? (k < gsplit ? g1[k] : g2[k - gsplit]) : 1.f;
        LAS float* d = scr + kk * 33 + 4 * (lane & 7); d[0] = wv[i][0] * gv; d[1] = wv[i][1] * gv; d[2] = wv[i][2] * gv; d[3] = wv[i][3] * gv; }
    LDS_WAIT();
    const int c = lane & 7;
#pragma unroll
    for (int j = 0; j < 4; ++j) { const int n = (lane >> 3) + 8 * j, nn = n0 + n; const int drow = lru ? rbase + (nn >> 7) * 256 + (nn & 127) : rbase + nn;
        const LAS float* s = scr + (8 * c) * 33 + n;
        u32x4 o; o.x = cvt_pk_bf16(s[0 * 33], s[1 * 33]); o.y = cvt_pk_bf16(s[2 * 33], s[3 * 33]); o.z = cvt_pk_bf16(s[4 * 33], s[5 * 33]); o.w = cvt_pk_bf16(s[6 * 33], s[7 * 33]);
        *(u32x4*)(WT + (size_t)drow * K + k0 + 8 * c) = o; }
    LDS_WAIT();
}

__device__ __forceinline__ void phase0(const Args& a, LAS unsigned char* lds) {
    const int tid = threadIdx.x, wave = __builtin_amdgcn_readfirstlane(tid >> 6), lane = tid & 63, G = gridDim.x;
    unsigned char* ws = a.ws;
    LAS float* scr = (LAS float*)(lds + wave * 16384);
    const int gw = blockIdx.x * 8 + wave, NGW = G * 8;
    constexpr int I_IN = 32 * 96, I_GLU = 16 * 32, I_OUT = 32 * 64, I_UP = 32 * 256, I_DOWN = 128 * 64, I_GATE = 32 * 64, I_PLE = 4 * 64, I_LRU = 8 * 32;
    constexpr int NITEMS = I_IN + I_GLU + I_OUT + I_UP + I_DOWN + I_GATE + I_PLE + I_LRU;
    for (int it = gw; it < NITEMS; it += NGW) {
        int r = it;
        if (r < I_UP) { tr_item(a.in[I_WUP], DM, DFF, (bf16_t*)(ws + WS_WUP), 0, 0, a.in[I_GMLP], a.in[I_GMLP], 1 << 30, scr, r, lane); continue; } r -= I_UP;
        if (r < I_DOWN) { tr_item(a.in[I_WDOWN], DFF, DM, (bf16_t*)(ws + WS_WDOWN), 0, 0, nullptr, nullptr, 0, scr, r, lane); continue; } r -= I_DOWN;
        if (r < I_IN) { tr_item(a.in[I_WIN], DM, NZ, (bf16_t*)(ws + WS_WIN), 0, 0, a.in[I_GMIX], a.in[I_GMIX], 1 << 30, scr, r, lane); continue; } r -= I_IN;
        if (r < I_OUT) { tr_item(a.in[I_WOUT], DM, DM, (bf16_t*)(ws + WS_WOUT), 0, 0, a.in[I_GMA], a.in[I_GMB], DH, scr, r, lane); continue; } r -= I_OUT;
        if (r < I_GATE) { tr_item(a.in[I_WGATE], DM, DM, (bf16_t*)(ws + WS_WGATE), 0, 0, a.in[I_GPLE], a.in[I_GPLE], 1 << 30, scr, r, lane); continue; } r -= I_GATE;
        if (r < I_GLU) { tr_item(a.in[I_WGLU], DH, DH, (bf16_t*)(ws + WS_WGLU), 0, 0, nullptr, nullptr, 0, scr, r, lane); continue; } r -= I_GLU;
        if (r < I_PLE) { tr_item(a.in[I_WPLE], DPLE, DM, (bf16_t*)(ws + WS_WPLE), 0, 0, nullptr, nullptr, 0, scr, r, lane); continue; } r -= I_PLE;
        { const int mat = r >> 5, h = mat >> 1, bj = mat & 1;
          tr_item((bj ? a.in[I_WI] : a.in[I_WA]) + (size_t)h * 65536, 256, 256, (bf16_t*)(ws + WS_WLRU), h * 512 + bj * 128, 1, nullptr, nullptr, 0, scr, r & 31, lane); }
    }
    float* rs0 = (float*)(ws + WS_SMALL + SM_RS0); bf16_t* XB = (bf16_t*)(ws + WS_AB); bf16_t* PB = (bf16_t*)(ws + WS_PB);
    for (int row = gw; row < MT; row += NGW) {
        const float* xr = row < MP ? a.in[I_XP] + (size_t)row * DM : a.in[I_XS] + (size_t)(row - MP) * DM;
        f32x4 v[8]; float s = 0.f;
#pragma unroll
        for (int j = 0; j < 8; ++j) { v[j] = ((const f32x4*)xr)[lane + 64 * j]; s += ssq4(v[j]); }
        s = wave_sum(s); if (lane == 0) rs0[row] = rsqrtf(s * (1.f / DM) + EPS);
#pragma unroll
        for (int j = 0; j < 8; ++j) ((u32x2*)(XB + (size_t)row * DM))[lane + 64 * j] = pk4(v[j]);
        const float* pr = row < MP ? a.in[I_PP] + (size_t)row * DPLE : a.in[I_PS] + (size_t)(row - MP) * DPLE;
        ((u32x2*)(PB + (size_t)row * DPLE))[lane] = pk4(((const f32x4*)pr)[lane]);
    }
    { float* SPL = (float*)(ws + WS_SMALL + SM_SPL);
      for (int i = blockIdx.x * 512 + tid; i < DH; i += G * 512) { const float xl = -a.in[I_LAM][i]; SPL[i] = -8.f * (fmaxf(xl, 0.f) + log1pf(expf(-fabsf(xl)))); } }
    float* AR = (float*)(ws + WS_SMALL + SM_AR); float* AI = (float*)(ws + WS_SMALL + SM_AI); float* A64R = (float*)(ws + WS_SMALL + SM_A64R); float* A64I = (float*)(ws + WS_SMALL + SM_A64I);
    bf16_t* BBB = (bf16_t*)(ws + WS_SMALL + SM_BBB); bf16_t* CMB = (bf16_t*)(ws + WS_SMALL + SM_CMB);
    for (int i = blockIdx.x * 512 + tid; i < 4096; i += G * 512) {
        const int g = i >> 6, p = i & 63;
        const float step = expf(a.in[I_LOGSTEP][g]), lr = a.in[I_LAMRE][i], li = a.in[I_LAMIM][i];
        const float mag = expf(lr * step); float sn, cs; sincosf(li * step, &sn, &cs);
        const float ar = mag * cs, ai = mag * sn, nr = ar - 1.f, ni = ai, den = lr * lr + li * li;
        const float cr = (nr * lr + ni * li) / den, ci = (ni * lr - nr * li) / den;
        AR[i] = ar; AI[i] = ai;
        float pr_ = ar, pi_ = ai;
#pragma unroll
        for (int q = 0; q < 6; ++q) { const float t0 = pr_ * pr_ - pi_ * pi_, t1 = 2.f * pr_ * pi_; pr_ = t0; pi_ = t1; }
        A64R[i] = pr_; A64I[i] = pi_;
        for (int c = 0; c < 16; ++c) {
            const float br = a.in[I_BRE][(size_t)i * 16 + c], bi = a.in[I_BIM][(size_t)i * 16 + c];
            BBB[((size_t)g * 128 + p) * 16 + c] = (bf16_t)(cvt_pk_bf16(cr * br - ci * bi, 0.f) & 0xffffu);
            BBB[((size_t)g * 128 + 64 + p) * 16 + c] = (bf16_t)(cvt_pk_bf16(cr * bi + ci * br, 0.f) & 0xffffu);
            CMB[((size_t)g * 16 + c) * 128 + p] = (bf16_t)(cvt_pk_bf16(a.in[I_CRE][((size_t)g * 16 + c) * 64 + p], 0.f) & 0xffffu);
            CMB[((size_t)g * 16 + c) * 128 + 64 + p] = (bf16_t)(cvt_pk_bf16(-a.in[I_CIM][((size_t)g * 16 + c) * 64 + p], 0.f) & 0xffffu);
        }
    }
}

__device__ __forceinline__ void s5_unit(const Args& a, LAS unsigned char* wl, int lane, int mode, int n, int g, int j) {
    unsigned char* ws = a.ws;
    const int fr = lane & 15, fq = lane >> 4;
    const float* AR = (const float*)(ws + WS_SMALL + SM_AR); const float* AI = (const float*)(ws + WS_SMALL + SM_AI);
    const bf16_t* BBB = (const bf16_t*)(ws + WS_SMALL + SM_BBB); const bf16_t* CMB = (const bf16_t*)(ws + WS_SMALL + SM_CMB);
    const bf16_t* Z = (const bf16_t*)(ws + WS_Z); bf16_t* YG = (bf16_t*)(ws + WS_YG); float* SUM = (float*)(ws + WS_S5SUM);
    LAS float* BuS = (LAS float*)wl; LAS bf16_t* Hs = (LAS bf16_t*)(wl + 8448);
    const float ar = AR[g * 64 + lane], ai = AI[g * 64 + lane];
    const bf16x8 zero8 = (bf16x8){0, 0, 0, 0, 0, 0, 0, 0};
    bf16x8 bb[8];
#pragma unroll
    for (int t = 0; t < 8; ++t) bb[t] = fq < 2 ? *(const bf16x8*)(BBB + ((size_t)g * 128 + 16 * t + fr) * 16 + 8 * fq) : zero8;
    bf16x8 cm[4];
#pragma unroll
    for (int kk = 0; kk < 4; ++kk) cm[kk] = *(const bf16x8*)(CMB + ((size_t)g * 16 + fr) * 128 + 32 * kk + 8 * fq);
    const f32x4 dsk = *(const f32x4*)(a.in[I_S5D] + 16 * g + 4 * fq);
    float hr = 0.f, hi = 0.f;
    if (mode == 1 && j > 0) {
        const float pr = ((const float*)(ws + WS_SMALL + SM_A64R))[g * 64 + lane], pi = ((const float*)(ws + WS_SMALL + SM_A64I))[g * 64 + lane];
        const float* sp = SUM + ((size_t)(n * 64 + g) * 32) * 128;
        for (int i = 0; i < j; ++i) { const float sr = sp[i * 128 + lane], si = sp[i * 128 + 64 + lane];
            const float t0 = pr * hr - pi * hi + sr, t1 = pr * hi + pi * hr + si; hr = t0; hi = t1; }
    }
    if (mode == 4 && j > 0) {
        float pr = ((const float*)(ws + WS_SMALL + SM_A64R))[g * 64 + lane], pi = ((const float*)(ws + WS_SMALL + SM_A64I))[g * 64 + lane];
#pragma unroll
        for (int q = 0; q < 2; ++q) { const float t0 = pr * pr - pi * pi, t1 = 2.f * pr * pi; pr = t0; pi = t1; }
        for (int v = 0; v < j; ++v) { const LAS float* ps = (const LAS float*)(wl + (v - j) * 16384 + 12800); const float sr = ps[lane], si = ps[64 + lane];
            const float t0 = pr * hr - pi * hi + sr, t1 = pr * hi + pi * hr + si; hr = t0; hi = t1; }
    }
    const int row0 = mode == 2 ? MP + 16 * j : ((mode == 3 || mode == 4) ? n * SEQ + 256 * j : n * SEQ + 64 * j);
    const int nblk = mode == 2 ? 1 : ((mode == 3 || mode == 1 || mode == 4) ? 16 : 4);
    for (int blk = 0; blk < nblk; ++blk) {
        const int r0 = row0 + 16 * blk;
        const bf16x8 ua = fq < 2 ? *(const bf16x8*)(Z + (size_t)(r0 + fr) * NZ + 16 * g + 8 * fq) : zero8;
        u32x2 u4raw = (u32x2){0u, 0u}; if (mode == 1 || mode == 2 || mode == 4) u4raw = *(const u32x2*)(Z + (size_t)(r0 + fr) * NZ + 16 * g + 4 * fq);
#pragma unroll
        for (int t = 0; t < 8; ++t) {
            const f32x4 c = __builtin_amdgcn_mfma_f32_16x16x32_bf16(ua, bb[t], (f32x4){0.f, 0.f, 0.f, 0.f}, 0, 0, 0);
#pragma unroll
            for (int jj = 0; jj < 4; ++jj) BuS[(4 * fq + jj) * 132 + 16 * t + fr] = c[jj];
        }
        LDS_WAIT();
        float burv[16], buiv[16];
#pragma unroll
        for (int t = 0; t < 16; ++t) { burv[t] = BuS[t * 132 + lane]; buiv[t] = BuS[t * 132 + 64 + lane]; }
#pragma unroll
        for (int t = 0; t < 16; ++t) {
            const float bur = burv[t], bui = buiv[t];
            if (mode == 2) { const size_t si = ((size_t)(r0 - MP + t) * 64 + g) * 64 + lane; hr = a.in[I_S5RE][si]; hi = a.in[I_S5IM][si]; }
            const float t0 = ar * hr - ai * hi + bur, t1 = ar * hi + ai * hr + bui; hr = t0; hi = t1;
            if (mode == 2) { const size_t si = ((size_t)(r0 - MP + t) * 64 + g) * 64 + lane; a.out[O_S5RS + si] = hr; a.out[O_S5IS + si] = hi; }
            if (mode == 1 || mode == 2 || mode == 4) { const unsigned w = cvt_pk_bf16(hr, hi); Hs[t * 136 + lane] = (bf16_t)(w & 0xffffu); Hs[t * 136 + 64 + lane] = (bf16_t)(w >> 16); }
        }
        if (mode == 1 || mode == 2 || mode == 4) {
            LDS_WAIT();
            f32x4 y = (f32x4){0.f, 0.f, 0.f, 0.f};
#pragma unroll
            for (int kk = 0; kk < 4; ++kk) { const bf16x8 hb = *(const LAS bf16x8*)(Hs + fr * 136 + 32 * kk + 8 * fq);
                y = __builtin_amdgcn_mfma_f32_16x16x32_bf16(cm[kk], hb, y, 0, 0, 0); }
            const f32x4 u4 = up4(u4raw); f32x4 o;
#pragma unroll
            for (int jj = 0; jj < 4; ++jj) o[jj] = gelu_t(y[jj] + dsk[jj] * u4[jj]);
            *(u32x2*)(YG + (size_t)(r0 + fr) * DH + 16 * g + 4 * fq) = pk4(o);
            LDS_WAIT();
        }
    }
    if (mode == 0) { float* sp = SUM + ((size_t)(n * 64 + g) * 32 + j) * 128; sp[lane] = hr; sp[64 + lane] = hi; }
    if (mode == 3) { LAS float* ps = (LAS float*)(wl + 12800); ps[lane] = hr; ps[64 + lane] = hi; }
    if (mode == 4 && j == 7) { a.out[O_S5RP + (size_t)(n * 64 + g) * 64 + lane] = hr; a.out[O_S5IP + (size_t)(n * 64 + g) * 64 + lane] = hi; }
}

__device__ __forceinline__ void conv_prompt(const Args& a) {
    unsigned char* ws = a.ws; const bf16_t* Z = (const bf16_t*)(ws + WS_Z); bf16_t* XC = (bf16_t*)(ws + WS_XC);
    const float* cw = a.in[I_CONVW]; const float* cb = a.in[I_CONVB];
    const int G = gridDim.x;
    for (int it = blockIdx.x * 512 + threadIdx.x; it < MP * 128; it += G * 512) {
        const int row = it >> 7, c = (it & 127) * 8, t = row & (SEQ - 1);
        float acc[8];
#pragma unroll
        for (int q = 0; q < 8; ++q) acc[q] = cb[c + q];
#pragma unroll
        for (int k = 0; k < 4; ++k) {
            if (t - 3 + k >= 0) {
                const u32x4 z = *(const u32x4*)(Z + (size_t)(row - 3 + k) * NZ + DH + c);
                const float x[8] = {bf_lo(z.x), bf_hi(z.x), bf_lo(z.y), bf_hi(z.y), bf_lo(z.z), bf_hi(z.z), bf_lo(z.w), bf_hi(z.w)};
#pragma unroll
                for (int q = 0; q < 8; ++q) acc[q] += cw[k * DH + c + q] * x[q];
                if (k == 3 && t >= SEQ - 3) {
                    float* o = a.out + O_CONVP + ((size_t)(row >> 11) * 3 + (t - (SEQ - 3))) * DH + c;
#pragma unroll
                    for (int q = 0; q < 8; ++q) o[q] = x[q];
                }
            }
        }
        u32x4 o; o.x = cvt_pk_bf16(acc[0], acc[1]); o.y = cvt_pk_bf16(acc[2], acc[3]); o.z = cvt_pk_bf16(acc[4], acc[5]); o.w = cvt_pk_bf16(acc[6], acc[7]);
        *(u32x4*)(XC + (size_t)row * DH + c) = o;
    }
}

__device__ __forceinline__ void conv_tile(const Args& a, int pm, int h) {
    unsigned char* ws = a.ws; const bf16_t* Z = (const bf16_t*)(ws + WS_Z); bf16_t* XC = (bf16_t*)(ws + WS_XC);
    const int tid = threadIdx.x, c = h * 256 + (tid & 31) * 8;
    float cwv[4][8], cbv[8];
#pragma unroll
    for (int q = 0; q < 8; ++q) { cbv[q] = a.in[I_CONVB][c + q];
#pragma unroll
        for (int k = 0; k < 4; ++k) cwv[k][q] = a.in[I_CONVW][k * DH + c + q]; }
#pragma unroll 1
    for (int r4 = 0; r4 < 16; r4 += 4) {
        u32x4 z[4][4];
#pragma unroll
        for (int rr = 0; rr < 4; ++rr) { const int row = pm * 256 + (tid >> 5) + 16 * (r4 + rr), t = row & (SEQ - 1);
#pragma unroll
            for (int k = 0; k < 4; ++k) z[rr][k] = (t - 3 + k >= 0) ? *(const u32x4*)(Z + (size_t)(row - 3 + k) * NZ + DH + c) : (u32x4){0u, 0u, 0u, 0u}; }
#pragma unroll
        for (int rr = 0; rr < 4; ++rr) { const int row = pm * 256 + (tid >> 5) + 16 * (r4 + rr), t = row & (SEQ - 1);
            float acc[8];
#pragma unroll
            for (int q = 0; q < 8; ++q) acc[q] = cbv[q];
#pragma unroll
            for (int k = 0; k < 4; ++k) { const u32x4 zz = z[rr][k];
                const float x[8] = {bf_lo(zz.x), bf_hi(zz.x), bf_lo(zz.y), bf_hi(zz.y), bf_lo(zz.z), bf_hi(zz.z), bf_lo(zz.w), bf_hi(zz.w)};
#pragma unroll
                for (int q = 0; q < 8; ++q) acc[q] += cwv[k][q] * x[q];
                if (k == 3 && t >= SEQ - 3) { float* o = a.out + O_CONVP + ((size_t)(row >> 11) * 3 + (t - (SEQ - 3))) * DH + c;
#pragma unroll
                    for (int q = 0; q < 8; ++q) o[q] = x[q]; } }
            u32x4 o; o.x = cvt_pk_bf16(acc[0], acc[1]); o.y = cvt_pk_bf16(acc[2], acc[3]); o.z = cvt_pk_bf16(acc[4], acc[5]); o.w = cvt_pk_bf16(acc[6], acc[7]);
            *(u32x4*)(XC + (size_t)row * DH + c) = o; }
    }
}

__device__ __forceinline__ void lru_sample(const Args& a, LAS unsigned char* lds, int unit) {
    unsigned char* ws = a.ws; const bf16_t* Z = (const bf16_t*)(ws + WS_Z); bf16_t* MG = (bf16_t*)(ws + WS_MERGED); float* ssB = (float*)(ws + WS_CTL) + SS_B * SS_STRIDE;
    LAS float* sxc = (LAS float*)lds;
    const int tid = threadIdx.x, s = unit >> 1, half = unit & 1, row = MP + s;
    const float* cw = a.in[I_CONVW]; const float* cs = a.in[I_CONV] + (size_t)s * 3 * DH;
    for (int c = tid; c < DH; c += 512) {
        const float xb = bf1(Z[(size_t)row * NZ + DH + c]);
        sxc[c] = a.in[I_CONVB][c] + cw[c] * cs[c] + cw[DH + c] * cs[DH + c] + cw[2 * DH + c] * cs[2 * DH + c] + cw[3 * DH + c] * xb;
        if ((c >> 9) == half) { float* o = a.out + O_CONVS + (size_t)s * 3 * DH; o[c] = cs[DH + c]; o[DH + c] = cs[2 * DH + c]; o[2 * DH + c] = xb; }
    }
    __syncthreads();
    float sq = 0.f;
    {
        const int c = half * 512 + tid, h = c >> 8, jj = c & 255;
        const float* wa = a.in[I_WA] + (size_t)h * 65536 + jj; const float* wi = a.in[I_WI] + (size_t)h * 65536 + jj;
        float ra = a.in[I_BA][c], ri = a.in[I_BI][c];
#pragma unroll 1
        for (int k0 = 0; k0 < 256; k0 += 32) {
            float wav[32], wiv[32];
#pragma unroll
            for (int q = 0; q < 32; ++q) { wav[q] = wa[(size_t)(k0 + q) * 256]; wiv[q] = wi[(size_t)(k0 + q) * 256]; }
#pragma unroll
            for (int q = 0; q < 32; ++q) { const float x = sxc[h * 256 + k0 + q]; ra += x * wav[q]; ri += x * wiv[q]; }
        }
        const float r = sigm(ra), ig = sigm(ri); const float xl = -a.in[I_LAM][c]; const float sp = fmaxf(xl, 0.f) + log1pf(expf(-fabsf(xl)));
        const float la = -8.f * r * sp, av = expf(la), bv = sqrtf(-expm1f(2.f * la)) * ig * sxc[c];
        const float hn = av * a.in[I_LRUH][(size_t)s * DH + c] + bv;
        a.out[O_LRUS + (size_t)s * DH + c] = hn;
        const float o = hn * gelu_t(bf1(Z[(size_t)row * NZ + 2 * DH + c]));
        MG[(size_t)row * DM + DH + c] = (bf16_t)(cvt_pk_bf16(o, 0.f) & 0xffffu);
        sq = o * o;
    }
    sq = wave_sum(sq);
    if ((tid & 63) == 0) atomicAdd(ssB + row, sq);
    __syncthreads();
}

__device__ __forceinline__ void lru_scan_unit(const Args& a, LAS unsigned char* lds, int unit) {
    unsigned char* ws = a.ws; const bf16_t* Z = (const bf16_t*)(ws + WS_Z); bf16_t* MG = (bf16_t*)(ws + WS_MERGED); float* ssB = (float*)(ws + WS_CTL) + SS_B * SS_STRIDE;
    const float* Ao = a.out; const float* Bo = a.out + (size_t)MP * DH;
    LAS float* sP = (LAS float*)lds; LAS float* sH = sP + 512; LAS float* rsum = sH + 512;
    const int tid = threadIdx.x, n = unit >> 6, ch = (unit & 63) * 16 + (tid & 15), j = tid >> 4;
    const size_t r0 = (size_t)n * SEQ + 64 * j;
    float P = 1.f, h = 0.f;
#pragma unroll 1
    for (int tb = 0; tb < 64; tb += 16) {
        float av[16], bv[16];
#pragma unroll
        for (int q = 0; q < 16; ++q) { av[q] = Ao[(r0 + tb + q) * DH + ch]; bv[q] = Bo[(r0 + tb + q) * DH + ch]; }
#pragma unroll
        for (int q = 0; q < 16; ++q) { h = av[q] * h + bv[q]; P *= av[q]; }
    }
    sP[tid] = P; sH[tid] = h;
    __syncthreads();
    float H = 0.f;
    for (int i = 0; i < j; ++i) H = sP[i * 16 + (tid & 15)] * H + sH[i * 16 + (tid & 15)];
    h = H;
#pragma unroll 1
    for (int tb = 0; tb < 64; tb += 16) {
        float av[16], bv[16]; bf16_t gz[16];
#pragma unroll
        for (int q = 0; q < 16; ++q) { const size_t row = r0 + tb + q; av[q] = Ao[row * DH + ch]; bv[q] = Bo[row * DH + ch]; gz[q] = Z[row * NZ + 2 * DH + ch]; }
#pragma unroll
        for (int q = 0; q < 16; ++q) {
            const size_t row = r0 + tb + q;
            h = av[q] * h + bv[q];
            const float o = h * gelu_t(bf1(gz[q]));
            MG[row * DM + DH + ch] = (bf16_t)(cvt_pk_bf16(o, 0.f) & 0xffffu);
            float s = o * o; s += __shfl_xor(s, 1); s += __shfl_xor(s, 2); s += __shfl_xor(s, 4); s += __shfl_xor(s, 8);
            if ((tid & 15) == 0) rsum[64 * j + tb + q] = s;
        }
    }
    __syncthreads();
    for (int r = tid; r < SEQ; r += 512) atomicAdd(ssB + (size_t)n * SEQ + r, rsum[r]);
    if (j == 31) a.out[O_LRUP + (size_t)n * DH + ch] = h;
    __syncthreads();
}

#define XB_TMO      128
#define XB_XCNT(j)  (256  + 64 * (j))
#define XB_XSUB(j)  (1280 + 64 * (j))
#define XB_XGEN(j)  (2304 + 64 * (j))
#define XB_TOP      3328
#define XB_TOPGEN   3392
#define XB_SPIN_CAP (1u << 18)
__device__ __forceinline__ unsigned xb_ld(unsigned* p)              { return __hip_atomic_load(p, __ATOMIC_RELAXED, __HIP_MEMORY_SCOPE_AGENT); }
__device__ __forceinline__ unsigned xb_add(unsigned* p, unsigned v) { return __hip_atomic_fetch_add(p, v, __ATOMIC_RELAXED, __HIP_MEMORY_SCOPE_AGENT); }
__device__ __forceinline__ unsigned xb_xcc_id() { return (unsigned)__builtin_amdgcn_s_getreg((3 << 11) | 20) & 0xFu; }
#define XB_SPIN(cond, bar) do { unsigned _sp = 0; while (cond) { __builtin_amdgcn_s_sleep(1); \
    if ((++_sp & 255u) == 0u) { if (xb_ld(&(bar)[XB_TMO])) break; if (_sp > XB_SPIN_CAP) { atomicAdd(&(bar)[XB_TMO], 1u); break; } } } } while (0)
struct XcdBarrier { unsigned* bar; unsigned x; volatile LAS unsigned* st; };
__device__ __forceinline__ XcdBarrier xcd_barrier_post(unsigned* bar, volatile LAS unsigned* st) {
    XcdBarrier b; b.bar = bar; b.x = xb_xcc_id(); b.st = st;
    if (threadIdx.x == 0) (void)xb_add(&bar[XB_XCNT(b.x)], 1u);
    return b;
}
__device__ __forceinline__ void xcd_barrier_complete(unsigned* bar, unsigned x, unsigned& nloc, unsigned& nx) {
    const unsigned G = gridDim.x * gridDim.y * gridDim.z;
    unsigned sum, cnt, mine, sp = 0u;
    for (;;) {
        sum = 0u; cnt = 0u; mine = 0u;
#pragma unroll
        for (unsigned j = 0; j < 16; ++j) { const unsigned c = xb_ld(&bar[XB_XCNT(j)]); sum += c; cnt += (c > 0u) ? 1u : 0u; mine = (j == x) ? c : mine; }
        if (sum == G) break;
        __builtin_amdgcn_s_sleep(1);
        if ((++sp & 255u) == 0u) { if (xb_ld(&bar[XB_TMO])) break; if (sp > XB_SPIN_CAP) { atomicAdd(&bar[XB_TMO], 1u); break; } }
    }
    nloc = mine > 0u ? mine : 1u; nx = cnt > 0u ? cnt : 1u;
}
__device__ __forceinline__ void xcd_barrier(const XcdBarrier& b) {
    asm volatile("s_waitcnt vmcnt(0)" ::: "memory");
    __syncthreads();
    if (threadIdx.x == 0) {
        unsigned* bar = b.bar;
        __builtin_amdgcn_s_waitcnt(0);
        unsigned nloc = b.st[0], nx = b.st[1];
        if (nloc == 0u) { xcd_barrier_complete(bar, b.x, nloc, nx); b.st[0] = nloc; b.st[1] = nx; }
        const unsigned old = xb_add(&bar[XB_XSUB(b.x)], 1u);
        const unsigned gen = old / nloc;
        if (old + 1u == (gen + 1u) * nloc) {
            __builtin_amdgcn_fence(__ATOMIC_RELEASE, "agent");
            asm volatile("s_waitcnt vmcnt(0)" ::: "memory");
            const unsigned og = xb_add(&bar[XB_TOP], 1u);
            const unsigned tg = og / nx;
            if (og + 1u == (tg + 1u) * nx) xb_add(&bar[XB_TOPGEN], 1u);
            else XB_SPIN(xb_ld(&bar[XB_TOPGEN]) == tg, bar);
            __builtin_amdgcn_fence(__ATOMIC_ACQUIRE, "agent");
            xb_add(&bar[XB_XGEN(b.x)], 1u);
            asm volatile("s_waitcnt vmcnt(0)" ::: "memory");
        } else {
            XB_SPIN(xb_ld(&bar[XB_XGEN(b.x)]) == gen, bar);
            __builtin_amdgcn_fence(__ATOMIC_ACQUIRE, "agent");
            asm volatile("s_waitcnt vmcnt(0)" ::: "memory");
        }
    }
    __syncthreads();
}

__global__ void __launch_bounds__(512, 2) fwd_kernel(Args a) {
    extern __shared__ __attribute__((aligned(16))) unsigned char lds_raw[];
    LAS unsigned char* lds = (LAS unsigned char*)lds_raw;
    const int tid = threadIdx.x, wave = __builtin_amdgcn_readfirstlane(tid >> 6), lane = tid & 63, G = gridDim.x;
    unsigned char* ws = a.ws;
    const int lo = a.ph_lo, hi = a.ph_hi;
    volatile LAS unsigned* MISC = (volatile LAS unsigned*)(lds + MISC_OFF);
    for (int u = tid; u < (LDS_BYTES - RING_BYTES) / 4; u += 512) ((LAS unsigned*)(lds + RING_BYTES))[u] = 0u;
    __syncthreads();
#if MK_LAUNCHES == 1
    XcdBarrier bar = xcd_barrier_post((unsigned*)(ws + WS_CTL) + CW_BAR, MISC + 8);
#define GRID_BAR() xcd_barrier(bar)
#else
#define GRID_BAR() do {} while (0)
#endif
#define IN(k) (lo <= (k) && (k) < hi)
#define BOTH(k) (IN(k) && IN((k) + 1))
#define ssb ((float*)(ws + WS_CTL))
#define AB ((bf16_t*)(ws + WS_AB))
#define Z ((bf16_t*)(ws + WS_Z))
#define YG ((bf16_t*)(ws + WS_YG))
#define MG ((bf16_t*)(ws + WS_MERGED))
#define HUP ((bf16_t*)(ws + WS_HUP))
#define PW ((bf16_t*)(ws + WS_PW))
#define PB ((bf16_t*)(ws + WS_PB))
#define XO (a.out + O_Y)

    if (IN(0)) { phase0(a, lds); if (BOTH(0)) GRID_BAR(); }

    if (IN(1)) {
        pg8::Gemm g{AB, (const bf16_t*)(ws + WS_WIN), DM, DM, DM, 0}; pg8::StaticOrder S; S.init(MP / 256, NZ / 256, G, (int)blockIdx.x);
        EpiWrap<EIn> E{{nullptr, (const float*)(ws + WS_SMALL + SM_RS0), Z}};
        pg8::gemm_phase<EpiWrap<EIn>, true>(lds, g, S, E);
        skinny_gemm<EIn, 8, 2>(lds, AB + (size_t)MP * DM, DM, (const bf16_t*)(ws + WS_WIN), DM, NZ, DM, E.e, G / 2);
        if (BOTH(1)) GRID_BAR();
    }

    if (IN(3)) {
        pg8::Gemm g{(const bf16_t*)(ws + WS_XC), (const bf16_t*)(ws + WS_WLRU), DH, 256, 256, 1}; pg8::StaticOrder S; S.init(MP / 256, 8, G, (int)blockIdx.x);
        { pg8::Unit cu; for (int i = 0; S.next(i, cu); ++i) conv_tile(a, cu.pm, cu.pn >> 1); }
        asm volatile("s_waitcnt vmcnt(0)" ::: "memory"); __syncthreads();
        ELru E{(const bf16_t*)(ws + WS_XC), a.in[I_BA], a.in[I_BI], (const float*)(ws + WS_SMALL + SM_SPL), a.out, a.out + (size_t)MP * DH};
        pg8::gemm_phase<ELru, true>(lds, g, S, E);
        for (int s = G - 1 - (int)blockIdx.x; s < 2 * MS; s += G) lru_sample(a, lds, s);
        for (int u = blockIdx.x; u < NB * 64; u += G) {
            const int n = u >> 6, g2 = u & 63;
            s5_unit(a, lds + wave * 16384, lane, 3, n, g2, wave);
            __syncthreads();
            s5_unit(a, lds + wave * 16384, lane, 4, n, g2, wave);
            __syncthreads();
        }
        for (int u = blockIdx.x * 8 + wave; u < 512; u += G * 8) s5_unit(a, lds + wave * 16384, lane, 2, 0, u >> 3, u & 7);
        if (BOTH(3)) GRID_BAR();
    }

    if (IN(4)) {
        pg8::Gemm g{YG, (const bf16_t*)(ws + WS_WGLU), DH, DH, DH, 0}; pg8::StaticOrder S; S.init(MP / 256, DH / 256, G, (int)blockIdx.x);
        EpiWrap<EGlu> E{{ssb + SS_A * SS_STRIDE, a.in[I_BGLU], YG, MG}};
        pg8::gemm_phase<EpiWrap<EGlu>, true>(lds, g, S, E);
        skinny_gemm<EGlu, 4>(lds, YG + (size_t)MP * DH, DH, (const bf16_t*)(ws + WS_WGLU), DH, DH, DH, E.e);
        for (int u = G - 1 - (int)blockIdx.x; u < NB * 64; u += G) lru_scan_unit(a, lds, u);
        if (BOTH(4)) GRID_BAR();
    }

    if (IN(5)) {
        pg8::Gemm g{MG, (const bf16_t*)(ws + WS_WOUT), DM, DM, DM, 0}; pg8::StaticOrder S; S.init(MP / 256, DM / 256, G, (int)blockIdx.x);
        { float* RAT = (float*)(ws + WS_SMALL + SM_RAT); float* RSB = (float*)(ws + WS_SMALL + SM_RSB);
          pg8::Unit cu;
          for (int ui = -1; ui < 0 || S.next(ui, cu); ++ui)
              for (int i = tid; i < (ui < 0 ? MS : 256); i += 512) { const int row = ui < 0 ? MP + i : cu.pm * 256 + i;
                  const float va = ssb[SS_A * SS_STRIDE + row] * (1.f / DH) + EPS, vb = ssb[SS_B * SS_STRIDE + row] * (1.f / DH) + EPS; RAT[row] = sqrtf(vb / va); RSB[row] = rsqrtf(vb); }
          asm volatile("s_waitcnt vmcnt(0)" ::: "memory"); __syncthreads(); }
        EpiWrap<EOut> E{{ssb + SS_1 * SS_STRIDE, (const float*)(ws + WS_SMALL + SM_RAT), (const float*)(ws + WS_SMALL + SM_RSB), a.in[I_XP], a.in[I_XS], XO, AB}};
        pg8::gemm_phase<EpiWrap<EOut>, true>(lds, g, S, E);
        skinny_gemm<EOut, 4>(lds, MG + (size_t)MP * DM, DM, (const bf16_t*)(ws + WS_WOUT), DM, DM, DM, E.e);
        if (BOTH(5)) GRID_BAR();
    }

    if (IN(6)) {
        pg8::Gemm g{AB, (const bf16_t*)(ws + WS_WUP), DM, DM, DM, 0}; pg8::StaticOrder S; S.init(MP / 256, DFF / 256, G, (int)blockIdx.x);
        EpiWrap<EUp> E{{nullptr, ssb + SS_1 * SS_STRIDE, HUP}};
        pg8::gemm_phase<EpiWrap<EUp>, true>(lds, g, S, E);
        skinny_gemm<EUp, 8, 2>(lds, AB + (size_t)MP * DM, DM, (const bf16_t*)(ws + WS_WUP), DM, DFF, DM, E.e);
        if (BOTH(6)) GRID_BAR();
    }

    if (IN(7)) {
        pg8::Gemm g{HUP, (const bf16_t*)(ws + WS_WDOWN), DFF, DFF, DFF, 0}; pg8::StaticOrder S; S.init(MP / 256, DM / 256, G, (int)blockIdx.x);
        EpiWrap<EDown> E{{ssb + SS_2 * SS_STRIDE, XO, AB}};
        pg8::gemm_phase<EpiWrap<EDown>, true>(lds, g, S, E);
        skinny_gemm<EDown, 4>(lds, HUP + (size_t)MP * DFF, DFF, (const bf16_t*)(ws + WS_WDOWN), DFF, DM, DFF, E.e);
        if (BOTH(7)) GRID_BAR();
    }

    if (IN(8)) {
        { pg8::Gemm g{PB, (const bf16_t*)(ws + WS_WPLE), DPLE, DPLE, DPLE, 0}; pg8::StaticOrder S; S.init(MP / 256, DM / 256, G, (int)blockIdx.x);
          EpiWrap<EPw> E{{nullptr, PW}};
          pg8::gemm_phase<EpiWrap<EPw>, true>(lds, g, S, E);
          skinny_gemm<EPw, 4>(lds, PB + (size_t)MP * DPLE, DPLE, (const bf16_t*)(ws + WS_WPLE), DPLE, DM, DPLE, E.e); }
        asm volatile("s_waitcnt vmcnt(0)" ::: "memory"); __syncthreads();
        { pg8::Gemm g{AB, (const bf16_t*)(ws + WS_WGATE), DM, DM, DM, 0}; pg8::StaticOrder S; S.init(MP / 256, DM / 256, G, (int)blockIdx.x);
          EpiWrap<EGate> E{{ssb + SS_3 * SS_STRIDE, ssb + SS_2 * SS_STRIDE, PW, XO}};
          pg8::gemm_phase<EpiWrap<EGate>, true>(lds, g, S, E);
          skinny_gemm<EGate, 4>(lds, AB + (size_t)MP * DM, DM, (const bf16_t*)(ws + WS_WGATE), DM, DM, DM, E.e); }
        if (BOTH(8)) GRID_BAR();
    }

    if (IN(9)) {
        const float* ss3 = ssb + SS_3 * SS_STRIDE; const float* gf = a.in[I_GFIN];
        f32x4 gv[8];
#pragma unroll
        for (int j = 0; j < 8; ++j) gv[j] = ((const f32x4*)gf)[lane + 64 * j];
        for (int row = blockIdx.x * 8 + wave; row < MT; row += 2 * G * 8) {
            const int row2 = row + G * 8; const bool has2 = row2 < MT; const int r2 = has2 ? row2 : row;
            f32x4* xa = (f32x4*)(XO + (size_t)row * DM); f32x4* xb2 = (f32x4*)(XO + (size_t)r2 * DM);
            f32x4 va[8], vb[8];
#pragma unroll
            for (int j = 0; j < 8; ++j) { va[j] = xa[lane + 64 * j]; vb[j] = xb2[lane + 64 * j]; }
            const float rsa = rsqrtf(ss3[row] * (1.f / DM) + EPS), rsb2 = rsqrtf(ss3[r2] * (1.f / DM) + EPS);
#pragma unroll
            for (int j = 0; j < 8; ++j) xa[lane + 64 * j] = va[j] * rsa * gv[j];
            if (has2) {
#pragma unroll
                for (int j = 0; j < 8; ++j) xb2[lane + 64 * j] = vb[j] * rsb2 * gv[j];
            }
        }
    }
#if MK_LAUNCHES == 1
    if (lo > hi) cg::this_grid().sync();
#endif
}

#undef ssb
#undef AB
#undef Z
#undef YG
#undef MG
#undef HUP
#undef PW
#undef PB
#undef XO
extern "C" void kernel_launch(void* const* d_in, const int* in_sizes, int n_in, void* d_out, int out_size, void* d_ws, size_t ws_size, hipStream_t stream) {
    static int grid = 0;
    if (grid == 0) {
        int dev = 0, cus = 0;
        if (n_in != 37 || ws_size < WS_END) { fprintf(stderr, "kernel_launch: unexpected inputs (n_in %d, ws %zu)\n", n_in, ws_size); grid = -1; return; }
        if (hipGetDevice(&dev) != hipSuccess || hipDeviceGetAttribute(&cus, hipDeviceAttributeMultiprocessorCount, dev) != hipSuccess) { grid = -1; return; }
        if (hipFuncSetAttribute((const void*)fwd_kernel, hipFuncAttributeMaxDynamicSharedMemorySize, LDS_BYTES) != hipSuccess) { fprintf(stderr, "kernel_launch: hipFuncSetAttribute failed\n"); grid = -1; return; }
        int per_cu = 0;
        if (hipOccupancyMaxActiveBlocksPerMultiprocessor(&per_cu, (const void*)fwd_kernel, 512, LDS_BYTES) != hipSuccess || per_cu < 1) { fprintf(stderr, "kernel_launch: occupancy query %d\n", per_cu); }
        (void)hipGetLastError();
        grid = cus;
    }
    if (grid < 0) return;
    (void)hipMemsetAsync((char*)d_ws + WS_CTL, 0, CTL_ZERO_BYTES, stream);
    Args a{};
    for (int i = 0; i < 37; ++i) a.in[i] = (const float*)d_in[i];
    a.out = (float*)d_out; a.ws = (unsigned char*)d_ws;
#if MK_LAUNCHES == 1
    a.ph_lo = 0; a.ph_hi = NPHASE;
    void* args[] = {&a};
    hipError_t e = hipLaunchCooperativeKernel((const void*)fwd_kernel, dim3(grid), dim3(512), args, LDS_BYTES, stream);
    if (e != hipSuccess) fprintf(stderr, "cooperative launch failed: %s (grid %d)\n", hipGetErrorString(e), grid);
#else
    for (int ph = 0; ph < NPHASE; ++ph) {
        a.ph_lo = ph; a.ph_hi = ph + 1;
        hipLaunchKernelGGL(fwd_kernel, dim3(grid), dim3(512), LDS_BYTES, stream, a);
    }
#endif
}
```

```cpp
#include <hip/hip_runtime.h>
#include <hip/hip_cooperative_groups.h>
#include <cstdio>
#include <cstdint>
namespace cg = cooperative_groups;

#ifndef MK_LAUNCHES
#define MK_LAUNCHES 1
#endif

#define LAS __attribute__((address_space(3)))
typedef unsigned short bf16_t;
typedef short bf16x8 __attribute__((ext_vector_type(8)));
typedef float f32x4 __attribute__((ext_vector_type(4)));
typedef unsigned u32x4 __attribute__((ext_vector_type(4)));
typedef unsigned u32x2 __attribute__((ext_vector_type(2)));

constexpr int DM = 2048, SEQ = 2048, NB = 4, MP = 8192, MS = 128, MT = 8320;
constexpr int NZ = 3072, DFF = 8192, DPLE = 256, DH = 1024;
constexpr float EPS = 1e-6f;
constexpr int NPHASE = 10;

constexpr size_t MiB = 1u << 20;
constexpr size_t WS_CTL = 0, CTL_ZERO_BYTES = 1 * MiB;
constexpr int SS_STRIDE = 8448;
constexpr int SS_A = 0, SS_B = 1, SS_1 = 2, SS_2 = 3, SS_3 = 4;
constexpr int CW_BAR = 65536;
constexpr size_t WS_SMALL = 1 * MiB;
constexpr size_t SM_RS0 = 0, SM_AR = 65536, SM_AI = SM_AR + 16384, SM_A64R = SM_AI + 16384, SM_A64I = SM_A64R + 16384,
                 SM_BBB = SM_A64I + 16384  , SM_CMB = SM_BBB + 262144  , SM_SPL = SM_CMB + 262144  , SM_RAT = 663552  , SM_RSB = SM_RAT + 34816  ;
constexpr size_t WS_WUP = 2 * MiB, WS_WDOWN = 34 * MiB, WS_WGATE = 66 * MiB, WS_WPLE = 74 * MiB, WS_PB = 75 * MiB, WS_AB = 80 * MiB;
constexpr size_t WS_E = 113 * MiB;
constexpr size_t WS_HUP = WS_E, WS_PW = WS_E;
constexpr size_t WS_WIN = 113 * MiB, WS_WGLU = 125 * MiB, WS_WOUT = 127 * MiB, WS_WLRU = 135 * MiB, WS_Z = 136 * MiB,
                 WS_YG = 185 * MiB, WS_MERGED = 202 * MiB, WS_XC = 235 * MiB, WS_S5SUM = 251 * MiB, WS_END = 255 * MiB;
static_assert(WS_HUP + (size_t)MT * DFF * 2 <= 256 * MiB, "hup fits");
static_assert(WS_Z + (size_t)MT * NZ * 2 <= WS_YG && WS_YG + (size_t)MT * DH * 2 <= WS_MERGED && WS_MERGED + (size_t)MT * DM * 2 <= WS_XC, "map");
static_assert(WS_AB + (size_t)MT * DM * 2 <= WS_E && WS_PB + (size_t)MT * DPLE * 2 <= WS_AB, "map2");

constexpr size_t O_Y = 0, O_S5RP = 17039360, O_S5IP = 17055744, O_LRUP = 17072128, O_CONVP = 17076224,
                 O_S5RS = 17088512, O_S5IS = 17612800, O_LRUS = 18137088, O_CONVS = 18268160;

constexpr int RING_BYTES = 131072, MISC_OFF = RING_BYTES + 320, LDS_BYTES = 147456;

__device__ __forceinline__ unsigned cvt_pk_bf16(float lo, float hi) { unsigned r; asm("v_cvt_pk_bf16_f32 %0, %1, %2" : "=v"(r) : "v"(lo), "v"(hi)); return r; }
__device__ __forceinline__ float bf_lo(unsigned u) { return __uint_as_float(u << 16); }
__device__ __forceinline__ float bf_hi(unsigned u) { return __uint_as_float(u & 0xffff0000u); }
__device__ __forceinline__ float bf1(bf16_t u) { return __uint_as_float(((unsigned)u) << 16); }
__device__ __forceinline__ float sigm(float x) { return __builtin_amdgcn_rcpf(1.f + __expf(-x)); }
__device__ __forceinline__ float gelu_t(float x) { const float u = 1.5957691216057308f * (x + 0.044715f * x * x * x); return x * __builtin_amdgcn_rcpf(1.f + __expf(-u)); }
__device__ __forceinline__ float wave_sum(float v) {
#pragma unroll
    for (int o = 1; o < 64; o <<= 1) v += __shfl_xor(v, o);
    return v;
}
#define LDS_WAIT() asm volatile("s_waitcnt lgkmcnt(0)" ::: "memory")

namespace pg8 {
constexpr int BM = 256, BK = 64, HALF = 128, HTB = HALF * BK * 2, STAGE_BYTES = 8 * HTB, NXCD = 8, WGM = 8;
__host__ __device__ __forceinline__ int lds_byte(int r, int c) { const int st = (r >> 4) * 2 + (c >> 5), rr = r & 15, cc = c & 31, ob = rr * 64 + cc * 2; return st * 1024 + (ob ^ (((ob >> 9) & 1) << 5)); }
__host__ __device__ __forceinline__ void stage_rc(int b, int& R, int& C) { const int st = b / 1024, sb = b % 1024, swz = sb ^ (((sb >> 9) & 1) << 5); R = (st >> 1) * 16 + swz / 64; C = (st & 1) * 32 + (swz % 64) / 2; }
__host__ __device__ __forceinline__ int perm32(int rho) { const int n = rho >> 4, i = rho & 15; return 8 * (i >> 2) + 4 * n + (i & 3); }
struct Unit { int pm, pn; };
struct Gemm { const bf16_t* A; const bf16_t* Bt; int lda, ldb, K, akmode; };
struct StaticOrder {
    int nM, nN, nwg, G, c;
    __device__ __forceinline__ void init(int nM_, int nN_, int G_, int c_) { nM = nM_; nN = nN_; nwg = nM * nN; G = G_; c = c_; }
    __device__ __forceinline__ bool next(int i, Unit& u) const {
        const long L = (long)i * G + c; if (L >= nwg) return false;
        int wgid = (int)L; { const int q = nwg / NXCD, r = nwg % NXCD, xcd = wgid % NXCD, off = wgid / NXCD; wgid = (xcd < r ? xcd * (q + 1) : r * (q + 1) + (xcd - r) * q) + off; }
        const int nig = WGM * nN, gid = wgid / nig, fm = gid * WGM, gsz = (nM - fm) < WGM ? (nM - fm) : WGM;
        u.pm = fm + ((wgid % nig) % gsz); u.pn = (wgid % nig) / gsz; return true;
    }
};

template <class Epi, bool ALIGN_EPI>
__device__ __forceinline__ void gemm_phase(LAS unsigned char* lds, const Gemm g, const StaticOrder& S, const Epi& E) {
    const int tid = threadIdx.x, wid = __builtin_amdgcn_readfirstlane(tid >> 6), lane = tid & 63, wr = wid >> 2, wc = wid & 3, fr = lane & 15, fq = lane >> 4;
    int K = g.K; asm volatile("" : "+s"(K));
    const int nt = K / BK;
    unsigned voffA[2], voffB[2];
#pragma unroll
    for (int i = 0; i < 2; ++i) { int R, C; stage_rc(tid * 16 + i * 8192, R, C);
        const int Rb = Epi::PERM ? ((R & ~31) + perm32(R & 31)) : R;
        voffA[i] = (unsigned)(R * g.lda + C) * 2u; voffB[i] = (unsigned)(Rb * g.ldb + C) * 2u; }
    const size_t kstep = (size_t)(BK * 2);
    const size_t hstepA = (size_t)HALF * g.lda * 2, hstepB = (size_t)HALF * g.ldb * 2;
    const size_t tstepA = 2 * hstepA, tstepB = 2 * hstepB;
    const unsigned ldsw = (unsigned)wid * 1024u;
    const int aoff = lds_byte(wr * 64 + fr, fq * 8), boff = lds_byte(wc * 32 + fr, fq * 8);
#define PG8_SA(b, h) (((b) * 2 + (h)) * HTB)
#define PG8_SB(b, h) ((4 + (b) * 2 + (h)) * HTB)
#define PG8_STAGE(bufoff, gbase, voff) do { _Pragma("unroll") for (int _i = 0; _i < 2; ++_i) \
        __builtin_amdgcn_global_load_lds((const unsigned*)((const char*)(gbase) + (voff)[_i]), (LAS unsigned*)(lds + (bufoff) + ldsw + _i * 8192), 16, 0, 0); } while (0)
#define PG8_LDA(dst, b, h) do { _Pragma("unroll") for (int m = 0; m < 4; ++m) _Pragma("unroll") for (int k = 0; k < 2; ++k) dst[m][k] = *(const LAS bf16x8*)(lds + PG8_SA(b, h) + aoff + m * 2048 + k * 1024); } while (0)
#define PG8_LDB(dst, b, h) do { _Pragma("unroll") for (int n = 0; n < 2; ++n) _Pragma("unroll") for (int k = 0; k < 2; ++k) dst[n][k] = *(const LAS bf16x8*)(lds + PG8_SB(b, h) + boff + n * 2048 + k * 1024); } while (0)
#define PG8_MMA(ai, bj, At, Bt) do { __builtin_amdgcn_s_setprio(1); _Pragma("unroll") for (int m = 0; m < 4; ++m) _Pragma("unroll") for (int n = 0; n < 2; ++n) _Pragma("unroll") for (int k = 0; k < 2; ++k) \
        acc[ai][bj][m][n] = __builtin_amdgcn_mfma_f32_16x16x32_bf16(Bt[n][k], At[m][k], acc[ai][bj][m][n], 0, 0, 0); __builtin_amdgcn_s_setprio(0); } while (0)
#define PG8_WAIT_V(n) asm volatile("s_waitcnt vmcnt(" #n ")" ::: "memory")
#define PG8_WAIT_L(n) asm volatile("s_waitcnt lgkmcnt(" #n ")" ::: "memory")
#define PG8_BAR __builtin_amdgcn_s_barrier()
#define PG8_SCHED __builtin_amdgcn_sched_barrier(0)
    Unit cur, nxt; int ui = 0;
    if (!S.next(0, cur)) return;
    f32x4 acc[2][2][4][2];
#pragma unroll
    for (int a = 0; a < 2; ++a)
#pragma unroll
        for (int b = 0; b < 2; ++b)
#pragma unroll
            for (int m = 0; m < 4; ++m)
#pragma unroll
                for (int n = 0; n < 2; ++n) acc[a][b][m][n] = (f32x4){0.f, 0.f, 0.f, 0.f};
    bf16x8 At[4][2], B0[2][2], B1[2][2];
    const char* cA = (const char*)g.A + (size_t)cur.pm * tstepA + (g.akmode ? (size_t)(cur.pn >> 1) * 512 : 0);
    const char* cB = (const char*)g.Bt + (size_t)cur.pn * tstepB;
    PG8_STAGE(PG8_SB(0, 0), cB, voffB); PG8_STAGE(PG8_SB(0, 1), cB + hstepB, voffB); PG8_STAGE(PG8_SA(0, 0), cA, voffA); PG8_STAGE(PG8_SA(0, 1), cA + hstepA, voffA);
    if (wr == 1) PG8_BAR;
    PG8_WAIT_V(2); PG8_BAR;
    PG8_STAGE(PG8_SB(1, 0), cB + kstep, voffB); PG8_STAGE(PG8_SA(1, 0), cA + kstep, voffA); PG8_STAGE(PG8_SB(1, 1), cB + hstepB + kstep, voffB);
    PG8_WAIT_V(6); PG8_BAR;
    for (;;) {
        const bool has_next = S.next(ui + 1, nxt);
        const char* nA = has_next ? (const char*)g.A + (size_t)nxt.pm * tstepA + (g.akmode ? (size_t)(nxt.pn >> 1) * 512 : 0) : cA;
        const char* nB = has_next ? (const char*)g.Bt + (size_t)nxt.pn * tstepB : cB;
        for (int t = 0; t < nt; t += 2) {
            const bool last = (t == nt - 2);
            const char* a1 = cA + (size_t)(t + 1) * kstep;
            const char* a2 = last ? nA : cA + (size_t)(t + 2) * kstep; const char* b2 = last ? nB : cB + (size_t)(t + 2) * kstep;
            const char* a3 = a2 + kstep; const char* b3 = b2 + kstep;
            if constexpr (Epi::MID) { if (t == (nt >> 1)) E.mid(acc, cur, wr, fr); }
            PG8_LDB(B0, 0, 0); PG8_LDB(B1, 0, 1); PG8_SCHED; PG8_LDA(At, 0, 0); PG8_STAGE(PG8_SA(1, 1), a1 + hstepA, voffA);
            PG8_WAIT_V(8); PG8_WAIT_L(0); PG8_BAR; PG8_MMA(0, 0, At, B0); PG8_MMA(0, 1, At, B1); PG8_BAR; PG8_SCHED;
            PG8_LDA(At, 0, 1); PG8_STAGE(PG8_SB(0, 0), b2, voffB); PG8_STAGE(PG8_SB(0, 1), b2 + hstepB, voffB); PG8_STAGE(PG8_SA(0, 0), a2, voffA);
            PG8_WAIT_V(8); PG8_WAIT_L(0); PG8_BAR; PG8_MMA(1, 0, At, B0); PG8_MMA(1, 1, At, B1); PG8_BAR; PG8_SCHED;
            PG8_LDB(B0, 1, 0); PG8_LDB(B1, 1, 1); PG8_SCHED; PG8_LDA(At, 1, 0); PG8_STAGE(PG8_SA(0, 1), a2 + hstepA, voffA);
            PG8_WAIT_V(8); PG8_WAIT_L(0); PG8_BAR; PG8_MMA(0, 0, At, B0); PG8_MMA(0, 1, At, B1); PG8_BAR; PG8_SCHED;
            PG8_LDA(At, 1, 1); PG8_STAGE(PG8_SB(1, 0), b3, voffB); PG8_STAGE(PG8_SB(1, 1), b3 + hstepB, voffB); PG8_STAGE(PG8_SA(1, 0), a3, voffA);
            PG8_WAIT_V(8); PG8_WAIT_L(0); PG8_BAR; PG8_MMA(1, 0, At, B0); PG8_MMA(1, 1, At, B1); PG8_BAR; PG8_SCHED;
        }
        if constexpr (ALIGN_EPI) { if (wr == 0) PG8_BAR; }
        E(acc, cur, wr, wc, fr, fq);
        if (!has_next) break;
#pragma unroll
        for (int a = 0; a < 2; ++a)
#pragma unroll
            for (int b = 0; b < 2; ++b)
#pragma unroll
                for (int m = 0; m < 4; ++m)
#pragma unroll
                    for (int n = 0; n < 2; ++n) acc[a][b][m][n] = (f32x4){0.f, 0.f, 0.f, 0.f};
        cur = nxt; cA = nA; cB = nB; ++ui;
        if constexpr (ALIGN_EPI) { if (wr == 1) PG8_BAR; }
    }
    PG8_WAIT_V(0);
    if constexpr (!ALIGN_EPI) { if (wr == 0) PG8_BAR; }
    PG8_BAR;
#undef PG8_SA
#undef PG8_SB
#undef PG8_STAGE
#undef PG8_LDA
#undef PG8_LDB
#undef PG8_MMA
#undef PG8_WAIT_V
#undef PG8_WAIT_L
#undef PG8_BAR
#undef PG8_SCHED
}
}

template <class E> struct EpiWrap {
    E e; static constexpr bool MID = E::MID, PERM = E::PERM;
    __device__ __forceinline__ void operator()(const f32x4 (&acc)[2][2][4][2], const pg8::Unit& u, int wr, int wc, int fr, int fq) const {
        if constexpr (E::HAS_RES) {
            f32x4 rc[2][2], rn[2][2];
            { const int row = u.pm * 256 + wr * 64 + fr;
#pragma unroll
              for (int bj = 0; bj < 2; ++bj)
#pragma unroll
                  for (int n = 0; n < 2; ++n) rc[bj][n] = e.res(row, u.pn * 256 + bj * 128 + wc * 32 + 8 * fq + 4 * n); }
#pragma unroll
            for (int idx = 0; idx < 8; ++idx) {
                const int ai = idx >> 2, m = idx & 3;
                const int row = u.pm * 256 + ai * 128 + wr * 64 + m * 16 + fr; const float rv = e.rowval(row); float s = 0.f;
                if (idx < 7) { const int rown = u.pm * 256 + ((idx + 1) >> 2) * 128 + wr * 64 + ((idx + 1) & 3) * 16 + fr;
#pragma unroll
                    for (int bj = 0; bj < 2; ++bj)
#pragma unroll
                        for (int n = 0; n < 2; ++n) rn[bj][n] = e.res(rown, u.pn * 256 + bj * 128 + wc * 32 + 8 * fq + 4 * n); }
#pragma unroll
                for (int bj = 0; bj < 2; ++bj) s += e.applyr8(row, u.pn * 256 + bj * 128 + wc * 32 + 8 * fq, acc[ai][bj][m][0], acc[ai][bj][m][1], rv, rc[bj][0], rc[bj][1]);
                if constexpr (E::HAS_SS) { s += __shfl_xor(s, 16); s += __shfl_xor(s, 32); if (fq == 0) atomicAdd(e.ss + row, s); }
                asm volatile("" ::: "memory");
#pragma unroll
                for (int bj = 0; bj < 2; ++bj)
#pragma unroll
                    for (int n = 0; n < 2; ++n) rc[bj][n] = rn[bj][n];
            }
            return;
        }
        if constexpr (E::PERM && !E::HAS_RES) {
#pragma unroll
            for (int ai = 0; ai < 2; ++ai)
#pragma unroll
                for (int m = 0; m < 4; ++m) {
                    const int row = u.pm * 256 + ai * 128 + wr * 64 + m * 16 + fr; const float rv = e.rowval(row); float s = 0.f;
#pragma unroll
                    for (int bj = 0; bj < 2; ++bj) s += e.apply8(row, u.pn * 256 + bj * 128 + wc * 32 + 8 * fq, acc[ai][bj][m][0], acc[ai][bj][m][1], rv);
                    if constexpr (E::HAS_SS) { s += __shfl_xor(s, 16); s += __shfl_xor(s, 32); if (fq == 0) atomicAdd(e.ss + row, s); }
                    asm volatile("" ::: "memory");
                }
            return;
        }
#pragma unroll
        for (int ai = 0; ai < 2; ++ai)
#pragma unroll
            for (int m = 0; m < 4; ++m) {
                const int row = u.pm * 256 + ai * 128 + wr * 64 + m * 16 + fr; const float rv = e.rowval(row); float s = 0.f;
#pragma unroll
                for (int bj = 0; bj < 2; ++bj)
#pragma unroll
                    for (int n = 0; n < 2; ++n) s += e.apply(row, u.pn * 256 + bj * 128 + wc * 32 + n * 16 + 4 * fq, acc[ai][bj][m][n], rv);
                if constexpr (E::HAS_SS) { s += __shfl_xor(s, 16); s += __shfl_xor(s, 32); if (fq == 0) atomicAdd(e.ss + row, s); }
                asm volatile("" ::: "memory");
            }
    }
    __device__ __forceinline__ void mid(f32x4 (&acc)[2][2][4][2], const pg8::Unit& u, int wr, int fr) const {
#pragma unroll
        for (int ai = 0; ai < 2; ++ai)
#pragma unroll
            for (int m = 0; m < 4; ++m) { const float r = e.kscale(u.pm * 256 + ai * 128 + wr * 64 + m * 16 + fr, 0);
#pragma unroll
                for (int bj = 0; bj < 2; ++bj)
#pragma unroll
                    for (int n = 0; n < 2; ++n) acc[ai][bj][m][n] = acc[ai][bj][m][n] * r; }
    }
};
__device__ __forceinline__ u32x2 pk4(f32x4 v) { u32x2 w; w.x = cvt_pk_bf16(v[0], v[1]); w.y = cvt_pk_bf16(v[2], v[3]); return w; }
__device__ __forceinline__ f32x4 up4(u32x2 w) { return (f32x4){bf_lo(w.x), bf_hi(w.x), bf_lo(w.y), bf_hi(w.y)}; }
__device__ __forceinline__ float ssq4(f32x4 v) { return (v[0] * v[0] + v[1] * v[1]) + (v[2] * v[2] + v[3] * v[3]); }

struct EIn {
    static constexpr bool HAS_RES = false, PERM = true; static constexpr bool MID = false, HAS_SS = false; float* ss; const float* rs0; bf16_t* Z;
    __device__ __forceinline__ float rowval(int row) const { return rs0[row]; }
    __device__ __forceinline__ float kscale(int, int) const { return 1.f; }
    __device__ __forceinline__ float apply(int row, int col, f32x4 v, float rv) const { *(u32x2*)(Z + (size_t)row * NZ + col) = pk4(v * rv); return 0.f; }
    __device__ __forceinline__ float apply8(int row, int col, f32x4 v0, f32x4 v1, float rv) const { u32x4 w; { const u32x2 a0 = pk4(v0 * rv), a1 = pk4(v1 * rv); w.x = a0.x; w.y = a0.y; w.z = a1.x; w.w = a1.y; } *(u32x4*)(Z + (size_t)row * NZ + col) = w; return 0.f; }
};
struct EGlu {
    static constexpr bool HAS_RES = false, PERM = true; static constexpr bool MID = false, HAS_SS = true; float* ss; const float* bglu; const bf16_t* YG; bf16_t* MG;
    __device__ __forceinline__ float rowval(int) const { return 0.f; }
    __device__ __forceinline__ float kscale(int, int) const { return 1.f; }
    __device__ __forceinline__ float apply(int row, int col, f32x4 v, float) const {
        const f32x4 b = *(const f32x4*)(bglu + col); const f32x4 yg = up4(*(const u32x2*)(YG + (size_t)row * DH + col)); f32x4 o;
#pragma unroll
        for (int j = 0; j < 4; ++j) o[j] = yg[j] * sigm(v[j] + b[j]);
        *(u32x2*)(MG + (size_t)row * DM + col) = pk4(o); return ssq4(o);
    }
    __device__ __forceinline__ float apply8(int row, int col, f32x4 v0, f32x4 v1, float) const {
        const f32x4 b0 = *(const f32x4*)(bglu + col), b1 = *(const f32x4*)(bglu + col + 4); const u32x4 yr = *(const u32x4*)(YG + (size_t)row * DH + col);
        const f32x4 y0 = up4((u32x2){yr.x, yr.y}), y1 = up4((u32x2){yr.z, yr.w}); f32x4 o0, o1;
#pragma unroll
        for (int j = 0; j < 4; ++j) { o0[j] = y0[j] * sigm(v0[j] + b0[j]); o1[j] = y1[j] * sigm(v1[j] + b1[j]); }
        u32x4 w; { const u32x2 a0 = pk4(o0), a1 = pk4(o1); w.x = a0.x; w.y = a0.y; w.z = a1.x; w.w = a1.y; } *(u32x4*)(MG + (size_t)row * DM + col) = w; return ssq4(o0) + ssq4(o1);
    }
};
struct EOut {
    static constexpr bool MID = true, HAS_SS = true; float* ss; const float* rat; const float* rsb; const float* xp; const float* xs; float* XO; bf16_t* AB;
    __device__ __forceinline__ float rowval(int row) const { return rsb[row]; }
    __device__ __forceinline__ float kscale(int row, int w) const { return w < 4 ? rat[row] : 1.f; }
    static constexpr bool HAS_RES = true, PERM = true;
    __device__ __forceinline__ f32x4 res(int row, int col) const { return *(const f32x4*)(xp + (size_t)row * DM + col); }
    __device__ __forceinline__ float applyr8(int row, int col, f32x4 v0, f32x4 v1, float rv, f32x4 r0, f32x4 r1) const {
        const f32x4 o0 = r0 + v0 * rv, o1 = r1 + v1 * rv; float* p = XO + (size_t)row * DM + col; *(f32x4*)p = o0; *(f32x4*)(p + 4) = o1;
        u32x4 w; { const u32x2 a0 = pk4(o0), a1 = pk4(o1); w.x = a0.x; w.y = a0.y; w.z = a1.x; w.w = a1.y; } *(u32x4*)(AB + (size_t)row * DM + col) = w; return ssq4(o0) + ssq4(o1); }
    __device__ __forceinline__ float applyr(int row, int col, f32x4 v, float rv, f32x4 r) const {
        const f32x4 o = r + v * rv;
        *(f32x4*)(XO + (size_t)row * DM + col) = o; *(u32x2*)(AB + (size_t)row * DM + col) = pk4(o); return ssq4(o); }
    __device__ __forceinline__ float apply(int row, int col, f32x4 v, float rv) const {
        const float* xr = row < MP ? xp + (size_t)row * DM : xs + (size_t)(row - MP) * DM;
        const f32x4 o = *(const f32x4*)(xr + col) + v * rv;
        *(f32x4*)(XO + (size_t)row * DM + col) = o; *(u32x2*)(AB + (size_t)row * DM + col) = pk4(o); return ssq4(o);
    }
};
struct EUp {
    static constexpr bool HAS_RES = false, PERM = true; static constexpr bool MID = false, HAS_SS = false; float* ss; const float* ss1; bf16_t* HUP;
    __device__ __forceinline__ float rowval(int row) const { return rsqrtf(ss1[row] * (1.f / DM) + EPS); }
    __device__ __forceinline__ float kscale(int, int) const { return 1.f; }
    __device__ __forceinline__ float apply(int row, int col, f32x4 v, float rv) const { f32x4 o;
#pragma unroll
        for (int j = 0; j < 4; ++j) { const float r = fmaxf(v[j] * rv, 0.f); o[j] = r * r; }
        *(u32x2*)(HUP + (size_t)row * DFF + col) = pk4(o); return 0.f; }
    __device__ __forceinline__ float apply8(int row, int col, f32x4 v0, f32x4 v1, float rv) const { f32x4 o0, o1;
#pragma unroll
        for (int j = 0; j < 4; ++j) { const float r0 = fmaxf(v0[j] * rv, 0.f), r1 = fmaxf(v1[j] * rv, 0.f); o0[j] = r0 * r0; o1[j] = r1 * r1; }
        u32x4 w; { const u32x2 a0 = pk4(o0), a1 = pk4(o1); w.x = a0.x; w.y = a0.y; w.z = a1.x; w.w = a1.y; } *(u32x4*)(HUP + (size_t)row * DFF + col) = w; return 0.f; }
};
struct EDown {
    static constexpr bool MID = false, HAS_SS = true; float* ss; float* XO; bf16_t* AB;
    __device__ __forceinline__ float rowval(int) const { return 0.f; }
    __device__ __forceinline__ float kscale(int, int) const { return 1.f; }
    static constexpr bool HAS_RES = true, PERM = true;
    __device__ __forceinline__ f32x4 res(int row, int col) const { return *(const f32x4*)(XO + (size_t)row * DM + col); }
    __device__ __forceinline__ float applyr8(int row, int col, f32x4 v0, f32x4 v1, float, f32x4 r0, f32x4 r1) const {
        const f32x4 o0 = r0 + v0, o1 = r1 + v1; float* p = XO + (size_t)row * DM + col; *(f32x4*)p = o0; *(f32x4*)(p + 4) = o1;
        u32x4 w; { const u32x2 a0 = pk4(o0), a1 = pk4(o1); w.x = a0.x; w.y = a0.y; w.z = a1.x; w.w = a1.y; } *(u32x4*)(AB + (size_t)row * DM + col) = w; return ssq4(o0) + ssq4(o1); }
    __device__ __forceinline__ float applyr(int row, int col, f32x4 v, float, f32x4 r) const {
        const f32x4 o = r + v; *(f32x4*)(XO + (size_t)row * DM + col) = o; *(u32x2*)(AB + (size_t)row * DM + col) = pk4(o); return ssq4(o); }
    __device__ __forceinline__ float apply(int row, int col, f32x4 v, float) const {
        float* p = XO + (size_t)row * DM + col; const f32x4 o = *(const f32x4*)p + v; *(f32x4*)p = o; *(u32x2*)(AB + (size_t)row * DM + col) = pk4(o); return ssq4(o); }
};
struct EPw {
    static constexpr bool HAS_RES = false, PERM = true; static constexpr bool MID = false, HAS_SS = false; float* ss; bf16_t* PW;
    __device__ __forceinline__ float rowval(int) const { return 0.f; }
    __device__ __forceinline__ float kscale(int, int) const { return 1.f; }
    __device__ __forceinline__ float apply(int row, int col, f32x4 v, float) const { *(u32x2*)(PW + (size_t)row * DM + col) = pk4(v); return 0.f; }
    __device__ __forceinline__ float apply8(int row, int col, f32x4 v0, f32x4 v1, float) const { u32x4 w; { const u32x2 a0 = pk4(v0), a1 = pk4(v1); w.x = a0.x; w.y = a0.y; w.z = a1.x; w.w = a1.y; } *(u32x4*)(PW + (size_t)row * DM + col) = w; return 0.f; }
};
struct EGate {
    static constexpr bool MID = false, HAS_SS = true; float* ss; const float* ss2; const bf16_t* PW; float* XO;
    __device__ __forceinline__ float rowval(int row) const { return rsqrtf(ss2[row] * (1.f / DM) + EPS); }
    __device__ __forceinline__ float kscale(int, int) const { return 1.f; }
    static constexpr bool HAS_RES = true, PERM = true;
    __device__ __forceinline__ f32x4 res(int row, int col) const { return *(const f32x4*)(XO + (size_t)row * DM + col); }
    __device__ __forceinline__ float applyr8(int row, int col, f32x4 v0, f32x4 v1, float rv, f32x4 r0, f32x4 r1) const {
        const u32x4 pr = *(const u32x4*)(PW + (size_t)row * DM + col); const f32x4 p0 = up4((u32x2){pr.x, pr.y}), p1 = up4((u32x2){pr.z, pr.w}); f32x4 o0 = r0, o1 = r1;
#pragma unroll
        for (int j = 0; j < 4; ++j) { o0[j] += p0[j] * sigm(v0[j] * rv); o1[j] += p1[j] * sigm(v1[j] * rv); }
        float* p = XO + (size_t)row * DM + col; *(f32x4*)p = o0; *(f32x4*)(p + 4) = o1; return ssq4(o0) + ssq4(o1); }
    __device__ __forceinline__ float applyr(int row, int col, f32x4 v, float rv, f32x4 r) const {
        f32x4 o = r; const f32x4 pw = up4(*(const u32x2*)(PW + (size_t)row * DM + col));
#pragma unroll
        for (int j = 0; j < 4; ++j) o[j] += pw[j] * sigm(v[j] * rv);
        *(f32x4*)(XO + (size_t)row * DM + col) = o; return ssq4(o); }
    __device__ __forceinline__ float apply(int row, int col, f32x4 v, float rv) const {
        float* p = XO + (size_t)row * DM + col; f32x4 o = *(const f32x4*)p; const f32x4 pw = up4(*(const u32x2*)(PW + (size_t)row * DM + col));
#pragma unroll
        for (int j = 0; j < 4; ++j) o[j] += pw[j] * sigm(v[j] * rv);
        *(f32x4*)p = o; return ssq4(o); }
};
__device__ __forceinline__ float em1(float x) {
    float p = x * (1.f + x * (0.5f + x * (0.16666667f + x * (0.041666668f + x * (0.0083333338f + x * (0.0013888889f + x * 0.0001984127f))))));
    if (__builtin_expect(__any(fabsf(x) >= 0.5f), 0)) p = fabsf(x) < 0.5f ? p : __expf(x) - 1.f;
    return p;
}
struct ELru {
    static constexpr bool MID = false, PERM = false; const bf16_t* XC; const float* ba; const float* bi; const float* spl; float* Ao; float* Bo;
    __device__ __forceinline__ void mid(f32x4 (&)[2][2][4][2], const pg8::Unit&, int, int) const {}
    __device__ __forceinline__ void operator()(const f32x4 (&acc)[2][2][4][2], const pg8::Unit& u, int wr, int wc, int fr, int fq) const {
#pragma unroll
        for (int n = 0; n < 2; ++n) {
            const int ch = (u.pn >> 1) * 256 + (u.pn & 1) * 128 + wc * 32 + n * 16 + 4 * fq;
            const f32x4 bav = *(const f32x4*)(ba + ch), biv = *(const f32x4*)(bi + ch), sp = *(const f32x4*)(spl + ch);
#pragma unroll
            for (int ai = 0; ai < 2; ++ai)
#pragma unroll
                for (int m = 0; m < 4; ++m) {
                    const int row = u.pm * 256 + ai * 128 + wr * 64 + m * 16 + fr;
                    const f32x4 xc = up4(*(const u32x2*)(XC + (size_t)row * DH + ch)); f32x4 av, bv;
#pragma unroll
                    for (int j = 0; j < 4; ++j) { const float r = sigm(acc[ai][0][m][n][j] + bav[j]), ig = sigm(acc[ai][1][m][n][j] + biv[j]);
                        const float la = r * sp[j]; av[j] = 1.f + em1(la); bv[j] = __builtin_amdgcn_sqrtf(fmaxf(-em1(2.f * la), 0.f)) * ig * xc[j]; }
                    *(f32x4*)(Ao + (size_t)row * DH + ch) = av; *(f32x4*)(Bo + (size_t)row * DH + ch) = bv;
                    asm volatile("" ::: "memory");
                }
        }
    }
};

template <class E, int MT = 8, int NG = 1>
__device__ __forceinline__ void skinny_gemm(LAS unsigned char* lds, const bf16_t* A, int lda, const bf16_t* Bt, int ldb, int N, int K, const E& e, int nb = 0) {
    const int tid = threadIdx.x, wid = __builtin_amdgcn_readfirstlane(tid >> 6), lane = tid & 63, fr = lane & 15, fq = lane >> 4;
    LAS f32x4* red = (LAS f32x4*)lds;
    constexpr int NH = 8 / MT;
    const int kw = K >> 3, k0w = wid * kw, nks = kw >> 5, nit = ((N >> 4) / NG) * NH, G = gridDim.x, NBk = nb ? nb : G;
    for (int iti = G - 1 - (int)blockIdx.x; iti < nit && (G - 1 - (int)blockIdx.x) < NBk; iti += NBk) {
        const int n0 = (iti / NH) * (16 * NG), r0 = (iti % NH) * (MT * 16);
        f32x4 acc[NG][MT];
#pragma unroll
        for (int q = 0; q < NG; ++q)
#pragma unroll
            for (int m = 0; m < MT; ++m) acc[q][m] = (f32x4){0.f, 0.f, 0.f, 0.f};
        const bf16_t* bp = Bt + (size_t)(n0 + fr) * ldb + k0w + 8 * fq;
        const bf16_t* ap = A + (size_t)(r0 + fr) * lda + k0w + 8 * fq;
        {
            bf16x8 bc[NG], ac[MT];
#pragma unroll
            for (int q = 0; q < NG; ++q) bc[q] = *(const bf16x8*)(bp + (size_t)(16 * q) * ldb);
#pragma unroll
            for (int m = 0; m < MT; ++m) ac[m] = *(const bf16x8*)(ap + (size_t)(16 * m) * lda);
            for (int ks = 0; ks < nks; ++ks) {
                const int kn = ks + 1 < nks ? ks + 1 : ks;
                bf16x8 bn[NG], an[MT];
#pragma unroll
                for (int q = 0; q < NG; ++q) bn[q] = *(const bf16x8*)(bp + (size_t)(16 * q) * ldb + 32 * kn);
#pragma unroll
                for (int m = 0; m < MT; ++m) an[m] = *(const bf16x8*)(ap + (size_t)(16 * m) * lda + 32 * kn);
#pragma unroll
                for (int q = 0; q < NG; ++q)
#pragma unroll
                    for (int m = 0; m < MT; ++m) acc[q][m] = __builtin_amdgcn_mfma_f32_16x16x32_bf16(bc[q], ac[m], acc[q][m], 0, 0, 0);
#pragma unroll
                for (int q = 0; q < NG; ++q) bc[q] = bn[q];
#pragma unroll
                for (int m = 0; m < MT; ++m) ac[m] = an[m];
            }
        }
#pragma unroll
        for (int q = 0; q < NG; ++q)
#pragma unroll
            for (int m = 0; m < MT; ++m) red[((wid * NG + q) * MT + m) * 64 + lane] = acc[q][m];
        __syncthreads();
        if (wid < MT) {
            const int row = MP + r0 + 16 * wid + fr; const float rv = e.rowval(row);
#pragma unroll
            for (int q = 0; q < NG; ++q) {
                f32x4 v = (f32x4){0.f, 0.f, 0.f, 0.f};
#pragma unroll
                for (int w = 0; w < 8; ++w) { f32x4 p = red[((w * NG + q) * MT + wid) * 64 + lane]; if constexpr (E::MID) p = p * e.kscale(row, w); v += p; }
                float s = e.apply(row, n0 + 16 * q + 4 * fq, v, rv);
                if constexpr (E::HAS_SS) { s += __shfl_xor(s, 16); s += __shfl_xor(s, 32); if (fq == 0) atomicAdd(e.ss + row, s); }
            }
        }
        __syncthreads();
    }
}

struct Args { const float* in[37]; float* out; unsigned char* ws; int ph_lo, ph_hi; };
enum { I_XP = 0, I_XS, I_S5RE, I_S5IM, I_LRUH, I_CONV, I_PP, I_PS, I_GMIX, I_WIN, I_LAMRE, I_LAMIM, I_LOGSTEP, I_BRE, I_BIM, I_CRE, I_CIM, I_S5D,
       I_WGLU, I_BGLU, I_CONVW, I_CONVB, I_WA, I_BA, I_WI, I_BI, I_LAM, I_GMA, I_GMB, I_WOUT, I_GMLP, I_WUP, I_WDOWN, I_GPLE, I_WGATE, I_WPLE, I_GFIN };

__device__ __forceinline__ void tr_item(const float* W, int K, int N, bf16_t* WT, int rbase, int lru, const float* g1, const float* g2, int gsplit,
                                        LAS float* scr, int item, int lane) {
    const int nblk = N / 32, kb = item / nblk, nb = item % nblk, k0 = 64 * kb, n0 = 32 * nb;
    f32x4 wv[8];
#pragma unroll
    for (int i = 0; i < 8; ++i) wv[i] = *(const f32x4*)(W + (size_t)(k0 + 8 * i + (lane >> 3)) * N + n0 + 4 * (lane & 7));
#pragma unroll
    for (int i = 0; i < 8; ++i) { const int kk = 8 * i + (lane >> 3), k = k0 + kk; const float gv = g1 ? (k < gsplit ? g1[k] : g2[k - gsplit]) : 1.f;
        LAS float* d = scr + kk * 33 + 4 * (lane & 7); d[0] = wv[i][0] * gv; d[1] = wv[i][1] * gv; d[2] = wv[i][2] * gv; d[3] = wv[i][3] * gv; }
    LDS_WAIT();
    const int c = lane & 7;
#pragma unroll
    for (int j = 0; j < 4; ++j) { const int n = (lane >> 3) + 8 * j, nn = n0 + n; const int drow = lru ? rbase + (nn >> 7) * 256 + (nn & 127) : rbase + nn;
        const LAS float* s = scr + (8 * c) * 33 + n;
        u32x4 o; o.x = cvt_pk_bf16(s[0 * 33], s[1 * 33]); o.y = cvt_pk_bf16(s[2 * 33], s[3 * 33]); o.z = cvt_pk_bf16(s[4 * 33], s[5 * 33]); o.w = cvt_pk_bf16(s[6 * 33], s[7 * 33]);
        *(u32x4*)(WT + (size_t)drow * K + k0 + 8 * c) = o; }
    LDS_WAIT();
}

__device__ __forceinline__ void phase0(const Args& a, LAS unsigned char* lds) {
    const int tid = threadIdx.x, wave = __builtin_amdgcn_readfirstlane(tid >> 6), lane = tid & 63, G = gridDim.x;
    unsigned char* ws = a.ws;
    LAS float* scr = (LAS float*)(lds + wave * 16384);
    const int gw = blockIdx.x * 8 + wave, NGW = G * 8;
    constexpr int I_IN = 32 * 96, I_GLU = 16 * 32, I_OUT = 32 * 64, I_UP = 32 * 256, I_DOWN = 128 * 64, I_GATE = 32 * 64, I_PLE = 4 * 64, I_LRU = 8 * 32;
    constexpr int NITEMS = I_IN + I_GLU + I_OUT + I_UP + I_DOWN + I_GATE + I_PLE + I_LRU;
    for (int it = gw; it < NITEMS; it += NGW) {
        int r = it;
        if (r < I_UP) { tr_item(a.in[I_WUP], DM, DFF, (bf16_t*)(ws + WS_WUP), 0, 0, a.in[I_GMLP], a.in[I_GMLP], 1 << 30, scr, r, lane); continue; } r -= I_UP;
        if (r < I_DOWN) { tr_item(a.in[I_WDOWN], DFF, DM, (bf16_t*)(ws + WS_WDOWN), 0, 0, nullptr, nullptr, 0, scr, r, lane); continue; } r -= I_DOWN;
        if (r < I_IN) { tr_item(a.in[I_WIN], DM, NZ, (bf16_t*)(ws + WS_WIN), 0, 0, a.in[I_GMIX], a.in[I_GMIX], 1 << 30, scr, r, lane); continue; } r -= I_IN;
        if (r < I_OUT) { tr_item(a.in[I_WOUT], DM, DM, (bf16_t*)(ws + WS_WOUT), 0, 0, a.in[I_GMA], a.in[I_GMB], DH, scr, r, lane); continue; } r -= I_OUT;
        if (r < I_GATE) { tr_item(a.in[I_WGATE], DM, DM, (bf16_t*)(ws + WS_WGATE), 0, 0, a.in[I_GPLE], a.in[I_GPLE], 1 << 30, scr, r, lane); continue; } r -= I_GATE;
        if (r < I_GLU) { tr_item(a.in[I_WGLU], DH, DH, (bf16_t*)(ws + WS_WGLU), 0, 0, nullptr, nullptr, 0, scr, r, lane); continue; } r -= I_GLU;
        if (r < I_PLE) { tr_item(a.in[I_WPLE], DPLE, DM, (bf16_t*)(ws + WS_WPLE), 0, 0, nullptr, nullptr, 0, scr, r, lane); continue; } r -= I_PLE;
        { const int mat = r >> 5, h = mat >> 1, bj = mat & 1;
          tr_item((bj ? a.in[I_WI] : a.in[I_WA]) + (size_t)h * 65536, 256, 256, (bf16_t*)(ws + WS_WLRU), h * 512 + bj * 128, 1, nullptr, nullptr, 0, scr, r & 31, lane); }
    }
    float* rs0 = (float*)(ws + WS_SMALL + SM_RS0); bf16_t* XB = (bf16_t*)(ws + WS_AB); bf16_t* PB = (bf16_t*)(ws + WS_PB);
    for (int row = gw; row < MT; row += NGW) {
        const float* xr = row < MP ? a.in[I_XP] + (size_t)row * DM : a.in[I_XS] + (size_t)(row - MP) * DM;
        f32x4 v[8]; float s = 0.f;
#pragma unroll
        for (int j = 0; j < 8; ++j) { v[j] = ((const f32x4*)xr)[lane + 64 * j]; s += ssq4(v[j]); }
        s = wave_sum(s); if (lane == 0) rs0[row] = rsqrtf(s * (1.f / DM) + EPS);
#pragma unroll
        for (int j = 0; j < 8; ++j) ((u32x2*)(XB + (size_t)row * DM))[lane + 64 * j] = pk4(v[j]);
        const float* pr = row < MP ? a.in[I_PP] + (size_t)row * DPLE : a.in[I_PS] + (size_t)(row - MP) * DPLE;
        ((u32x2*)(PB + (size_t)row * DPLE))[lane] = pk4(((const f32x4*)pr)[lane]);
    }
    { float* SPL = (float*)(ws + WS_SMALL + SM_SPL);
      for (int i = blockIdx.x * 512 + tid; i < DH; i += G * 512) { const float xl = -a.in[I_LAM][i]; SPL[i] = -8.f * (fmaxf(xl, 0.f) + log1pf(expf(-fabsf(xl)))); } }
    float* AR = (float*)(ws + WS_SMALL + SM_AR); float* AI = (float*)(ws + WS_SMALL + SM_AI); float* A64R = (float*)(ws + WS_SMALL + SM_A64R); float* A64I = (float*)(ws + WS_SMALL + SM_A64I);
    bf16_t* BBB = (bf16_t*)(ws + WS_SMALL + SM_BBB); bf16_t* CMB = (bf16_t*)(ws + WS_SMALL + SM_CMB);
    for (int i = blockIdx.x * 512 + tid; i < 4096; i += G * 512) {
        const int g = i >> 6, p = i & 63;
        const float step = expf(a.in[I_LOGSTEP][g]), lr = a.in[I_LAMRE][i], li = a.in[I_LAMIM][i];
        const float mag = expf(lr * step); float sn, cs; sincosf(li * step, &sn, &cs);
        const float ar = mag * cs, ai = mag * sn, nr = ar - 1.f, ni = ai, den = lr * lr + li * li;
        const float cr = (nr * lr + ni * li) / den, ci = (ni * lr - nr * li) / den;
        AR[i] = ar; AI[i] = ai;
        float pr_ = ar, pi_ = ai;
#pragma unroll
        for (int q = 0; q < 6; ++q) { const float t0 = pr_ * pr_ - pi_ * pi_, t1 = 2.f * pr_ * pi_; pr_ = t0; pi_ = t1; }
        A64R[i] = pr_; A64I[i] = pi_;
        for (int c = 0; c < 16; ++c) {
            const float br = a.in[I_BRE][(size_t)i * 16 + c], bi = a.in[I_BIM][(size_t)i * 16 + c];
            BBB[((size_t)g * 128 + p) * 16 + c] = (bf16_t)(cvt_pk_bf16(cr * br - ci * bi, 0.f) & 0xffffu);
            BBB[((size_t)g * 128 + 64 + p) * 16 + c] = (bf16_t)(cvt_pk_bf16(cr * bi + ci * br, 0.f) & 0xffffu);
            CMB[((size_t)g * 16 + c) * 128 + p] = (bf16_t)(cvt_pk_bf16(a.in[I_CRE][((size_t)g * 16 + c) * 64 + p], 0.f) & 0xffffu);
            CMB[((size_t)g * 16 + c) * 128 + 64 + p] = (bf16_t)(cvt_pk_bf16(-a.in[I_CIM][((size_t)g * 16 + c) * 64 + p], 0.f) & 0xffffu);
        }
    }
}

__device__ __forceinline__ void s5_unit(const Args& a, LAS unsigned char* wl, int lane, int mode, int n, int g, int j) {
    unsigned char* ws = a.ws;
    const int fr = lane & 15, fq = lane >> 4;
    const float* AR = (const float*)(ws + WS_SMALL + SM_AR); const float* AI = (const float*)(ws + WS_SMALL + SM_AI);
    const bf16_t* BBB = (const bf16_t*)(ws + WS_SMALL + SM_BBB); const bf16_t* CMB = (const bf16_t*)(ws + WS_SMALL + SM_CMB);
    const bf16_t* Z = (const bf16_t*)(ws + WS_Z); bf16_t* YG = (bf16_t*)(ws + WS_YG); float* SUM = (float*)(ws + WS_S5SUM);
    LAS float* BuS = (LAS float*)wl; LAS bf16_t* Hs = (LAS bf16_t*)(wl + 8448);
    const float ar = AR[g * 64 + lane], ai = AI[g * 64 + lane];
    const bf16x8 zero8 = (bf16x8){0, 0, 0, 0, 0, 0, 0, 0};
    bf16x8 bb[8];
#pragma unroll
    for (int t = 0; t < 8; ++t) bb[t] = fq < 2 ? *(const bf16x8*)(BBB + ((size_t)g * 128 + 16 * t + fr) * 16 + 8 * fq) : zero8;
    bf16x8 cm[4];
#pragma unroll
    for (int kk = 0; kk < 4; ++kk) cm[kk] = *(const bf16x8*)(CMB + ((size_t)g * 16 + fr) * 128 + 32 * kk + 8 * fq);
    const f32x4 dsk = *(const f32x4*)(a.in[I_S5D] + 16 * g + 4 * fq);
    float hr = 0.f, hi = 0.f;
    if (mode == 1 && j > 0) {
        const float pr = ((const float*)(ws + WS_SMALL + SM_A64R))[g * 64 + lane], pi = ((const float*)(ws + WS_SMALL + SM_A64I))[g * 64 + lane];
        const float* sp = SUM + ((size_t)(n * 64 + g) * 32) * 128;
        for (int i = 0; i < j; ++i) { const float sr = sp[i * 128 + lane], si = sp[i * 128 + 64 + lane];
            const float t0 = pr * hr - pi * hi + sr, t1 = pr * hi + pi * hr + si; hr = t0; hi = t1; }
    }
    if (mode == 4 && j > 0) {
        float pr = ((const float*)(ws + WS_SMALL + SM_A64R))[g * 64 + lane], pi = ((const float*)(ws + WS_SMALL + SM_A64I))[g * 64 + lane];
#pragma unroll
        for (int q = 0; q < 2; ++q) { const float t0 = pr * pr - pi * pi, t1 = 2.f * pr * pi; pr = t0; pi = t1; }
        for (int v = 0; v < j; ++v) { const LAS float* ps = (const LAS float*)(wl + (v - j) * 16384 + 12800); const float sr = ps[lane], si = ps[64 + lane];
            const float t0 = pr * hr - pi * hi + sr, t1 = pr * hi + pi * hr + si; hr = t0; hi = t1; }
    }
    const int row0 = mode == 2 ? MP + 16 * j : ((mode == 3 || mode == 4) ? n * SEQ + 256 * j : n * SEQ + 64 * j);
    const int nblk = mode == 2 ? 1 : ((mode == 3 || mode == 1 || mode == 4) ? 16 : 4);
    for (int blk = 0; blk < nblk; ++blk) {
        const int r0 = row0 + 16 * blk;
        const bf16x8 ua = fq < 2 ? *(const bf16x8*)(Z + (size_t)(r0 + fr) * NZ + 16 * g + 8 * fq) : zero8;
        u32x2 u4raw = (u32x2){0u, 0u}; if (mode == 1 || mode == 2 || mode == 4) u4raw = *(const u32x2*)(Z + (size_t)(r0 + fr) * NZ + 16 * g + 4 * fq);
#pragma unroll
        for (int t = 0; t < 8; ++t) {
            const f32x4 c = __builtin_amdgcn_mfma_f32_16x16x32_bf16(ua, bb[t], (f32x4){0.f, 0.f, 0.f, 0.f}, 0, 0, 0);
#pragma unroll
            for (int jj = 0; jj < 4; ++jj) BuS[(4 * fq + jj) * 132 + 16 * t + fr] = c[jj];
        }
        LDS_WAIT();
        float burv[16], buiv[16];
#pragma unroll
        for (int t = 0; t < 16; ++t) { burv[t] = BuS[t * 132 + lane]; buiv[t] = BuS[t * 132 + 64 + lane]; }
#pragma unroll
        for (int t = 0; t < 16; ++t) {
            const float bur = burv[t], bui = buiv[t];
            if (mode == 2) { const size_t si = ((size_t)(r0 - MP + t) * 64 + g) * 64 + lane; hr = a.in[I_S5RE][si]; hi = a.in[I_S5IM][si]; }
            const float t0 = ar * hr - ai * hi + bur, t1 = ar * hi + ai * hr + bui; hr = t0; hi = t1;
            if (mode == 2) { const size_t si = ((size_t)(r0 - MP + t) * 64 + g) * 64 + lane; a.out[O_S5RS + si] = hr; a.out[O_S5IS + si] = hi; }
            if (mode == 1 || mode == 2 || mode == 4) { const unsigned w = cvt_pk_bf16(hr, hi); Hs[t * 136 + lane] = (bf16_t)(w & 0xffffu); Hs[t * 136 + 64 + lane] = (bf16_t)(w >> 16); }
        }
        if (mode == 1 || mode == 2 || mode == 4) {
            LDS_WAIT();
            f32x4 y = (f32x4){0.f, 0.f, 0.f, 0.f};
#pragma unroll
            for (int kk = 0; kk < 4; ++kk) { const bf16x8 hb = *(const LAS bf16x8*)(Hs + fr * 136 + 32 * kk + 8 * fq);
                y = __builtin_amdgcn_mfma_f32_16x16x32_bf16(cm[kk], hb, y, 0, 0, 0); }
            const f32x4 u4 = up4(u4raw); f32x4 o;
#pragma unroll
            for (int jj = 0; jj < 4; ++jj) o[jj] = gelu_t(y[jj] + dsk[jj] * u4[jj]);
            *(u32x2*)(YG + (size_t)(r0 + fr) * DH + 16 * g + 4 * fq) = pk4(o);
            LDS_WAIT();
        }
    }
    if (mode == 0) { float* sp = SUM + ((size_t)(n * 64 + g) * 32 + j) * 128; sp[lane] = hr; sp[64 + lane] = hi; }
    if (mode == 3) { LAS float* ps = (LAS float*)(wl + 12800); ps[lane] = hr; ps[64 + lane] = hi; }
    if (mode == 4 && j == 7) { a.out[O_S5RP + (size_t)(n * 64 + g) * 64 + lane] = hr; a.out[O_S5IP + (size_t)(n * 64 + g) * 64 + lane] = hi; }
}

__device__ __forceinline__ void conv_prompt(const Args& a) {
    unsigned char* ws = a.ws; const bf16_t* Z = (const bf16_t*)(ws + WS_Z); bf16_t* XC = (bf16_t*)(ws + WS_XC);
    const float* cw = a.in[I_CONVW]; const float* cb = a.in[I_CONVB];
    const int G = gridDim.x;
    for (int it = blockIdx.x * 512 + threadIdx.x; it < MP * 128; it += G * 512) {
        const int row = it >> 7, c = (it & 127) * 8, t = row & (SEQ - 1);
        float acc[8];
#pragma unroll
        for (int q = 0; q < 8; ++q) acc[q] = cb[c + q];
#pragma unroll
        for (int k = 0; k < 4; ++k) {
            if (t - 3 + k >= 0) {
                const u32x4 z = *(const u32x4*)(Z + (size_t)(row - 3 + k) * NZ + DH + c);
                const float x[8] = {bf_lo(z.x), bf_hi(z.x), bf_lo(z.y), bf_hi(z.y), bf_lo(z.z), bf_hi(z.z), bf_lo(z.w), bf_hi(z.w)};
#pragma unroll
                for (int q = 0; q < 8; ++q) acc[q] += cw[k * DH + c + q] * x[q];
                if (k == 3 && t >= SEQ - 3) {
                    float* o = a.out + O_CONVP + ((size_t)(row >> 11) * 3 + (t - (SEQ - 3))) * DH + c;
#pragma unroll
                    for (int q = 0; q < 8; ++q) o[q] = x[q];
                }
            }
        }
        u32x4 o; o.x = cvt_pk_bf16(acc[0], acc[1]); o.y = cvt_pk_bf16(acc[2], acc[3]); o.z = cvt_pk_bf16(acc[4], acc[5]); o.w = cvt_pk_bf16(acc[6], acc[7]);
        *(u32x4*)(XC + (size_t)row * DH + c) = o;
    }
}

__device__ __forceinline__ void conv_tile(const Args& a, int pm, int h) {
    unsigned char* ws = a.ws; const bf16_t* Z = (const bf16_t*)(ws + WS_Z); bf16_t* XC = (bf16_t*)(ws + WS_XC);
    const int tid = threadIdx.x, c = h * 256 + (tid & 31) * 8;
    float cwv[4][8], cbv[8];
#pragma unroll
    for (int q = 0; q < 8; ++q) { cbv[q] = a.in[I_CONVB][c + q];
#pragma unroll
        for (int k = 0; k < 4; ++k) cwv[k][q] = a.in[I_CONVW][k * DH + c + q]; }
#pragma unroll 1
    for (int r4 = 0; r4 < 16; r4 += 4) {
        u32x4 z[4][4];
#pragma unroll
        for (int rr = 0; rr < 4; ++rr) { const int row = pm * 256 + (tid >> 5) + 16 * (r4 + rr), t = row & (SEQ - 1);
#pragma unroll
            for (int k = 0; k < 4; ++k) z[rr][k] = (t - 3 + k >= 0) ? *(const u32x4*)(Z + (size_t)(row - 3 + k) * NZ + DH + c) : (u32x4){0u, 0u, 0u, 0u}; }
#pragma unroll
        for (int rr = 0; rr < 4; ++rr) { const int row = pm * 256 + (tid >> 5) + 16 * (r4 + rr), t = row & (SEQ - 1);
            float acc[8];
#pragma unroll
            for (int q = 0; q < 8; ++q) acc[q] = cbv[q];
#pragma unroll
            for (int k = 0; k < 4; ++k) { const u32x4 zz = z[rr][k];
                const float x[8] = {bf_lo(zz.x), bf_hi(zz.x), bf_lo(zz.y), bf_hi(zz.y), bf_lo(zz.z), bf_hi(zz.z), bf_lo(zz.w), bf_hi(zz.w)};
#pragma unroll
                for (int q = 0; q < 8; ++q) acc[q] += cwv[k][q] * x[q];
                if (k == 3 && t >= SEQ - 3) { float* o = a.out + O_CONVP + ((size_t)(row >> 11) * 3 + (t - (SEQ - 3))) * DH + c;
#pragma unroll
                    for (int q = 0; q < 8; ++q) o[q] = x[q]; } }
            u32x4 o; o.x = cvt_pk_bf16(acc[0], acc[1]); o.y = cvt_pk_bf16(acc[2], acc[3]); o.z = cvt_pk_bf16(acc[4], acc[5]); o.w = cvt_pk_bf16(acc[6], acc[7]);
            *(u32x4*)(XC + (size_t)row * DH + c) = o; }
    }
}

__device__ __forceinline__ void lru_sample(const Args& a, LAS unsigned char* lds, int unit) {
    unsigned char* ws = a.ws; const bf16_t* Z = (const bf16_t*)(ws + WS_Z); bf16_t* MG = (bf16_t*)(ws + WS_MERGED); float* ssB = (float*)(ws + WS_CTL) + SS_B * SS_STRIDE;
    LAS float* sxc = (LAS float*)lds;
    const int tid = threadIdx.x, s = unit >> 1, half = unit & 1, row = MP + s;
    const float* cw = a.in[I_CONVW]; const float* cs = a.in[I_CONV] + (size_t)s * 3 * DH;
    for (int c = tid; c < DH; c += 512) {
        const float xb = bf1(Z[(size_t)row * NZ + DH + c]);
        sxc[c] = a.in[I_CONVB][c] + cw[c] * cs[c] + cw[DH + c] * cs[DH + c] + cw[2 * DH + c] * cs[2 * DH + c] + cw[3 * DH + c] * xb;
        if ((c >> 9) == half) { float* o = a.out + O_CONVS + (size_t)s * 3 * DH; o[c] = cs[DH + c]; o[DH + c] = cs[2 * DH + c]; o[2 * DH + c] = xb; }
    }
    __syncthreads();
    float sq = 0.f;
    {
        const int c = half * 512 + tid, h = c >> 8, jj = c & 255;
        const float* wa = a.in[I_WA] + (size_t)h * 65536 + jj; const float* wi = a.in[I_WI] + (size_t)h * 65536 + jj;
        float ra = a.in[I_BA][c], ri = a.in[I_BI][c];
#pragma unroll 1
        for (int k0 = 0; k0 < 256; k0 += 32) {
            float wav[32], wiv[32];
#pragma unroll
            for (int q = 0; q < 32; ++q) { wav[q] = wa[(size_t)(k0 + q) * 256]; wiv[q] = wi[(size_t)(k0 + q) * 256]; }
#pragma unroll
            for (int q = 0; q < 32; ++q) { const float x = sxc[h * 256 + k0 + q]; ra += x * wav[q]; ri += x * wiv[q]; }
        }
        const float r = sigm(ra), ig = sigm(ri); const float xl = -a.in[I_LAM][c]; const float sp = fmaxf(xl, 0.f) + log1pf(expf(-fabsf(xl)));
        const float la = -8.f * r * sp, av = expf(la), bv = sqrtf(-expm1f(2.f * la)) * ig * sxc[c];
        const float hn = av * a.in[I_LRUH][(size_t)s * DH + c] + bv;
        a.out[O_LRUS + (size_t)s * DH + c] = hn;
        const float o = hn * gelu_t(bf1(Z[(size_t)row * NZ + 2 * DH + c]));
        MG[(size_t)row * DM + DH + c] = (bf16_t)(cvt_pk_bf16(o, 0.f) & 0xffffu);
        sq = o * o;
    }
    sq = wave_sum(sq);
    if ((tid & 63) == 0) atomicAdd(ssB + row, sq);
    __syncthreads();
}

__device__ __forceinline__ void lru_scan_unit(const Args& a, LAS unsigned char* lds, int unit) {
    unsigned char* ws = a.ws; const bf16_t* Z = (const bf16_t*)(ws + WS_Z); bf16_t* MG = (bf16_t*)(ws + WS_MERGED); float* ssB = (float*)(ws + WS_CTL) + SS_B * SS_STRIDE;
    const float* Ao = a.out; const float* Bo = a.out + (size_t)MP * DH;
    LAS float* sP = (LAS float*)lds; LAS float* sH = sP + 512; LAS float* rsum = sH + 512;
    const int tid = threadIdx.x, n = unit >> 6, ch = (unit & 63) * 16 + (tid & 15), j = tid >> 4;
    const size_t r0 = (size_t)n * SEQ + 64 * j;
    float P = 1.f, h = 0.f;
#pragma unroll 1
    for (int tb = 0; tb < 64; tb += 16) {
        float av[16], bv[16];
#pragma unroll
        for (int q = 0; q < 16; ++q) { av[q] = Ao[(r0 + tb + q) * DH + ch]; bv[q] = Bo[(r0 + tb + q) * DH + ch]; }
#pragma unroll
        for (int q = 0; q < 16; ++q) { h = av[q] * h + bv[q]; P *= av[q]; }
    }
    sP[tid] = P; sH[tid] = h;
    __syncthreads();
    float H = 0.f;
    for (int i = 0; i < j; ++i) H = sP[i * 16 + (tid & 15)] * H + sH[i * 16 + (tid & 15)];
    h = H;
#pragma unroll 1
    for (int tb = 0; tb < 64; tb += 16) {
        float av[16], bv[16]; bf16_t gz[16];
#pragma unroll
        for (int q = 0; q < 16; ++q) { const size_t row = r0 + tb + q; av[q] = Ao[row * DH + ch]; bv[q] = Bo[row * DH + ch]; gz[q] = Z[row * NZ + 2 * DH + ch]; }
#pragma unroll
        for (int q = 0; q < 16; ++q) {
            const size_t row = r0 + tb + q;
            h = av[q] * h + bv[q];
            const float o = h * gelu_t(bf1(gz[q]));
            MG[row * DM + DH + ch] = (bf16_t)(cvt_pk_bf16(o, 0.f) & 0xffffu);
            float s = o * o; s += __shfl_xor(s, 1); s += __shfl_xor(s, 2); s += __shfl_xor(s, 4); s += __shfl_xor(s, 8);
            if ((tid & 15) == 0) rsum[64 * j + tb + q] = s;
        }
    }
    __syncthreads();
    for (int r = tid; r < SEQ; r += 512) atomicAdd(ssB + (size_t)n * SEQ + r, rsum[r]);
    if (j == 31) a.out[O_LRUP + (size_t)n * DH + ch] = h;
    __syncthreads();
}

#define XB_TMO      128
#define XB_XCNT(j)  (256  + 64 * (j))
#define XB_XSUB(j)  (1280 + 64 * (j))
#define XB_XGEN(j)  (2304 + 64 * (j))
#define XB_TOP      3328
#define XB_TOPGEN   3392
#define XB_SPIN_CAP (1u << 18)
__device__ __forceinline__ unsigned xb_ld(unsigned* p)              { return __hip_atomic_load(p, __ATOMIC_RELAXED, __HIP_MEMORY_SCOPE_AGENT); }
__device__ __forceinline__ unsigned xb_add(unsigned* p, unsigned v) { return __hip_atomic_fetch_add(p, v, __ATOMIC_RELAXED, __HIP_MEMORY_SCOPE_AGENT); }
__device__ __forceinline__ unsigned xb_xcc_id() { return (unsigned)__builtin_amdgcn_s_getreg((3 << 11) | 20) & 0xFu; }
#define XB_SPIN(cond, bar) do { unsigned _sp = 0; while (cond) { __builtin_amdgcn_s_sleep(1); \
    if ((++_sp & 255u) == 0u) { if (xb_ld(&(bar)[XB_TMO])) break; if (_sp > XB_SPIN_CAP) { atomicAdd(&(bar)[XB_TMO], 1u); break; } } } } while (0)
struct XcdBarrier { unsigned* bar; unsigned x; volatile LAS unsigned* st; };
__device__ __forceinline__ XcdBarrier xcd_barrier_post(unsigned* bar, volatile LAS unsigned* st) {
    XcdBarrier b; b.bar = bar; b.x = xb_xcc_id(); b.st = st;
    if (threadIdx.x == 0) (void)xb_add(&bar[XB_XCNT(b.x)], 1u);
    return b;
}
__device__ __forceinline__ void xcd_barrier_complete(unsigned* bar, unsigned x, unsigned& nloc, unsigned& nx) {
    const unsigned G = gridDim.x * gridDim.y * gridDim.z;
    unsigned sum, cnt, mine, sp = 0u;
    for (;;) {
        sum = 0u; cnt = 0u; mine = 0u;
#pragma unroll
        for (unsigned j = 0; j < 16; ++j) { const unsigned c = xb_ld(&bar[XB_XCNT(j)]); sum += c; cnt += (c > 0u) ? 1u : 0u; mine = (j == x) ? c : mine; }
        if (sum == G) break;
        __builtin_amdgcn_s_sleep(1);
        if ((++sp & 255u) == 0u) { if (xb_ld(&bar[XB_TMO])) break; if (sp > XB_SPIN_CAP) { atomicAdd(&bar[XB_TMO], 1u); break; } }
    }
    nloc = mine > 0u ? mine : 1u; nx = cnt > 0u ? cnt : 1u;
}
__device__ __forceinline__ void xcd_barrier(const XcdBarrier& b) {
    asm volatile("s_waitcnt vmcnt(0)" ::: "memory");
    __syncthreads();
    if (threadIdx.x == 0) {
        unsigned* bar = b.bar;
        __builtin_amdgcn_s_waitcnt(0);
        unsigned nloc = b.st[0], nx = b.st[1];
        if (nloc == 0u) { xcd_barrier_complete(bar, b.x, nloc, nx); b.st[0] = nloc; b.st[1] = nx; }
        const unsigned old = xb_add(&bar[XB_XSUB(b.x)], 1u);
        const unsigned gen = old / nloc;
        if (old + 1u == (gen + 1u) * nloc) {
            __builtin_amdgcn_fence(__ATOMIC_RELEASE, "agent");
            asm volatile("s_waitcnt vmcnt(0)" ::: "memory");
            const unsigned og = xb_add(&bar[XB_TOP], 1u);
            const unsigned tg = og / nx;
            if (og + 1u == (tg + 1u) * nx) xb_add(&bar[XB_TOPGEN], 1u);
            else XB_SPIN(xb_ld(&bar[XB_TOPGEN]) == tg, bar);
            __builtin_amdgcn_fence(__ATOMIC_ACQUIRE, "agent");
            xb_add(&bar[XB_XGEN(b.x)], 1u);
            asm volatile("s_waitcnt vmcnt(0)" ::: "memory");
        } else {
            XB_SPIN(xb_ld(&bar[XB_XGEN(b.x)]) == gen, bar);
            __builtin_amdgcn_fence(__ATOMIC_ACQUIRE, "agent");
            asm volatile("s_waitcnt vmcnt(0)" ::: "memory");
        }
    }
    __syncthreads();
}

__global__ void __launch_bounds__(512, 2) fwd_kernel(Args a) {
    extern __shared__ __attribute__((aligned(16))) unsigned char lds_raw[];
    LAS unsigned char* lds = (LAS unsigned char*)lds_raw;
    const int tid = threadIdx.x, wave = __builtin_amdgcn_readfirstlane(tid >> 6), lane = tid & 63, G = gridDim.x;
    unsigned char* ws = a.ws;
    const int lo = a.ph_lo, hi = a.ph_hi;
    volatile LAS unsigned* MISC = (volatile LAS unsigned*)(lds + MISC_OFF);
    for (int u = tid; u < (LDS_BYTES - RING_BYTES) / 4; u += 512) ((LAS unsigned*)(lds + RING_BYTES))[u] = 0u;
    __syncthreads();
#if MK_LAUNCHES == 1
    XcdBarrier bar = xcd_barrier_post((unsigned*)(ws + WS_CTL) + CW_BAR, MISC + 8);
#define GRID_BAR() xcd_barrier(bar)
#else
#define GRID_BAR() do {} while (0)
#endif
#define IN(k) (lo <= (k) && (k) < hi)
#define BOTH(k) (IN(k) && IN((k) + 1))
#define ssb ((float*)(ws + WS_CTL))
#define AB ((bf16_t*)(ws + WS_AB))
#define Z ((bf16_t*)(ws + WS_Z))
#define YG ((bf16_t*)(ws + WS_YG))
#define MG ((bf16_t*)(ws + WS_MERGED))
#define HUP ((bf16_t*)(ws + WS_HUP))
#define PW ((bf16_t*)(ws + WS_PW))
#define PB ((bf16_t*)(ws + WS_PB))
#define XO (a.out + O_Y)

    if (IN(0)) { phase0(a, lds); if (BOTH(0)) GRID_BAR(); }

    if (IN(1)) {
        pg8::Gemm g{AB, (const bf16_t*)(ws + WS_WIN), DM, DM, DM, 0}; pg8::StaticOrder S; S.init(MP / 256, NZ / 256, G, (int)blockIdx.x);
        EpiWrap<EIn> E{{nullptr, (const float*)(ws + WS_SMALL + SM_RS0), Z}};
        pg8::gemm_phase<EpiWrap<EIn>, true>(lds, g, S, E);
        skinny_gemm<EIn, 8, 2>(lds, AB + (size_t)MP * DM, DM, (const bf16_t*)(ws + WS_WIN), DM, NZ, DM, E.e, G / 2);
        if (BOTH(1)) GRID_BAR();
    }

    if (IN(3)) {
        pg8::Gemm g{(const bf16_t*)(ws + WS_XC), (const bf16_t*)(ws + WS_WLRU), DH, 256, 256, 1}; pg8::StaticOrder S; S.init(MP / 256, 8, G, (int)blockIdx.x);
        { pg8::Unit cu; for (int i = 0; S.next(i, cu); ++i) conv_tile(a, cu.pm, cu.pn >> 1); }
        asm volatile("s_waitcnt vmcnt(0)" ::: "memory"); __syncthreads();
        ELru E{(const bf16_t*)(ws + WS_XC), a.in[I_BA], a.in[I_BI], (const float*)(ws + WS_SMALL + SM_SPL), a.out, a.out + (size_t)MP * DH};
        pg8::gemm_phase<ELru, true>(lds, g, S, E);
        for (int s = G - 1 - (int)blockIdx.x; s < 2 * MS; s += G) lru_sample(a, lds, s);
        for (int u = blockIdx.x; u < NB * 64; u += G) {
            const int n = u >> 6, g2 = u & 63;
            s5_unit(a, lds + wave * 16384, lane, 3, n, g2, wave);
            __syncthreads();
            s5_unit(a, lds + wave * 16384, lane, 4, n, g2, wave);
            __syncthreads();
        }
        for (int u = blockIdx.x * 8 + wave; u < 512; u += G * 8) s5_unit(a, lds + wave * 16384, lane, 2, 0, u >> 3, u & 7);
        if (BOTH(3)) GRID_BAR();
    }

    if (IN(4)) {
        pg8::Gemm g{YG, (const bf16_t*)(ws + WS_WGLU), DH, DH, DH, 0}; pg8::StaticOrder S; S.init(MP / 256, DH / 256, G, (int)blockIdx.x);
        EpiWrap<EGlu> E{{ssb + SS_A * SS_STRIDE, a.in[I_BGLU], YG, MG}};
        pg8::gemm_phase<EpiWrap<EGlu>, true>(lds, g, S, E);
        skinny_gemm<EGlu, 4>(lds, YG + (size_t)MP * DH, DH, (const bf16_t*)(ws + WS_WGLU), DH, DH, DH, E.e);
        for (int u = G - 1 - (int)blockIdx.x; u < NB * 64; u += G) lru_scan_unit(a, lds, u);
        if (BOTH(4)) GRID_BAR();
    }

    if (IN(5)) {
        pg8::Gemm g{MG, (const bf16_t*)(ws + WS_WOUT), DM, DM, DM, 0}; pg8::StaticOrder S; S.init(MP / 256, DM / 256, G, (int)blockIdx.x);
        { float* RAT = (float*)(ws + WS_SMALL + SM_RAT); float* RSB = (float*)(ws + WS_SMALL + SM_RSB);
          pg8::Unit cu;
          for (int ui = -1; ui < 0 || S.next(ui, cu); ++ui)
              for (int i = tid; i < (ui < 0 ? MS : 256); i += 512) { const int row = ui < 0 ? MP + i : cu.pm * 256 + i;
                  const float va = ssb[SS_A * SS_STRIDE + row] * (1.f / DH) + EPS, vb = ssb[SS_B * SS_STRIDE + row] * (1.f / DH) + EPS; RAT[row] = sqrtf(vb / va); RSB[row] = rsqrtf(vb); }
          asm volatile("s_waitcnt vmcnt(0)" ::: "memory"); __syncthreads(); }
        EpiWrap<EOut> E{{ssb + SS_1 * SS_STRIDE, (const float*)(ws + WS_SMALL + SM_RAT), (const float*)(ws + WS_SMALL + SM_RSB), a.in[I_XP], a.in[I_XS], XO, AB}};
        pg8::gemm_phase<EpiWrap<EOut>, true>(lds, g, S, E);
        skinny_gemm<EOut, 4>(lds, MG + (size_t)MP * DM, DM, (const bf16_t*)(ws + WS_WOUT), DM, DM, DM, E.e);
        if (BOTH(5)) GRID_BAR();
    }

    if (IN(6)) {
        pg8::Gemm g{AB, (const bf16_t*)(ws + WS_WUP), DM, DM, DM, 0}; pg8::StaticOrder S; S.init(MP / 256, DFF / 256, G, (int)blockIdx.x);
        EpiWrap<EUp> E{{nullptr, ssb + SS_1 * SS_STRIDE, HUP}};
        pg8::gemm_phase<EpiWrap<EUp>, true>(lds, g, S, E);
        skinny_gemm<EUp, 8, 2>(lds, AB + (size_t)MP * DM, DM, (const bf16_t*)(ws + WS_WUP), DM, DFF, DM, E.e);
        if (BOTH(6)) GRID_BAR();
    }

    if (IN(7)) {
        pg8::Gemm g{HUP, (const bf16_t*)(ws + WS_WDOWN), DFF, DFF, DFF, 0}; pg8::StaticOrder S; S.init(MP / 256, DM / 256, G, (int)blockIdx.x);
        EpiWrap<EDown> E{{ssb + SS_2 * SS_STRIDE, XO, AB}};
        pg8::gemm_phase<EpiWrap<EDown>, true>(lds, g, S, E);
        skinny_gemm<EDown, 4>(lds, HUP + (size_t)MP * DFF, DFF, (const bf16_t*)(ws + WS_WDOWN), DFF, DM, DFF, E.e);
        if (BOTH(7)) GRID_BAR();
    }

    if (IN(8)) {
        { pg8::Gemm g{PB, (const bf16_t*)(ws + WS_WPLE), DPLE, DPLE, DPLE, 0}; pg8::StaticOrder S; S.init(MP / 256, DM / 256, G, (int)blockIdx.x);
          EpiWrap<EPw> E{{nullptr, PW}};
          pg8::gemm_phase<EpiWrap<EPw>, true>(lds, g, S, E);
          skinny_gemm<EPw, 4>(lds, PB + (size_t)MP * DPLE, DPLE, (const bf16_t*)(ws + WS_WPLE), DPLE, DM, DPLE, E.e); }
        asm volatile("s_waitcnt vmcnt(0)" ::: "memory"); __syncthreads();
        { pg8::Gemm g{AB, (const bf16_t*)(ws + WS_WGATE), DM, DM, DM, 0}; pg8::StaticOrder S; S.init(MP / 256, DM / 256, G, (int)blockIdx.x);
          EpiWrap<EGate> E{{ssb + SS_3 * SS_STRIDE, ssb + SS_2 * SS_STRIDE, PW, XO}};
          pg8::gemm_phase<EpiWrap<EGate>, true>(lds, g, S, E);
          skinny_gemm<EGate, 4>(lds, AB + (size_t)MP * DM, DM, (const bf16_t*)(ws + WS_WGATE), DM, DM, DM, E.e); }
        if (BOTH(8)) GRID_BAR();
    }

    if (IN(9)) {
        const float* ss3 = ssb + SS_3 * SS_STRIDE; const float* gf = a.in[I_GFIN];
        f32x4 gv[8];
#pragma unroll
        for (int j = 0; j < 8; ++j) gv[j] = ((const f32x4*)gf)[lane + 64 * j];
        for (int row = blockIdx.x * 8 + wave; row < MT; row += 2 * G * 8) {
            const int row2 = row + G * 8; const bool has2 = row2 < MT; const int r2 = has2 ? row2 : row;
            f32x4* xa = (f32x4*)(XO + (size_t)row * DM); f32x4* xb2 = (f32x4*)(XO + (size_t)r2 * DM);
            f32x4 va[8], vb[8];
#pragma unroll
            for (int j = 0; j < 8; ++j) { va[j] = xa[lane + 64 * j]; vb[j] = xb2[lane + 64 * j]; }
            const float rsa = rsqrtf(ss3[row] * (1.f / DM) + EPS), rsb2 = rsqrtf(ss3[r2] * (1.f / DM) + EPS);
#pragma unroll
            for (int j = 0; j < 8; ++j) xa[lane + 64 * j] = va[j] * rsa * gv[j];
            if (has2) {
#pragma unroll
                for (int j = 0; j < 8; ++j) xb2[lane + 64 * j] = vb[j] * rsb2 * gv[j];
            }
        }
    }
#if MK_LAUNCHES == 1
    if (lo > hi) cg::this_grid().sync();
#endif
}

#undef ssb
#undef AB
#undef Z
#undef YG
#undef MG
#undef HUP
#undef PW
#undef PB
#undef XO
extern "C" void kernel_launch(void* const* d_in, const int* in_sizes, int n_in, void* d_out, int out_size, void* d_ws, size_t ws_size, hipStream_t stream) {
    static int grid = 0;
    if (grid == 0) {
        int dev = 0, cus = 0;
        if (n_in != 37 || ws_size < WS_END) { fprintf(stderr, "kernel_launch: unexpected inputs (n_in %d, ws %zu)\n", n_in, ws_size); grid = -1; return; }
        if (hipGetDevice(&dev) != hipSuccess || hipDeviceGetAttribute(&cus, hipDeviceAttributeMultiprocessorCount, dev) != hipSuccess) { grid = -1; return; }
        if (hipFuncSetAttribute((const void*)fwd_kernel, hipFuncAttributeMaxDynamicSharedMemorySize, LDS_BYTES) != hipSuccess) { fprintf(stderr, "kernel_launch: hipFuncSetAttribute failed\n"); grid = -1; return; }
        int per_cu = 0;
        if (hipOccupancyMaxActiveBlocksPerMultiprocessor(&per_cu, (const void*)fwd_kernel, 512, LDS_BYTES) != hipSuccess || per_cu < 1) { fprintf(stderr, "kernel_launch: occupancy query %d\n", per_cu); }
        (void)hipGetLastError();
        grid = cus;
    }
    if (grid < 0) return;
    (void)hipMemsetAsync((char*)d_ws + WS_CTL, 0, CTL_ZERO_BYTES, stream);
    Args a{};
    for (int i = 0; i < 37; ++i) a.in[i] = (const float*)d_in[i];
    a.out = (float*)d_out; a.ws = (unsigned char*)d_ws;
#if MK_LAUNCHES == 1
    a.ph_lo = 0; a.ph_hi = NPHASE;
    void* args[] = {&a};
    hipError_t e = hipLaunchCooperativeKernel((const void*)fwd_kernel, dim3(grid), dim3(512), args, LDS_BYTES, stream);
    if (e != hipSuccess) fprintf(stderr, "cooperative launch failed: %s (grid %d)\n", hipGetErrorString(e), grid);
#else
    for (int ph = 0; ph < NPHASE; ++ph) {
        a.ph_lo = ph; a.ph_hi = ph + 1;
        hipLaunchKernelGGL(fwd_kernel, dim3(grid), dim3(512), LDS_BYTES, stream, a);
    }
#endif
}
```

```cpp
#include <hip/hip_runtime.h>
#include <hip/hip_cooperative_groups.h>
#include <cstdio>
#include <cstdint>
namespace cg = cooperative_groups;

#ifndef MK_LAUNCHES
#define MK_LAUNCHES 1
#endif

#define LAS __attribute__((address_space(3)))
typedef unsigned short bf16_t;
typedef short bf16x8 __attribute__((ext_vector_type(8)));
typedef float f32x4 __attribute__((ext_vector_type(4)));
typedef unsigned u32x4 __attribute__((ext_vector_type(4)));
typedef unsigned u32x2 __attribute__((ext_vector_type(2)));

constexpr int DM = 2048, SEQ = 2048, NB = 4, MP = 8192, MS = 128, MT = 8320;
constexpr int NZ = 3072, DFF = 8192, DPLE = 256, DH = 1024;
constexpr float EPS = 1e-6f;
constexpr int NPHASE = 10;

constexpr size_t MiB = 1u << 20;
constexpr size_t WS_CTL = 0, CTL_ZERO_BYTES = 1 * MiB;
constexpr int SS_STRIDE = 8448;
constexpr int SS_A = 0, SS_B = 1, SS_1 = 2, SS_2 = 3, SS_3 = 4;
constexpr int CW_BAR = 65536;
constexpr size_t WS_SMALL = 1 * MiB;
constexpr size_t SM_RS0 = 0, SM_AR = 65536, SM_AI = SM_AR + 16384, SM_A64R = SM_AI + 16384, SM_A64I = SM_A64R + 16384,
                 SM_BBB = SM_A64I + 16384  , SM_CMB = SM_BBB + 262144  , SM_SPL = SM_CMB + 262144  , SM_RAT = 663552  , SM_RSB = SM_RAT + 34816  ;
constexpr size_t WS_WUP = 2 * MiB, WS_WDOWN = 34 * MiB, WS_WGATE = 66 * MiB, WS_WPLE = 74 * MiB, WS_PB = 75 * MiB, WS_AB = 80 * MiB;
constexpr size_t WS_E = 113 * MiB;
constexpr size_t WS_HUP = WS_E, WS_PW = WS_E;
constexpr size_t WS_WIN = 113 * MiB, WS_WGLU = 125 * MiB, WS_WOUT = 127 * MiB, WS_WLRU = 135 * MiB, WS_Z = 136 * MiB,
                 WS_YG = 185 * MiB, WS_MERGED = 202 * MiB, WS_XC = 235 * MiB, WS_S5SUM = 251 * MiB, WS_END = 255 * MiB;
static_assert(WS_HUP + (size_t)MT * DFF * 2 <= 256 * MiB, "hup fits");
static_assert(WS_Z + (size_t)MT * NZ * 2 <= WS_YG && WS_YG + (size_t)MT * DH * 2 <= WS_MERGED && WS_MERGED + (size_t)MT * DM * 2 <= WS_XC, "map");
static_assert(WS_AB + (size_t)MT * DM * 2 <= WS_E && WS_PB + (size_t)MT * DPLE * 2 <= WS_AB, "map2");

constexpr size_t O_Y = 0, O_S5RP = 17039360, O_S5IP = 17055744, O_LRUP = 17072128, O_CONVP = 17076224,
                 O_S5RS = 17088512, O_S5IS = 17612800, O_LRUS = 18137088, O_CONVS = 18268160;

constexpr int RING_BYTES = 131072, MISC_OFF = RING_BYTES + 320, LDS_BYTES = 147456;

__device__ __forceinline__ unsigned cvt_pk_bf16(float lo, float hi) { unsigned r; asm("v_cvt_pk_bf16_f32 %0, %1, %2" : "=v"(r) : "v"(lo), "v"(hi)); return r; }
__device__ __forceinline__ float bf_lo(unsigned u) { return __uint_as_float(u << 16); }
__device__ __forceinline__ float bf_hi(unsigned u) { return __uint_as_float(u & 0xffff0000u); }
__device__ __forceinline__ float bf1(bf16_t u) { return __uint_as_float(((unsigned)u) << 16); }
__device__ __forceinline__ float sigm(float x) { return __builtin_amdgcn_rcpf(1.f + __expf(-x)); }
__device__ __forceinline__ float gelu_t(float x) { const float u = 1.5957691216057308f * (x + 0.044715f * x * x * x); return x * __builtin_amdgcn_rcpf(1.f + __expf(-u)); }
__device__ __forceinline__ float wave_sum(float v) {
#pragma unroll
    for (int o = 1; o < 64; o <<= 1) v += __shfl_xor(v, o);
    return v;
}
#define LDS_WAIT() asm volatile("s_waitcnt lgkmcnt(0)" ::: "memory")

namespace pg8 {
constexpr int BM = 256, BK = 64, HALF = 128, HTB = HALF * BK * 2, STAGE_BYTES = 8 * HTB, NXCD = 8, WGM = 8;
__host__ __device__ __forceinline__ int lds_byte(int r, int c) { const int st = (r >> 4) * 2 + (c >> 5), rr = r & 15, cc = c & 31, ob = rr * 64 + cc * 2; return st * 1024 + (ob ^ (((ob >> 9) & 1) << 5)); }
__host__ __device__ __forceinline__ void stage_rc(int b, int& R, int& C) { const int st = b / 1024, sb = b % 1024, swz = sb ^ (((sb >> 9) & 1) << 5); R = (st >> 1) * 16 + swz / 64; C = (st & 1) * 32 + (swz % 64) / 2; }
__host__ __device__ __forceinline__ int perm32(int rho) { const int n = rho >> 4, i = rho & 15; return 8 * (i >> 2) + 4 * n + (i & 3); }
struct Unit { int pm, pn; };
struct Gemm { const bf16_t* A; const bf16_t* Bt; int lda, ldb, K, akmode; };
struct StaticOrder {
    int nM, nN, nwg, G, c;
    __device__ __forceinline__ void init(int nM_, int nN_, int G_, int c_) { nM = nM_; nN = nN_; nwg = nM * nN; G = G_; c = c_; }
    __device__ __forceinline__ bool next(int i, Unit& u) const {
        const long L = (long)i * G + c; if (L >= nwg) return false;
        int wgid = (int)L; { const int q = nwg / NXCD, r = nwg % NXCD, xcd = wgid % NXCD, off = wgid / NXCD; wgid = (xcd < r ? xcd * (q + 1) : r * (q + 1) + (xcd - r) * q) + off; }
        const int nig = WGM * nN, gid = wgid / nig, fm = gid * WGM, gsz = (nM - fm) < WGM ? (nM - fm) : WGM;
        u.pm = fm + ((wgid % nig) % gsz); u.pn = (wgid % nig) / gsz; return true;
    }
};

template <class Epi, bool ALIGN_EPI>
__device__ __forceinline__ void gemm_phase(LAS unsigned char* lds, const Gemm g, const StaticOrder& S, const Epi& E) {
    const int tid = threadIdx.x, wid = __builtin_amdgcn_readfirstlane(tid >> 6), lane = tid & 63, wr = wid >> 2, wc = wid & 3, fr = lane & 15, fq = lane >> 4;
    int K = g.K; asm volatile("" : "+s"(K));
    const int nt = K / BK;
    unsigned voffA[2], voffB[2];
#pragma unroll
    for (int i = 0; i < 2; ++i) { int R, C; stage_rc(tid * 16 + i * 8192, R, C);
        const int Rb = Epi::PERM ? ((R & ~31) + perm32(R & 31)) : R;
        voffA[i] = (unsigned)(R * g.lda + C) * 2u; voffB[i] = (unsigned)(Rb * g.ldb + C) * 2u; }
    const size_t kstep = (size_t)(BK * 2);
    const size_t hstepA = (size_t)HALF * g.lda * 2, hstepB = (size_t)HALF * g.ldb * 2;
    const size_t tstepA = 2 * hstepA, tstepB = 2 * hstepB;
    const unsigned ldsw = (unsigned)wid * 1024u;
    const int aoff = lds_byte(wr * 64 + fr, fq * 8), boff = lds_byte(wc * 32 + fr, fq * 8);
#define PG8_SA(b, h) (((b) * 2 + (h)) * HTB)
#define PG8_SB(b, h) ((4 + (b) * 2 + (h)) * HTB)
#define PG8_STAGE(bufoff, gbase, voff) do { _Pragma("unroll") for (int _i = 0; _i < 2; ++_i) \
        __builtin_amdgcn_global_load_lds((const unsigned*)((const char*)(gbase) + (voff)[_i]), (LAS unsigned*)(lds + (bufoff) + ldsw + _i * 8192), 16, 0, 0); } while (0)
#define PG8_LDA(dst, b, h) do { _Pragma("unroll") for (int m = 0; m < 4; ++m) _Pragma("unroll") for (int k = 0; k < 2; ++k) dst[m][k] = *(const LAS bf16x8*)(lds + PG8_SA(b, h) + aoff + m * 2048 + k * 1024); } while (0)
#define PG8_LDB(dst, b, h) do { _Pragma("unroll") for (int n = 0; n < 2; ++n) _Pragma("unroll") for (int k = 0; k < 2; ++k) dst[n][k] = *(const LAS bf16x8*)(lds + PG8_SB(b, h) + boff + n * 2048 + k * 1024); } while (0)
#define PG8_MMA(ai, bj, At, Bt) do { __builtin_amdgcn_s_setprio(1); _Pragma("unroll") for (int m = 0; m < 4; ++m) _Pragma("unroll") for (int n = 0; n < 2; ++n) _Pragma("unroll") for (int k = 0; k < 2; ++k) \
        acc[ai][bj][m][n] = __builtin_amdgcn_mfma_f32_16x16x32_bf16(Bt[n][k], At[m][k], acc[ai][bj][m][n], 0, 0, 0); __builtin_amdgcn_s_setprio(0); } while (0)
#define PG8_WAIT_V(n) asm volatile("s_waitcnt vmcnt(" #n ")" ::: "memory")
#define PG8_WAIT_L(n) asm volatile("s_waitcnt lgkmcnt(" #n ")" ::: "memory")
#define PG8_BAR __builtin_amdgcn_s_barrier()
#define PG8_SCHED __builtin_amdgcn_sched_barrier(0)
    Unit cur, nxt; int ui = 0;
    if (!S.next(0, cur)) return;
    f32x4 acc[2][2][4][2];
#pragma unroll
    for (int a = 0; a < 2; ++a)
#pragma unroll
        for (int b = 0; b < 2; ++b)
#pragma unroll
            for (int m = 0; m < 4; ++m)
#pragma unroll
                for (int n = 0; n < 2; ++n) acc[a][b][m][n] = (f32x4){0.f, 0.f, 0.f, 0.f};
    bf16x8 At[4][2], B0[2][2], B1[2][2];
    const char* cA = (const char*)g.A + (size_t)cur.pm * tstepA + (g.akmode ? (size_t)(cur.pn >> 1) * 512 : 0);
    const char* cB = (const char*)g.Bt + (size_t)cur.pn * tstepB;
    PG8_STAGE(PG8_SB(0, 0), cB, voffB); PG8_STAGE(PG8_SB(0, 1), cB + hstepB, voffB); PG8_STAGE(PG8_SA(0, 0), cA, voffA); PG8_STAGE(PG8_SA(0, 1), cA + hstepA, voffA);
    if (wr == 1) PG8_BAR;
    PG8_WAIT_V(2); PG8_BAR;
    PG8_STAGE(PG8_SB(1, 0), cB + kstep, voffB); PG8_STAGE(PG8_SA(1, 0), cA + kstep, voffA); PG8_STAGE(PG8_SB(1, 1), cB + hstepB + kstep, voffB);
    PG8_WAIT_V(6); PG8_BAR;
    for (;;) {
        const bool has_next = S.next(ui + 1, nxt);
        const char* nA = has_next ? (const char*)g.A + (size_t)nxt.pm * tstepA + (g.akmode ? (size_t)(nxt.pn >> 1) * 512 : 0) : cA;
        const char* nB = has_next ? (const char*)g.Bt + (size_t)nxt.pn * tstepB : cB;
        for (int t = 0; t < nt; t += 2) {
            const bool last = (t == nt - 2);
            const char* a1 = cA + (size_t)(t + 1) * kstep;
            const char* a2 = last ? nA : cA + (size_t)(t + 2) * kstep; const char* b2 = last ? nB : cB + (size_t)(t + 2) * kstep;
            const char* a3 = a2 + kstep; const char* b3 = b2 + kstep;
            if constexpr (Epi::MID) { if (t == (nt >> 1)) E.mid(acc, cur, wr, fr); }
            PG8_LDB(B0, 0, 0); PG8_LDB(B1, 0, 1); PG8_SCHED; PG8_LDA(At, 0, 0); PG8_STAGE(PG8_SA(1, 1), a1 + hstepA, voffA);
            PG8_WAIT_V(8); PG8_WAIT_L(0); PG8_BAR; PG8_MMA(0, 0, At, B0); PG8_MMA(0, 1, At, B1); PG8_BAR; PG8_SCHED;
            PG8_LDA(At, 0, 1); PG8_STAGE(PG8_SB(0, 0), b2, voffB); PG8_STAGE(PG8_SB(0, 1), b2 + hstepB, voffB); PG8_STAGE(PG8_SA(0, 0), a2, voffA);
            PG8_WAIT_V(8); PG8_WAIT_L(0); PG8_BAR; PG8_MMA(1, 0, At, B0); PG8_MMA(1, 1, At, B1); PG8_BAR; PG8_SCHED;
            PG8_LDB(B0, 1, 0); PG8_LDB(B1, 1, 1); PG8_SCHED; PG8_LDA(At, 1, 0); PG8_STAGE(PG8_SA(0, 1), a2 + hstepA, voffA);
            PG8_WAIT_V(8); PG8_WAIT_L(0); PG8_BAR; PG8_MMA(0, 0, At, B0); PG8_MMA(0, 1, At, B1); PG8_BAR; PG8_SCHED;
            PG8_LDA(At, 1, 1); PG8_STAGE(PG8_SB(1, 0), b3, voffB); PG8_STAGE(PG8_SB(1, 1), b3 + hstepB, voffB); PG8_STAGE(PG8_SA(1, 0), a3, voffA);
            PG8_WAIT_V(8); PG8_WAIT_L(0); PG8_BAR; PG8_MMA(1, 0, At, B0); PG8_MMA(1, 1, At, B1); PG8_BAR; PG8_SCHED;
        }
        if constexpr (ALIGN_EPI) { if (wr == 0) PG8_BAR; }
        E(acc, cur, wr, wc, fr, fq);
        if (!has_next) break;
#pragma unroll
        for (int a = 0; a < 2; ++a)
#pragma unroll
            for (int b = 0; b < 2; ++b)
#pragma unroll
                for (int m = 0; m < 4; ++m)
#pragma unroll
                    for (int n = 0; n < 2; ++n) acc[a][b][m][n] = (f32x4){0.f, 0.f, 0.f, 0.f};
        cur = nxt; cA = nA; cB = nB; ++ui;
        if constexpr (ALIGN_EPI) { if (wr == 1) PG8_BAR; }
    }
    PG8_WAIT_V(0);
    if constexpr (!ALIGN_EPI) { if (wr == 0) PG8_BAR; }
    PG8_BAR;
#undef PG8_SA
#undef PG8_SB
#undef PG8_STAGE
#undef PG8_LDA
#undef PG8_LDB
#undef PG8_MMA
#undef PG8_WAIT_V
#undef PG8_WAIT_L
#undef PG8_BAR
#undef PG8_SCHED
}
}

template <class E> struct EpiWrap {
    E e; static constexpr bool MID = E::MID, PERM = E::PERM;
    __device__ __forceinline__ void operator()(const f32x4 (&acc)[2][2][4][2], const pg8::Unit& u, int wr, int wc, int fr, int fq) const {
        if constexpr (E::HAS_RES) {
            f32x4 rc[2][2], rn[2][2];
            { const int row = u.pm * 256 + wr * 64 + fr;
#pragma unroll
              for (int bj = 0; bj < 2; ++bj)
#pragma unroll
                  for (int n = 0; n < 2; ++n) rc[bj][n] = e.res(row, u.pn * 256 + bj * 128 + wc * 32 + 8 * fq + 4 * n); }
#pragma unroll
            for (int idx = 0; idx < 8; ++idx) {
                const int ai = idx >> 2, m = idx & 3;
                const int row = u.pm * 256 + ai * 128 + wr * 64 + m * 16 + fr; const float rv = e.rowval(row); float s = 0.f;
                if (idx < 7) { const int rown = u.pm * 256 + ((idx + 1) >> 2) * 128 + wr * 64 + ((idx + 1) & 3) * 16 + fr;
#pragma unroll
                    for (int bj = 0; bj < 2; ++bj)
#pragma unroll
                        for (int n = 0; n < 2; ++n) rn[bj][n] = e.res(rown, u.pn * 256 + bj * 128 + wc * 32 + 8 * fq + 4 * n); }
#pragma unroll
                for (int bj = 0; bj < 2; ++bj) s += e.applyr8(row, u.pn * 256 + bj * 128 + wc * 32 + 8 * fq, acc[ai][bj][m][0], acc[ai][bj][m][1], rv, rc[bj][0], rc[bj][1]);
                if constexpr (E::HAS_SS) { s += __shfl_xor(s, 16); s += __shfl_xor(s, 32); if (fq == 0) atomicAdd(e.ss + row, s); }
                asm volatile("" ::: "memory");
#pragma unroll
                for (int bj = 0; bj < 2; ++bj)
#pragma unroll
                    for (int n = 0; n < 2; ++n) rc[bj][n] = rn[bj][n];
            }
            return;
        }
        if constexpr (E::PERM && !E::HAS_RES) {
#pragma unroll
            for (int ai = 0; ai < 2; ++ai)
#pragma unroll
                for (int m = 0; m < 4; ++m) {
                    const int row = u.pm * 256 + ai * 128 + wr * 64 + m * 16 + fr; const float rv = e.rowval(row); float s = 0.f;
#pragma unroll
                    for (int bj = 0; bj < 2; ++bj) s += e.apply8(row, u.pn * 256 + bj * 128 + wc * 32 + 8 * fq, acc[ai][bj][m][0], acc[ai][bj][m][1], rv);
                    if constexpr (E::HAS_SS) { s += __shfl_xor(s, 16); s += __shfl_xor(s, 32); if (fq == 0) atomicAdd(e.ss + row, s); }
                    asm volatile("" ::: "memory");
                }
            return;
        }
#pragma unroll
        for (int ai = 0; ai < 2; ++ai)
#pragma unroll
            for (int m = 0; m < 4; ++m) {
                const int row = u.pm * 256 + ai * 128 + wr * 64 + m * 16 + fr; const float rv = e.rowval(row); float s = 0.f;
#pragma unroll
                for (int bj = 0; bj < 2; ++bj)
#pragma unroll
                    for (int n = 0; n < 2; ++n) s += e.apply(row, u.pn * 256 + bj * 128 + wc * 32 + n * 16 + 4 * fq, acc[ai][bj][m][n], rv);
                if constexpr (E::HAS_SS) { s += __shfl_xor(s, 16); s += __shfl_xor(s, 32); if (fq == 0) atomicAdd(e.ss + row, s); }
                asm volatile("" ::: "memory");
            }
    }
    __device__ __forceinline__ void mid(f32x4 (&acc)[2][2][4][2], const pg8::Unit& u, int wr, int fr) const {
#pragma unroll
        for (int ai = 0; ai < 2; ++ai)
#pragma unroll
            for (int m = 0; m < 4; ++m) { const float r = e.kscale(u.pm * 256 + ai * 128 + wr * 64 + m * 16 + fr, 0);
#pragma unroll
                for (int bj = 0; bj < 2; ++bj)
#pragma unroll
                    for (int n = 0; n < 2; ++n) acc[ai][bj][m][n] = acc[ai][bj][m][n] * r; }
    }
};
__device__ __forceinline__ u32x2 pk4(f32x4 v) { u32x2 w; w.x = cvt_pk_bf16(v[0], v[1]); w.y = cvt_pk_bf16(v[2], v[3]); return w; }
__device__ __forceinline__ f32x4 up4(u32x2 w) { return (f32x4){bf_lo(w.x), bf_hi(w.x), bf_lo(w.y), bf_hi(w.y)}; }
__device__ __forceinline__ float ssq4(f32x4 v) { return (v[0] * v[0] + v[1] * v[1]) + (v[2] * v[2] + v[3] * v[3]); }

struct EIn {
    static constexpr bool HAS_RES = false, PERM = true; static constexpr bool MID = false, HAS_SS = false; float* ss; const float* rs0; bf16_t* Z;
    __device__ __forceinline__ float rowval(int row) const { return rs0[row]; }
    __device__ __forceinline__ float kscale(int, int) const { return 1.f; }
    __device__ __forceinline__ float apply(int row, int col, f32x4 v, float rv) const { *(u32x2*)(Z + (size_t)row * NZ + col) = pk4(v * rv); return 0.f; }
    __device__ __forceinline__ float apply8(int row, int col, f32x4 v0, f32x4 v1, float rv) const { u32x4 w; { const u32x2 a0 = pk4(v0 * rv), a1 = pk4(v1 * rv); w.x = a0.x; w.y = a0.y; w.z = a1.x; w.w = a1.y; } *(u32x4*)(Z + (size_t)row * NZ + col) = w; return 0.f; }
};
struct EGlu {
    static constexpr bool HAS_RES = false, PERM = true; static constexpr bool MID = false, HAS_SS = true; float* ss; const float* bglu; const bf16_t* YG; bf16_t* MG;
    __device__ __forceinline__ float rowval(int) const { return 0.f; }
    __device__ __forceinline__ float kscale(int, int) const { return 1.f; }
    __device__ __forceinline__ float apply(int row, int col, f32x4 v, float) const {
        const f32x4 b = *(const f32x4*)(bglu + col); const f32x4 yg = up4(*(const u32x2*)(YG + (size_t)row * DH + col)); f32x4 o;
#pragma unroll
        for (int j = 0; j < 4; ++j) o[j] = yg[j] * sigm(v[j] + b[j]);
        *(u32x2*)(MG + (size_t)row * DM + col) = pk4(o); return ssq4(o);
    }
    __device__ __forceinline__ float apply8(int row, int col, f32x4 v0, f32x4 v1, float) const {
        const f32x4 b0 = *(const f32x4*)(bglu + col), b1 = *(const f32x4*)(bglu + col + 4); const u32x4 yr = *(const u32x4*)(YG + (size_t)row * DH + col);
        const f32x4 y0 = up4((u32x2){yr.x, yr.y}), y1 = up4((u32x2){yr.z, yr.w}); f32x4 o0, o1;
#pragma unroll
        for (int j = 0; j < 4; ++j) { o0[j] = y0[j] * sigm(v0[j] + b0[j]); o1[j] = y1[j] * sigm(v1[j] + b1[j]); }
        u32x4 w; { const u32x2 a0 = pk4(o0), a1 = pk4(o1); w.x = a0.x; w.y = a0.y; w.z = a1.x; w.w = a1.y; } *(u32x4*)(MG + (size_t)row * DM + col) = w; return ssq4(o0) + ssq4(o1);
    }
};
struct EOut {
    static constexpr bool MID = true, HAS_SS = true; float* ss; const float* rat; const float* rsb; const float* xp; const float* xs; float* XO; bf16_t* AB;
    __device__ __forceinline__ float rowval(int row) const { return rsb[row]; }
    __device__ __forceinline__ float kscale(int row, int w) const { return w < 4 ? rat[row] : 1.f; }
    static constexpr bool HAS_RES = true, PERM = true;
    __device__ __forceinline__ f32x4 res(int row, int col) const { return *(const f32x4*)(xp + (size_t)row * DM + col); }
    __device__ __forceinline__ float applyr8(int row, int col, f32x4 v0, f32x4 v1, float rv, f32x4 r0, f32x4 r1) const {
        const f32x4 o0 = r0 + v0 * rv, o1 = r1 + v1 * rv; float* p = XO + (size_t)row * DM + col; *(f32x4*)p = o0; *(f32x4*)(p + 4) = o1;
        u32x4 w; { const u32x2 a0 = pk4(o0), a1 = pk4(o1); w.x = a0.x; w.y = a0.y; w.z = a1.x; w.w = a1.y; } *(u32x4*)(AB + (size_t)row * DM + col) = w; return ssq4(o0) + ssq4(o1); }
    __device__ __forceinline__ float applyr(int row, int col, f32x4 v, float rv, f32x4 r) const {
        const f32x4 o = r + v * rv;
        *(f32x4*)(XO + (size_t)row * DM + col) = o; *(u32x2*)(AB + (size_t)row * DM + col) = pk4(o); return ssq4(o); }
    __device__ __forceinline__ float apply(int row, int col, f32x4 v, float rv) const {
        const float* xr = row < MP ? xp + (size_t)row * DM : xs + (size_t)(row - MP) * DM;
        const f32x4 o = *(const f32x4*)(xr + col) + v * rv;
        *(f32x4*)(XO + (size_t)row * DM + col) = o; *(u32x2*)(AB + (size_t)row * DM + col) = pk4(o); return ssq4(o);
    }
};
struct EUp {
    static constexpr bool HAS_RES = false, PERM = true; static constexpr bool MID = false, HAS_SS = false; float* ss; const float* ss1; bf16_t* HUP;
    __device__ __forceinline__ float rowval(int row) const { return rsqrtf(ss1[row] * (1.f / DM) + EPS); }
    __device__ __forceinline__ float kscale(int, int) const { return 1.f; }
    __device__ __forceinline__ float apply(int row, int col, f32x4 v, float rv) const { f32x4 o;
#pragma unroll
        for (int j = 0; j < 4; ++j) { const float r = fmaxf(v[j] * rv, 0.f); o[j] = r * r; }
        *(u32x2*)(HUP + (size_t)row * DFF + col) = pk4(o); return 0.f; }
    __device__ __forceinline__ float apply8(int row, int col, f32x4 v0, f32x4 v1, float rv) const { f32x4 o0, o1;
#pragma unroll
        for (int j = 0; j < 4; ++j) { const float r0 = fmaxf(v0[j] * rv, 0.f), r1 = fmaxf(v1[j] * rv, 0.f); o0[j] = r0 * r0; o1[j] = r1 * r1; }
        u32x4 w; { const u32x2 a0 = pk4(o0), a1 = pk4(o1); w.x = a0.x; w.y = a0.y; w.z = a1.x; w.w = a1.y; } *(u32x4*)(HUP + (size_t)row * DFF + col) = w; return 0.f; }
};
struct EDown {
    static constexpr bool MID = false, HAS_SS = true; float* ss; float* XO; bf16_t* AB;
    __device__ __forceinline__ float rowval(int) const { return 0.f; }
    __device__ __forceinline__ float kscale(int, int) const { return 1.f; }
    static constexpr bool HAS_RES = true, PERM = true;
    __device__ __forceinline__ f32x4 res(int row, int col) const { return *(const f32x4*)(XO + (size_t)row * DM + col); }
    __device__ __forceinline__ float applyr8(int row, int col, f32x4 v0, f32x4 v1, float, f32x4 r0, f32x4 r1) const {
        const f32x4 o0 = r0 + v0, o1 = r1 + v1; float* p = XO + (size_t)row * DM + col; *(f32x4*)p = o0; *(f32x4*)(p + 4) = o1;
        u32x4 w; { const u32x2 a0 = pk4(o0), a1 = pk4(o1); w.x = a0.x; w.y = a0.y; w.z = a1.x; w.w = a1.y; } *(u32x4*)(AB + (size_t)row * DM + col) = w; return ssq4(o0) + ssq4(o1); }
    __device__ __forceinline__ float applyr(int row, int col, f32x4 v, float, f32x4 r) const {
        const f32x4 o = r + v; *(f32x4*)(XO + (size_t)row * DM + col) = o; *(u32x2*)(AB + (size_t)row * DM + col) = pk4(o); return ssq4(o); }
    __device__ __forceinline__ float apply(int row, int col, f32x4 v, float) const {
        float* p = XO + (size_t)row * DM + col; const f32x4 o = *(const f32x4*)p + v; *(f32x4*)p = o; *(u32x2*)(AB + (size_t)row * DM + col) = pk4(o); return ssq4(o); }
};
struct EPw {
    static constexpr bool HAS_RES = false, PERM = true; static constexpr bool MID = false, HAS_SS = false; float* ss; bf16_t* PW;
    __device__ __forceinline__ float rowval(int) const { return 0.f; }
    __device__ __forceinline__ float kscale(int, int) const { return 1.f; }
    __device__ __forceinline__ float apply(int row, int col, f32x4 v, float) const { *(u32x2*)(PW + (size_t)row * DM + col) = pk4(v); return 0.f; }
    __device__ __forceinline__ float apply8(int row, int col, f32x4 v0, f32x4 v1, float) const { u32x4 w; { const u32x2 a0 = pk4(v0), a1 = pk4(v1); w.x = a0.x; w.y = a0.y; w.z = a1.x; w.w = a1.y; } *(u32x4*)(PW + (size_t)row * DM + col) = w; return 0.f; }
};
struct EGate {
    static constexpr bool MID = false, HAS_SS = true; float* ss; const float* ss2; const bf16_t* PW; float* XO;
    __device__ __forceinline__ float rowval(int row) const { return rsqrtf(ss2[row] * (1.f / DM) + EPS); }
    __device__ __forceinline__ float kscale(int, int) const { return 1.f; }
    static constexpr bool HAS_RES = true, PERM = true;
    __device__ __forceinline__ f32x4 res(int row, int col) const { return *(const f32x4*)(XO + (size_t)row * DM + col); }
    __device__ __forceinline__ float applyr8(int row, int col, f32x4 v0, f32x4 v1, float rv, f32x4 r0, f32x4 r1) const {
        const u32x4 pr = *(const u32x4*)(PW + (size_t)row * DM + col); const f32x4 p0 = up4((u32x2){pr.x, pr.y}), p1 = up4((u32x2){pr.z, pr.w}); f32x4 o0 = r0, o1 = r1;
#pragma unroll
        for (int j = 0; j < 4; ++j) { o0[j] += p0[j] * sigm(v0[j] * rv); o1[j] += p1[j] * sigm(v1[j] * rv); }
        float* p = XO + (size_t)row * DM + col; *(f32x4*)p = o0; *(f32x4*)(p + 4) = o1; return ssq4(o0) + ssq4(o1); }
    __device__ __forceinline__ float applyr(int row, int col, f32x4 v, float rv, f32x4 r) const {
        f32x4 o = r; const f32x4 pw = up4(*(const u32x2*)(PW + (size_t)row * DM + col));
#pragma unroll
        for (int j = 0; j < 4; ++j) o[j] += pw[j] * sigm(v[j] * rv);
        *(f32x4*)(XO + (size_t)row * DM + col) = o; return ssq4(o); }
    __device__ __forceinline__ float apply(int row, int col, f32x4 v, float rv) const {
        float* p = XO + (size_t)row * DM + col; f32x4 o = *(const f32x4*)p; const f32x4 pw = up4(*(const u32x2*)(PW + (size_t)row * DM + col));
#pragma unroll
        for (int j = 0; j < 4; ++j) o[j] += pw[j] * sigm(v[j] * rv);
        *(f32x4*)p = o; return ssq4(o); }
};
__device__ __forceinline__ float em1(float x) {
    float p = x * (1.f + x * (0.5f + x * (0.16666667f + x * (0.041666668f + x * (0.0083333338f + x * (0.0013888889f + x * 0.0001984127f))))));
    if (__builtin_expect(__any(fabsf(x) >= 0.5f), 0)) p = fabsf(x) < 0.5f ? p : __expf(x) - 1.f;
    return p;
}
struct ELru {
    static constexpr bool MID = false, PERM = false; const bf16_t* XC; const float* ba; const float* bi; const float* spl; float* Ao; float* Bo;
    __device__ __forceinline__ void mid(f32x4 (&)[2][2][4][2], const pg8::Unit&, int, int) const {}
    __device__ __forceinline__ void operator()(const f32x4 (&acc)[2][2][4][2], const pg8::Unit& u, int wr, int wc, int fr, int fq) const {
#pragma unroll
        for (int n = 0; n < 2; ++n) {
            const int ch = (u.pn >> 1) * 256 + (u.pn & 1) * 128 + wc * 32 + n * 16 + 4 * fq;
            const f32x4 bav = *(const f32x4*)(ba + ch), biv = *(const f32x4*)(bi + ch), sp = *(const f32x4*)(spl + ch);
#pragma unroll
            for (int ai = 0; ai < 2; ++ai)
#pragma unroll
                for (int m = 0; m < 4; ++m) {
                    const int row = u.pm * 256 + ai * 128 + wr * 64 + m * 16 + fr;
                    const f32x4 xc = up4(*(const u32x2*)(XC + (size_t)row * DH + ch)); f32x4 av, bv;
#pragma unroll
                    for (int j = 0; j < 4; ++j) { const float r = sigm(acc[ai][0][m][n][j] + bav[j]), ig = sigm(acc[ai][1][m][n][j] + biv[j]);
                        const float la = r * sp[j]; av[j] = 1.f + em1(la); bv[j] = __builtin_amdgcn_sqrtf(fmaxf(-em1(2.f * la), 0.f)) * ig * xc[j]; }
                    *(f32x4*)(Ao + (size_t)row * DH + ch) = av; *(f32x4*)(Bo + (size_t)row * DH + ch) = bv;
                    asm volatile("" ::: "memory");
                }
        }
    }
};

template <class E, int MT = 8, int NG = 1>
__device__ __forceinline__ void skinny_gemm(LAS unsigned char* lds, const bf16_t* A, int lda, const bf16_t* Bt, int ldb, int N, int K, const E& e, int nb = 0) {
    const int tid = threadIdx.x, wid = __builtin_amdgcn_readfirstlane(tid >> 6), lane = tid & 63, fr = lane & 15, fq = lane >> 4;
    LAS f32x4* red = (LAS f32x4*)lds;
    constexpr int NH = 8 / MT;
    const int kw = K >> 3, k0w = wid * kw, nks = kw >> 5, nit = ((N >> 4) / NG) * NH, G = gridDim.x, NBk = nb ? nb : G;
    for (int iti = G - 1 - (int)blockIdx.x; iti < nit && (G - 1 - (int)blockIdx.x) < NBk; iti += NBk) {
        const int n0 = (iti / NH) * (16 * NG), r0 = (iti % NH) * (MT * 16);
        f32x4 acc[NG][MT];
#pragma unroll
        for (int q = 0; q < NG; ++q)
#pragma unroll
            for (int m = 0; m < MT; ++m) acc[q][m] = (f32x4){0.f, 0.f, 0.f, 0.f};
        const bf16_t* bp = Bt + (size_t)(n0 + fr) * ldb + k0w + 8 * fq;
        const bf16_t* ap = A + (size_t)(r0 + fr) * lda + k0w + 8 * fq;
        {
            bf16x8 bc[NG], ac[MT];
#pragma unroll
            for (int q = 0; q < NG; ++q) bc[q] = *(const bf16x8*)(bp + (size_t)(16 * q) * ldb);
#pragma unroll
            for (int m = 0; m < MT; ++m) ac[m] = *(const bf16x8*)(ap + (size_t)(16 * m) * lda);
            for (int ks = 0; ks < nks; ++ks) {
                const int kn = ks + 1 < nks ? ks + 1 : ks;
                bf16x8 bn[NG], an[MT];
#pragma unroll
                for (int q = 0; q < NG; ++q) bn[q] = *(const bf16x8*)(bp + (size_t)(16 * q) * ldb + 32 * kn);
#pragma unroll
                for (int m = 0; m < MT; ++m) an[m] = *(const bf16x8*)(ap + (size_t)(16 * m) * lda + 32 * kn);
#pragma unroll
                for (int q = 0; q < NG; ++q)
#pragma unroll
                    for (int m = 0; m < MT; ++m) acc[q][m] = __builtin_amdgcn_mfma_f32_16x16x32_bf16(bc[q], ac[m], acc[q][m], 0, 0, 0);
#pragma unroll
                for (int q = 0; q < NG; ++q) bc[q] = bn[q];
#pragma unroll
                for (int m = 0; m < MT; ++m) ac[m] = an[m];
            }
        }
#pragma unroll
        for (int q = 0; q < NG; ++q)
#pragma unroll
            for (int m = 0; m < MT; ++m) red[((wid * NG + q) * MT + m) * 64 + lane] = acc[q][m];
        __syncthreads();
        if (wid < MT) {
            const int row = MP + r0 + 16 * wid + fr; const float rv = e.rowval(row);
#pragma unroll
            for (int q = 0; q < NG; ++q) {
                f32x4 v = (f32x4){0.f, 0.f, 0.f, 0.f};
#pragma unroll
                for (int w = 0; w < 8; ++w) { f32x4 p = red[((w * NG + q) * MT + wid) * 64 + lane]; if constexpr (E::MID) p = p * e.kscale(row, w); v += p; }
                float s = e.apply(row, n0 + 16 * q + 4 * fq, v, rv);
                if constexpr (E::HAS_SS) { s += __shfl_xor(s, 16); s += __shfl_xor(s, 32); if (fq == 0) atomicAdd(e.ss + row, s); }
            }
        }
        __syncthreads();
    }
}

struct Args { const float* in[37]; float* out; unsigned char* ws; int ph_lo, ph_hi; };
enum { I_XP = 0, I_XS, I_S5RE, I_S5IM, I_LRUH, I_CONV, I_PP, I_PS, I_GMIX, I_WIN, I_LAMRE, I_LAMIM, I_LOGSTEP, I_BRE, I_BIM, I_CRE, I_CIM, I_S5D,
       I_WGLU, I_BGLU, I_CONVW, I_CONVB, I_WA, I_BA, I_WI, I_BI, I_LAM, I_GMA, I_GMB, I_WOUT, I_GMLP, I_WUP, I_WDOWN, I_GPLE, I_WGATE, I_WPLE, I_GFIN };

__device__ __forceinline__ void tr_item(const float* W, int K, int N, bf16_t* WT, int rbase, int lru, const float* g1, const float* g2, int gsplit,
                                        LAS float* scr, int item, int lane) {
    const int nblk = N / 32, kb = item / nblk, nb = item % nblk, k0 = 64 * kb, n0 = 32 * nb;
    f32x4 wv[8];
#pragma unroll
    for (int i = 0; i < 8; ++i) wv[i] = *(const f32x4*)(W + (size_t)(k0 + 8 * i + (lane >> 3)) * N + n0 + 4 * (lane & 7));
#pragma unroll
    for (int i = 0; i < 8; ++i) { const int kk = 8 * i + (lane >> 3), k = k0 + kk; const float gv = g1 ? (k < gsplit ? g1[k] : g2[k - gsplit]) : 1.f;
        LAS float* d = scr + kk * 33 + 4 * (lane & 7); d[0] = wv[i][0] * gv; d[1] = wv[i][1] * gv; d[2] = wv[i][2] * gv; d[3] = wv[i][3] * gv; }
    LDS_WAIT();
    const int c = lane & 7;
#pragma unroll
    for (int j = 0; j < 4; ++j) { const int n = (lane >> 3) + 8 * j, nn = n0 + n; const int drow = lru ? rbase + (nn >> 7) * 256 + (nn & 127) : rbase + nn;
        const LAS float* s = scr + (8 * c) * 33 + n;
        u32x4 o; o.x = cvt_pk_bf16(s[0 * 33], s[1 * 33]); o.y = cvt_pk_bf16(s[2 * 33], s[3 * 33]); o.z = cvt_pk_bf16(s[4 * 33], s[5 * 33]); o.w = cvt_pk_bf16(s[6 * 33], s[7 * 33]);
        *(u32x4*)(WT + (size_t)drow * K + k0 + 8 * c) = o; }
    LDS_WAIT();
}

__device__ __forceinline__ void phase0(const Args& a, LAS unsigned char* lds) {
    const int tid = threadIdx.x, wave = __builtin_amdgcn_readfirstlane(tid >> 6), lane = tid & 63, G = gridDim.x;
    unsigned char* ws = a.ws;
    LAS float* scr = (LAS float*)(lds + wave * 16384);
    const int gw = blockIdx.x * 8 + wave, NGW = G * 8;
    constexpr int I_IN = 32 * 96, I_GLU = 16 * 32, I_OUT = 32 * 64, I_UP = 32 * 256, I_DOWN = 128 * 64, I_GATE = 32 * 64, I_PLE = 4 * 64, I_LRU = 8 * 32;
    constexpr int NITEMS = I_IN + I_UP + I_DOWN + I_LRU;
    for (int it = gw; it < NITEMS; it += NGW) {
        int r = it;
        if (r < I_UP) { tr_item(a.in[I_WUP], DM, DFF, (bf16_t*)(ws + WS_WUP), 0, 0, a.in[I_GMLP], a.in[I_GMLP], 1 << 30, scr, r, lane); continue; } r -= I_UP;
        if (r < I_DOWN) { tr_item(a.in[I_WDOWN], DFF, DM, (bf16_t*)(ws + WS_WDOWN), 0, 0, nullptr, nullptr, 0, scr, r, lane); continue; } r -= I_DOWN;
        if (r < I_IN) { tr_item(a.in[I_WIN], DM, NZ, (bf16_t*)(ws + WS_WIN), 0, 0, a.in[I_GMIX], a.in[I_GMIX], 1 << 30, scr, r, lane); continue; } r -= I_IN;
        { const int mat = r >> 5, h = mat >> 1, bj = mat & 1;
          tr_item((bj ? a.in[I_WI] : a.in[I_WA]) + (size_t)h * 65536, 256, 256, (bf16_t*)(ws + WS_WLRU), h * 512 + bj * 128, 1, nullptr, nullptr, 0, scr, r & 31, lane); }
    }
    float* rs0 = (float*)(ws + WS_SMALL + SM_RS0); bf16_t* XB = (bf16_t*)(ws + WS_AB); bf16_t* PB = (bf16_t*)(ws + WS_PB);
    for (int row = gw; row < MT; row += NGW) {
        const float* xr = row < MP ? a.in[I_XP] + (size_t)row * DM : a.in[I_XS] + (size_t)(row - MP) * DM;
        f32x4 v[8]; float s = 0.f;
#pragma unroll
        for (int j = 0; j < 8; ++j) { v[j] = ((const f32x4*)xr)[lane + 64 * j]; s += ssq4(v[j]); }
        s = wave_sum(s); if (lane == 0) rs0[row] = rsqrtf(s * (1.f / DM) + EPS);
#pragma unroll
        for (int j = 0; j < 8; ++j) ((u32x2*)(XB + (size_t)row * DM))[lane + 64 * j] = pk4(v[j]);
        const float* pr = row < MP ? a.in[I_PP] + (size_t)row * DPLE : a.in[I_PS] + (size_t)(row - MP) * DPLE;
        ((u32x2*)(PB + (size_t)row * DPLE))[lane] = pk4(((const f32x4*)pr)[lane]);
    }
    { float* SPL = (float*)(ws + WS_SMALL + SM_SPL);
      for (int i = blockIdx.x * 512 + tid; i < DH; i += G * 512) { const float xl = -a.in[I_LAM][i]; SPL[i] = -8.f * (fmaxf(xl, 0.f) + log1pf(expf(-fabsf(xl)))); } }
    float* AR = (float*)(ws + WS_SMALL + SM_AR); float* AI = (float*)(ws + WS_SMALL + SM_AI); float* A64R = (float*)(ws + WS_SMALL + SM_A64R); float* A64I = (float*)(ws + WS_SMALL + SM_A64I);
    bf16_t* BBB = (bf16_t*)(ws + WS_SMALL + SM_BBB); bf16_t* CMB = (bf16_t*)(ws + WS_SMALL + SM_CMB);
    for (int i = blockIdx.x * 512 + tid; i < 4096; i += G * 512) {
        const int g = i >> 6, p = i & 63;
        const float step = expf(a.in[I_LOGSTEP][g]), lr = a.in[I_LAMRE][i], li = a.in[I_LAMIM][i];
        const float mag = expf(lr * step); float sn, cs; sincosf(li * step, &sn, &cs);
        const float ar = mag * cs, ai = mag * sn, nr = ar - 1.f, ni = ai, den = lr * lr + li * li;
        const float cr = (nr * lr + ni * li) / den, ci = (ni * lr - nr * li) / den;
        AR[i] = ar; AI[i] = ai;
        float pr_ = ar, pi_ = ai;
#pragma unroll
        for (int q = 0; q < 6; ++q) { const float t0 = pr_ * pr_ - pi_ * pi_, t1 = 2.f * pr_ * pi_; pr_ = t0; pi_ = t1; }
        A64R[i] = pr_; A64I[i] = pi_;
        for (int c = 0; c < 16; ++c) {
            const float br = a.in[I_BRE][(size_t)i * 16 + c], bi = a.in[I_BIM][(size_t)i * 16 + c];
            BBB[((size_t)g * 128 + p) * 16 + c] = (bf16_t)(cvt_pk_bf16(cr * br - ci * bi, 0.f) & 0xffffu);
            BBB[((size_t)g * 128 + 64 + p) * 16 + c] = (bf16_t)(cvt_pk_bf16(cr * bi + ci * br, 0.f) & 0xffffu);
            CMB[((size_t)g * 16 + c) * 128 + p] = (bf16_t)(cvt_pk_bf16(a.in[I_CRE][((size_t)g * 16 + c) * 64 + p], 0.f) & 0xffffu);
            CMB[((size_t)g * 16 + c) * 128 + 64 + p] = (bf16_t)(cvt_pk_bf16(-a.in[I_CIM][((size_t)g * 16 + c) * 64 + p], 0.f) & 0xffffu);
        }
    }
}

__device__ __forceinline__ void s5_unit(const Args& a, LAS unsigned char* wl, int lane, int mode, int n, int g, int j) {
    unsigned char* ws = a.ws;
    const int fr = lane & 15, fq = lane >> 4;
    const float* AR = (const float*)(ws + WS_SMALL + SM_AR); const float* AI = (const float*)(ws + WS_SMALL + SM_AI);
    const bf16_t* BBB = (const bf16_t*)(ws + WS_SMALL + SM_BBB); const bf16_t* CMB = (const bf16_t*)(ws + WS_SMALL + SM_CMB);
    const bf16_t* Z = (const bf16_t*)(ws + WS_Z); bf16_t* YG = (bf16_t*)(ws + WS_YG); float* SUM = (float*)(ws + WS_S5SUM);
    LAS float* BuS = (LAS float*)wl; LAS bf16_t* Hs = (LAS bf16_t*)(wl + 8448);
    const float ar = AR[g * 64 + lane], ai = AI[g * 64 + lane];
    const bf16x8 zero8 = (bf16x8){0, 0, 0, 0, 0, 0, 0, 0};
    bf16x8 bb[8];
#pragma unroll
    for (int t = 0; t < 8; ++t) bb[t] = fq < 2 ? *(const bf16x8*)(BBB + ((size_t)g * 128 + 16 * t + fr) * 16 + 8 * fq) : zero8;
    bf16x8 cm[4];
#pragma unroll
    for (int kk = 0; kk < 4; ++kk) cm[kk] = *(const bf16x8*)(CMB + ((size_t)g * 16 + fr) * 128 + 32 * kk + 8 * fq);
    const f32x4 dsk = *(const f32x4*)(a.in[I_S5D] + 16 * g + 4 * fq);
    float hr = 0.f, hi = 0.f;
    if (mode == 1 && j > 0) {
        const float pr = ((const float*)(ws + WS_SMALL + SM_A64R))[g * 64 + lane], pi = ((const float*)(ws + WS_SMALL + SM_A64I))[g * 64 + lane];
        const float* sp = SUM + ((size_t)(n * 64 + g) * 32) * 128;
        for (int i = 0; i < j; ++i) { const float sr = sp[i * 128 + lane], si = sp[i * 128 + 64 + lane];
            const float t0 = pr * hr - pi * hi + sr, t1 = pr * hi + pi * hr + si; hr = t0; hi = t1; }
    }
    if (mode == 4 && j > 0) {
        float pr = ((const float*)(ws + WS_SMALL + SM_A64R))[g * 64 + lane], pi = ((const float*)(ws + WS_SMALL + SM_A64I))[g * 64 + lane];
#pragma unroll
        for (int q = 0; q < 2; ++q) { const float t0 = pr * pr - pi * pi, t1 = 2.f * pr * pi; pr = t0; pi = t1; }
        for (int v = 0; v < j; ++v) { const LAS float* ps = (const LAS float*)(wl + (v - j) * 16384 + 12800); const float sr = ps[lane], si = ps[64 + lane];
            const float t0 = pr * hr - pi * hi + sr, t1 = pr * hi + pi * hr + si; hr = t0; hi = t1; }
    }
    const int row0 = mode == 2 ? MP + 16 * j : ((mode == 3 || mode == 4) ? n * SEQ + 256 * j : n * SEQ + 64 * j);
    const int nblk = mode == 2 ? 1 : ((mode == 3 || mode == 1 || mode == 4) ? 16 : 4);
    for (int blk = 0; blk < nblk; ++blk) {
        const int r0 = row0 + 16 * blk;
        const bf16x8 ua = fq < 2 ? *(const bf16x8*)(Z + (size_t)(r0 + fr) * NZ + 16 * g + 8 * fq) : zero8;
        u32x2 u4raw = (u32x2){0u, 0u}; if (mode == 1 || mode == 2 || mode == 4) u4raw = *(const u32x2*)(Z + (size_t)(r0 + fr) * NZ + 16 * g + 4 * fq);
#pragma unroll
        for (int t = 0; t < 8; ++t) {
            const f32x4 c = __builtin_amdgcn_mfma_f32_16x16x32_bf16(ua, bb[t], (f32x4){0.f, 0.f, 0.f, 0.f}, 0, 0, 0);
#pragma unroll
            for (int jj = 0; jj < 4; ++jj) BuS[(4 * fq + jj) * 132 + 16 * t + fr] = c[jj];
        }
        LDS_WAIT();
        float burv[16], buiv[16];
#pragma unroll
        for (int t = 0; t < 16; ++t) { burv[t] = BuS[t * 132 + lane]; buiv[t] = BuS[t * 132 + 64 + lane]; }
#pragma unroll
        for (int t = 0; t < 16; ++t) {
            const float bur = burv[t], bui = buiv[t];
            if (mode == 2) { const size_t si = ((size_t)(r0 - MP + t) * 64 + g) * 64 + lane; hr = a.in[I_S5RE][si]; hi = a.in[I_S5IM][si]; }
            const float t0 = ar * hr - ai * hi + bur, t1 = ar * hi + ai * hr + bui; hr = t0; hi = t1;
            if (mode == 2) { const size_t si = ((size_t)(r0 - MP + t) * 64 + g) * 64 + lane; a.out[O_S5RS + si] = hr; a.out[O_S5IS + si] = hi; }
            if (mode == 1 || mode == 2 || mode == 4) { const unsigned w = cvt_pk_bf16(hr, hi); Hs[t * 136 + lane] = (bf16_t)(w & 0xffffu); Hs[t * 136 + 64 + lane] = (bf16_t)(w >> 16); }
        }
        if (mode == 1 || mode == 2 || mode == 4) {
            LDS_WAIT();
            f32x4 y = (f32x4){0.f, 0.f, 0.f, 0.f};
#pragma unroll
            for (int kk = 0; kk < 4; ++kk) { const bf16x8 hb = *(const LAS bf16x8*)(Hs + fr * 136 + 32 * kk + 8 * fq);
                y = __builtin_amdgcn_mfma_f32_16x16x32_bf16(cm[kk], hb, y, 0, 0, 0); }
            const f32x4 u4 = up4(u4raw); f32x4 o;
#pragma unroll
            for (int jj = 0; jj < 4; ++jj) o[jj] = gelu_t(y[jj] + dsk[jj] * u4[jj]);
            *(u32x2*)(YG + (size_t)(r0 + fr) * DH + 16 * g + 4 * fq) = pk4(o);
            LDS_WAIT();
        }
    }
    if (mode == 0) { float* sp = SUM + ((size_t)(n * 64 + g) * 32 + j) * 128; sp[lane] = hr; sp[64 + lane] = hi; }
    if (mode == 3) { LAS float* ps = (LAS float*)(wl + 12800); ps[lane] = hr; ps[64 + lane] = hi; }
    if (mode == 4 && j == 7) { a.out[O_S5RP + (size_t)(n * 64 + g) * 64 + lane] = hr; a.out[O_S5IP + (size_t)(n * 64 + g) * 64 + lane] = hi; }
}

__device__ __forceinline__ void conv_prompt(const Args& a) {
    unsigned char* ws = a.ws; const bf16_t* Z = (const bf16_t*)(ws + WS_Z); bf16_t* XC = (bf16_t*)(ws + WS_XC);
    const float* cw = a.in[I_CONVW]; const float* cb = a.in[I_CONVB];
    const int G = gridDim.x;
    for (int it = blockIdx.x * 512 + threadIdx.x; it < MP * 128; it += G * 512) {
        const int row = it >> 7, c = (it & 127) * 8, t = row & (SEQ - 1);
        float acc[8];
#pragma unroll
        for (int q = 0; q < 8; ++q) acc[q] = cb[c + q];
#pragma unroll
        for (int k = 0; k < 4; ++k) {
            if (t - 3 + k >= 0) {
                const u32x4 z = *(const u32x4*)(Z + (size_t)(row - 3 + k) * NZ + DH + c);
                const float x[8] = {bf_lo(z.x), bf_hi(z.x), bf_lo(z.y), bf_hi(z.y), bf_lo(z.z), bf_hi(z.z), bf_lo(z.w), bf_hi(z.w)};
#pragma unroll
                for (int q = 0; q < 8; ++q) acc[q] += cw[k * DH + c + q] * x[q];
                if (k == 3 && t >= SEQ - 3) {
                    float* o = a.out + O_CONVP + ((size_t)(row >> 11) * 3 + (t - (SEQ - 3))) * DH + c;
#pragma unroll
                    for (int q = 0; q < 8; ++q) o[q] = x[q];
                }
            }
        }
        u32x4 o; o.x = cvt_pk_bf16(acc[0], acc[1]); o.y = cvt_pk_bf16(acc[2], acc[3]); o.z = cvt_pk_bf16(acc[4], acc[5]); o.w = cvt_pk_bf16(acc[6], acc[7]);
        *(u32x4*)(XC + (size_t)row * DH + c) = o;
    }
}

__device__ __forceinline__ void conv_tile(const Args& a, int pm, int h) {
    unsigned char* ws = a.ws; const bf16_t* Z = (const bf16_t*)(ws + WS_Z); bf16_t* XC = (bf16_t*)(ws + WS_XC);
    const int tid = threadIdx.x, c = h * 256 + (tid & 31) * 8;
    float cwv[4][8], cbv[8];
#pragma unroll
    for (int q = 0; q < 8; ++q) { cbv[q] = a.in[I_CONVB][c + q];
#pragma unroll
        for (int k = 0; k < 4; ++k) cwv[k][q] = a.in[I_CONVW][k * DH + c + q]; }
#pragma unroll 1
    for (int r4 = 0; r4 < 16; r4 += 4) {
        u32x4 z[4][4];
#pragma unroll
        for (int rr = 0; rr < 4; ++rr) { const int row = pm * 256 + (tid >> 5) + 16 * (r4 + rr), t = row & (SEQ - 1);
#pragma unroll
            for (int k = 0; k < 4; ++k) z[rr][k] = (t - 3 + k >= 0) ? *(const u32x4*)(Z + (size_t)(row - 3 + k) * NZ + DH + c) : (u32x4){0u, 0u, 0u, 0u}; }
#pragma unroll
        for (int rr = 0; rr < 4; ++rr) { const int row = pm * 256 + (tid >> 5) + 16 * (r4 + rr), t = row & (SEQ - 1);
            float acc[8];
#pragma unroll
            for (int q = 0; q < 8; ++q) acc[q] = cbv[q];
#pragma unroll
            for (int k = 0; k < 4; ++k) { const u32x4 zz = z[rr][k];
                const float x[8] = {bf_lo(zz.x), bf_hi(zz.x), bf_lo(zz.y), bf_hi(zz.y), bf_lo(zz.z), bf_hi(zz.z), bf_lo(zz.w), bf_hi(zz.w)};
#pragma unroll
                for (int q = 0; q < 8; ++q) acc[q] += cwv[k][q] * x[q];
                if (k == 3 && t >= SEQ - 3) { float* o = a.out + O_CONVP + ((size_t)(row >> 11) * 3 + (t - (SEQ - 3))) * DH + c;
#pragma unroll
                    for (int q = 0; q < 8; ++q) o[q] = x[q]; } }
            u32x4 o; o.x = cvt_pk_bf16(acc[0], acc[1]); o.y = cvt_pk_bf16(acc[2], acc[3]); o.z = cvt_pk_bf16(acc[4], acc[5]); o.w = cvt_pk_bf16(acc[6], acc[7]);
            *(u32x4*)(XC + (size_t)row * DH + c) = o; }
    }
}

__device__ __forceinline__ void lru_sample(const Args& a, LAS unsigned char* lds, int unit) {
    unsigned char* ws = a.ws; const bf16_t* Z = (const bf16_t*)(ws + WS_Z); bf16_t* MG = (bf16_t*)(ws + WS_MERGED); float* ssB = (float*)(ws + WS_CTL) + SS_B * SS_STRIDE;
    LAS float* sxc = (LAS float*)lds;
    const int tid = threadIdx.x, s = unit >> 1, half = unit & 1, row = MP + s;
    const float* cw = a.in[I_CONVW]; const float* cs = a.in[I_CONV] + (size_t)s * 3 * DH;
    for (int c = tid; c < DH; c += 512) {
        const float xb = bf1(Z[(size_t)row * NZ + DH + c]);
        sxc[c] = a.in[I_CONVB][c] + cw[c] * cs[c] + cw[DH + c] * cs[DH + c] + cw[2 * DH + c] * cs[2 * DH + c] + cw[3 * DH + c] * xb;
        if ((c >> 9) == half) { float* o = a.out + O_CONVS + (size_t)s * 3 * DH; o[c] = cs[DH + c]; o[DH + c] = cs[2 * DH + c]; o[2 * DH + c] = xb; }
    }
    __syncthreads();
    float sq = 0.f;
    {
        const int c = half * 512 + tid, h = c >> 8, jj = c & 255;
        const float* wa = a.in[I_WA] + (size_t)h * 65536 + jj; const float* wi = a.in[I_WI] + (size_t)h * 65536 + jj;
        float ra = a.in[I_BA][c], ri = a.in[I_BI][c];
#pragma unroll 1
        for (int k0 = 0; k0 < 256; k0 += 32) {
            float wav[32], wiv[32];
#pragma unroll
            for (int q = 0; q < 32; ++q) { wav[q] = wa[(size_t)(k0 + q) * 256]; wiv[q] = wi[(size_t)(k0 + q) * 256]; }
#pragma unroll
            for (int q = 0; q < 32; ++q) { const float x = sxc[h * 256 + k0 + q]; ra += x * wav[q]; ri += x * wiv[q]; }
        }
        const float r = sigm(ra), ig = sigm(ri); const float xl = -a.in[I_LAM][c]; const float sp = fmaxf(xl, 0.f) + log1pf(expf(-fabsf(xl)));
        const float la = -8.f * r * sp, av = expf(la), bv = sqrtf(-expm1f(2.f * la)) * ig * sxc[c];
        const float hn = av * a.in[I_LRUH][(size_t)s * DH + c] + bv;
        a.out[O_LRUS + (size_t)s * DH + c] = hn;
        const float o = hn * gelu_t(bf1(Z[(size_t)row * NZ + 2 * DH + c]));
        MG[(size_t)row * DM + DH + c] = (bf16_t)(cvt_pk_bf16(o, 0.f) & 0xffffu);
        sq = o * o;
    }
    sq = wave_sum(sq);
    if ((tid & 63) == 0) atomicAdd(ssB + row, sq);
    __syncthreads();
}

__device__ __forceinline__ void lru_scan_unit(const Args& a, LAS unsigned char* lds, int unit) {
    unsigned char* ws = a.ws; const bf16_t* Z = (const bf16_t*)(ws + WS_Z); bf16_t* MG = (bf16_t*)(ws + WS_MERGED); float* ssB = (float*)(ws + WS_CTL) + SS_B * SS_STRIDE;
    const float* Ao = a.out; const float* Bo = a.out + (size_t)MP * DH;
    LAS float* sP = (LAS float*)lds; LAS float* sH = sP + 512; LAS float* rsum = sH + 512;
    const int tid = threadIdx.x, n = unit >> 6, ch = (unit & 63) * 16 + (tid & 15), j = tid >> 4;
    const size_t r0 = (size_t)n * SEQ + 64 * j;
    float P = 1.f, h = 0.f;
#pragma unroll 1
    for (int tb = 0; tb < 64; tb += 16) {
        float av[16], bv[16];
#pragma unroll
        for (int q = 0; q < 16; ++q) { av[q] = Ao[(r0 + tb + q) * DH + ch]; bv[q] = Bo[(r0 + tb + q) * DH + ch]; }
#pragma unroll
        for (int q = 0; q < 16; ++q) { h = av[q] * h + bv[q]; P *= av[q]; }
    }
    sP[tid] = P; sH[tid] = h;
    __syncthreads();
    float H = 0.f;
    for (int i = 0; i < j; ++i) H = sP[i * 16 + (tid & 15)] * H + sH[i * 16 + (tid & 15)];
    h = H;
#pragma unroll 1
    for (int tb = 0; tb < 64; tb += 16) {
        float av[16], bv[16]; bf16_t gz[16];
#pragma unroll
        for (int q = 0; q < 16; ++q) { const size_t row = r0 + tb + q; av[q] = Ao[row * DH + ch]; bv[q] = Bo[row * DH + ch]; gz[q] = Z[row * NZ + 2 * DH + ch]; }
#pragma unroll
        for (int q = 0; q < 16; ++q) {
            const size_t row = r0 + tb + q;
            h = av[q] * h + bv[q];
            const float o = h * gelu_t(bf1(gz[q]));
            MG[row * DM + DH + ch] = (bf16_t)(cvt_pk_bf16(o, 0.f) & 0xffffu);
            float s = o * o; s += __shfl_xor(s, 1); s += __shfl_xor(s, 2); s += __shfl_xor(s, 4); s += __shfl_xor(s, 8);
            if ((tid & 15) == 0) rsum[64 * j + tb + q] = s;
        }
    }
    __syncthreads();
    for (int r = tid; r < SEQ; r += 512) atomicAdd(ssB + (size_t)n * SEQ + r, rsum[r]);
    if (j == 31) a.out[O_LRUP + (size_t)n * DH + ch] = h;
    __syncthreads();
}

#define XB_TMO      128
#define XB_XCNT(j)  (256  + 64 * (j))
#define XB_XSUB(j)  (1280 + 64 * (j))
#define XB_XGEN(j)  (2304 + 64 * (j))
#define XB_TOP      3328
#define XB_TOPGEN   3392
#define XB_SPIN_CAP (1u << 18)
__device__ __forceinline__ unsigned xb_ld(unsigned* p)              { return __hip_atomic_load(p, __ATOMIC_RELAXED, __HIP_MEMORY_SCOPE_AGENT); }
__device__ __forceinline__ unsigned xb_add(unsigned* p, unsigned v) { return __hip_atomic_fetch_add(p, v, __ATOMIC_RELAXED, __HIP_MEMORY_SCOPE_AGENT); }
__device__ __forceinline__ unsigned xb_xcc_id() { return (unsigned)__builtin_amdgcn_s_getreg((3 << 11) | 20) & 0xFu; }
#define XB_SPIN(cond, bar) do { unsigned _sp = 0; while (cond) { __builtin_amdgcn_s_sleep(1); \
    if ((++_sp & 255u) == 0u) { if (xb_ld(&(bar)[XB_TMO])) break; if (_sp > XB_SPIN_CAP) { atomicAdd(&(bar)[XB_TMO], 1u); break; } } } } while (0)
struct XcdBarrier { unsigned* bar; unsigned x; volatile LAS unsigned* st; };
__device__ __forceinline__ XcdBarrier xcd_barrier_post(unsigned* bar, volatile LAS unsigned* st) {
    XcdBarrier b; b.bar = bar; b.x = xb_xcc_id(); b.st = st;
    if (threadIdx.x == 0) (void)xb_add(&bar[XB_XCNT(b.x)], 1u);
    return b;
}
__device__ __forceinline__ void xcd_barrier_complete(unsigned* bar, unsigned x, unsigned& nloc, unsigned& nx) {
    const unsigned G = gridDim.x * gridDim.y * gridDim.z;
    unsigned sum, cnt, mine, sp = 0u;
    for (;;) {
        sum = 0u; cnt = 0u; mine = 0u;
#pragma unroll
        for (unsigned j = 0; j < 16; ++j) { const unsigned c = xb_ld(&bar[XB_XCNT(j)]); sum += c; cnt += (c > 0u) ? 1u : 0u; mine = (j == x) ? c : mine; }
        if (sum == G) break;
        __builtin_amdgcn_s_sleep(1);
        if ((++sp & 255u) == 0u) { if (xb_ld(&bar[XB_TMO])) break; if (sp > XB_SPIN_CAP) { atomicAdd(&bar[XB_TMO], 1u); break; } }
    }
    nloc = mine > 0u ? mine : 1u; nx = cnt > 0u ? cnt : 1u;
}
__device__ __forceinline__ void xcd_barrier(const XcdBarrier& b) {
    asm volatile("s_waitcnt vmcnt(0)" ::: "memory");
    __syncthreads();
    if (threadIdx.x == 0) {
        unsigned* bar = b.bar;
        __builtin_amdgcn_s_waitcnt(0);
        unsigned nloc = b.st[0], nx = b.st[1];
        if (nloc == 0u) { xcd_barrier_complete(bar, b.x, nloc, nx); b.st[0] = nloc; b.st[1] = nx; }
        const unsigned old = xb_add(&bar[XB_XSUB(b.x)], 1u);
        const unsigned gen = old / nloc;
        if (old + 1u == (gen + 1u) * nloc) {
            __builtin_amdgcn_fence(__ATOMIC_RELEASE, "agent");
            asm volatile("s_waitcnt vmcnt(0)" ::: "memory");
            const unsigned og = xb_add(&bar[XB_TOP], 1u);
            const unsigned tg = og / nx;
            if (og + 1u == (tg + 1u) * nx) xb_add(&bar[XB_TOPGEN], 1u);
            else XB_SPIN(xb_ld(&bar[XB_TOPGEN]) == tg, bar);
            __builtin_amdgcn_fence(__ATOMIC_ACQUIRE, "agent");
            xb_add(&bar[XB_XGEN(b.x)], 1u);
            asm volatile("s_waitcnt vmcnt(0)" ::: "memory");
        } else {
            XB_SPIN(xb_ld(&bar[XB_XGEN(b.x)]) == gen, bar);
            __builtin_amdgcn_fence(__ATOMIC_ACQUIRE, "agent");
            asm volatile("s_waitcnt vmcnt(0)" ::: "memory");
        }
    }
    __syncthreads();
}

__global__ void __launch_bounds__(512, 2) fwd_kernel(Args a) {
    extern __shared__ __attribute__((aligned(16))) unsigned char lds_raw[];
    LAS unsigned char* lds = (LAS unsigned char*)lds_raw;
    const int tid = threadIdx.x, wave = __builtin_amdgcn_readfirstlane(tid >> 6), lane = tid & 63, G = gridDim.x;
    unsigned char* ws = a.ws;
    const int lo = a.ph_lo, hi = a.ph_hi;
    volatile LAS unsigned* MISC = (volatile LAS unsigned*)(lds + MISC_OFF);
    for (int u = tid; u < (LDS_BYTES - RING_BYTES) / 4; u += 512) ((LAS unsigned*)(lds + RING_BYTES))[u] = 0u;
    __syncthreads();
#if MK_LAUNCHES == 1
    XcdBarrier bar = xcd_barrier_post((unsigned*)(ws + WS_CTL) + CW_BAR, MISC + 8);
#define GRID_BAR() xcd_barrier(bar)
#else
#define GRID_BAR() do {} while (0)
#endif
#define IN(k) (lo <= (k) && (k) < hi)
#define BOTH(k) (IN(k) && IN((k) + 1))
#define ssb ((float*)(ws + WS_CTL))
#define AB ((bf16_t*)(ws + WS_AB))
#define Z ((bf16_t*)(ws + WS_Z))
#define YG ((bf16_t*)(ws + WS_YG))
#define MG ((bf16_t*)(ws + WS_MERGED))
#define HUP ((bf16_t*)(ws + WS_HUP))
#define PW ((bf16_t*)(ws + WS_PW))
#define PB ((bf16_t*)(ws + WS_PB))
#define XO (a.out + O_Y)

    if (IN(0)) { phase0(a, lds); if (BOTH(0)) GRID_BAR(); }

    if (IN(1)) {
        pg8::Gemm g{AB, (const bf16_t*)(ws + WS_WIN), DM, DM, DM, 0}; pg8::StaticOrder S; S.init(MP / 256, NZ / 256, G, (int)blockIdx.x);
        EpiWrap<EIn> E{{nullptr, (const float*)(ws + WS_SMALL + SM_RS0), Z}};
        pg8::gemm_phase<EpiWrap<EIn>, true>(lds, g, S, E);
        skinny_gemm<EIn, 8, 2>(lds, AB + (size_t)MP * DM, DM, (const bf16_t*)(ws + WS_WIN), DM, NZ, DM, E.e, G / 2);
        if ((int)blockIdx.x >= G / 2) {
            const int w = ((int)blockIdx.x - G / 2) * 8 + wave, nw = (G - G / 2) * 8; LAS float* scr = (LAS float*)(lds + wave * 16384);
            constexpr int J_OUT = 32 * 64, J_GATE = 32 * 64, J_GLU = 16 * 32, J_PLE = 4 * 64;
            for (int it = w; it < J_OUT + J_GATE + J_GLU + J_PLE; it += nw) {
                int r = it;
                if (r < J_OUT) { tr_item(a.in[I_WOUT], DM, DM, (bf16_t*)(ws + WS_WOUT), 0, 0, a.in[I_GMA], a.in[I_GMB], DH, scr, r, lane); continue; } r -= J_OUT;
                if (r < J_GATE) { tr_item(a.in[I_WGATE], DM, DM, (bf16_t*)(ws + WS_WGATE), 0, 0, a.in[I_GPLE], a.in[I_GPLE], 1 << 30, scr, r, lane); continue; } r -= J_GATE;
                if (r < J_GLU) { tr_item(a.in[I_WGLU], DH, DH, (bf16_t*)(ws + WS_WGLU), 0, 0, nullptr, nullptr, 0, scr, r, lane); continue; } r -= J_GLU;
                tr_item(a.in[I_WPLE], DPLE, DM, (bf16_t*)(ws + WS_WPLE), 0, 0, nullptr, nullptr, 0, scr, r, lane);
            }
        }
        if (BOTH(1)) GRID_BAR();
    }

    if (IN(3)) {
        pg8::Gemm g{(const bf16_t*)(ws + WS_XC), (const bf16_t*)(ws + WS_WLRU), DH, 256, 256, 1}; pg8::StaticOrder S; S.init(MP / 256, 8, G, (int)blockIdx.x);
        { pg8::Unit cu; for (int i = 0; S.next(i, cu); ++i) conv_tile(a, cu.pm, cu.pn >> 1); }
        asm volatile("s_waitcnt vmcnt(0)" ::: "memory"); __syncthreads();
        ELru E{(const bf16_t*)(ws + WS_XC), a.in[I_BA], a.in[I_BI], (const float*)(ws + WS_SMALL + SM_SPL), a.out, a.out + (size_t)MP * DH};
        pg8::gemm_phase<ELru, true>(lds, g, S, E);
        for (int s = G - 1 - (int)blockIdx.x; s < 2 * MS; s += G) lru_sample(a, lds, s);
        for (int u = blockIdx.x; u < NB * 64; u += G) {
            const int n = u >> 6, g2 = u & 63;
            s5_unit(a, lds + wave * 16384, lane, 3, n, g2, wave);
            __syncthreads();
            s5_unit(a, lds + wave * 16384, lane, 4, n, g2, wave);
            __syncthreads();
        }
        for (int u = blockIdx.x * 8 + wave; u < 512; u += G * 8) s5_unit(a, lds + wave * 16384, lane, 2, 0, u >> 3, u & 7);
        if (BOTH(3)) GRID_BAR();
    }

    if (IN(4)) {
        pg8::Gemm g{YG, (const bf16_t*)(ws + WS_WGLU), DH, DH, DH, 0}; pg8::StaticOrder S; S.init(MP / 256, DH / 256, G, (int)blockIdx.x);
        EpiWrap<EGlu> E{{ssb + SS_A * SS_STRIDE, a.in[I_BGLU], YG, MG}};
        pg8::gemm_phase<EpiWrap<EGlu>, true>(lds, g, S, E);
        skinny_gemm<EGlu, 4>(lds, YG + (size_t)MP * DH, DH, (const bf16_t*)(ws + WS_WGLU), DH, DH, DH, E.e);
        for (int u = G - 1 - (int)blockIdx.x; u < NB * 64; u += G) lru_scan_unit(a, lds, u);
        if (BOTH(4)) GRID_BAR();
    }

    if (IN(5)) {
        pg8::Gemm g{MG, (const bf16_t*)(ws + WS_WOUT), DM, DM, DM, 0}; pg8::StaticOrder S; S.init(MP / 256, DM / 256, G, (int)blockIdx.x);
        { float* RAT = (float*)(ws + WS_SMALL + SM_RAT); float* RSB = (float*)(ws + WS_SMALL + SM_RSB);
          pg8::Unit cu;
          for (int ui = -1; ui < 0 || S.next(ui, cu); ++ui)
              for (int i = tid; i < (ui < 0 ? MS : 256); i += 512) { const int row = ui < 0 ? MP + i : cu.pm * 256 + i;
                  const float va = ssb[SS_A * SS_STRIDE + row] * (1.f / DH) + EPS, vb = ssb[SS_B * SS_STRIDE + row] * (1.f / DH) + EPS; RAT[row] = sqrtf(vb / va); RSB[row] = rsqrtf(vb); }
          asm volatile("s_waitcnt vmcnt(0)" ::: "memory"); __syncthreads(); }
        EpiWrap<EOut> E{{ssb + SS_1 * SS_STRIDE, (const float*)(ws + WS_SMALL + SM_RAT), (const float*)(ws + WS_SMALL + SM_RSB), a.in[I_XP], a.in[I_XS], XO, AB}};
        pg8::gemm_phase<EpiWrap<EOut>, true>(lds, g, S, E);
        skinny_gemm<EOut, 4>(lds, MG + (size_t)MP * DM, DM, (const bf16_t*)(ws + WS_WOUT), DM, DM, DM, E.e);
        if (BOTH(5)) GRID_BAR();
    }

    if (IN(6)) {
        pg8::Gemm g{AB, (const bf16_t*)(ws + WS_WUP), DM, DM, DM, 0}; pg8::StaticOrder S; S.init(MP / 256, DFF / 256, G, (int)blockIdx.x);
        EpiWrap<EUp> E{{nullptr, ssb + SS_1 * SS_STRIDE, HUP}};
        pg8::gemm_phase<EpiWrap<EUp>, true>(lds, g, S, E);
        skinny_gemm<EUp, 8, 2>(lds, AB + (size_t)MP * DM, DM, (const bf16_t*)(ws + WS_WUP), DM, DFF, DM, E.e);
        if (BOTH(6)) GRID_BAR();
    }

    if (IN(7)) {
        pg8::Gemm g{HUP, (const bf16_t*)(ws + WS_WDOWN), DFF, DFF, DFF, 0}; pg8::StaticOrder S; S.init(MP / 256, DM / 256, G, (int)blockIdx.x);
        EpiWrap<EDown> E{{ssb + SS_2 * SS_STRIDE, XO, AB}};
        pg8::gemm_phase<EpiWrap<EDown>, true>(lds, g, S, E);
        skinny_gemm<EDown, 4>(lds, HUP + (size_t)MP * DFF, DFF, (const bf16_t*)(ws + WS_WDOWN), DFF, DM, DFF, E.e);
        if (BOTH(7)) GRID_BAR();
    }

    if (IN(8)) {
        { pg8::Gemm g{PB, (const bf16_t*)(ws + WS_WPLE), DPLE, DPLE, DPLE, 0}; pg8::StaticOrder S; S.init(MP / 256, DM / 256, G, (int)blockIdx.x);
          EpiWrap<EPw> E{{nullptr, PW}};
          pg8::gemm_phase<EpiWrap<EPw>, true>(lds, g, S, E);
          skinny_gemm<EPw, 4>(lds, PB + (size_t)MP * DPLE, DPLE, (const bf16_t*)(ws + WS_WPLE), DPLE, DM, DPLE, E.e); }
        asm volatile("s_waitcnt vmcnt(0)" ::: "memory"); __syncthreads();
        { pg8::Gemm g{AB, (const bf16_t*)(ws + WS_WGATE), DM, DM, DM, 0}; pg8::StaticOrder S; S.init(MP / 256, DM / 256, G, (int)blockIdx.x);
          EpiWrap<EGate> E{{ssb + SS_3 * SS_STRIDE, ssb + SS_2 * SS_STRIDE, PW, XO}};
          pg8::gemm_phase<EpiWrap<EGate>, true>(lds, g, S, E);
          skinny_gemm<EGate, 4>(lds, AB + (size_t)MP * DM, DM, (const bf16_t*)(ws + WS_WGATE), DM, DM, DM, E.e); }
        if (BOTH(8)) GRID_BAR();
    }

    if (IN(9)) {
        const float* ss3 = ssb + SS_3 * SS_STRIDE; const float* gf = a.in[I_GFIN];
        f32x4 gv[8];
#pragma unroll
        for (int j = 0; j < 8; ++j) gv[j] = ((const f32x4*)gf)[lane + 64 * j];
        for (int row = blockIdx.x * 8 + wave; row < MT; row += 2 * G * 8) {
            const int row2 = row + G * 8; const bool has2 = row2 < MT; const int r2 = has2 ? row2 : row;
            f32x4* xa = (f32x4*)(XO + (size_t)row * DM); f32x4* xb2 = (f32x4*)(XO + (size_t)r2 * DM);
            f32x4 va[8], vb[8];
#pragma unroll
            for (int j = 0; j < 8; ++j) { va[j] = xa[lane + 64 * j]; vb[j] = xb2[lane + 64 * j]; }
            const float rsa = rsqrtf(ss3[row] * (1.f / DM) + EPS), rsb2 = rsqrtf(ss3[r2] * (1.f / DM) + EPS);
#pragma unroll
            for (int j = 0; j < 8; ++j) xa[lane + 64 * j] = va[j] * rsa * gv[j];
            if (has2) {
#pragma unroll
                for (int j = 0; j < 8; ++j) xb2[lane + 64 * j] = vb[j] * rsb2 * gv[j];
            }
        }
    }
#if MK_LAUNCHES == 1
    if (lo > hi) cg::this_grid().sync();
#endif
}

#undef ssb
#undef AB
#undef Z
#undef YG
#undef MG
#undef HUP
#undef PW
#undef PB
#undef XO
extern "C" void kernel_launch(void* const* d_in, const int* in_sizes, int n_in, void* d_out, int out_size, void* d_ws, size_t ws_size, hipStream_t stream) {
    static int grid = 0;
    if (grid == 0) {
        int dev = 0, cus = 0;
        if (n_in != 37 || ws_size < WS_END) { fprintf(stderr, "kernel_launch: unexpected inputs (n_in %d, ws %zu)\n", n_in, ws_size); grid = -1; return; }
        if (hipGetDevice(&dev) != hipSuccess || hipDeviceGetAttribute(&cus, hipDeviceAttributeMultiprocessorCount, dev) != hipSuccess) { grid = -1; return; }
        if (hipFuncSetAttribute((const void*)fwd_kernel, hipFuncAttributeMaxDynamicSharedMemorySize, LDS_BYTES) != hipSuccess) { fprintf(stderr, "kernel_launch: hipFuncSetAttribute failed\n"); grid = -1; return; }
        int per_cu = 0;
        if (hipOccupancyMaxActiveBlocksPerMultiprocessor(&per_cu, (const void*)fwd_kernel, 512, LDS_BYTES) != hipSuccess || per_cu < 1) { fprintf(stderr, "kernel_launch: occupancy query %d\n", per_cu); }
        (void)hipGetLastError();
        grid = cus;
    }
    if (grid < 0) return;
    (void)hipMemsetAsync((char*)d_ws + WS_CTL, 0, CTL_ZERO_BYTES, stream);
    Args a{};
    for (int i = 0; i < 37; ++i) a.in[i] = (const float*)d_in[i];
    a.out = (float*)d_out; a.ws = (unsigned char*)d_ws;
#if MK_LAUNCHES == 1
    a.ph_lo = 0; a.ph_hi = NPHASE;
    void* args[] = {&a};
    hipError_t e = hipLaunchCooperativeKernel((const void*)fwd_kernel, dim3(grid), dim3(512), args, LDS_BYTES, stream);
    if (e != hipSuccess) fprintf(stderr, "cooperative launch failed: %s (grid %d)\n", hipGetErrorString(e), grid);
#else
    for (int ph = 0; ph < NPHASE; ++ph) {
        a.ph_lo = ph; a.ph_hi = ph + 1;
        hipLaunchKernelGGL(fwd_kernel, dim3(grid), dim3(512), LDS_BYTES, stream, a);
    }
#endif
}
```

```cpp
#include <hip/hip_runtime.h>
#include <hip/hip_cooperative_groups.h>
#include <cstdio>
#include <cstdint>
namespace cg = cooperative_groups;

#ifndef MK_LAUNCHES
#define MK_LAUNCHES 1
#endif

#define LAS __attribute__((address_space(3)))
typedef unsigned short bf16_t;
typedef short bf16x8 __attribute__((ext_vector_type(8)));
typedef float f32x4 __attribute__((ext_vector_type(4)));
typedef unsigned u32x4 __attribute__((ext_vector_type(4)));
typedef unsigned u32x2 __attribute__((ext_vector_type(2)));

constexpr int DM = 2048, SEQ = 2048, NB = 4, MP = 8192, MS = 128, MT = 8320;
constexpr int NZ = 3072, DFF = 8192, DPLE = 256, DH = 1024;
constexpr float EPS = 1e-6f;
constexpr int NPHASE = 10;

constexpr size_t MiB = 1u << 20;
constexpr size_t WS_CTL = 0, CTL_ZERO_BYTES = 1 * MiB;
constexpr int SS_STRIDE = 8448;
constexpr int SS_A = 0, SS_B = 1, SS_1 = 2, SS_2 = 3, SS_3 = 4;
constexpr int CW_BAR = 65536;
constexpr size_t WS_SMALL = 1 * MiB;
constexpr size_t SM_RS0 = 0, SM_AR = 65536, SM_AI = SM_AR + 16384, SM_A64R = SM_AI + 16384, SM_A64I = SM_A64R + 16384,
                 SM_BBB = SM_A64I + 16384  , SM_CMB = SM_BBB + 262144  , SM_SPL = SM_CMB + 262144  , SM_RAT = 663552  , SM_RSB = SM_RAT + 34816  ;
constexpr size_t WS_WUP = 2 * MiB, WS_WDOWN = 34 * MiB, WS_WGATE = 66 * MiB, WS_WPLE = 74 * MiB, WS_PB = 75 * MiB, WS_AB = 80 * MiB;
constexpr size_t WS_E = 113 * MiB;
constexpr size_t WS_HUP = WS_E, WS_PW = WS_E;
constexpr size_t WS_WIN = 113 * MiB, WS_WGLU = 125 * MiB, WS_WOUT = 127 * MiB, WS_WLRU = 135 * MiB, WS_Z = 136 * MiB,
                 WS_YG = 185 * MiB, WS_MERGED = 202 * MiB, WS_XC = 235 * MiB, WS_S5SUM = 251 * MiB, WS_END = 255 * MiB;
static_assert(WS_HUP + (size_t)MT * DFF * 2 <= 256 * MiB, "hup fits");
static_assert(WS_Z + (size_t)MT * NZ * 2 <= WS_YG && WS_YG + (size_t)MT * DH * 2 <= WS_MERGED && WS_MERGED + (size_t)MT * DM * 2 <= WS_XC, "map");
static_assert(WS_AB + (size_t)MT * DM * 2 <= WS_E && WS_PB + (size_t)MT * DPLE * 2 <= WS_AB, "map2");

constexpr size_t O_Y = 0, O_S5RP = 17039360, O_S5IP = 17055744, O_LRUP = 17072128, O_CONVP = 17076224,
                 O_S5RS = 17088512, O_S5IS = 17612800, O_LRUS = 18137088, O_CONVS = 18268160;

constexpr int RING_BYTES = 131072, MISC_OFF = RING_BYTES + 320, LDS_BYTES = 147456;

__device__ __forceinline__ unsigned cvt_pk_bf16(float lo, float hi) { unsigned r; asm("v_cvt_pk_bf16_f32 %0, %1, %2" : "=v"(r) : "v"(lo), "v"(hi)); return r; }
__device__ __forceinline__ float bf_lo(unsigned u) { return __uint_as_float(u << 16); }
__device__ __forceinline__ float bf_hi(unsigned u) { return __uint_as_float(u & 0xffff0000u); }
__device__ __forceinline__ float bf1(bf16_t u) { return __uint_as_float(((unsigned)u) << 16); }
__device__ __forceinline__ float sigm(float x) { return __builtin_amdgcn_rcpf(1.f + __expf(-x)); }
__device__ __forceinline__ float gelu_t(float x) { const float u = 1.5957691216057308f * (x + 0.044715f * x * x * x); return x * __builtin_amdgcn_rcpf(1.f + __expf(-u)); }
__device__ __forceinline__ float wave_sum(float v) {
#pragma unroll
    for (int o = 1; o < 64; o <<= 1) v += __shfl_xor(v, o);
    return v;
}
#define LDS_WAIT() asm volatile("s_waitcnt lgkmcnt(0)" ::: "memory")

namespace pg8 {
constexpr int BM = 256, BK = 64, HALF = 128, HTB = HALF * BK * 2, STAGE_BYTES = 8 * HTB, NXCD = 8, WGM = 8;
__host__ __device__ __forceinline__ int lds_byte(int r, int c) { const int st = (r >> 4) * 2 + (c >> 5), rr = r & 15, cc = c & 31, ob = rr * 64 + cc * 2; return st * 1024 + (ob ^ (((ob >> 9) & 1) << 5)); }
__host__ __device__ __forceinline__ void stage_rc(int b, int& R, int& C) { const int st = b / 1024, sb = b % 1024, swz = sb ^ (((sb >> 9) & 1) << 5); R = (st >> 1) * 16 + swz / 64; C = (st & 1) * 32 + (swz % 64) / 2; }
__host__ __device__ __forceinline__ int perm32(int rho) { const int n = rho >> 4, i = rho & 15; return 8 * (i >> 2) + 4 * n + (i & 3); }
struct Unit { int pm, pn; };
struct Gemm { const bf16_t* A; const bf16_t* Bt; int lda, ldb, K, akmode; };
struct StaticOrder {
    int nM, nN, nwg, G, c;
    __device__ __forceinline__ void init(int nM_, int nN_, int G_, int c_) { nM = nM_; nN = nN_; nwg = nM * nN; G = G_; c = c_; }
    __device__ __forceinline__ bool next(int i, Unit& u) const {
        const long L = (long)i * G + c; if (L >= nwg) return false;
        int wgid = (int)L; { const int q = nwg / NXCD, r = nwg % NXCD, xcd = wgid % NXCD, off = wgid / NXCD; wgid = (xcd < r ? xcd * (q + 1) : r * (q + 1) + (xcd - r) * q) + off; }
        const int nig = WGM * nN, gid = wgid / nig, fm = gid * WGM, gsz = (nM - fm) < WGM ? (nM - fm) : WGM;
        u.pm = fm + ((wgid % nig) % gsz); u.pn = (wgid % nig) / gsz; return true;
    }
};

template <class Epi, bool ALIGN_EPI>
__device__ __forceinline__ void gemm_phase(LAS unsigned char* lds, const Gemm g, const StaticOrder& S, const Epi& E) {
    const int tid = threadIdx.x, wid = __builtin_amdgcn_readfirstlane(tid >> 6), lane = tid & 63, wr = wid >> 2, wc = wid & 3, fr = lane & 15, fq = lane >> 4;
    int K = g.K; asm volatile("" : "+s"(K));
    const int nt = K / BK;
    unsigned voffA[2], voffB[2];
#pragma unroll
    for (int i = 0; i < 2; ++i) { int R, C; stage_rc(tid * 16 + i * 8192, R, C);
        const int Rb = Epi::PERM ? ((R & ~31) + perm32(R & 31)) : R;
        voffA[i] = (unsigned)(R * g.lda + C) * 2u; voffB[i] = (unsigned)(Rb * g.ldb + C) * 2u; }
    const size_t kstep = (size_t)(BK * 2);
    const size_t hstepA = (size_t)HALF * g.lda * 2, hstepB = (size_t)HALF * g.ldb * 2;
    const size_t tstepA = 2 * hstepA, tstepB = 2 * hstepB;
    const unsigned ldsw = (unsigned)wid * 1024u;
    const int aoff = lds_byte(wr * 64 + fr, fq * 8), boff = lds_byte(wc * 32 + fr, fq * 8);
#define PG8_SA(b, h) (((b) * 2 + (h)) * HTB)
#define PG8_SB(b, h) ((4 + (b) * 2 + (h)) * HTB)
#define PG8_STAGE(bufoff, gbase, voff) do { _Pragma("unroll") for (int _i = 0; _i < 2; ++_i) \
        __builtin_amdgcn_global_load_lds((const unsigned*)((const char*)(gbase) + (voff)[_i]), (LAS unsigned*)(lds + (bufoff) + ldsw + _i * 8192), 16, 0, 0); } while (0)
#define PG8_LDA(dst, b, h) do { _Pragma("unroll") for (int m = 0; m < 4; ++m) _Pragma("unroll") for (int k = 0; k < 2; ++k) dst[m][k] = *(const LAS bf16x8*)(lds + PG8_SA(b, h) + aoff + m * 2048 + k * 1024); } while (0)
#define PG8_LDB(dst, b, h) do { _Pragma("unroll") for (int n = 0; n < 2; ++n) _Pragma("unroll") for (int k = 0; k < 2; ++k) dst[n][k] = *(const LAS bf16x8*)(lds + PG8_SB(b, h) + boff + n * 2048 + k * 1024); } while (0)
#define PG8_MMA(ai, bj, At, Bt) do { __builtin_amdgcn_s_setprio(1); _Pragma("unroll") for (int m = 0; m < 4; ++m) _Pragma("unroll") for (int n = 0; n < 2; ++n) _Pragma("unroll") for (int k = 0; k < 2; ++k) \
        acc[ai][bj][m][n] = __builtin_amdgcn_mfma_f32_16x16x32_bf16(Bt[n][k], At[m][k], acc[ai][bj][m][n], 0, 0, 0); __builtin_amdgcn_s_setprio(0); } while (0)
#define PG8_WAIT_V(n) asm volatile("s_waitcnt vmcnt(" #n ")" ::: "memory")
#define PG8_WAIT_L(n) asm volatile("s_waitcnt lgkmcnt(" #n ")" ::: "memory")
#define PG8_BAR __builtin_amdgcn_s_barrier()
#define PG8_SCHED __builtin_amdgcn_sched_barrier(0)
    Unit cur, nxt; int ui = 0;
    if (!S.next(0, cur)) return;
    f32x4 acc[2][2][4][2];
#pragma unroll
    for (int a = 0; a < 2; ++a)
#pragma unroll
        for (int b = 0; b < 2; ++b)
#pragma unroll
            for (int m = 0; m < 4; ++m)
#pragma unroll
                for (int n = 0; n < 2; ++n) acc[a][b][m][n] = (f32x4){0.f, 0.f, 0.f, 0.f};
    bf16x8 At[4][2], B0[2][2], B1[2][2];
    const char* cA = (const char*)g.A + (size_t)cur.pm * tstepA + (g.akmode ? (size_t)(cur.pn >> 1) * 512 : 0);
    const char* cB = (const char*)g.Bt + (size_t)cur.pn * tstepB;
    PG8_STAGE(PG8_SB(0, 0), cB, voffB); PG8_STAGE(PG8_SB(0, 1), cB + hstepB, voffB); PG8_STAGE(PG8_SA(0, 0), cA, voffA); PG8_STAGE(PG8_SA(0, 1), cA + hstepA, voffA);
    if (wr == 1) PG8_BAR;
    PG8_WAIT_V(2); PG8_BAR;
    PG8_STAGE(PG8_SB(1, 0), cB + kstep, voffB); PG8_STAGE(PG8_SA(1, 0), cA + kstep, voffA); PG8_STAGE(PG8_SB(1, 1), cB + hstepB + kstep, voffB);
    PG8_WAIT_V(6); PG8_BAR;
    for (;;) {
        const bool has_next = S.next(ui + 1, nxt);
        const char* nA = has_next ? (const char*)g.A + (size_t)nxt.pm * tstepA + (g.akmode ? (size_t)(nxt.pn >> 1) * 512 : 0) : cA;
        const char* nB = has_next ? (const char*)g.Bt + (size_t)nxt.pn * tstepB : cB;
        for (int t = 0; t < nt; t += 2) {
            const bool last = (t == nt - 2);
            const char* a1 = cA + (size_t)(t + 1) * kstep;
            const char* a2 = last ? nA : cA + (size_t)(t + 2) * kstep; const char* b2 = last ? nB : cB + (size_t)(t + 2) * kstep;
            const char* a3 = a2 + kstep; const char* b3 = b2 + kstep;
            if constexpr (Epi::MID) { if (t == (nt >> 1)) E.mid(acc, cur, wr, fr); }
            PG8_LDB(B0, 0, 0); PG8_LDB(B1, 0, 1); PG8_SCHED; PG8_LDA(At, 0, 0); PG8_STAGE(PG8_SA(1, 1), a1 + hstepA, voffA);
            PG8_WAIT_V(8); PG8_WAIT_L(0); PG8_BAR; PG8_MMA(0, 0, At, B0); PG8_MMA(0, 1, At, B1); PG8_BAR; PG8_SCHED;
            PG8_LDA(At, 0, 1); PG8_STAGE(PG8_SB(0, 0), b2, voffB); PG8_STAGE(PG8_SB(0, 1), b2 + hstepB, voffB); PG8_STAGE(PG8_SA(0, 0), a2, voffA);
            PG8_WAIT_V(8); PG8_WAIT_L(0); PG8_BAR; PG8_MMA(1, 0, At, B0); PG8_MMA(1, 1, At, B1); PG8_BAR; PG8_SCHED;
            PG8_LDB(B0, 1, 0); PG8_LDB(B1, 1, 1); PG8_SCHED; PG8_LDA(At, 1, 0); PG8_STAGE(PG8_SA(0, 1), a2 + hstepA, voffA);
            PG8_WAIT_V(8); PG8_WAIT_L(0); PG8_BAR; PG8_MMA(0, 0, At, B0); PG8_MMA(0, 1, At, B1); PG8_BAR; PG8_SCHED;
            PG8_LDA(At, 1, 1); PG8_STAGE(PG8_SB(1, 0), b3, voffB); PG8_STAGE(PG8_SB(1, 1), b3 + hstepB, voffB); PG8_STAGE(PG8_SA(1, 0), a3, voffA);
            PG8_WAIT_V(8); PG8_WAIT_L(0); PG8_BAR; PG8_MMA(1, 0, At, B0); PG8_MMA(1, 1, At, B1); PG8_BAR; PG8_SCHED;
        }
        if constexpr (ALIGN_EPI) { if (wr == 0) PG8_BAR; }
        E(acc, cur, wr, wc, fr, fq);
        if (!has_next) break;
#pragma unroll
        for (int a = 0; a < 2; ++a)
#pragma unroll
            for (int b = 0; b < 2; ++b)
#pragma unroll
                for (int m = 0; m < 4; ++m)
#pragma unroll
                    for (int n = 0; n < 2; ++n) acc[a][b][m][n] = (f32x4){0.f, 0.f, 0.f, 0.f};
        cur = nxt; cA = nA; cB = nB; ++ui;
        if constexpr (ALIGN_EPI) { if (wr == 1) PG8_BAR; }
    }
    PG8_WAIT_V(0);
    if constexpr (!ALIGN_EPI) { if (wr == 0) PG8_BAR; }
    PG8_BAR;
#undef PG8_SA
#undef PG8_SB
#undef PG8_STAGE
#undef PG8_LDA
#undef PG8_LDB
#undef PG8_MMA
#undef PG8_WAIT_V
#undef PG8_WAIT_L
#undef PG8_BAR
#undef PG8_SCHED
}
}

template <class E> struct EpiWrap {
    E e; static constexpr bool MID = E::MID, PERM = E::PERM;
    __device__ __forceinline__ void operator()(const f32x4 (&acc)[2][2][4][2], const pg8::Unit& u, int wr, int wc, int fr, int fq) const {
        if constexpr (E::HAS_RES) {
            f32x4 rc[2][2], rn[2][2];
            { const int row = u.pm * 256 + wr * 64 + fr;
#pragma unroll
              for (int bj = 0; bj < 2; ++bj)
#pragma unroll
                  for (int n = 0; n < 2; ++n) rc[bj][n] = e.res(row, u.pn * 256 + bj * 128 + wc * 32 + 8 * fq + 4 * n); }
#pragma unroll
            for (int idx = 0; idx < 8; ++idx) {
                const int ai = idx >> 2, m = idx & 3;
                const int row = u.pm * 256 + ai * 128 + wr * 64 + m * 16 + fr; const float rv = e.rowval(row); float s = 0.f;
                if (idx < 7) { const int rown = u.pm * 256 + ((idx + 1) >> 2) * 128 + wr * 64 + ((idx + 1) & 3) * 16 + fr;
#pragma unroll
                    for (int bj = 0; bj < 2; ++bj)
#pragma unroll
                        for (int n = 0; n < 2; ++n) rn[bj][n] = e.res(rown, u.pn * 256 + bj * 128 + wc * 32 + 8 * fq + 4 * n); }
#pragma unroll
                for (int bj = 0; bj < 2; ++bj) s += e.applyr8(row, u.pn * 256 + bj * 128 + wc * 32 + 8 * fq, acc[ai][bj][m][0], acc[ai][bj][m][1], rv, rc[bj][0], rc[bj][1]);
                if constexpr (E::HAS_SS) { s += __shfl_xor(s, 16); s += __shfl_xor(s, 32); if (fq == 0) atomicAdd(e.ss + row, s); }
                asm volatile("" ::: "memory");
#pragma unroll
                for (int bj = 0; bj < 2; ++bj)
#pragma unroll
                    for (int n = 0; n < 2; ++n) rc[bj][n] = rn[bj][n];
            }
            return;
        }
        if constexpr (E::PERM && !E::HAS_RES) {
#pragma unroll
            for (int ai = 0; ai < 2; ++ai)
#pragma unroll
                for (int m = 0; m < 4; ++m) {
                    const int row = u.pm * 256 + ai * 128 + wr * 64 + m * 16 + fr; const float rv = e.rowval(row); float s = 0.f;
#pragma unroll
                    for (int bj = 0; bj < 2; ++bj) s += e.apply8(row, u.pn * 256 + bj * 128 + wc * 32 + 8 * fq, acc[ai][bj][m][0], acc[ai][bj][m][1], rv);
                    if constexpr (E::HAS_SS) { s += __shfl_xor(s, 16); s += __shfl_xor(s, 32); if (fq == 0) atomicAdd(e.ss + row, s); }
                    asm volatile("" ::: "memory");
                }
            return;
        }
#pragma unroll
        for (int ai = 0; ai < 2; ++ai)
#pragma unroll
            for (int m = 0; m < 4; ++m) {
                const int row = u.pm * 256 + ai * 128 + wr * 64 + m * 16 + fr; const float rv = e.rowval(row); float s = 0.f;
#pragma unroll
                for (int bj = 0; bj < 2; ++bj)
#pragma unroll
                    for (int n = 0; n < 2; ++n) s += e.apply(row, u.pn * 256 + bj * 128 + wc * 32 + n * 16 + 4 * fq, acc[ai][bj][m][n], rv);
                if constexpr (E::HAS_SS) { s += __shfl_xor(s, 16); s += __shfl_xor(s, 32); if (fq == 0) atomicAdd(e.ss + row, s); }
                asm volatile("" ::: "memory");
            }
    }
    __device__ __forceinline__ void mid(f32x4 (&acc)[2][2][4][2], const pg8::Unit& u, int wr, int fr) const {
#pragma unroll
        for (int ai = 0; ai < 2; ++ai)
#pragma unroll
            for (int m = 0; m < 4; ++m) { const float r = e.kscale(u.pm * 256 + ai * 128 + wr * 64 + m * 16 + fr, 0);
#pragma unroll
                for (int bj = 0; bj < 2; ++bj)
#pragma unroll
                    for (int n = 0; n < 2; ++n) acc[ai][bj][m][n] = acc[ai][bj][m][n] * r; }
    }
};
__device__ __forceinline__ u32x2 pk4(f32x4 v) { u32x2 w; w.x = cvt_pk_bf16(v[0], v[1]); w.y = cvt_pk_bf16(v[2], v[3]); return w; }
__device__ __forceinline__ f32x4 up4(u32x2 w) { return (f32x4){bf_lo(w.x), bf_hi(w.x), bf_lo(w.y), bf_hi(w.y)}; }
__device__ __forceinline__ float ssq4(f32x4 v) { return (v[0] * v[0] + v[1] * v[1]) + (v[2] * v[2] + v[3] * v[3]); }

struct EIn {
    static constexpr bool HAS_RES = false, PERM = true; static constexpr bool MID = false, HAS_SS = false; float* ss; const float* rs0; bf16_t* Z;
    __device__ __forceinline__ float rowval(int row) const { return rs0[row]; }
    __device__ __forceinline__ float kscale(int, int) const { return 1.f; }
    __device__ __forceinline__ float apply(int row, int col, f32x4 v, float rv) const { *(u32x2*)(Z + (size_t)row * NZ + col) = pk4(v * rv); return 0.f; }
    __device__ __forceinline__ float apply8(int row, int col, f32x4 v0, f32x4 v1, float rv) const { u32x4 w; { const u32x2 a0 = pk4(v0 * rv), a1 = pk4(v1 * rv); w.x = a0.x; w.y = a0.y; w.z = a1.x; w.w = a1.y; } *(u32x4*)(Z + (size_t)row * NZ + col) = w; return 0.f; }
};
struct EGlu {
    static constexpr bool HAS_RES = false, PERM = true; static constexpr bool MID = false, HAS_SS = true; float* ss; const float* bglu; const bf16_t* YG; bf16_t* MG;
    __device__ __forceinline__ float rowval(int) const { return 0.f; }
    __device__ __forceinline__ float kscale(int, int) const { return 1.f; }
    __device__ __forceinline__ float apply(int row, int col, f32x4 v, float) const {
        const f32x4 b = *(const f32x4*)(bglu + col); const f32x4 yg = up4(*(const u32x2*)(YG + (size_t)row * DH + col)); f32x4 o;
#pragma unroll
        for (int j = 0; j < 4; ++j) o[j] = yg[j] * sigm(v[j] + b[j]);
        *(u32x2*)(MG + (size_t)row * DM + col) = pk4(o); return ssq4(o);
    }
    __device__ __forceinline__ float apply8(int row, int col, f32x4 v0, f32x4 v1, float) const {
        const f32x4 b0 = *(const f32x4*)(bglu + col), b1 = *(const f32x4*)(bglu + col + 4); const u32x4 yr = *(const u32x4*)(YG + (size_t)row * DH + col);
        const f32x4 y0 = up4((u32x2){yr.x, yr.y}), y1 = up4((u32x2){yr.z, yr.w}); f32x4 o0, o1;
#pragma unroll
        for (int j = 0; j < 4; ++j) { o0[j] = y0[j] * sigm(v0[j] + b0[j]); o1[j] = y1[j] * sigm(v1[j] + b1[j]); }
        u32x4 w; { const u32x2 a0 = pk4(o0), a1 = pk4(o1); w.x = a0.x; w.y = a0.y; w.z = a1.x; w.w = a1.y; } *(u32x4*)(MG + (size_t)row * DM + col) = w; return ssq4(o0) + ssq4(o1);
    }
};
struct EOut {
    static constexpr bool MID = true, HAS_SS = true; float* ss; const float* rat; const float* rsb; const float* xp; const float* xs; float* XO; bf16_t* AB;
    __device__ __forceinline__ float rowval(int row) const { return rsb[row]; }
    __device__ __forceinline__ float kscale(int row, int w) const { return w < 4 ? rat[row] : 1.f; }
    static constexpr bool HAS_RES = true, PERM = true;
    __device__ __forceinline__ f32x4 res(int row, int col) const { return *(const f32x4*)(xp + (size_t)row * DM + col); }
    __device__ __forceinline__ float applyr8(int row, int col, f32x4 v0, f32x4 v1, float rv, f32x4 r0, f32x4 r1) const {
        const f32x4 o0 = r0 + v0 * rv, o1 = r1 + v1 * rv; float* p = XO + (size_t)row * DM + col; *(f32x4*)p = o0; *(f32x4*)(p + 4) = o1;
        u32x4 w; { const u32x2 a0 = pk4(o0), a1 = pk4(o1); w.x = a0.x; w.y = a0.y; w.z = a1.x; w.w = a1.y; } *(u32x4*)(AB + (size_t)row * DM + col) = w; return ssq4(o0) + ssq4(o1); }
    __device__ __forceinline__ float applyr(int row, int col, f32x4 v, float rv, f32x4 r) const {
        const f32x4 o = r + v * rv;
        *(f32x4*)(XO + (size_t)row * DM + col) = o; *(u32x2*)(AB + (size_t)row * DM + col) = pk4(o); return ssq4(o); }
    __device__ __forceinline__ float apply(int row, int col, f32x4 v, float rv) const {
        const float* xr = row < MP ? xp + (size_t)row * DM : xs + (size_t)(row - MP) * DM;
        const f32x4 o = *(const f32x4*)(xr + col) + v * rv;
        *(f32x4*)(XO + (size_t)row * DM + col) = o; *(u32x2*)(AB + (size_t)row * DM + col) = pk4(o); return ssq4(o);
    }
};
struct EUp {
    static constexpr bool HAS_RES = false, PERM = true; static constexpr bool MID = false, HAS_SS = false; float* ss; const float* ss1; bf16_t* HUP;
    __device__ __forceinline__ float rowval(int row) const { return rsqrtf(ss1[row] * (1.f / DM) + EPS); }
    __device__ __forceinline__ float kscale(int, int) const { return 1.f; }
    __device__ __forceinline__ float apply(int row, int col, f32x4 v, float rv) const { f32x4 o;
#pragma unroll
        for (int j = 0; j < 4; ++j) { const float r = fmaxf(v[j] * rv, 0.f); o[j] = r * r; }
        *(u32x2*)(HUP + (size_t)row * DFF + col) = pk4(o); return 0.f; }
    __device__ __forceinline__ float apply8(int row, int col, f32x4 v0, f32x4 v1, float rv) const { f32x4 o0, o1;
#pragma unroll
        for (int j = 0; j < 4; ++j) { const float r0 = fmaxf(v0[j] * rv, 0.f), r1 = fmaxf(v1[j] * rv, 0.f); o0[j] = r0 * r0; o1[j] = r1 * r1; }
        u32x4 w; { const u32x2 a0 = pk4(o0), a1 = pk4(o1); w.x = a0.x; w.y = a0.y; w.z = a1.x; w.w = a1.y; } *(u32x4*)(HUP + (size_t)row * DFF + col) = w; return 0.f; }
};
struct EDown {
    static constexpr bool MID = false, HAS_SS = true; float* ss; float* XO; bf16_t* AB;
    __device__ __forceinline__ float rowval(int) const { return 0.f; }
    __device__ __forceinline__ float kscale(int, int) const { return 1.f; }
    static constexpr bool HAS_RES = true, PERM = true;
    __device__ __forceinline__ f32x4 res(int row, int col) const { return *(const f32x4*)(XO + (size_t)row * DM + col); }
    __device__ __forceinline__ float applyr8(int row, int col, f32x4 v0, f32x4 v1, float, f32x4 r0, f32x4 r1) const {
        const f32x4 o0 = r0 + v0, o1 = r1 + v1; float* p = XO + (size_t)row * DM + col; *(f32x4*)p = o0; *(f32x4*)(p + 4) = o1;
        u32x4 w; { const u32x2 a0 = pk4(o0), a1 = pk4(o1); w.x = a0.x; w.y = a0.y; w.z = a1.x; w.w = a1.y; } *(u32x4*)(AB + (size_t)row * DM + col) = w; return ssq4(o0) + ssq4(o1); }
    __device__ __forceinline__ float applyr(int row, int col, f32x4 v, float, f32x4 r) const {
        const f32x4 o = r + v; *(f32x4*)(XO + (size_t)row * DM + col) = o; *(u32x2*)(AB + (size_t)row * DM + col) = pk4(o); return ssq4(o); }
    __device__ __forceinline__ float apply(int row, int col, f32x4 v, float) const {
        float* p = XO + (size_t)row * DM + col; const f32x4 o = *(const f32x4*)p + v; *(f32x4*)p = o; *(u32x2*)(AB + (size_t)row * DM + col) = pk4(o); return ssq4(o); }
};
struct EPw {
    static constexpr bool HAS_RES = false, PERM = true; static constexpr bool MID = false, HAS_SS = false; float* ss; bf16_t* PW;
    __device__ __forceinline__ float rowval(int) const { return 0.f; }
    __device__ __forceinline__ float kscale(int, int) const { return 1.f; }
    __device__ __forceinline__ float apply(int row, int col, f32x4 v, float) const { *(u32x2*)(PW + (size_t)row * DM + col) = pk4(v); return 0.f; }
    __device__ __forceinline__ float apply8(int row, int col, f32x4 v0, f32x4 v1, float) const { u32x4 w; { const u32x2 a0 = pk4(v0), a1 = pk4(v1); w.x = a0.x; w.y = a0.y; w.z = a1.x; w.w = a1.y; } *(u32x4*)(PW + (size_t)row * DM + col) = w; return 0.f; }
};
struct EGate {
    static constexpr bool MID = false, HAS_SS = true; float* ss; const float* ss2; const bf16_t* PW; float* XO;
    __device__ __forceinline__ float rowval(int row) const { return rsqrtf(ss2[row] * (1.f / DM) + EPS); }
    __device__ __forceinline__ float kscale(int, int) const { return 1.f; }
    static constexpr bool HAS_RES = true, PERM = true;
    __device__ __forceinline__ f32x4 res(int row, int col) const { return *(const f32x4*)(XO + (size_t)row * DM + col); }
    __device__ __forceinline__ float applyr8(int row, int col, f32x4 v0, f32x4 v1, float rv, f32x4 r0, f32x4 r1) const {
        const u32x4 pr = *(const u32x4*)(PW + (size_t)row * DM + col); const f32x4 p0 = up4((u32x2){pr.x, pr.y}), p1 = up4((u32x2){pr.z, pr.w}); f32x4 o0 = r0, o1 = r1;
#pragma unroll
        for (int j = 0; j < 4; ++j) { o0[j] += p0[j] * sigm(v0[j] * rv); o1[j] += p1[j] * sigm(v1[j] * rv); }
        float* p = XO + (size_t)row * DM + col; *(f32x4*)p = o0; *(f32x4*)(p + 4) = o1; return ssq4(o0) + ssq4(o1); }
    __device__ __forceinline__ float applyr(int row, int col, f32x4 v, float rv, f32x4 r) const {
        f32x4 o = r; const f32x4 pw = up4(*(const u32x2*)(PW + (size_t)row * DM + col));
#pragma unroll
        for (int j = 0; j < 4; ++j) o[j] += pw[j] * sigm(v[j] * rv);
        *(f32x4*)(XO + (size_t)row * DM + col) = o; return ssq4(o); }
    __device__ __forceinline__ float apply(int row, int col, f32x4 v, float rv) const {
        float* p = XO + (size_t)row * DM + col; f32x4 o = *(const f32x4*)p; const f32x4 pw = up4(*(const u32x2*)(PW + (size_t)row * DM + col));
#pragma unroll
        for (int j = 0; j < 4; ++j) o[j] += pw[j] * sigm(v[j] * rv);
        *(f32x4*)p = o; return ssq4(o); }
};
__device__ __forceinline__ float em1(float x) {
    float p = x * (1.f + x * (0.5f + x * (0.16666667f + x * (0.041666668f + x * (0.0083333338f + x * (0.0013888889f + x * 0.0001984127f))))));
    if (__builtin_expect(__any(fabsf(x) >= 0.5f), 0)) p = fabsf(x) < 0.5f ? p : __expf(x) - 1.f;
    return p;
}
struct ELru {
    static constexpr bool MID = false, PERM = false; const bf16_t* XC; const float* ba; const float* bi; const float* spl; float* Ao; float* Bo;
    __device__ __forceinline__ void mid(f32x4 (&)[2][2][4][2], const pg8::Unit&, int, int) const {}
    __device__ __forceinline__ void operator()(const f32x4 (&acc)[2][2][4][2], const pg8::Unit& u, int wr, int wc, int fr, int fq) const {
#pragma unroll
        for (int n = 0; n < 2; ++n) {
            const int ch = (u.pn >> 1) * 256 + (u.pn & 1) * 128 + wc * 32 + n * 16 + 4 * fq;
            const f32x4 bav = *(const f32x4*)(ba + ch), biv = *(const f32x4*)(bi + ch), sp = *(const f32x4*)(spl + ch);
#pragma unroll
            for (int ai = 0; ai < 2; ++ai)
#pragma unroll
                for (int m = 0; m < 4; ++m) {
                    const int row = u.pm * 256 + ai * 128 + wr * 64 + m * 16 + fr;
                    const f32x4 xc = up4(*(const u32x2*)(XC + (size_t)row * DH + ch)); f32x4 av, bv;
#pragma unroll
                    for (int j = 0; j < 4; ++j) { const float r = sigm(acc[ai][0][m][n][j] + bav[j]), ig = sigm(acc[ai][1][m][n][j] + biv[j]);
                        const float la = r * sp[j]; av[j] = 1.f + em1(la); bv[j] = __builtin_amdgcn_sqrtf(fmaxf(-em1(2.f * la), 0.f)) * ig * xc[j]; }
                    *(f32x4*)(Ao + (size_t)row * DH + ch) = av; *(f32x4*)(Bo + (size_t)row * DH + ch) = bv;
                    asm volatile("" ::: "memory");
                }
        }
    }
};

template <class E, int MT = 8, int NG = 1>
__device__ __forceinline__ void skinny_gemm(LAS unsigned char* lds, const bf16_t* A, int lda, const bf16_t* Bt, int ldb, int N, int K, const E& e, int nb = 0) {
    const int tid = threadIdx.x, wid = __builtin_amdgcn_readfirstlane(tid >> 6), lane = tid & 63, fr = lane & 15, fq = lane >> 4;
    LAS f32x4* red = (LAS f32x4*)lds;
    constexpr int NH = 8 / MT;
    const int kw = K >> 3, k0w = wid * kw, nks = kw >> 5, nit = ((N >> 4) / NG) * NH, G = gridDim.x, NBk = nb ? nb : G;
    for (int iti = G - 1 - (int)blockIdx.x; iti < nit && (G - 1 - (int)blockIdx.x) < NBk; iti += NBk) {
        const int n0 = (iti / NH) * (16 * NG), r0 = (iti % NH) * (MT * 16);
        f32x4 acc[NG][MT];
#pragma unroll
        for (int q = 0; q < NG; ++q)
#pragma unroll
            for (int m = 0; m < MT; ++m) acc[q][m] = (f32x4){0.f, 0.f, 0.f, 0.f};
        const bf16_t* bp = Bt + (size_t)(n0 + fr) * ldb + k0w + 8 * fq;
        const bf16_t* ap = A + (size_t)(r0 + fr) * lda + k0w + 8 * fq;
        {
            bf16x8 bc[NG], ac[MT];
#pragma unroll
            for (int q = 0; q < NG; ++q) bc[q] = *(const bf16x8*)(bp + (size_t)(16 * q) * ldb);
#pragma unroll
            for (int m = 0; m < MT; ++m) ac[m] = *(const bf16x8*)(ap + (size_t)(16 * m) * lda);
            for (int ks = 0; ks < nks; ++ks) {
                const int kn = ks + 1 < nks ? ks + 1 : ks;
                bf16x8 bn[NG], an[MT];
#pragma unroll
                for (int q = 0; q < NG; ++q) bn[q] = *(const bf16x8*)(bp + (size_t)(16 * q) * ldb + 32 * kn);
#pragma unroll
                for (int m = 0; m < MT; ++m) an[m] = *(const bf16x8*)(ap + (size_t)(16 * m) * lda + 32 * kn);
#pragma unroll
                for (int q = 0; q < NG; ++q)
#pragma unroll
                    for (int m = 0; m < MT; ++m) acc[q][m] = __builtin_amdgcn_mfma_f32_16x16x32_bf16(bc[q], ac[m], acc[q][m], 0, 0, 0);
#pragma unroll
                for (int q = 0; q < NG; ++q) bc[q] = bn[q];
#pragma unroll
                for (int m = 0; m < MT; ++m) ac[m] = an[m];
            }
        }
#pragma unroll
        for (int q = 0; q < NG; ++q)
#pragma unroll
            for (int m = 0; m < MT; ++m) red[((wid * NG + q) * MT + m) * 64 + lane] = acc[q][m];
        __syncthreads();
        if (wid < MT) {
            const int row = MP + r0 + 16 * wid + fr; const float rv = e.rowval(row);
#pragma unroll
            for (int q = 0; q < NG; ++q) {
                f32x4 v = (f32x4){0.f, 0.f, 0.f, 0.f};
#pragma unroll
                for (int w = 0; w < 8; ++w) { f32x4 p = red[((w * NG + q) * MT + wid) * 64 + lane]; if constexpr (E::MID) p = p * e.kscale(row, w); v += p; }
                float s = e.apply(row, n0 + 16 * q + 4 * fq, v, rv);
                if constexpr (E::HAS_SS) { s += __shfl_xor(s, 16); s += __shfl_xor(s, 32); if (fq == 0) atomicAdd(e.ss + row, s); }
            }
        }
        __syncthreads();
    }
}

struct Args { const float* in[37]; float* out; unsigned char* ws; int ph_lo, ph_hi; };
enum { I_XP = 0, I_XS, I_S5RE, I_S5IM, I_LRUH, I_CONV, I_PP, I_PS, I_GMIX, I_WIN, I_LAMRE, I_LAMIM, I_LOGSTEP, I_BRE, I_BIM, I_CRE, I_CIM, I_S5D,
       I_WGLU, I_BGLU, I_CONVW, I_CONVB, I_WA, I_BA, I_WI, I_BI, I_LAM, I_GMA, I_GMB, I_WOUT, I_GMLP, I_WUP, I_WDOWN, I_GPLE, I_WGATE, I_WPLE, I_GFIN };

__device__ __forceinline__ void tr_item(const float* W, int K, int N, bf16_t* WT, int rbase, int lru, const float* g1, const float* g2, int gsplit,
                                        LAS float* scr, int item, int lane) {
    const int nblk = N / 32, kb = item / nblk, nb = item % nblk, k0 = 64 * kb, n0 = 32 * nb;
    f32x4 wv[8];
#pragma unroll
    for (int i = 0; i < 8; ++i) wv[i] = *(const f32x4*)(W + (size_t)(k0 + 8 * i + (lane >> 3)) * N + n0 + 4 * (lane & 7));
#pragma unroll
    for (int i = 0; i < 8; ++i) { const int kk = 8 * i + (lane >> 3), k = k0 + kk; const float gv = g1 ? (k < gsplit ? g1[k] : g2[k - gsplit]) : 1.f;
        LAS float* d = scr + kk * 33 + 4 * (lane & 7); d[0] = wv[i][0] * gv; d[1] = wv[i][1] * gv; d[2] = wv[i][2] * gv; d[3] = wv[i][3] * gv; }
    LDS_WAIT();
    const int c = lane & 7;
#pragma unroll
    for (int j = 0; j < 4; ++j) { const int n = (lane >> 3) + 8 * j, nn = n0 + n; const int drow = lru ? rbase + (nn >> 7) * 256 + (nn & 127) : rbase + nn;
        const LAS float* s = scr + (8 * c) * 33 + n;
        u32x4 o; o.x = cvt_pk_bf16(s[0 * 33], s[1 * 33]); o.y = cvt_pk_bf16(s[2 * 33], s[3 * 33]); o.z = cvt_pk_bf16(s[4 * 33], s[5 * 33]); o.w = cvt_pk_bf16(s[6 * 33], s[7 * 33]);
        *(u32x4*)(WT + (size_t)drow * K + k0 + 8 * c) = o; }
    LDS_WAIT();
}

__device__ __forceinline__ void phase0(const Args& a, LAS unsigned char* lds) {
    const int tid = threadIdx.x, wave = __builtin_amdgcn_readfirstlane(tid >> 6), lane = tid & 63, G = gridDim.x;
    unsigned char* ws = a.ws;
    LAS float* scr = (LAS float*)(lds + wave * 16384);
    const int gw = blockIdx.x * 8 + wave, NGW = G * 8;
    constexpr int I_IN = 32 * 96, I_UP = 32 * 256, I_DOWN = 5120  , I_LRU = 8 * 32;
    constexpr int NITEMS = I_IN + I_UP + I_DOWN + I_LRU;
    for (int it = gw; it < NITEMS; it += NGW) {
        int r = it;
        if (r < I_UP) { tr_item(a.in[I_WUP], DM, DFF, (bf16_t*)(ws + WS_WUP), 0, 0, a.in[I_GMLP], a.in[I_GMLP], 1 << 30, scr, r, lane); continue; } r -= I_UP;
        if (r < I_DOWN) { tr_item(a.in[I_WDOWN], DFF, DM, (bf16_t*)(ws + WS_WDOWN), 0, 0, nullptr, nullptr, 0, scr, r, lane); continue; } r -= I_DOWN;
        if (r < I_IN) { tr_item(a.in[I_WIN], DM, NZ, (bf16_t*)(ws + WS_WIN), 0, 0, a.in[I_GMIX], a.in[I_GMIX], 1 << 30, scr, r, lane); continue; } r -= I_IN;
        { const int mat = r >> 5, h = mat >> 1, bj = mat & 1;
          tr_item((bj ? a.in[I_WI] : a.in[I_WA]) + (size_t)h * 65536, 256, 256, (bf16_t*)(ws + WS_WLRU), h * 512 + bj * 128, 1, nullptr, nullptr, 0, scr, r & 31, lane); }
    }
    float* rs0 = (float*)(ws + WS_SMALL + SM_RS0); bf16_t* XB = (bf16_t*)(ws + WS_AB); bf16_t* PB = (bf16_t*)(ws + WS_PB);
    for (int row = gw; row < MT; row += NGW) {
        const float* xr = row < MP ? a.in[I_XP] + (size_t)row * DM : a.in[I_XS] + (size_t)(row - MP) * DM;
        f32x4 v[8]; float s = 0.f;
#pragma unroll
        for (int j = 0; j < 8; ++j) { v[j] = ((const f32x4*)xr)[lane + 64 * j]; s += ssq4(v[j]); }
        s = wave_sum(s); if (lane == 0) rs0[row] = rsqrtf(s * (1.f / DM) + EPS);
#pragma unroll
        for (int j = 0; j < 8; ++j) ((u32x2*)(XB + (size_t)row * DM))[lane + 64 * j] = pk4(v[j]);
        const float* pr = row < MP ? a.in[I_PP] + (size_t)row * DPLE : a.in[I_PS] + (size_t)(row - MP) * DPLE;
        ((u32x2*)(PB + (size_t)row * DPLE))[lane] = pk4(((const f32x4*)pr)[lane]);
    }
    { float* SPL = (float*)(ws + WS_SMALL + SM_SPL);
      for (int i = blockIdx.x * 512 + tid; i < DH; i += G * 512) { const float xl = -a.in[I_LAM][i]; SPL[i] = -8.f * (fmaxf(xl, 0.f) + log1pf(expf(-fabsf(xl)))); } }
    float* AR = (float*)(ws + WS_SMALL + SM_AR); float* AI = (float*)(ws + WS_SMALL + SM_AI); float* A64R = (float*)(ws + WS_SMALL + SM_A64R); float* A64I = (float*)(ws + WS_SMALL + SM_A64I);
    bf16_t* BBB = (bf16_t*)(ws + WS_SMALL + SM_BBB); bf16_t* CMB = (bf16_t*)(ws + WS_SMALL + SM_CMB);
    for (int i = blockIdx.x * 512 + tid; i < 4096; i += G * 512) {
        const int g = i >> 6, p = i & 63;
        const float step = expf(a.in[I_LOGSTEP][g]), lr = a.in[I_LAMRE][i], li = a.in[I_LAMIM][i];
        const float mag = expf(lr * step); float sn, cs; sincosf(li * step, &sn, &cs);
        const float ar = mag * cs, ai = mag * sn, nr = ar - 1.f, ni = ai, den = lr * lr + li * li;
        const float cr = (nr * lr + ni * li) / den, ci = (ni * lr - nr * li) / den;
        AR[i] = ar; AI[i] = ai;
        float pr_ = ar, pi_ = ai;
#pragma unroll
        for (int q = 0; q < 6; ++q) { const float t0 = pr_ * pr_ - pi_ * pi_, t1 = 2.f * pr_ * pi_; pr_ = t0; pi_ = t1; }
        A64R[i] = pr_; A64I[i] = pi_;
        for (int c = 0; c < 16; ++c) {
            const float br = a.in[I_BRE][(size_t)i * 16 + c], bi = a.in[I_BIM][(size_t)i * 16 + c];
            BBB[((size_t)g * 128 + p) * 16 + c] = (bf16_t)(cvt_pk_bf16(cr * br - ci * bi, 0.f) & 0xffffu);
            BBB[((size_t)g * 128 + 64 + p) * 16 + c] = (bf16_t)(cvt_pk_bf16(cr * bi + ci * br, 0.f) & 0xffffu);
            CMB[((size_t)g * 16 + c) * 128 + p] = (bf16_t)(cvt_pk_bf16(a.in[I_CRE][((size_t)g * 16 + c) * 64 + p], 0.f) & 0xffffu);
            CMB[((size_t)g * 16 + c) * 128 + 64 + p] = (bf16_t)(cvt_pk_bf16(-a.in[I_CIM][((size_t)g * 16 + c) * 64 + p], 0.f) & 0xffffu);
        }
    }
}

__device__ __forceinline__ void s5_unit(const Args& a, LAS unsigned char* wl, int lane, int mode, int n, int g, int j) {
    unsigned char* ws = a.ws;
    const int fr = lane & 15, fq = lane >> 4;
    const float* AR = (const float*)(ws + WS_SMALL + SM_AR); const float* AI = (const float*)(ws + WS_SMALL + SM_AI);
    const bf16_t* BBB = (const bf16_t*)(ws + WS_SMALL + SM_BBB); const bf16_t* CMB = (const bf16_t*)(ws + WS_SMALL + SM_CMB);
    const bf16_t* Z = (const bf16_t*)(ws + WS_Z); bf16_t* YG = (bf16_t*)(ws + WS_YG); float* SUM = (float*)(ws + WS_S5SUM);
    LAS float* BuS = (LAS float*)wl; LAS bf16_t* Hs = (LAS bf16_t*)(wl + 8448);
    const float ar = AR[g * 64 + lane], ai = AI[g * 64 + lane];
    const bf16x8 zero8 = (bf16x8){0, 0, 0, 0, 0, 0, 0, 0};
    bf16x8 bb[8];
#pragma unroll
    for (int t = 0; t < 8; ++t) bb[t] = fq < 2 ? *(const bf16x8*)(BBB + ((size_t)g * 128 + 16 * t + fr) * 16 + 8 * fq) : zero8;
    bf16x8 cm[4];
#pragma unroll
    for (int kk = 0; kk < 4; ++kk) cm[kk] = *(const bf16x8*)(CMB + ((size_t)g * 16 + fr) * 128 + 32 * kk + 8 * fq);
    const f32x4 dsk = *(const f32x4*)(a.in[I_S5D] + 16 * g + 4 * fq);
    float hr = 0.f, hi = 0.f;
    if (mode == 1 && j > 0) {
        const float pr = ((const float*)(ws + WS_SMALL + SM_A64R))[g * 64 + lane], pi = ((const float*)(ws + WS_SMALL + SM_A64I))[g * 64 + lane];
        const float* sp = SUM + ((size_t)(n * 64 + g) * 32) * 128;
        for (int i = 0; i < j; ++i) { const float sr = sp[i * 128 + lane], si = sp[i * 128 + 64 + lane];
            const float t0 = pr * hr - pi * hi + sr, t1 = pr * hi + pi * hr + si; hr = t0; hi = t1; }
    }
    if (mode == 4 && j > 0) {
        float pr = ((const float*)(ws + WS_SMALL + SM_A64R))[g * 64 + lane], pi = ((const float*)(ws + WS_SMALL + SM_A64I))[g * 64 + lane];
#pragma unroll
        for (int q = 0; q < 2; ++q) { const float t0 = pr * pr - pi * pi, t1 = 2.f * pr * pi; pr = t0; pi = t1; }
        for (int v = 0; v < j; ++v) { const LAS float* ps = (const LAS float*)(wl + (v - j) * 16384 + 12800); const float sr = ps[lane], si = ps[64 + lane];
            const float t0 = pr * hr - pi * hi + sr, t1 = pr * hi + pi * hr + si; hr = t0; hi = t1; }
    }
    const int row0 = mode == 2 ? MP + 16 * j : ((mode == 3 || mode == 4) ? n * SEQ + 256 * j : n * SEQ + 64 * j);
    const int nblk = mode == 2 ? 1 : ((mode == 3 || mode == 1 || mode == 4) ? 16 : 4);
    for (int blk = 0; blk < nblk; ++blk) {
        const int r0 = row0 + 16 * blk;
        const bf16x8 ua = fq < 2 ? *(const bf16x8*)(Z + (size_t)(r0 + fr) * NZ + 16 * g + 8 * fq) : zero8;
        u32x2 u4raw = (u32x2){0u, 0u}; if (mode == 1 || mode == 2 || mode == 4) u4raw = *(const u32x2*)(Z + (size_t)(r0 + fr) * NZ + 16 * g + 4 * fq);
#pragma unroll
        for (int t = 0; t < 8; ++t) {
            const f32x4 c = __builtin_amdgcn_mfma_f32_16x16x32_bf16(ua, bb[t], (f32x4){0.f, 0.f, 0.f, 0.f}, 0, 0, 0);
#pragma unroll
            for (int jj = 0; jj < 4; ++jj) BuS[(4 * fq + jj) * 132 + 16 * t + fr] = c[jj];
        }
        LDS_WAIT();
        float burv[16], buiv[16];
#pragma unroll
        for (int t = 0; t < 16; ++t) { burv[t] = BuS[t * 132 + lane]; buiv[t] = BuS[t * 132 + 64 + lane]; }
#pragma unroll
        for (int t = 0; t < 16; ++t) {
            const float bur = burv[t], bui = buiv[t];
            if (mode == 2) { const size_t si = ((size_t)(r0 - MP + t) * 64 + g) * 64 + lane; hr = a.in[I_S5RE][si]; hi = a.in[I_S5IM][si]; }
            const float t0 = ar * hr - ai * hi + bur, t1 = ar * hi + ai * hr + bui; hr = t0; hi = t1;
            if (mode == 2) { const size_t si = ((size_t)(r0 - MP + t) * 64 + g) * 64 + lane; a.out[O_S5RS + si] = hr; a.out[O_S5IS + si] = hi; }
            if (mode == 1 || mode == 2 || mode == 4) { const unsigned w = cvt_pk_bf16(hr, hi); Hs[t * 136 + lane] = (bf16_t)(w & 0xffffu); Hs[t * 136 + 64 + lane] = (bf16_t)(w >> 16); }
        }
        if (mode == 1 || mode == 2 || mode == 4) {
            LDS_WAIT();
            f32x4 y = (f32x4){0.f, 0.f, 0.f, 0.f};
#pragma unroll
            for (int kk = 0; kk < 4; ++kk) { const bf16x8 hb = *(const LAS bf16x8*)(Hs + fr * 136 + 32 * kk + 8 * fq);
                y = __builtin_amdgcn_mfma_f32_16x16x32_bf16(cm[kk], hb, y, 0, 0, 0); }
            const f32x4 u4 = up4(u4raw); f32x4 o;
#pragma unroll
            for (int jj = 0; jj < 4; ++jj) o[jj] = gelu_t(y[jj] + dsk[jj] * u4[jj]);
            *(u32x2*)(YG + (size_t)(r0 + fr) * DH + 16 * g + 4 * fq) = pk4(o);
            LDS_WAIT();
        }
    }
    if (mode == 0) { float* sp = SUM + ((size_t)(n * 64 + g) * 32 + j) * 128; sp[lane] = hr; sp[64 + lane] = hi; }
    if (mode == 3) { LAS float* ps = (LAS float*)(wl + 12800); ps[lane] = hr; ps[64 + lane] = hi; }
    if (mode == 4 && j == 7) { a.out[O_S5RP + (size_t)(n * 64 + g) * 64 + lane] = hr; a.out[O_S5IP + (size_t)(n * 64 + g) * 64 + lane] = hi; }
}

__device__ __forceinline__ void conv_prompt(const Args& a) {
    unsigned char* ws = a.ws; const bf16_t* Z = (const bf16_t*)(ws + WS_Z); bf16_t* XC = (bf16_t*)(ws + WS_XC);
    const float* cw = a.in[I_CONVW]; const float* cb = a.in[I_CONVB];
    const int G = gridDim.x;
    for (int it = blockIdx.x * 512 + threadIdx.x; it < MP * 128; it += G * 512) {
        const int row = it >> 7, c = (it & 127) * 8, t = row & (SEQ - 1);
        float acc[8];
#pragma unroll
        for (int q = 0; q < 8; ++q) acc[q] = cb[c + q];
#pragma unroll
        for (int k = 0; k < 4; ++k) {
            if (t - 3 + k >= 0) {
                const u32x4 z = *(const u32x4*)(Z + (size_t)(row - 3 + k) * NZ + DH + c);
                const float x[8] = {bf_lo(z.x), bf_hi(z.x), bf_lo(z.y), bf_hi(z.y), bf_lo(z.z), bf_hi(z.z), bf_lo(z.w), bf_hi(z.w)};
#pragma unroll
                for (int q = 0; q < 8; ++q) acc[q] += cw[k * DH + c + q] * x[q];
                if (k == 3 && t >= SEQ - 3) {
                    float* o = a.out + O_CONVP + ((size_t)(row >> 11) * 3 + (t - (SEQ - 3))) * DH + c;
#pragma unroll
                    for (int q = 0; q < 8; ++q) o[q] = x[q];
                }
            }
        }
        u32x4 o; o.x = cvt_pk_bf16(acc[0], acc[1]); o.y = cvt_pk_bf16(acc[2], acc[3]); o.z = cvt_pk_bf16(acc[4], acc[5]); o.w = cvt_pk_bf16(acc[6], acc[7]);
        *(u32x4*)(XC + (size_t)row * DH + c) = o;
    }
}

__device__ __forceinline__ void conv_tile(const Args& a, int pm, int h) {
    unsigned char* ws = a.ws; const bf16_t* Z = (const bf16_t*)(ws + WS_Z); bf16_t* XC = (bf16_t*)(ws + WS_XC);
    const int tid = threadIdx.x, c = h * 256 + (tid & 31) * 8;
    float cwv[4][8], cbv[8];
#pragma unroll
    for (int q = 0; q < 8; ++q) { cbv[q] = a.in[I_CONVB][c + q];
#pragma unroll
        for (int k = 0; k < 4; ++k) cwv[k][q] = a.in[I_CONVW][k * DH + c + q]; }
#pragma unroll 1
    for (int r4 = 0; r4 < 16; r4 += 4) {
        u32x4 z[4][4];
#pragma unroll
        for (int rr = 0; rr < 4; ++rr) { const int row = pm * 256 + (tid >> 5) + 16 * (r4 + rr), t = row & (SEQ - 1);
#pragma unroll
            for (int k = 0; k < 4; ++k) z[rr][k] = (t - 3 + k >= 0) ? *(const u32x4*)(Z + (size_t)(row - 3 + k) * NZ + DH + c) : (u32x4){0u, 0u, 0u, 0u}; }
#pragma unroll
        for (int rr = 0; rr < 4; ++rr) { const int row = pm * 256 + (tid >> 5) + 16 * (r4 + rr), t = row & (SEQ - 1);
            float acc[8];
#pragma unroll
            for (int q = 0; q < 8; ++q) acc[q] = cbv[q];
#pragma unroll
            for (int k = 0; k < 4; ++k) { const u32x4 zz = z[rr][k];
                const float x[8] = {bf_lo(zz.x), bf_hi(zz.x), bf_lo(zz.y), bf_hi(zz.y), bf_lo(zz.z), bf_hi(zz.z), bf_lo(zz.w), bf_hi(zz.w)};
#pragma unroll
                for (int q = 0; q < 8; ++q) acc[q] += cwv[k][q] * x[q];
                if (k == 3 && t >= SEQ - 3) { float* o = a.out + O_CONVP + ((size_t)(row >> 11) * 3 + (t - (SEQ - 3))) * DH + c;
#pragma unroll
                    for (int q = 0; q < 8; ++q) o[q] = x[q]; } }
            u32x4 o; o.x = cvt_pk_bf16(acc[0], acc[1]); o.y = cvt_pk_bf16(acc[2], acc[3]); o.z = cvt_pk_bf16(acc[4], acc[5]); o.w = cvt_pk_bf16(acc[6], acc[7]);
            *(u32x4*)(XC + (size_t)row * DH + c) = o; }
    }
}

__device__ __forceinline__ void lru_sample(const Args& a, LAS unsigned char* lds, int unit) {
    unsigned char* ws = a.ws; const bf16_t* Z = (const bf16_t*)(ws + WS_Z); bf16_t* MG = (bf16_t*)(ws + WS_MERGED); float* ssB = (float*)(ws + WS_CTL) + SS_B * SS_STRIDE;
    LAS float* sxc = (LAS float*)lds;
    const int tid = threadIdx.x, s = unit >> 1, half = unit & 1, row = MP + s;
    const float* cw = a.in[I_CONVW]; const float* cs = a.in[I_CONV] + (size_t)s * 3 * DH;
    for (int c = tid; c < DH; c += 512) {
        const float xb = bf1(Z[(size_t)row * NZ + DH + c]);
        sxc[c] = a.in[I_CONVB][c] + cw[c] * cs[c] + cw[DH + c] * cs[DH + c] + cw[2 * DH + c] * cs[2 * DH + c] + cw[3 * DH + c] * xb;
        if ((c >> 9) == half) { float* o = a.out + O_CONVS + (size_t)s * 3 * DH; o[c] = cs[DH + c]; o[DH + c] = cs[2 * DH + c]; o[2 * DH + c] = xb; }
    }
    __syncthreads();
    float sq = 0.f;
    {
        const int c = half * 512 + tid, h = c >> 8, jj = c & 255;
        const float* wa = a.in[I_WA] + (size_t)h * 65536 + jj; const float* wi = a.in[I_WI] + (size_t)h * 65536 + jj;
        float ra = a.in[I_BA][c], ri = a.in[I_BI][c];
#pragma unroll 1
        for (int k0 = 0; k0 < 256; k0 += 32) {
            float wav[32], wiv[32];
#pragma unroll
            for (int q = 0; q < 32; ++q) { wav[q] = wa[(size_t)(k0 + q) * 256]; wiv[q] = wi[(size_t)(k0 + q) * 256]; }
#pragma unroll
            for (int q = 0; q < 32; ++q) { const float x = sxc[h * 256 + k0 + q]; ra += x * wav[q]; ri += x * wiv[q]; }
        }
        const float r = sigm(ra), ig = sigm(ri); const float xl = -a.in[I_LAM][c]; const float sp = fmaxf(xl, 0.f) + log1pf(expf(-fabsf(xl)));
        const float la = -8.f * r * sp, av = expf(la), bv = sqrtf(-expm1f(2.f * la)) * ig * sxc[c];
        const float hn = av * a.in[I_LRUH][(size_t)s * DH + c] + bv;
        a.out[O_LRUS + (size_t)s * DH + c] = hn;
        const float o = hn * gelu_t(bf1(Z[(size_t)row * NZ + 2 * DH + c]));
        MG[(size_t)row * DM + DH + c] = (bf16_t)(cvt_pk_bf16(o, 0.f) & 0xffffu);
        sq = o * o;
    }
    sq = wave_sum(sq);
    if ((tid & 63) == 0) atomicAdd(ssB + row, sq);
    __syncthreads();
}

__device__ __forceinline__ void lru_scan_unit(const Args& a, LAS unsigned char* lds, int unit) {
    unsigned char* ws = a.ws; const bf16_t* Z = (const bf16_t*)(ws + WS_Z); bf16_t* MG = (bf16_t*)(ws + WS_MERGED); float* ssB = (float*)(ws + WS_CTL) + SS_B * SS_STRIDE;
    const float* Ao = a.out; const float* Bo = a.out + (size_t)MP * DH;
    LAS float* sP = (LAS float*)lds; LAS float* sH = sP + 512; LAS float* rsum = sH + 512;
    const int tid = threadIdx.x, n = unit >> 6, ch = (unit & 63) * 16 + (tid & 15), j = tid >> 4;
    const size_t r0 = (size_t)n * SEQ + 64 * j;
    float P = 1.f, h = 0.f;
#pragma unroll 1
    for (int tb = 0; tb < 64; tb += 16) {
        float av[16], bv[16];
#pragma unroll
        for (int q = 0; q < 16; ++q) { av[q] = Ao[(r0 + tb + q) * DH + ch]; bv[q] = Bo[(r0 + tb + q) * DH + ch]; }
#pragma unroll
        for (int q = 0; q < 16; ++q) { h = av[q] * h + bv[q]; P *= av[q]; }
    }
    sP[tid] = P; sH[tid] = h;
    __syncthreads();
    float H = 0.f;
    for (int i = 0; i < j; ++i) H = sP[i * 16 + (tid & 15)] * H + sH[i * 16 + (tid & 15)];
    h = H;
#pragma unroll 1
    for (int tb = 0; tb < 64; tb += 16) {
        float av[16], bv[16]; bf16_t gz[16];
#pragma unroll
        for (int q = 0; q < 16; ++q) { const size_t row = r0 + tb + q; av[q] = Ao[row * DH + ch]; bv[q] = Bo[row * DH + ch]; gz[q] = Z[row * NZ + 2 * DH + ch]; }
#pragma unroll
        for (int q = 0; q < 16; ++q) {
            const size_t row = r0 + tb + q;
            h = av[q] * h + bv[q];
            const float o = h * gelu_t(bf1(gz[q]));
            MG[row * DM + DH + ch] = (bf16_t)(cvt_pk_bf16(o, 0.f) & 0xffffu);
            float s = o * o; s += __shfl_xor(s, 1); s += __shfl_xor(s, 2); s += __shfl_xor(s, 4); s += __shfl_xor(s, 8);
            if ((tid & 15) == 0) rsum[64 * j + tb + q] = s;
        }
    }
    __syncthreads();
    for (int r = tid; r < SEQ; r += 512) atomicAdd(ssB + (size_t)n * SEQ + r, rsum[r]);
    if (j == 31) a.out[O_LRUP + (size_t)n * DH + ch] = h;
    __syncthreads();
}

#define XB_TMO      128
#define XB_XCNT(j)  (256  + 64 * (j))
#define XB_XSUB(j)  (1280 + 64 * (j))
#define XB_XGEN(j)  (2304 + 64 * (j))
#define XB_TOP      3328
#define XB_TOPGEN   3392
#define XB_SPIN_CAP (1u << 18)
__device__ __forceinline__ unsigned xb_ld(unsigned* p)              { return __hip_atomic_load(p, __ATOMIC_RELAXED, __HIP_MEMORY_SCOPE_AGENT); }
__device__ __forceinline__ unsigned xb_add(unsigned* p, unsigned v) { return __hip_atomic_fetch_add(p, v, __ATOMIC_RELAXED, __HIP_MEMORY_SCOPE_AGENT); }
__device__ __forceinline__ unsigned xb_xcc_id() { return (unsigned)__builtin_amdgcn_s_getreg((3 << 11) | 20) & 0xFu; }
#define XB_SPIN(cond, bar) do { unsigned _sp = 0; while (cond) { __builtin_amdgcn_s_sleep(1); \
    if ((++_sp & 255u) == 0u) { if (xb_ld(&(bar)[XB_TMO])) break; if (_sp > XB_SPIN_CAP) { atomicAdd(&(bar)[XB_TMO], 1u); break; } } } } while (0)
struct XcdBarrier { unsigned* bar; unsigned x; volatile LAS unsigned* st; };
__device__ __forceinline__ XcdBarrier xcd_barrier_post(unsigned* bar, volatile LAS unsigned* st) {
    XcdBarrier b; b.bar = bar; b.x = xb_xcc_id(); b.st = st;
    if (threadIdx.x == 0) (void)xb_add(&bar[XB_XCNT(b.x)], 1u);
    return b;
}
__device__ __forceinline__ void xcd_barrier_complete(unsigned* bar, unsigned x, unsigned& nloc, unsigned& nx) {
    const unsigned G = gridDim.x * gridDim.y * gridDim.z;
    unsigned sum, cnt, mine, sp = 0u;
    for (;;) {
        sum = 0u; cnt = 0u; mine = 0u;
#pragma unroll
        for (unsigned j = 0; j < 16; ++j) { const unsigned c = xb_ld(&bar[XB_XCNT(j)]); sum += c; cnt += (c > 0u) ? 1u : 0u; mine = (j == x) ? c : mine; }
        if (sum == G) break;
        __builtin_amdgcn_s_sleep(1);
        if ((++sp & 255u) == 0u) { if (xb_ld(&bar[XB_TMO])) break; if (sp > XB_SPIN_CAP) { atomicAdd(&bar[XB_TMO], 1u); break; } }
    }
    nloc = mine > 0u ? mine : 1u; nx = cnt > 0u ? cnt : 1u;
}
__device__ __forceinline__ void xcd_barrier(const XcdBarrier& b) {
    asm volatile("s_waitcnt vmcnt(0)" ::: "memory");
    __syncthreads();
    if (threadIdx.x == 0) {
        unsigned* bar = b.bar;
        __builtin_amdgcn_s_waitcnt(0);
        unsigned nloc = b.st[0], nx = b.st[1];
        if (nloc == 0u) { xcd_barrier_complete(bar, b.x, nloc, nx); b.st[0] = nloc; b.st[1] = nx; }
        const unsigned old = xb_add(&bar[XB_XSUB(b.x)], 1u);
        const unsigned gen = old / nloc;
        if (old + 1u == (gen + 1u) * nloc) {
            __builtin_amdgcn_fence(__ATOMIC_RELEASE, "agent");
            asm volatile("s_waitcnt vmcnt(0)" ::: "memory");
            const unsigned og = xb_add(&bar[XB_TOP], 1u);
            const unsigned tg = og / nx;
            if (og + 1u == (tg + 1u) * nx) xb_add(&bar[XB_TOPGEN], 1u);
            else XB_SPIN(xb_ld(&bar[XB_TOPGEN]) == tg, bar);
            __builtin_amdgcn_fence(__ATOMIC_ACQUIRE, "agent");
            xb_add(&bar[XB_XGEN(b.x)], 1u);
            asm volatile("s_waitcnt vmcnt(0)" ::: "memory");
        } else {
            XB_SPIN(xb_ld(&bar[XB_XGEN(b.x)]) == gen, bar);
            __builtin_amdgcn_fence(__ATOMIC_ACQUIRE, "agent");
            asm volatile("s_waitcnt vmcnt(0)" ::: "memory");
        }
    }
    __syncthreads();
}

__global__ void __launch_bounds__(512, 2) fwd_kernel(Args a) {
    extern __shared__ __attribute__((aligned(16))) unsigned char lds_raw[];
    LAS unsigned char* lds = (LAS unsigned char*)lds_raw;
    const int tid = threadIdx.x, wave = __builtin_amdgcn_readfirstlane(tid >> 6), lane = tid & 63, G = gridDim.x;
    unsigned char* ws = a.ws;
    const int lo = a.ph_lo, hi = a.ph_hi;
    volatile LAS unsigned* MISC = (volatile LAS unsigned*)(lds + MISC_OFF);
    for (int u = tid; u < (LDS_BYTES - RING_BYTES) / 4; u += 512) ((LAS unsigned*)(lds + RING_BYTES))[u] = 0u;
    __syncthreads();
#if MK_LAUNCHES == 1
    XcdBarrier bar = xcd_barrier_post((unsigned*)(ws + WS_CTL) + CW_BAR, MISC + 8);
#define GRID_BAR() xcd_barrier(bar)
#else
#define GRID_BAR() do {} while (0)
#endif
#define IN(k) (lo <= (k) && (k) < hi)
#define BOTH(k) (IN(k) && IN((k) + 1))
#define ssb ((float*)(ws + WS_CTL))
#define AB ((bf16_t*)(ws + WS_AB))
#define Z ((bf16_t*)(ws + WS_Z))
#define YG ((bf16_t*)(ws + WS_YG))
#define MG ((bf16_t*)(ws + WS_MERGED))
#define HUP ((bf16_t*)(ws + WS_HUP))
#define PW ((bf16_t*)(ws + WS_PW))
#define PB ((bf16_t*)(ws + WS_PB))
#define XO (a.out + O_Y)

    if (IN(0)) { phase0(a, lds); if (BOTH(0)) GRID_BAR(); }

    if (IN(1)) {
        pg8::Gemm g{AB, (const bf16_t*)(ws + WS_WIN), DM, DM, DM, 0}; pg8::StaticOrder S; S.init(MP / 256, NZ / 256, G, (int)blockIdx.x);
        EpiWrap<EIn> E{{nullptr, (const float*)(ws + WS_SMALL + SM_RS0), Z}};
        pg8::gemm_phase<EpiWrap<EIn>, true>(lds, g, S, E);
        skinny_gemm<EIn, 8, 2>(lds, AB + (size_t)MP * DM, DM, (const bf16_t*)(ws + WS_WIN), DM, NZ, DM, E.e, G / 2);
        if ((int)blockIdx.x >= G / 2) {
            const int w = ((int)blockIdx.x - G / 2) * 8 + wave, nw = (G - G / 2) * 8; LAS float* scr = (LAS float*)(lds + wave * 16384);
            constexpr int J_OUT = 32 * 64, J_GATE = 32 * 64, J_GLU = 16 * 32, J_PLE = 4 * 64;
            for (int it = w; it < J_OUT + J_GATE + J_GLU + J_PLE; it += nw) {
                int r = it;
                if (r < J_OUT) { tr_item(a.in[I_WOUT], DM, DM, (bf16_t*)(ws + WS_WOUT), 0, 0, a.in[I_GMA], a.in[I_GMB], DH, scr, r, lane); continue; } r -= J_OUT;
                if (r < J_GATE) { tr_item(a.in[I_WGATE], DM, DM, (bf16_t*)(ws + WS_WGATE), 0, 0, a.in[I_GPLE], a.in[I_GPLE], 1 << 30, scr, r, lane); continue; } r -= J_GATE;
                if (r < J_GLU) { tr_item(a.in[I_WGLU], DH, DH, (bf16_t*)(ws + WS_WGLU), 0, 0, nullptr, nullptr, 0, scr, r, lane); continue; } r -= J_GLU;
                tr_item(a.in[I_WPLE], DPLE, DM, (bf16_t*)(ws + WS_WPLE), 0, 0, nullptr, nullptr, 0, scr, r, lane);
            }
        }
        if (BOTH(1)) GRID_BAR();
    }

    if (IN(3)) {
        pg8::Gemm g{(const bf16_t*)(ws + WS_XC), (const bf16_t*)(ws + WS_WLRU), DH, 256, 256, 1}; pg8::StaticOrder S; S.init(MP / 256, 8, G, (int)blockIdx.x);
        { pg8::Unit cu; for (int i = 0; S.next(i, cu); ++i) conv_tile(a, cu.pm, cu.pn >> 1); }
        asm volatile("s_waitcnt vmcnt(0)" ::: "memory"); __syncthreads();
        ELru E{(const bf16_t*)(ws + WS_XC), a.in[I_BA], a.in[I_BI], (const float*)(ws + WS_SMALL + SM_SPL), a.out, a.out + (size_t)MP * DH};
        pg8::gemm_phase<ELru, true>(lds, g, S, E);
        for (int s = G - 1 - (int)blockIdx.x; s < 2 * MS; s += G) lru_sample(a, lds, s);
        for (int u = blockIdx.x; u < NB * 64; u += G) {
            const int n = u >> 6, g2 = u & 63;
            s5_unit(a, lds + wave * 16384, lane, 3, n, g2, wave);
            __syncthreads();
            s5_unit(a, lds + wave * 16384, lane, 4, n, g2, wave);
            __syncthreads();
        }
        for (int u = blockIdx.x * 8 + wave; u < 512; u += G * 8) s5_unit(a, lds + wave * 16384, lane, 2, 0, u >> 3, u & 7);
        if (BOTH(3)) GRID_BAR();
    }

    if (IN(4)) {
        pg8::Gemm g{YG, (const bf16_t*)(ws + WS_WGLU), DH, DH, DH, 0}; pg8::StaticOrder S; S.init(MP / 256, DH / 256, G, (int)blockIdx.x);
        EpiWrap<EGlu> E{{ssb + SS_A * SS_STRIDE, a.in[I_BGLU], YG, MG}};
        pg8::gemm_phase<EpiWrap<EGlu>, true>(lds, g, S, E);
        skinny_gemm<EGlu, 4>(lds, YG + (size_t)MP * DH, DH, (const bf16_t*)(ws + WS_WGLU), DH, DH, DH, E.e);
        for (int u = G - 1 - (int)blockIdx.x; u < NB * 64; u += G) lru_scan_unit(a, lds, u);
        if ((int)blockIdx.x >= G / 2) {
            const int w = ((int)blockIdx.x - G / 2) * 8 + wave, nw = (G - G / 2) * 8;
            for (int it = 5120 + w; it < 128 * 64; it += nw) tr_item(a.in[I_WDOWN], DFF, DM, (bf16_t*)(ws + WS_WDOWN), 0, 0, nullptr, nullptr, 0, (LAS float*)(lds + wave * 16384), it, lane);
        }
        if (BOTH(4)) GRID_BAR();
    }

    if (IN(5)) {
        pg8::Gemm g{MG, (const bf16_t*)(ws + WS_WOUT), DM, DM, DM, 0}; pg8::StaticOrder S; S.init(MP / 256, DM / 256, G, (int)blockIdx.x);
        { float* RAT = (float*)(ws + WS_SMALL + SM_RAT); float* RSB = (float*)(ws + WS_SMALL + SM_RSB);
          pg8::Unit cu;
          for (int ui = -1; ui < 0 || S.next(ui, cu); ++ui)
              for (int i = tid; i < (ui < 0 ? MS : 256); i += 512) { const int row = ui < 0 ? MP + i : cu.pm * 256 + i;
                  const float va = ssb[SS_A * SS_STRIDE + row] * (1.f / DH) + EPS, vb = ssb[SS_B * SS_STRIDE + row] * (1.f / DH) + EPS; RAT[row] = sqrtf(vb / va); RSB[row] = rsqrtf(vb); }
          asm volatile("s_waitcnt vmcnt(0)" ::: "memory"); __syncthreads(); }
        EpiWrap<EOut> E{{ssb + SS_1 * SS_STRIDE, (const float*)(ws + WS_SMALL + SM_RAT), (const float*)(ws + WS_SMALL + SM_RSB), a.in[I_XP], a.in[I_XS], XO, AB}};
        pg8::gemm_phase<EpiWrap<EOut>, true>(lds, g, S, E);
        skinny_gemm<EOut, 4>(lds, MG + (size_t)MP * DM, DM, (const bf16_t*)(ws + WS_WOUT), DM, DM, DM, E.e);
        if (BOTH(5)) GRID_BAR();
    }

    if (IN(6)) {
        pg8::Gemm g{AB, (const bf16_t*)(ws + WS_WUP), DM, DM, DM, 0}; pg8::StaticOrder S; S.init(MP / 256, DFF / 256, G, (int)blockIdx.x);
        EpiWrap<EUp> E{{nullptr, ssb + SS_1 * SS_STRIDE, HUP}};
        pg8::gemm_phase<EpiWrap<EUp>, true>(lds, g, S, E);
        skinny_gemm<EUp, 8, 2>(lds, AB + (size_t)MP * DM, DM, (const bf16_t*)(ws + WS_WUP), DM, DFF, DM, E.e);
        if (BOTH(6)) GRID_BAR();
    }

    if (IN(7)) {
        pg8::Gemm g{HUP, (const bf16_t*)(ws + WS_WDOWN), DFF, DFF, DFF, 0}; pg8::StaticOrder S; S.init(MP / 256, DM / 256, G, (int)blockIdx.x);
        EpiWrap<EDown> E{{ssb + SS_2 * SS_STRIDE, XO, AB}};
        pg8::gemm_phase<EpiWrap<EDown>, true>(lds, g, S, E);
        skinny_gemm<EDown, 4>(lds, HUP + (size_t)MP * DFF, DFF, (const bf16_t*)(ws + WS_WDOWN), DFF, DM, DFF, E.e);
        if (BOTH(7)) GRID_BAR();
    }

    if (IN(8)) {
        { pg8::Gemm g{PB, (const bf16_t*)(ws + WS_WPLE), DPLE, DPLE, DPLE, 0}; pg8::StaticOrder S; S.init(MP / 256, DM / 256, G, (int)blockIdx.x);
          EpiWrap<EPw> E{{nullptr, PW}};
          pg8::gemm_phase<EpiWrap<EPw>, true>(lds, g, S, E);
          skinny_gemm<EPw, 4>(lds, PB + (size_t)MP * DPLE, DPLE, (const bf16_t*)(ws + WS_WPLE), DPLE, DM, DPLE, E.e); }
        asm volatile("s_waitcnt vmcnt(0)" ::: "memory"); __syncthreads();
        { pg8::Gemm g{AB, (const bf16_t*)(ws + WS_WGATE), DM, DM, DM, 0}; pg8::StaticOrder S; S.init(MP / 256, DM / 256, G, (int)blockIdx.x);
          EpiWrap<EGate> E{{ssb + SS_3 * SS_STRIDE, ssb + SS_2 * SS_STRIDE, PW, XO}};
          pg8::gemm_phase<EpiWrap<EGate>, true>(lds, g, S, E);
          skinny_gemm<EGate, 4>(lds, AB + (size_t)MP * DM, DM, (const bf16_t*)(ws + WS_WGATE), DM, DM, DM, E.e); }
        if (BOTH(8)) GRID_BAR();
    }

    if (IN(9)) {
        const float* ss3 = ssb + SS_3 * SS_STRIDE; const float* gf = a.in[I_GFIN];
        f32x4 gv[8];
#pragma unroll
        for (int j = 0; j < 8; ++j) gv[j] = ((const f32x4*)gf)[lane + 64 * j];
        for (int row = blockIdx.x * 8 + wave; row < MT; row += 2 * G * 8) {
            const int row2 = row + G * 8; const bool has2 = row2 < MT; const int r2 = has2 ? row2 : row;
            f32x4* xa = (f32x4*)(XO + (size_t)row * DM); f32x4* xb2 = (f32x4*)(XO + (size_t)r2 * DM);
            f32x4 va[8], vb[8];
#pragma unroll
            for (int j = 0; j < 8; ++j) { va[j] = xa[lane + 64 * j]; vb[j] = xb2[lane + 64 * j]; }
            const float rsa = rsqrtf(ss3[row] * (1.f / DM) + EPS), rsb2 = rsqrtf(ss3[r2] * (1.f / DM) + EPS);
#pragma unroll
            for (int j = 0; j < 8; ++j) xa[lane + 64 * j] = va[j] * rsa * gv[j];
            if (has2) {
#pragma unroll
                for (int j = 0; j < 8; ++j) xb2[lane + 64 * j] = vb[j] * rsb2 * gv[j];
            }
        }
    }
#if MK_LAUNCHES == 1
    if (lo > hi) cg::this_grid().sync();
#endif
}

#undef ssb
#undef AB
#undef Z
#undef YG
#undef MG
#undef HUP
#undef PW
#undef PB
#undef XO
extern "C" void kernel_launch(void* const* d_in, const int* in_sizes, int n_in, void* d_out, int out_size, void* d_ws, size_t ws_size, hipStream_t stream) {
    static int grid = 0;
    if (grid == 0) {
        int dev = 0, cus = 0;
        if (n_in != 37 || ws_size < WS_END) { fprintf(stderr, "kernel_launch: unexpected inputs (n_in %d, ws %zu)\n", n_in, ws_size); grid = -1; return; }
        if (hipGetDevice(&dev) != hipSuccess || hipDeviceGetAttribute(&cus, hipDeviceAttributeMultiprocessorCount, dev) != hipSuccess) { grid = -1; return; }
        if (hipFuncSetAttribute((const void*)fwd_kernel, hipFuncAttributeMaxDynamicSharedMemorySize, LDS_BYTES) != hipSuccess) { fprintf(stderr, "kernel_launch: hipFuncSetAttribute failed\n"); grid = -1; return; }
        int per_cu = 0;
        if (hipOccupancyMaxActiveBlocksPerMultiprocessor(&per_cu, (const void*)fwd_kernel, 512, LDS_BYTES) != hipSuccess || per_cu < 1) { fprintf(stderr, "kernel_launch: occupancy query %d\n", per_cu); }
        (void)hipGetLastError();
        grid = cus;
    }
    if (grid < 0) return;
    (void)hipMemsetAsync((char*)d_ws + WS_CTL, 0, CTL_ZERO_BYTES, stream);
    Args a{};
    for (int i = 0; i < 37; ++i) a.in[i] = (const float*)d_in[i];
    a.out = (float*)d_out; a.ws = (unsigned char*)d_ws;
#if MK_LAUNCHES == 1
    a.ph_lo = 0; a.ph_hi = NPHASE;
    void* args[] = {&a};
    hipError_t e = hipLaunchCooperativeKernel((const void*)fwd_kernel, dim3(grid), dim3(512), args, LDS_BYTES, stream);
    if (e != hipSuccess) fprintf(stderr, "cooperative launch failed: %s (grid %d)\n", hipGetErrorString(e), grid);
#else
    for (int ph = 0; ph < NPHASE; ++ph) {
        a.ph_lo = ph; a.ph_hi = ph + 1;
        hipLaunchKernelGGL(fwd_kernel, dim3(grid), dim3(512), LDS_BYTES, stream, a);
    }
#endif
}
```

```cpp
#include <hip/hip_runtime.h>
#include <hip/hip_cooperative_groups.h>
#include <cstdio>
#include <cstdint>
namespace cg = cooperative_groups;

#ifndef MK_LAUNCHES
#define MK_LAUNCHES 1
#endif

#define LAS __attribute__((address_space(3)))
typedef unsigned short bf16_t;
typedef short bf16x8 __attribute__((ext_vector_type(8)));
typedef float f32x4 __attribute__((ext_vector_type(4)));
typedef unsigned u32x4 __attribute__((ext_vector_type(4)));
typedef unsigned u32x2 __attribute__((ext_vector_type(2)));

constexpr int DM = 2048, SEQ = 2048, NB = 4, MP = 8192, MS = 128, MT = 8320;
constexpr int NZ = 3072, DFF = 8192, DPLE = 256, DH = 1024;
constexpr float EPS = 1e-6f;
constexpr int NPHASE = 10;

constexpr size_t MiB = 1u << 20;
constexpr size_t WS_CTL = 0, CTL_ZERO_BYTES = 1 * MiB;
constexpr int SS_STRIDE = 8448;
constexpr int SS_A = 0, SS_B = 1, SS_1 = 2, SS_2 = 3, SS_3 = 4;
constexpr int CW_BAR = 65536;
constexpr size_t WS_SMALL = 1 * MiB;
constexpr size_t SM_RS0 = 0, SM_AR = 65536, SM_AI = SM_AR + 16384, SM_A64R = SM_AI + 16384, SM_A64I = SM_A64R + 16384,
                 SM_BBB = SM_A64I + 16384  , SM_CMB = SM_BBB + 262144  , SM_SPL = SM_CMB + 262144  , SM_RAT = 663552  , SM_RSB = SM_RAT + 34816  ;
constexpr size_t WS_WUP = 2 * MiB, WS_WDOWN = 34 * MiB, WS_WGATE = 66 * MiB, WS_WPLE = 74 * MiB, WS_PB = 75 * MiB, WS_AB = 80 * MiB;
constexpr size_t WS_E = 113 * MiB;
constexpr size_t WS_HUP = WS_E, WS_PW = WS_E;
constexpr size_t WS_WIN = 113 * MiB, WS_WGLU = 125 * MiB, WS_WOUT = 127 * MiB, WS_WLRU = 135 * MiB, WS_Z = 136 * MiB,
                 WS_YG = 185 * MiB, WS_MERGED = 202 * MiB, WS_XC = 235 * MiB, WS_S5SUM = 251 * MiB, WS_END = 255 * MiB;
static_assert(WS_HUP + (size_t)MT * DFF * 2 <= 256 * MiB, "hup fits");
static_assert(WS_Z + (size_t)MT * NZ * 2 <= WS_YG && WS_YG + (size_t)MT * DH * 2 <= WS_MERGED && WS_MERGED + (size_t)MT * DM * 2 <= WS_XC, "map");
static_assert(WS_AB + (size_t)MT * DM * 2 <= WS_E && WS_PB + (size_t)MT * DPLE * 2 <= WS_AB, "map2");

constexpr size_t O_Y = 0, O_S5RP = 17039360, O_S5IP = 17055744, O_LRUP = 17072128, O_CONVP = 17076224,
                 O_S5RS = 17088512, O_S5IS = 17612800, O_LRUS = 18137088, O_CONVS = 18268160;

constexpr int RING_BYTES = 131072, MISC_OFF = RING_BYTES + 320, LDS_BYTES = 147456;

__device__ __forceinline__ unsigned cvt_pk_bf16(float lo, float hi) { unsigned r; asm("v_cvt_pk_bf16_f32 %0, %1, %2" : "=v"(r) : "v"(lo), "v"(hi)); return r; }
__device__ __forceinline__ float bf_lo(unsigned u) { return __uint_as_float(u << 16); }
__device__ __forceinline__ float bf_hi(unsigned u) { return __uint_as_float(u & 0xffff0000u); }
__device__ __forceinline__ float bf1(bf16_t u) { return __uint_as_float(((unsigned)u) << 16); }
__device__ __forceinline__ float sigm(float x) { return __builtin_amdgcn_rcpf(1.f + __expf(-x)); }
__device__ __forceinline__ float gelu_t(float x) { const float u = 1.5957691216057308f * (x + 0.044715f * x * x * x); return x * __builtin_amdgcn_rcpf(1.f + __expf(-u)); }
__device__ __forceinline__ float wave_sum(float v) {
#pragma unroll
    for (int o = 1; o < 64; o <<= 1) v += __shfl_xor(v, o);
    return v;
}
#define LDS_WAIT() asm volatile("s_waitcnt lgkmcnt(0)" ::: "memory")

namespace pg8 {
constexpr int BM = 256, BK = 64, HALF = 128, HTB = HALF * BK * 2, STAGE_BYTES = 8 * HTB, NXCD = 8, WGM = 8;
__host__ __device__ __forceinline__ int lds_byte(int r, int c) { const int st = (r >> 4) * 2 + (c >> 5), rr = r & 15, cc = c & 31, ob = rr * 64 + cc * 2; return st * 1024 + (ob ^ (((ob >> 9) & 1) << 5)); }
__host__ __device__ __forceinline__ void stage_rc(int b, int& R, int& C) { const int st = b / 1024, sb = b % 1024, swz = sb ^ (((sb >> 9) & 1) << 5); R = (st >> 1) * 16 + swz / 64; C = (st & 1) * 32 + (swz % 64) / 2; }
__host__ __device__ __forceinline__ int perm32(int rho) { const int n = rho >> 4, i = rho & 15; return 8 * (i >> 2) + 4 * n + (i & 3); }
struct Unit { int pm, pn; };
struct Gemm { const bf16_t* A; const bf16_t* Bt; int lda, ldb, K, akmode; };
struct StaticOrder {
    int nM, nN, nwg, G, c;
    __device__ __forceinline__ void init(int nM_, int nN_, int G_, int c_) { nM = nM_; nN = nN_; nwg = nM * nN; G = G_; c = c_; }
    __device__ __forceinline__ bool next(int i, Unit& u) const {
        const long L = (long)i * G + c; if (L >= nwg) return false;
        int wgid = (int)L; { const int q = nwg / NXCD, r = nwg % NXCD, xcd = wgid % NXCD, off = wgid / NXCD; wgid = (xcd < r ? xcd * (q + 1) : r * (q + 1) + (xcd - r) * q) + off; }
        const int nig = WGM * nN, gid = wgid / nig, fm = gid * WGM, gsz = (nM - fm) < WGM ? (nM - fm) : WGM;
        u.pm = fm + ((wgid % nig) % gsz); u.pn = (wgid % nig) / gsz; return true;
    }
};

template <class Epi, bool ALIGN_EPI>
__device__ __forceinline__ void gemm_phase(LAS unsigned char* lds, const Gemm g, const StaticOrder& S, const Epi& E) {
    const int tid = threadIdx.x, wid = __builtin_amdgcn_readfirstlane(tid >> 6), lane = tid & 63, wr = wid >> 2, wc = wid & 3, fr = lane & 15, fq = lane >> 4;
    int K = g.K; asm volatile("" : "+s"(K));
    const int nt = K / BK;
    unsigned voffA[2], voffB[2];
#pragma unroll
    for (int i = 0; i < 2; ++i) { int R, C; stage_rc(tid * 16 + i * 8192, R, C);
        const int Rb = Epi::PERM ? ((R & ~31) + perm32(R & 31)) : R;
        voffA[i] = (unsigned)(R * g.lda + C) * 2u; voffB[i] = (unsigned)(Rb * g.ldb + C) * 2u; }
    const size_t kstep = (size_t)(BK * 2);
    const size_t hstepA = (size_t)HALF * g.lda * 2, hstepB = (size_t)HALF * g.ldb * 2;
    const size_t tstepA = 2 * hstepA, tstepB = 2 * hstepB;
    const unsigned ldsw = (unsigned)wid * 1024u;
    const int aoff = lds_byte(wr * 64 + fr, fq * 8), boff = lds_byte(wc * 32 + fr, fq * 8);
#define PG8_SA(b, h) (((b) * 2 + (h)) * HTB)
#define PG8_SB(b, h) ((4 + (b) * 2 + (h)) * HTB)
#define PG8_STAGE(bufoff, gbase, voff) do { _Pragma("unroll") for (int _i = 0; _i < 2; ++_i) \
        __builtin_amdgcn_global_load_lds((const unsigned*)((const char*)(gbase) + (voff)[_i]), (LAS unsigned*)(lds + (bufoff) + ldsw + _i * 8192), 16, 0, 0); } while (0)
#define PG8_LDA(dst, b, h) do { _Pragma("unroll") for (int m = 0; m < 4; ++m) _Pragma("unroll") for (int k = 0; k < 2; ++k) dst[m][k] = *(const LAS bf16x8*)(lds + PG8_SA(b, h) + aoff + m * 2048 + k * 1024); } while (0)
#define PG8_LDB(dst, b, h) do { _Pragma("unroll") for (int n = 0; n < 2; ++n) _Pragma("unroll") for (int k = 0; k < 2; ++k) dst[n][k] = *(const LAS bf16x8*)(lds + PG8_SB(b, h) + boff + n * 2048 + k * 1024); } while (0)
#define PG8_MMA(ai, bj, At, Bt) do { __builtin_amdgcn_s_setprio(1); _Pragma("unroll") for (int m = 0; m < 4; ++m) _Pragma("unroll") for (int n = 0; n < 2; ++n) _Pragma("unroll") for (int k = 0; k < 2; ++k) \
        acc[ai][bj][m][n] = __builtin_amdgcn_mfma_f32_16x16x32_bf16(Bt[n][k], At[m][k], acc[ai][bj][m][n], 0, 0, 0); __builtin_amdgcn_s_setprio(0); } while (0)
#define PG8_WAIT_V(n) asm volatile("s_waitcnt vmcnt(" #n ")" ::: "memory")
#define PG8_WAIT_L(n) asm volatile("s_waitcnt lgkmcnt(" #n ")" ::: "memory")
#define PG8_BAR __builtin_amdgcn_s_barrier()
#define PG8_SCHED __builtin_amdgcn_sched_barrier(0)
    Unit cur, nxt; int ui = 0;
    if (!S.next(0, cur)) return;
    f32x4 acc[2][2][4][2];
#pragma unroll
    for (int a = 0; a < 2; ++a)
#pragma unroll
        for (int b = 0; b < 2; ++b)
#pragma unroll
            for (int m = 0; m < 4; ++m)
#pragma unroll
                for (int n = 0; n < 2; ++n) acc[a][b][m][n] = (f32x4){0.f, 0.f, 0.f, 0.f};
    bf16x8 At[4][2], B0[2][2], B1[2][2];
    const char* cA = (const char*)g.A + (size_t)cur.pm * tstepA + (g.akmode ? (size_t)(cur.pn >> 1) * 512 : 0);
    const char* cB = (const char*)g.Bt + (size_t)cur.pn * tstepB;
    PG8_STAGE(PG8_SB(0, 0), cB, voffB); PG8_STAGE(PG8_SB(0, 1), cB + hstepB, voffB); PG8_STAGE(PG8_SA(0, 0), cA, voffA); PG8_STAGE(PG8_SA(0, 1), cA + hstepA, voffA);
    if (wr == 1) PG8_BAR;
    PG8_WAIT_V(2); PG8_BAR;
    PG8_STAGE(PG8_SB(1, 0), cB + kstep, voffB); PG8_STAGE(PG8_SA(1, 0), cA + kstep, voffA); PG8_STAGE(PG8_SB(1, 1), cB + hstepB + kstep, voffB);
    PG8_WAIT_V(6); PG8_BAR;
    for (;;) {
        const bool has_next = S.next(ui + 1, nxt);
        const char* nA = has_next ? (const char*)g.A + (size_t)nxt.pm * tstepA + (g.akmode ? (size_t)(nxt.pn >> 1) * 512 : 0) : cA;
        const char* nB = has_next ? (const char*)g.Bt + (size_t)nxt.pn * tstepB : cB;
        for (int t = 0; t < nt; t += 2) {
            const bool last = (t == nt - 2);
            const char* a1 = cA + (size_t)(t + 1) * kstep;
            const char* a2 = last ? nA : cA + (size_t)(t + 2) * kstep; const char* b2 = last ? nB : cB + (size_t)(t + 2) * kstep;
            const char* a3 = a2 + kstep; const char* b3 = b2 + kstep;
            if constexpr (Epi::MID) { if (t == (nt >> 1)) E.mid(acc, cur, wr, fr); }
            PG8_LDB(B0, 0, 0); PG8_LDB(B1, 0, 1); PG8_SCHED; PG8_LDA(At, 0, 0); PG8_STAGE(PG8_SA(1, 1), a1 + hstepA, voffA);
            PG8_WAIT_V(8); PG8_WAIT_L(0); PG8_BAR; PG8_MMA(0, 0, At, B0); PG8_MMA(0, 1, At, B1); PG8_BAR; PG8_SCHED;
            PG8_LDA(At, 0, 1); PG8_STAGE(PG8_SB(0, 0), b2, voffB); PG8_STAGE(PG8_SB(0, 1), b2 + hstepB, voffB); PG8_STAGE(PG8_SA(0, 0), a2, voffA);
            PG8_WAIT_V(8); PG8_WAIT_L(0); PG8_BAR; PG8_MMA(1, 0, At, B0); PG8_MMA(1, 1, At, B1); PG8_BAR; PG8_SCHED;
            PG8_LDB(B0, 1, 0); PG8_LDB(B1, 1, 1); PG8_SCHED; PG8_LDA(At, 1, 0); PG8_STAGE(PG8_SA(0, 1), a2 + hstepA, voffA);
            PG8_WAIT_V(8); PG8_WAIT_L(0); PG8_BAR; PG8_MMA(0, 0, At, B0); PG8_MMA(0, 1, At, B1); PG8_BAR; PG8_SCHED;
            PG8_LDA(At, 1, 1); PG8_STAGE(PG8_SB(1, 0), b3, voffB); PG8_STAGE(PG8_SB(1, 1), b3 + hstepB, voffB); PG8_STAGE(PG8_SA(1, 0), a3, voffA);
            PG8_WAIT_V(8); PG8_WAIT_L(0); PG8_BAR; PG8_MMA(1, 0, At, B0); PG8_MMA(1, 1, At, B1); PG8_BAR; PG8_SCHED;
        }
        if constexpr (ALIGN_EPI) { if (wr == 0) PG8_BAR; }
        E(acc, cur, wr, wc, fr, fq);
        if (!has_next) break;
#pragma unroll
        for (int a = 0; a < 2; ++a)
#pragma unroll
            for (int b = 0; b < 2; ++b)
#pragma unroll
                for (int m = 0; m < 4; ++m)
#pragma unroll
                    for (int n = 0; n < 2; ++n) acc[a][b][m][n] = (f32x4){0.f, 0.f, 0.f, 0.f};
        cur = nxt; cA = nA; cB = nB; ++ui;
        if constexpr (ALIGN_EPI) { if (wr == 1) PG8_BAR; }
    }
    PG8_WAIT_V(0);
    if constexpr (!ALIGN_EPI) { if (wr == 0) PG8_BAR; }
    PG8_BAR;
#undef PG8_SA
#undef PG8_SB
#undef PG8_STAGE
#undef PG8_LDA
#undef PG8_LDB
#undef PG8_MMA
#undef PG8_WAIT_V
#undef PG8_WAIT_L
#undef PG8_BAR
#undef PG8_SCHED
}
}

template <class E> struct EpiWrap {
    E e; static constexpr bool MID = E::MID, PERM = E::PERM;
    __device__ __forceinline__ void operator()(const f32x4 (&acc)[2][2][4][2], const pg8::Unit& u, int wr, int wc, int fr, int fq) const {
        if constexpr (E::HAS_RES) {
            f32x4 rc[2][2], rn[2][2];
            { const int row = u.pm * 256 + wr * 64 + fr;
#pragma unroll
              for (int bj = 0; bj < 2; ++bj)
#pragma unroll
                  for (int n = 0; n < 2; ++n) rc[bj][n] = e.res(row, u.pn * 256 + bj * 128 + wc * 32 + 8 * fq + 4 * n); }
#pragma unroll
            for (int idx = 0; idx < 8; ++idx) {
                const int ai = idx >> 2, m = idx & 3;
                const int row = u.pm * 256 + ai * 128 + wr * 64 + m * 16 + fr; const float rv = e.rowval(row); float s = 0.f;
                if (idx < 7) { const int rown = u.pm * 256 + ((idx + 1) >> 2) * 128 + wr * 64 + ((idx + 1) & 3) * 16 + fr;
#pragma unroll
                    for (int bj = 0; bj < 2; ++bj)
#pragma unroll
                        for (int n = 0; n < 2; ++n) rn[bj][n] = e.res(rown, u.pn * 256 + bj * 128 + wc * 32 + 8 * fq + 4 * n); }
#pragma unroll
                for (int bj = 0; bj < 2; ++bj) s += e.applyr8(row, u.pn * 256 + bj * 128 + wc * 32 + 8 * fq, acc[ai][bj][m][0], acc[ai][bj][m][1], rv, rc[bj][0], rc[bj][1]);
                if constexpr (E::HAS_SS) { s += __shfl_xor(s, 16); s += __shfl_xor(s, 32); if (fq == 0) atomicAdd(e.ss + row, s); }
                asm volatile("" ::: "memory");
#pragma unroll
                for (int bj = 0; bj < 2; ++bj)
#pragma unroll
                    for (int n = 0; n < 2; ++n) rc[bj][n] = rn[bj][n];
            }
            return;
        }
        if constexpr (E::PERM && !E::HAS_RES) {
#pragma unroll
            for (int ai = 0; ai < 2; ++ai)
#pragma unroll
                for (int m = 0; m < 4; ++m) {
                    const int row = u.pm * 256 + ai * 128 + wr * 64 + m * 16 + fr; const float rv = e.rowval(row); float s = 0.f;
#pragma unroll
                    for (int bj = 0; bj < 2; ++bj) s += e.apply8(row, u.pn * 256 + bj * 128 + wc * 32 + 8 * fq, acc[ai][bj][m][0], acc[ai][bj][m][1], rv);
                    if constexpr (E::HAS_SS) { s += __shfl_xor(s, 16); s += __shfl_xor(s, 32); if (fq == 0) atomicAdd(e.ss + row, s); }
                    asm volatile("" ::: "memory");
                }
            return;
        }
#pragma unroll
        for (int ai = 0; ai < 2; ++ai)
#pragma unroll
            for (int m = 0; m < 4; ++m) {
                const int row = u.pm * 256 + ai * 128 + wr * 64 + m * 16 + fr; const float rv = e.rowval(row); float s = 0.f;
#pragma unroll
                for (int bj = 0; bj < 2; ++bj)
#pragma unroll
                    for (int n = 0; n < 2; ++n) s += e.apply(row, u.pn * 256 + bj * 128 + wc * 32 + n * 16 + 4 * fq, acc[ai][bj][m][n], rv);
                if constexpr (E::HAS_SS) { s += __shfl_xor(s, 16); s += __shfl_xor(s, 32); if (fq == 0) atomicAdd(e.ss + row, s); }
                asm volatile("" ::: "memory");
            }
    }
    __device__ __forceinline__ void mid(f32x4 (&acc)[2][2][4][2], const pg8::Unit& u, int wr, int fr) const {
#pragma unroll
        for (int ai = 0; ai < 2; ++ai)
#pragma unroll
            for (int m = 0; m < 4; ++m) { const float r = e.kscale(u.pm * 256 + ai * 128 + wr * 64 + m * 16 + fr, 0);
#pragma unroll
                for (int bj = 0; bj < 2; ++bj)
#pragma unroll
                    for (int n = 0; n < 2; ++n) acc[ai][bj][m][n] = acc[ai][bj][m][n] * r; }
    }
};
__device__ __forceinline__ u32x2 pk4(f32x4 v) { u32x2 w; w.x = cvt_pk_bf16(v[0], v[1]); w.y = cvt_pk_bf16(v[2], v[3]); return w; }
__device__ __forceinline__ f32x4 up4(u32x2 w) { return (f32x4){bf_lo(w.x), bf_hi(w.x), bf_lo(w.y), bf_hi(w.y)}; }
__device__ __forceinline__ float ssq4(f32x4 v) { return (v[0] * v[0] + v[1] * v[1]) + (v[2] * v[2] + v[3] * v[3]); }

struct EIn {
    static constexpr bool HAS_RES = false, PERM = true; static constexpr bool MID = false, HAS_SS = false; float* ss; const float* rs0; bf16_t* Z;
    __device__ __forceinline__ float rowval(int row) const { return rs0[row]; }
    __device__ __forceinline__ float kscale(int, int) const { return 1.f; }
    __device__ __forceinline__ float apply(int row, int col, f32x4 v, float rv) const { *(u32x2*)(Z + (size_t)row * NZ + col) = pk4(v * rv); return 0.f; }
    __device__ __forceinline__ float apply8(int row, int col, f32x4 v0, f32x4 v1, float rv) const { u32x4 w; { const u32x2 a0 = pk4(v0 * rv), a1 = pk4(v1 * rv); w.x = a0.x; w.y = a0.y; w.z = a1.x; w.w = a1.y; } *(u32x4*)(Z + (size_t)row * NZ + col) = w; return 0.f; }
};
struct EGlu {
    static constexpr bool HAS_RES = false, PERM = true; static constexpr bool MID = false, HAS_SS = true; float* ss; const float* bglu; const bf16_t* YG; bf16_t* MG;
    __device__ __forceinline__ float rowval(int) const { return 0.f; }
    __device__ __forceinline__ float kscale(int, int) const { return 1.f; }
    __device__ __forceinline__ float apply(int row, int col, f32x4 v, float) const {
        const f32x4 b = *(const f32x4*)(bglu + col); const f32x4 yg = up4(*(const u32x2*)(YG + (size_t)row * DH + col)); f32x4 o;
#pragma unroll
        for (int j = 0; j < 4; ++j) o[j] = yg[j] * sigm(v[j] + b[j]);
        *(u32x2*)(MG + (size_t)row * DM + col) = pk4(o); return ssq4(o);
    }
    __device__ __forceinline__ float apply8(int row, int col, f32x4 v0, f32x4 v1, float) const {
        const f32x4 b0 = *(const f32x4*)(bglu + col), b1 = *(const f32x4*)(bglu + col + 4); const u32x4 yr = *(const u32x4*)(YG + (size_t)row * DH + col);
        const f32x4 y0 = up4((u32x2){yr.x, yr.y}), y1 = up4((u32x2){yr.z, yr.w}); f32x4 o0, o1;
#pragma unroll
        for (int j = 0; j < 4; ++j) { o0[j] = y0[j] * sigm(v0[j] + b0[j]); o1[j] = y1[j] * sigm(v1[j] + b1[j]); }
        u32x4 w; { const u32x2 a0 = pk4(o0), a1 = pk4(o1); w.x = a0.x; w.y = a0.y; w.z = a1.x; w.w = a1.y; } *(u32x4*)(MG + (size_t)row * DM + col) = w; return ssq4(o0) + ssq4(o1);
    }
};
struct EOut {
    static constexpr bool MID = true, HAS_SS = true; float* ss; const float* rat; const float* rsb; const float* xp; const float* xs; float* XO; bf16_t* AB;
    __device__ __forceinline__ float rowval(int row) const { return rsb[row]; }
    __device__ __forceinline__ float kscale(int row, int w) const { return w < 4 ? rat[row] : 1.f; }
    static constexpr bool HAS_RES = true, PERM = true;
    __device__ __forceinline__ f32x4 res(int row, int col) const { return *(const f32x4*)(xp + (size_t)row * DM + col); }
    __device__ __forceinline__ float applyr8(int row, int col, f32x4 v0, f32x4 v1, float rv, f32x4 r0, f32x4 r1) const {
        const f32x4 o0 = r0 + v0 * rv, o1 = r1 + v1 * rv; float* p = XO + (size_t)row * DM + col; *(f32x4*)p = o0; *(f32x4*)(p + 4) = o1;
        u32x4 w; { const u32x2 a0 = pk4(o0), a1 = pk4(o1); w.x = a0.x; w.y = a0.y; w.z = a1.x; w.w = a1.y; } *(u32x4*)(AB + (size_t)row * DM + col) = w; return ssq4(o0) + ssq4(o1); }
    __device__ __forceinline__ float applyr(int row, int col, f32x4 v, float rv, f32x4 r) const {
        const f32x4 o = r + v * rv;
        *(f32x4*)(XO + (size_t)row * DM + col) = o; *(u32x2*)(AB + (size_t)row * DM + col) = pk4(o); return ssq4(o); }
    __device__ __forceinline__ float apply(int row, int col, f32x4 v, float rv) const {
        const float* xr = row < MP ? xp + (size_t)row * DM : xs + (size_t)(row - MP) * DM;
        const f32x4 o = *(const f32x4*)(xr + col) + v * rv;
        *(f32x4*)(XO + (size_t)row * DM + col) = o; *(u32x2*)(AB + (size_t)row * DM + col) = pk4(o); return ssq4(o);
    }
};
struct EUp {
    static constexpr bool HAS_RES = false, PERM = true; static constexpr bool MID = false, HAS_SS = false; float* ss; const float* ss1; bf16_t* HUP;
    __device__ __forceinline__ float rowval(int row) const { return rsqrtf(ss1[row] * (1.f / DM) + EPS); }
    __device__ __forceinline__ float kscale(int, int) const { return 1.f; }
    __device__ __forceinline__ float apply(int row, int col, f32x4 v, float rv) const { f32x4 o;
#pragma unroll
        for (int j = 0; j < 4; ++j) { const float r = fmaxf(v[j] * rv, 0.f); o[j] = r * r; }
        *(u32x2*)(HUP + (size_t)row * DFF + col) = pk4(o); return 0.f; }
    __device__ __forceinline__ float apply8(int row, int col, f32x4 v0, f32x4 v1, float rv) const { f32x4 o0, o1;
#pragma unroll
        for (int j = 0; j < 4; ++j) { const float r0 = fmaxf(v0[j] * rv, 0.f), r1 = fmaxf(v1[j] * rv, 0.f); o0[j] = r0 * r0; o1[j] = r1 * r1; }
        u32x4 w; { const u32x2 a0 = pk4(o0), a1 = pk4(o1); w.x = a0.x; w.y = a0.y; w.z = a1.x; w.w = a1.y; } *(u32x4*)(HUP + (size_t)row * DFF + col) = w; return 0.f; }
};
struct EDown {
    static constexpr bool MID = false, HAS_SS = true; float* ss; float* XO; bf16_t* AB;
    __device__ __forceinline__ float rowval(int) const { return 0.f; }
    __device__ __forceinline__ float kscale(int, int) const { return 1.f; }
    static constexpr bool HAS_RES = true, PERM = true;
    __device__ __forceinline__ f32x4 res(int row, int col) const { return *(const f32x4*)(XO + (size_t)row * DM + col); }
    __device__ __forceinline__ float applyr8(int row, int col, f32x4 v0, f32x4 v1, float, f32x4 r0, f32x4 r1) const {
        const f32x4 o0 = r0 + v0, o1 = r1 + v1; float* p = XO + (size_t)row * DM + col; *(f32x4*)p = o0; *(f32x4*)(p + 4) = o1;
        u32x4 w; { const u32x2 a0 = pk4(o0), a1 = pk4(o1); w.x = a0.x; w.y = a0.y; w.z = a1.x; w.w = a1.y; } *(u32x4*)(AB + (size_t)row * DM + col) = w; return ssq4(o0) + ssq4(o1); }
    __device__ __forceinline__ float applyr(int row, int col, f32x4 v, float, f32x4 r) const {
        const f32x4 o = r + v; *(f32x4*)(XO + (size_t)row * DM + col) = o; *(u32x2*)(AB + (size_t)row * DM + col) = pk4(o); return ssq4(o); }
    __device__ __forceinline__ float apply(int row, int col, f32x4 v, float) const {
        float* p = XO + (size_t)row * DM + col; const f32x4 o = *(const f32x4*)p + v; *(f32x4*)p = o; *(u32x2*)(AB + (size_t)row * DM + col) = pk4(o); return ssq4(o); }
};
struct EPw {
    static constexpr bool HAS_RES = false, PERM = true; static constexpr bool MID = false, HAS_SS = false; float* ss; bf16_t* PW;
    __device__ __forceinline__ float rowval(int) const { return 0.f; }
    __device__ __forceinline__ float kscale(int, int) const { return 1.f; }
    __device__ __forceinline__ float apply(int row, int col, f32x4 v, float) const { *(u32x2*)(PW + (size_t)row * DM + col) = pk4(v); return 0.f; }
    __device__ __forceinline__ float apply8(int row, int col, f32x4 v0, f32x4 v1, float) const { u32x4 w; { const u32x2 a0 = pk4(v0), a1 = pk4(v1); w.x = a0.x; w.y = a0.y; w.z = a1.x; w.w = a1.y; } *(u32x4*)(PW + (size_t)row * DM + col) = w; return 0.f; }
};
struct EGate {
    static constexpr bool MID = false, HAS_SS = true; float* ss; const float* ss2; const bf16_t* PW; float* XO;
    __device__ __forceinline__ float rowval(int row) const { return rsqrtf(ss2[row] * (1.f / DM) + EPS); }
    __device__ __forceinline__ float kscale(int, int) const { return 1.f; }
    static constexpr bool HAS_RES = true, PERM = true;
    __device__ __forceinline__ f32x4 res(int row, int col) const { return *(const f32x4*)(XO + (size_t)row * DM + col); }
    __device__ __forceinline__ float applyr8(int row, int col, f32x4 v0, f32x4 v1, float rv, f32x4 r0, f32x4 r1) const {
        const u32x4 pr = *(const u32x4*)(PW + (size_t)row * DM + col); const f32x4 p0 = up4((u32x2){pr.x, pr.y}), p1 = up4((u32x2){pr.z, pr.w}); f32x4 o0 = r0, o1 = r1;
#pragma unroll
        for (int j = 0; j < 4; ++j) { o0[j] += p0[j] * sigm(v0[j] * rv); o1[j] += p1[j] * sigm(v1[j] * rv); }
        float* p = XO + (size_t)row * DM + col; *(f32x4*)p = o0; *(f32x4*)(p + 4) = o1; return ssq4(o0) + ssq4(o1); }
    __device__ __forceinline__ float applyr(int row, int col, f32x4 v, float rv, f32x4 r) const {
        f32x4 o = r; const f32x4 pw = up4(*(const u32x2*)(PW + (size_t)row * DM + col));
#pragma unroll
        for (int j = 0; j < 4; ++j) o[j] += pw[j] * sigm(v[j] * rv);
        *(f32x4*)(XO + (size_t)row * DM + col) = o; return ssq4(o); }
    __device__ __forceinline__ float apply(int row, int col, f32x4 v, float rv) const {
        float* p = XO + (size_t)row * DM + col; f32x4 o = *(const f32x4*)p; const f32x4 pw = up4(*(const u32x2*)(PW + (size_t)row * DM + col));
#pragma unroll
        for (int j = 0; j < 4; ++j) o[j] += pw[j] * sigm(v[j] * rv);
        *(f32x4*)p = o; return ssq4(o); }
};
__device__ __forceinline__ float em1(float x) {
    float p = x * (1.f + x * (0.5f + x * (0.16666667f + x * (0.041666668f + x * (0.0083333338f + x * (0.0013888889f + x * 0.0001984127f))))));
    if (__builtin_expect(__any(fabsf(x) >= 0.5f), 0)) p = fabsf(x) < 0.5f ? p : __expf(x) - 1.f;
    return p;
}
struct ELru {
    static constexpr bool MID = false, PERM = false; const bf16_t* XC; const float* ba; const float* bi; const float* spl; float* Ao; float* Bo;
    __device__ __forceinline__ void mid(f32x4 (&)[2][2][4][2], const pg8::Unit&, int, int) const {}
    __device__ __forceinline__ void operator()(const f32x4 (&acc)[2][2][4][2], const pg8::Unit& u, int wr, int wc, int fr, int fq) const {
#pragma unroll
        for (int n = 0; n < 2; ++n) {
            const int ch = (u.pn >> 1) * 256 + (u.pn & 1) * 128 + wc * 32 + n * 16 + 4 * fq;
            const f32x4 bav = *(const f32x4*)(ba + ch), biv = *(const f32x4*)(bi + ch), sp = *(const f32x4*)(spl + ch);
#pragma unroll
            for (int ai = 0; ai < 2; ++ai)
#pragma unroll
                for (int m = 0; m < 4; ++m) {
                    const int row = u.pm * 256 + ai * 128 + wr * 64 + m * 16 + fr;
                    const f32x4 xc = up4(*(const u32x2*)(XC + (size_t)row * DH + ch)); f32x4 av, bv;
#pragma unroll
                    for (int j = 0; j < 4; ++j) { const float r = sigm(acc[ai][0][m][n][j] + bav[j]), ig = sigm(acc[ai][1][m][n][j] + biv[j]);
                        const float la = r * sp[j]; av[j] = 1.f + em1(la); bv[j] = __builtin_amdgcn_sqrtf(fmaxf(-em1(2.f * la), 0.f)) * ig * xc[j]; }
                    *(f32x4*)(Ao + (size_t)row * DH + ch) = av; *(f32x4*)(Bo + (size_t)row * DH + ch) = bv;
                    asm volatile("" ::: "memory");
                }
        }
    }
};

template <class E, int MT = 8, int NG = 1>
__device__ __forceinline__ void skinny_gemm(LAS unsigned char* lds, const bf16_t* A, int lda, const bf16_t* Bt, int ldb, int N, int K, const E& e, int nb = 0) {
    const int tid = threadIdx.x, wid = __builtin_amdgcn_readfirstlane(tid >> 6), lane = tid & 63, fr = lane & 15, fq = lane >> 4;
    LAS f32x4* red = (LAS f32x4*)lds;
    constexpr int NH = 8 / MT;
    const int kw = K >> 3, k0w = wid * kw, nks = kw >> 5, nit = ((N >> 4) / NG) * NH, G = gridDim.x, NBk = nb ? nb : G;
    for (int iti = G - 1 - (int)blockIdx.x; iti < nit && (G - 1 - (int)blockIdx.x) < NBk; iti += NBk) {
        const int n0 = (iti / NH) * (16 * NG), r0 = (iti % NH) * (MT * 16);
        f32x4 acc[NG][MT];
#pragma unroll
        for (int q = 0; q < NG; ++q)
#pragma unroll
            for (int m = 0; m < MT; ++m) acc[q][m] = (f32x4){0.f, 0.f, 0.f, 0.f};
        const bf16_t* bp = Bt + (size_t)(n0 + fr) * ldb + k0w + 8 * fq;
        const bf16_t* ap = A + (size_t)(r0 + fr) * lda + k0w + 8 * fq;
        {
            bf16x8 bc[NG], ac[MT];
#pragma unroll
            for (int q = 0; q < NG; ++q) bc[q] = *(const bf16x8*)(bp + (size_t)(16 * q) * ldb);
#pragma unroll
            for (int m = 0; m < MT; ++m) ac[m] = *(const bf16x8*)(ap + (size_t)(16 * m) * lda);
            for (int ks = 0; ks < nks; ++ks) {
                const int kn = ks + 1 < nks ? ks + 1 : ks;
                bf16x8 bn[NG], an[MT];
#pragma unroll
                for (int q = 0; q < NG; ++q) bn[q] = *(const bf16x8*)(bp + (size_t)(16 * q) * ldb + 32 * kn);
#pragma unroll
                for (int m = 0; m < MT; ++m) an[m] = *(const bf16x8*)(ap + (size_t)(16 * m) * lda + 32 * kn);
#pragma unroll
                for (int q = 0; q < NG; ++q)
#pragma unroll
                    for (int m = 0; m < MT; ++m) acc[q][m] = __builtin_amdgcn_mfma_f32_16x16x32_bf16(bc[q], ac[m], acc[q][m], 0, 0, 0);
#pragma unroll
                for (int q = 0; q < NG; ++q) bc[q] = bn[q];
#pragma unroll
                for (int m = 0; m < MT; ++m) ac[m] = an[m];
            }
        }
#pragma unroll
        for (int q = 0; q < NG; ++q)
#pragma unroll
            for (int m = 0; m < MT; ++m) red[((wid * NG + q) * MT + m) * 64 + lane] = acc[q][m];
        __syncthreads();
        if (wid < MT) {
            const int row = MP + r0 + 16 * wid + fr; const float rv = e.rowval(row);
#pragma unroll
            for (int q = 0; q < NG; ++q) {
                f32x4 v = (f32x4){0.f, 0.f, 0.f, 0.f};
#pragma unroll
                for (int w = 0; w < 8; ++w) { f32x4 p = red[((w * NG + q) * MT + wid) * 64 + lane]; if constexpr (E::MID) p = p * e.kscale(row, w); v += p; }
                float s = e.apply(row, n0 + 16 * q + 4 * fq, v, rv);
                if constexpr (E::HAS_SS) { s += __shfl_xor(s, 16); s += __shfl_xor(s, 32); if (fq == 0) atomicAdd(e.ss + row, s); }
            }
        }
        __syncthreads();
    }
}

struct Args { const float* in[37]; float* out; unsigned char* ws; int ph_lo, ph_hi; };
enum { I_XP = 0, I_XS, I_S5RE, I_S5IM, I_LRUH, I_CONV, I_PP, I_PS, I_GMIX, I_WIN, I_LAMRE, I_LAMIM, I_LOGSTEP, I_BRE, I_BIM, I_CRE, I_CIM, I_S5D,
       I_WGLU, I_BGLU, I_CONVW, I_CONVB, I_WA, I_BA, I_WI, I_BI, I_LAM, I_GMA, I_GMB, I_WOUT, I_GMLP, I_WUP, I_WDOWN, I_GPLE, I_WGATE, I_WPLE, I_GFIN };

__device__ __forceinline__ void tr_item(const float* W, int K, int N, bf16_t* WT, int rbase, int lru, const float* g1, const float* g2, int gsplit,
                                        LAS float* scr, int item, int lane) {
    const int nblk = N / 32, kb = item / nblk, nb = item % nblk, k0 = 64 * kb, n0 = 32 * nb;
    f32x4 wv[8];
#pragma unroll
    for (int i = 0; i < 8; ++i) wv[i] = __builtin_nontemporal_load((const f32x4*)(W + (size_t)(k0 + 8 * i + (lane >> 3)) * N + n0 + 4 * (lane & 7)));
#pragma unroll
    for (int i = 0; i < 8; ++i) { const int kk = 8 * i + (lane >> 3), k = k0 + kk; const float gv = g1 ? (k < gsplit ? g1[k] : g2[k - gsplit]) : 1.f;
        LAS float* d = scr + kk * 33 + 4 * (lane & 7); d[0] = wv[i][0] * gv; d[1] = wv[i][1] * gv; d[2] = wv[i][2] * gv; d[3] = wv[i][3] * gv; }
    LDS_WAIT();
    const int c = lane & 7;
#pragma unroll
    for (int j = 0; j < 4; ++j) { const int n = (lane >> 3) + 8 * j, nn = n0 + n; const int drow = lru ? rbase + (nn >> 7) * 256 + (nn & 127) : rbase + nn;
        const LAS float* s = scr + (8 * c) * 33 + n;
        u32x4 o; o.x = cvt_pk_bf16(s[0 * 33], s[1 * 33]); o.y = cvt_pk_bf16(s[2 * 33], s[3 * 33]); o.z = cvt_pk_bf16(s[4 * 33], s[5 * 33]); o.w = cvt_pk_bf16(s[6 * 33], s[7 * 33]);
        *(u32x4*)(WT + (size_t)drow * K + k0 + 8 * c) = o; }
    LDS_WAIT();
}

__device__ __forceinline__ void phase0(const Args& a, LAS unsigned char* lds) {
    const int tid = threadIdx.x, wave = __builtin_amdgcn_readfirstlane(tid >> 6), lane = tid & 63, G = gridDim.x;
    unsigned char* ws = a.ws;
    LAS float* scr = (LAS float*)(lds + wave * 16384);
    const int gw = blockIdx.x * 8 + wave, NGW = G * 8;
    constexpr int I_IN = 32 * 96, I_UP = 32 * 256, I_DOWN = 5120  , I_LRU = 8 * 32;
    constexpr int NITEMS = I_IN + I_UP + I_DOWN + I_LRU;
    for (int it = gw; it < NITEMS; it += NGW) {
        int r = it;
        if (r < I_UP) { tr_item(a.in[I_WUP], DM, DFF, (bf16_t*)(ws + WS_WUP), 0, 0, a.in[I_GMLP], a.in[I_GMLP], 1 << 30, scr, r, lane); continue; } r -= I_UP;
        if (r < I_DOWN) { tr_item(a.in[I_WDOWN], DFF, DM, (bf16_t*)(ws + WS_WDOWN), 0, 0, nullptr, nullptr, 0, scr, r, lane); continue; } r -= I_DOWN;
        if (r < I_IN) { tr_item(a.in[I_WIN], DM, NZ, (bf16_t*)(ws + WS_WIN), 0, 0, a.in[I_GMIX], a.in[I_GMIX], 1 << 30, scr, r, lane); continue; } r -= I_IN;
        { const int mat = r >> 5, h = mat >> 1, bj = mat & 1;
          tr_item((bj ? a.in[I_WI] : a.in[I_WA]) + (size_t)h * 65536, 256, 256, (bf16_t*)(ws + WS_WLRU), h * 512 + bj * 128, 1, nullptr, nullptr, 0, scr, r & 31, lane); }
    }
    float* rs0 = (float*)(ws + WS_SMALL + SM_RS0); bf16_t* XB = (bf16_t*)(ws + WS_AB); bf16_t* PB = (bf16_t*)(ws + WS_PB);
    for (int row = gw; row < MT; row += NGW) {
        const float* xr = row < MP ? a.in[I_XP] + (size_t)row * DM : a.in[I_XS] + (size_t)(row - MP) * DM;
        f32x4 v[8]; float s = 0.f;
#pragma unroll
        for (int j = 0; j < 8; ++j) { v[j] = ((const f32x4*)xr)[lane + 64 * j]; s += ssq4(v[j]); }
        s = wave_sum(s); if (lane == 0) rs0[row] = rsqrtf(s * (1.f / DM) + EPS);
#pragma unroll
        for (int j = 0; j < 8; ++j) ((u32x2*)(XB + (size_t)row * DM))[lane + 64 * j] = pk4(v[j]);
        const float* pr = row < MP ? a.in[I_PP] + (size_t)row * DPLE : a.in[I_PS] + (size_t)(row - MP) * DPLE;
        ((u32x2*)(PB + (size_t)row * DPLE))[lane] = pk4(((const f32x4*)pr)[lane]);
    }
    { float* SPL = (float*)(ws + WS_SMALL + SM_SPL);
      for (int i = blockIdx.x * 512 + tid; i < DH; i += G * 512) { const float xl = -a.in[I_LAM][i]; SPL[i] = -8.f * (fmaxf(xl, 0.f) + log1pf(expf(-fabsf(xl)))); } }
    float* AR = (float*)(ws + WS_SMALL + SM_AR); float* AI = (float*)(ws + WS_SMALL + SM_AI); float* A64R = (float*)(ws + WS_SMALL + SM_A64R); float* A64I = (float*)(ws + WS_SMALL + SM_A64I);
    bf16_t* BBB = (bf16_t*)(ws + WS_SMALL + SM_BBB); bf16_t* CMB = (bf16_t*)(ws + WS_SMALL + SM_CMB);
    for (int i = blockIdx.x * 512 + tid; i < 4096; i += G * 512) {
        const int g = i >> 6, p = i & 63;
        const float step = expf(a.in[I_LOGSTEP][g]), lr = a.in[I_LAMRE][i], li = a.in[I_LAMIM][i];
        const float mag = expf(lr * step); float sn, cs; sincosf(li * step, &sn, &cs);
        const float ar = mag * cs, ai = mag * sn, nr = ar - 1.f, ni = ai, den = lr * lr + li * li;
        const float cr = (nr * lr + ni * li) / den, ci = (ni * lr - nr * li) / den;
        AR[i] = ar; AI[i] = ai;
        float pr_ = ar, pi_ = ai;
#pragma unroll
        for (int q = 0; q < 6; ++q) { const float t0 = pr_ * pr_ - pi_ * pi_, t1 = 2.f * pr_ * pi_; pr_ = t0; pi_ = t1; }
        A64R[i] = pr_; A64I[i] = pi_;
        for (int c = 0; c < 16; ++c) {
            const float br = a.in[I_BRE][(size_t)i * 16 + c], bi = a.in[I_BIM][(size_t)i * 16 + c];
            BBB[((size_t)g * 128 + p) * 16 + c] = (bf16_t)(cvt_pk_bf16(cr * br - ci * bi, 0.f) & 0xffffu);
            BBB[((size_t)g * 128 + 64 + p) * 16 + c] = (bf16_t)(cvt_pk_bf16(cr * bi + ci * br, 0.f) & 0xffffu);
            CMB[((size_t)g * 16 + c) * 128 + p] = (bf16_t)(cvt_pk_bf16(a.in[I_CRE][((size_t)g * 16 + c) * 64 + p], 0.f) & 0xffffu);
            CMB[((size_t)g * 16 + c) * 128 + 64 + p] = (bf16_t)(cvt_pk_bf16(-a.in[I_CIM][((size_t)g * 16 + c) * 64 + p], 0.f) & 0xffffu);
        }
    }
}

__device__ __forceinline__ void s5_unit(const Args& a, LAS unsigned char* wl, int lane, int mode, int n, int g, int j) {
    unsigned char* ws = a.ws;
    const int fr = lane & 15, fq = lane >> 4;
    const float* AR = (const float*)(ws + WS_SMALL + SM_AR); const float* AI = (const float*)(ws + WS_SMALL + SM_AI);
    const bf16_t* BBB = (const bf16_t*)(ws + WS_SMALL + SM_BBB); const bf16_t* CMB = (const bf16_t*)(ws + WS_SMALL + SM_CMB);
    const bf16_t* Z = (const bf16_t*)(ws + WS_Z); bf16_t* YG = (bf16_t*)(ws + WS_YG); float* SUM = (float*)(ws + WS_S5SUM);
    LAS float* BuS = (LAS float*)wl; LAS bf16_t* Hs = (LAS bf16_t*)(wl + 8448);
    const float ar = AR[g * 64 + lane], ai = AI[g * 64 + lane];
    const bf16x8 zero8 = (bf16x8){0, 0, 0, 0, 0, 0, 0, 0};
    bf16x8 bb[8];
#pragma unroll
    for (int t = 0; t < 8; ++t) bb[t] = fq < 2 ? *(const bf16x8*)(BBB + ((size_t)g * 128 + 16 * t + fr) * 16 + 8 * fq) : zero8;
    bf16x8 cm[4];
#pragma unroll
    for (int kk = 0; kk < 4; ++kk) cm[kk] = *(const bf16x8*)(CMB + ((size_t)g * 16 + fr) * 128 + 32 * kk + 8 * fq);
    const f32x4 dsk = *(const f32x4*)(a.in[I_S5D] + 16 * g + 4 * fq);
    float hr = 0.f, hi = 0.f;
    if (mode == 1 && j > 0) {
        const float pr = ((const float*)(ws + WS_SMALL + SM_A64R))[g * 64 + lane], pi = ((const float*)(ws + WS_SMALL + SM_A64I))[g * 64 + lane];
        const float* sp = SUM + ((size_t)(n * 64 + g) * 32) * 128;
        for (int i = 0; i < j; ++i) { const float sr = sp[i * 128 + lane], si = sp[i * 128 + 64 + lane];
            const float t0 = pr * hr - pi * hi + sr, t1 = pr * hi + pi * hr + si; hr = t0; hi = t1; }
    }
    if (mode == 4 && j > 0) {
        float pr = ((const float*)(ws + WS_SMALL + SM_A64R))[g * 64 + lane], pi = ((const float*)(ws + WS_SMALL + SM_A64I))[g * 64 + lane];
#pragma unroll
        for (int q = 0; q < 2; ++q) { const float t0 = pr * pr - pi * pi, t1 = 2.f * pr * pi; pr = t0; pi = t1; }
        for (int v = 0; v < j; ++v) { const LAS float* ps = (const LAS float*)(wl + (v - j) * 16384 + 12800); const float sr = ps[lane], si = ps[64 + lane];
            const float t0 = pr * hr - pi * hi + sr, t1 = pr * hi + pi * hr + si; hr = t0; hi = t1; }
    }
    const int row0 = mode == 2 ? MP + 16 * j : ((mode == 3 || mode == 4) ? n * SEQ + 256 * j : n * SEQ + 64 * j);
    const int nblk = mode == 2 ? 1 : ((mode == 3 || mode == 1 || mode == 4) ? 16 : 4);
    for (int blk = 0; blk < nblk; ++blk) {
        const int r0 = row0 + 16 * blk;
        const bf16x8 ua = fq < 2 ? *(const bf16x8*)(Z + (size_t)(r0 + fr) * NZ + 16 * g + 8 * fq) : zero8;
        u32x2 u4raw = (u32x2){0u, 0u}; if (mode == 1 || mode == 2 || mode == 4) u4raw = *(const u32x2*)(Z + (size_t)(r0 + fr) * NZ + 16 * g + 4 * fq);
#pragma unroll
        for (int t = 0; t < 8; ++t) {
            const f32x4 c = __builtin_amdgcn_mfma_f32_16x16x32_bf16(ua, bb[t], (f32x4){0.f, 0.f, 0.f, 0.f}, 0, 0, 0);
#pragma unroll
            for (int jj = 0; jj < 4; ++jj) BuS[(4 * fq + jj) * 132 + 16 * t + fr] = c[jj];
        }
        LDS_WAIT();
        float burv[16], buiv[16];
#pragma unroll
        for (int t = 0; t < 16; ++t) { burv[t] = BuS[t * 132 + lane]; buiv[t] = BuS[t * 132 + 64 + lane]; }
#pragma unroll
        for (int t = 0; t < 16; ++t) {
            const float bur = burv[t], bui = buiv[t];
            if (mode == 2) { const size_t si = ((size_t)(r0 - MP + t) * 64 + g) * 64 + lane; hr = a.in[I_S5RE][si]; hi = a.in[I_S5IM][si]; }
            const float t0 = ar * hr - ai * hi + bur, t1 = ar * hi + ai * hr + bui; hr = t0; hi = t1;
            if (mode == 2) { const size_t si = ((size_t)(r0 - MP + t) * 64 + g) * 64 + lane; a.out[O_S5RS + si] = hr; a.out[O_S5IS + si] = hi; }
            if (mode == 1 || mode == 2 || mode == 4) { const unsigned w = cvt_pk_bf16(hr, hi); Hs[t * 136 + lane] = (bf16_t)(w & 0xffffu); Hs[t * 136 + 64 + lane] = (bf16_t)(w >> 16); }
        }
        if (mode == 1 || mode == 2 || mode == 4) {
            LDS_WAIT();
            f32x4 y = (f32x4){0.f, 0.f, 0.f, 0.f};
#pragma unroll
            for (int kk = 0; kk < 4; ++kk) { const bf16x8 hb = *(const LAS bf16x8*)(Hs + fr * 136 + 32 * kk + 8 * fq);
                y = __builtin_amdgcn_mfma_f32_16x16x32_bf16(cm[kk], hb, y, 0, 0, 0); }
            const f32x4 u4 = up4(u4raw); f32x4 o;
#pragma unroll
            for (int jj = 0; jj < 4; ++jj) o[jj] = gelu_t(y[jj] + dsk[jj] * u4[jj]);
            *(u32x2*)(YG + (size_t)(r0 + fr) * DH + 16 * g + 4 * fq) = pk4(o);
            LDS_WAIT();
        }
    }
    if (mode == 0) { float* sp = SUM + ((size_t)(n * 64 + g) * 32 + j) * 128; sp[lane] = hr; sp[64 + lane] = hi; }
    if (mode == 3) { LAS float* ps = (LAS float*)(wl + 12800); ps[lane] = hr; ps[64 + lane] = hi; }
    if (mode == 4 && j == 7) { a.out[O_S5RP + (size_t)(n * 64 + g) * 64 + lane] = hr; a.out[O_S5IP + (size_t)(n * 64 + g) * 64 + lane] = hi; }
}

__device__ __forceinline__ void conv_prompt(const Args& a) {
    unsigned char* ws = a.ws; const bf16_t* Z = (const bf16_t*)(ws + WS_Z); bf16_t* XC = (bf16_t*)(ws + WS_XC);
    const float* cw = a.in[I_CONVW]; const float* cb = a.in[I_CONVB];
    const int G = gridDim.x;
    for (int it = blockIdx.x * 512 + threadIdx.x; it < MP * 128; it += G * 512) {
        const int row = it >> 7, c = (it & 127) * 8, t = row & (SEQ - 1);
        float acc[8];
#pragma unroll
        for (int q = 0; q < 8; ++q) acc[q] = cb[c + q];
#pragma unroll
        for (int k = 0; k < 4; ++k) {
            if (t - 3 + k >= 0) {
                const u32x4 z = *(const u32x4*)(Z + (size_t)(row - 3 + k) * NZ + DH + c);
                const float x[8] = {bf_lo(z.x), bf_hi(z.x), bf_lo(z.y), bf_hi(z.y), bf_lo(z.z), bf_hi(z.z), bf_lo(z.w), bf_hi(z.w)};
#pragma unroll
                for (int q = 0; q < 8; ++q) acc[q] += cw[k * DH + c + q] * x[q];
                if (k == 3 && t >= SEQ - 3) {
                    float* o = a.out + O_CONVP + ((size_t)(row >> 11) * 3 + (t - (SEQ - 3))) * DH + c;
#pragma unroll
                    for (int q = 0; q < 8; ++q) o[q] = x[q];
                }
            }
        }
        u32x4 o; o.x = cvt_pk_bf16(acc[0], acc[1]); o.y = cvt_pk_bf16(acc[2], acc[3]); o.z = cvt_pk_bf16(acc[4], acc[5]); o.w = cvt_pk_bf16(acc[6], acc[7]);
        *(u32x4*)(XC + (size_t)row * DH + c) = o;
    }
}

__device__ __forceinline__ void conv_tile(const Args& a, int pm, int h) {
    unsigned char* ws = a.ws; const bf16_t* Z = (const bf16_t*)(ws + WS_Z); bf16_t* XC = (bf16_t*)(ws + WS_XC);
    const int tid = threadIdx.x, c = h * 256 + (tid & 31) * 8;
    float cwv[4][8], cbv[8];
#pragma unroll
    for (int q = 0; q < 8; ++q) { cbv[q] = a.in[I_CONVB][c + q];
#pragma unroll
        for (int k = 0; k < 4; ++k) cwv[k][q] = a.in[I_CONVW][k * DH + c + q]; }
#pragma unroll 1
    for (int r4 = 0; r4 < 16; r4 += 4) {
        u32x4 z[4][4];
#pragma unroll
        for (int rr = 0; rr < 4; ++rr) { const int row = pm * 256 + (tid >> 5) + 16 * (r4 + rr), t = row & (SEQ - 1);
#pragma unroll
            for (int k = 0; k < 4; ++k) z[rr][k] = (t - 3 + k >= 0) ? *(const u32x4*)(Z + (size_t)(row - 3 + k) * NZ + DH + c) : (u32x4){0u, 0u, 0u, 0u}; }
#pragma unroll
        for (int rr = 0; rr < 4; ++rr) { const int row = pm * 256 + (tid >> 5) + 16 * (r4 + rr), t = row & (SEQ - 1);
            float acc[8];
#pragma unroll
            for (int q = 0; q < 8; ++q) acc[q] = cbv[q];
#pragma unroll
            for (int k = 0; k < 4; ++k) { const u32x4 zz = z[rr][k];
                const float x[8] = {bf_lo(zz.x), bf_hi(zz.x), bf_lo(zz.y), bf_hi(zz.y), bf_lo(zz.z), bf_hi(zz.z), bf_lo(zz.w), bf_hi(zz.w)};
#pragma unroll
                for (int q = 0; q < 8; ++q) acc[q] += cwv[k][q] * x[q];
                if (k == 3 && t >= SEQ - 3) { float* o = a.out + O_CONVP + ((size_t)(row >> 11) * 3 + (t - (SEQ - 3))) * DH + c;
#pragma unroll
                    for (int q = 0; q < 8; ++q) o[q] = x[q]; } }
            u32x4 o; o.x = cvt_pk_bf16(acc[0], acc[1]); o.y = cvt_pk_bf16(acc[2], acc[3]); o.z = cvt_pk_bf16(acc[4], acc[5]); o.w = cvt_pk_bf16(acc[6], acc[7]);
            *(u32x4*)(XC + (size_t)row * DH + c) = o; }
    }
}

__device__ __forceinline__ void lru_sample(const Args& a, LAS unsigned char* lds, int unit) {
    unsigned char* ws = a.ws; const bf16_t* Z = (const bf16_t*)(ws + WS_Z); bf16_t* MG = (bf16_t*)(ws + WS_MERGED); float* ssB = (float*)(ws + WS_CTL) + SS_B * SS_STRIDE;
    LAS float* sxc = (LAS float*)lds;
    const int tid = threadIdx.x, s = unit >> 1, half = unit & 1, row = MP + s;
    const float* cw = a.in[I_CONVW]; const float* cs = a.in[I_CONV] + (size_t)s * 3 * DH;
    for (int c = tid; c < DH; c += 512) {
        const float xb = bf1(Z[(size_t)row * NZ + DH + c]);
        sxc[c] = a.in[I_CONVB][c] + cw[c] * cs[c] + cw[DH + c] * cs[DH + c] + cw[2 * DH + c] * cs[2 * DH + c] + cw[3 * DH + c] * xb;
        if ((c >> 9) == half) { float* o = a.out + O_CONVS + (size_t)s * 3 * DH; o[c] = cs[DH + c]; o[DH + c] = cs[2 * DH + c]; o[2 * DH + c] = xb; }
    }
    __syncthreads();
    float sq = 0.f;
    {
        const int c = half * 512 + tid, h = c >> 8, jj = c & 255;
        const float* wa = a.in[I_WA] + (size_t)h * 65536 + jj; const float* wi = a.in[I_WI] + (size_t)h * 65536 + jj;
        float ra = a.in[I_BA][c], ri = a.in[I_BI][c];
#pragma unroll 1
        for (int k0 = 0; k0 < 256; k0 += 32) {
            float wav[32], wiv[32];
#pragma unroll
            for (int q = 0; q < 32; ++q) { wav[q] = wa[(size_t)(k0 + q) * 256]; wiv[q] = wi[(size_t)(k0 + q) * 256]; }
#pragma unroll
            for (int q = 0; q < 32; ++q) { const float x = sxc[h * 256 + k0 + q]; ra += x * wav[q]; ri += x * wiv[q]; }
        }
        const float r = sigm(ra), ig = sigm(ri); const float xl = -a.in[I_LAM][c]; const float sp = fmaxf(xl, 0.f) + log1pf(expf(-fabsf(xl)));
        const float la = -8.f * r * sp, av = expf(la), bv = sqrtf(-expm1f(2.f * la)) * ig * sxc[c];
        const float hn = av * a.in[I_LRUH][(size_t)s * DH + c] + bv;
        a.out[O_LRUS + (size_t)s * DH + c] = hn;
        const float o = hn * gelu_t(bf1(Z[(size_t)row * NZ + 2 * DH + c]));
        MG[(size_t)row * DM + DH + c] = (bf16_t)(cvt_pk_bf16(o, 0.f) & 0xffffu);
        sq = o * o;
    }
    sq = wave_sum(sq);
    if ((tid & 63) == 0) atomicAdd(ssB + row, sq);
    __syncthreads();
}

__device__ __forceinline__ void lru_scan_unit(const Args& a, LAS unsigned char* lds, int unit) {
    unsigned char* ws = a.ws; const bf16_t* Z = (const bf16_t*)(ws + WS_Z); bf16_t* MG = (bf16_t*)(ws + WS_MERGED); float* ssB = (float*)(ws + WS_CTL) + SS_B * SS_STRIDE;
    const float* Ao = a.out; const float* Bo = a.out + (size_t)MP * DH;
    LAS float* sP = (LAS float*)lds; LAS float* sH = sP + 512; LAS float* rsum = sH + 512;
    const int tid = threadIdx.x, n = unit >> 6, ch = (unit & 63) * 16 + (tid & 15), j = tid >> 4;
    const size_t r0 = (size_t)n * SEQ + 64 * j;
    float P = 1.f, h = 0.f;
#pragma unroll 1
    for (int tb = 0; tb < 64; tb += 16) {
        float av[16], bv[16];
#pragma unroll
        for (int q = 0; q < 16; ++q) { av[q] = Ao[(r0 + tb + q) * DH + ch]; bv[q] = Bo[(r0 + tb + q) * DH + ch]; }
#pragma unroll
        for (int q = 0; q < 16; ++q) { h = av[q] * h + bv[q]; P *= av[q]; }
    }
    sP[tid] = P; sH[tid] = h;
    __syncthreads();
    float H = 0.f;
    for (int i = 0; i < j; ++i) H = sP[i * 16 + (tid & 15)] * H + sH[i * 16 + (tid & 15)];
    h = H;
#pragma unroll 1
    for (int tb = 0; tb < 64; tb += 16) {
        float av[16], bv[16]; bf16_t gz[16];
#pragma unroll
        for (int q = 0; q < 16; ++q) { const size_t row = r0 + tb + q; av[q] = Ao[row * DH + ch]; bv[q] = Bo[row * DH + ch]; gz[q] = Z[row * NZ + 2 * DH + ch]; }
#pragma unroll
        for (int q = 0; q < 16; ++q) {
            const size_t row = r0 + tb + q;
            h = av[q] * h + bv[q];
            const float o = h * gelu_t(bf1(gz[q]));
            MG[row * DM + DH + ch] = (bf16_t)(cvt_pk_bf16(o, 0.f) & 0xffffu);
            float s = o * o; s += __shfl_xor(s, 1); s += __shfl_xor(s, 2); s += __shfl_xor(s, 4); s += __shfl_xor(s, 8);
            if ((tid & 15) == 0) rsum[64 * j + tb + q] = s;
        }
    }
    __syncthreads();
    for (int r = tid; r < SEQ; r += 512) atomicAdd(ssB + (size_t)n * SEQ + r, rsum[r]);
    if (j == 31) a.out[O_LRUP + (size_t)n * DH + ch] = h;
    __syncthreads();
}

#define XB_TMO      128
#define XB_XCNT(j)  (256  + 64 * (j))
#define XB_XSUB(j)  (1280 + 64 * (j))
#define XB_XGEN(j)  (2304 + 64 * (j))
#define XB_TOP      3328
#define XB_TOPGEN   3392
#define XB_SPIN_CAP (1u << 18)
__device__ __forceinline__ unsigned xb_ld(unsigned* p)              { return __hip_atomic_load(p, __ATOMIC_RELAXED, __HIP_MEMORY_SCOPE_AGENT); }
__device__ __forceinline__ unsigned xb_add(unsigned* p, unsigned v) { return __hip_atomic_fetch_add(p, v, __ATOMIC_RELAXED, __HIP_MEMORY_SCOPE_AGENT); }
__device__ __forceinline__ unsigned xb_xcc_id() { return (unsigned)__builtin_amdgcn_s_getreg((3 << 11) | 20) & 0xFu; }
#define XB_SPIN(cond, bar) do { unsigned _sp = 0; while (cond) { __builtin_amdgcn_s_sleep(1); \
    if ((++_sp & 255u) == 0u) { if (xb_ld(&(bar)[XB_TMO])) break; if (_sp > XB_SPIN_CAP) { atomicAdd(&(bar)[XB_TMO], 1u); break; } } } } while (0)
struct XcdBarrier { unsigned* bar; unsigned x; volatile LAS unsigned* st; };
__device__ __forceinline__ XcdBarrier xcd_barrier_post(unsigned* bar, volatile LAS unsigned* st) {
    XcdBarrier b; b.bar = bar; b.x = xb_xcc_id(); b.st = st;
    if (threadIdx.x == 0) (void)xb_add(&bar[XB_XCNT(b.x)], 1u);
    return b;
}
__device__ __forceinline__ void xcd_barrier_complete(unsigned* bar, unsigned x, unsigned& nloc, unsigned& nx) {
    const unsigned G = gridDim.x * gridDim.y * gridDim.z;
    unsigned sum, cnt, mine, sp = 0u;
    for (;;) {
        sum = 0u; cnt = 0u; mine = 0u;
#pragma unroll
        for (unsigned j = 0; j < 16; ++j) { const unsigned c = xb_ld(&bar[XB_XCNT(j)]); sum += c; cnt += (c > 0u) ? 1u : 0u; mine = (j == x) ? c : mine; }
        if (sum == G) break;
        __builtin_amdgcn_s_sleep(1);
        if ((++sp & 255u) == 0u) { if (xb_ld(&bar[XB_TMO])) break; if (sp > XB_SPIN_CAP) { atomicAdd(&bar[XB_TMO], 1u); break; } }
    }
    nloc = mine > 0u ? mine : 1u; nx = cnt > 0u ? cnt : 1u;
}
__device__ __forceinline__ void xcd_barrier(const XcdBarrier& b) {
    asm volatile("s_waitcnt vmcnt(0)" ::: "memory");
    __syncthreads();
    if (threadIdx.x == 0) {
        unsigned* bar = b.bar;
        __builtin_amdgcn_s_waitcnt(0);
        unsigned nloc = b.st[0], nx = b.st[1];
        if (nloc == 0u) { xcd_barrier_complete(bar, b.x, nloc, nx); b.st[0] = nloc; b.st[1] = nx; }
        const unsigned old = xb_add(&bar[XB_XSUB(b.x)], 1u);
        const unsigned gen = old / nloc;
        if (old + 1u == (gen + 1u) * nloc) {
            __builtin_amdgcn_fence(__ATOMIC_RELEASE, "agent");
            asm volatile("s_waitcnt vmcnt(0)" ::: "memory");
            const unsigned og = xb_add(&bar[XB_TOP], 1u);
            const unsigned tg = og / nx;
            if (og + 1u == (tg + 1u) * nx) xb_add(&bar[XB_TOPGEN], 1u);
            else XB_SPIN(xb_ld(&bar[XB_TOPGEN]) == tg, bar);
            __builtin_amdgcn_fence(__ATOMIC_ACQUIRE, "agent");
            xb_add(&bar[XB_XGEN(b.x)], 1u);
            asm volatile("s_waitcnt vmcnt(0)" ::: "memory");
        } else {
            XB_SPIN(xb_ld(&bar[XB_XGEN(b.x)]) == gen, bar);
            __builtin_amdgcn_fence(__ATOMIC_ACQUIRE, "agent");
            asm volatile("s_waitcnt vmcnt(0)" ::: "memory");
        }
    }
    __syncthreads();
}

__global__ void __launch_bounds__(512, 2) fwd_kernel(Args a) {
    extern __shared__ __attribute__((aligned(16))) unsigned char lds_raw[];
    LAS unsigned char* lds = (LAS unsigned char*)lds_raw;
    const int tid = threadIdx.x, wave = __builtin_amdgcn_readfirstlane(tid >> 6), lane = tid & 63, G = gridDim.x;
    unsigned char* ws = a.ws;
    const int lo = a.ph_lo, hi = a.ph_hi;
    volatile LAS unsigned* MISC = (volatile LAS unsigned*)(lds + MISC_OFF);
    for (int u = tid; u < (LDS_BYTES - RING_BYTES) / 4; u += 512) ((LAS unsigned*)(lds + RING_BYTES))[u] = 0u;
    __syncthreads();
#if MK_LAUNCHES == 1
    XcdBarrier bar = xcd_barrier_post((unsigned*)(ws + WS_CTL) + CW_BAR, MISC + 8);
#define GRID_BAR() xcd_barrier(bar)
#else
#define GRID_BAR() do {} while (0)
#endif
#define IN(k) (lo <= (k) && (k) < hi)
#define BOTH(k) (IN(k) && IN((k) + 1))
#define ssb ((float*)(ws + WS_CTL))
#define AB ((bf16_t*)(ws + WS_AB))
#define Z ((bf16_t*)(ws + WS_Z))
#define YG ((bf16_t*)(ws + WS_YG))
#define MG ((bf16_t*)(ws + WS_MERGED))
#define HUP ((bf16_t*)(ws + WS_HUP))
#define PW ((bf16_t*)(ws + WS_PW))
#define PB ((bf16_t*)(ws + WS_PB))
#define XO (a.out + O_Y)

    if (IN(0)) { phase0(a, lds); if (BOTH(0)) GRID_BAR(); }

    if (IN(1)) {
        pg8::Gemm g{AB, (const bf16_t*)(ws + WS_WIN), DM, DM, DM, 0}; pg8::StaticOrder S; S.init(MP / 256, NZ / 256, G, (int)blockIdx.x);
        EpiWrap<EIn> E{{nullptr, (const float*)(ws + WS_SMALL + SM_RS0), Z}};
        pg8::gemm_phase<EpiWrap<EIn>, true>(lds, g, S, E);
        skinny_gemm<EIn, 8, 2>(lds, AB + (size_t)MP * DM, DM, (const bf16_t*)(ws + WS_WIN), DM, NZ, DM, E.e, G / 2);
        if ((int)blockIdx.x >= G / 2) {
            const int w = ((int)blockIdx.x - G / 2) * 8 + wave, nw = (G - G / 2) * 8; LAS float* scr = (LAS float*)(lds + wave * 16384);
            constexpr int J_OUT = 32 * 64, J_GATE = 32 * 64, J_GLU = 16 * 32, J_PLE = 4 * 64;
            for (int it = w; it < J_OUT + J_GATE + J_GLU + J_PLE; it += nw) {
                int r = it;
                if (r < J_OUT) { tr_item(a.in[I_WOUT], DM, DM, (bf16_t*)(ws + WS_WOUT), 0, 0, a.in[I_GMA], a.in[I_GMB], DH, scr, r, lane); continue; } r -= J_OUT;
                if (r < J_GATE) { tr_item(a.in[I_WGATE], DM, DM, (bf16_t*)(ws + WS_WGATE), 0, 0, a.in[I_GPLE], a.in[I_GPLE], 1 << 30, scr, r, lane); continue; } r -= J_GATE;
                if (r < J_GLU) { tr_item(a.in[I_WGLU], DH, DH, (bf16_t*)(ws + WS_WGLU), 0, 0, nullptr, nullptr, 0, scr, r, lane); continue; } r -= J_GLU;
                tr_item(a.in[I_WPLE], DPLE, DM, (bf16_t*)(ws + WS_WPLE), 0, 0, nullptr, nullptr, 0, scr, r, lane);
            }
        }
        if (BOTH(1)) GRID_BAR();
    }

    if (IN(3)) {
        pg8::Gemm g{(const bf16_t*)(ws + WS_XC), (const bf16_t*)(ws + WS_WLRU), DH, 256, 256, 1}; pg8::StaticOrder S; S.init(MP / 256, 8, G, (int)blockIdx.x);
        { pg8::Unit cu; for (int i = 0; S.next(i, cu); ++i) conv_tile(a, cu.pm, cu.pn >> 1); }
        asm volatile("s_waitcnt vmcnt(0)" ::: "memory"); __syncthreads();
        ELru E{(const bf16_t*)(ws + WS_XC), a.in[I_BA], a.in[I_BI], (const float*)(ws + WS_SMALL + SM_SPL), a.out, a.out + (size_t)MP * DH};
        pg8::gemm_phase<ELru, true>(lds, g, S, E);
        for (int s = G - 1 - (int)blockIdx.x; s < 2 * MS; s += G) lru_sample(a, lds, s);
        for (int u = blockIdx.x; u < NB * 64; u += G) {
            const int n = u >> 6, g2 = u & 63;
            s5_unit(a, lds + wave * 16384, lane, 3, n, g2, wave);
            __syncthreads();
            s5_unit(a, lds + wave * 16384, lane, 4, n, g2, wave);
            __syncthreads();
        }
        for (int u = blockIdx.x * 8 + wave; u < 512; u += G * 8) s5_unit(a, lds + wave * 16384, lane, 2, 0, u >> 3, u & 7);
        if (BOTH(3)) GRID_BAR();
    }

    if (IN(4)) {
        pg8::Gemm g{YG, (const bf16_t*)(ws + WS_WGLU), DH, DH, DH, 0}; pg8::StaticOrder S; S.init(MP / 256, DH / 256, G, (int)blockIdx.x);
        EpiWrap<EGlu> E{{ssb + SS_A * SS_STRIDE, a.in[I_BGLU], YG, MG}};
        pg8::gemm_phase<EpiWrap<EGlu>, true>(lds, g, S, E);
        skinny_gemm<EGlu, 4>(lds, YG + (size_t)MP * DH, DH, (const bf16_t*)(ws + WS_WGLU), DH, DH, DH, E.e);
        for (int u = G - 1 - (int)blockIdx.x; u < NB * 64; u += G) lru_scan_unit(a, lds, u);
        if ((int)blockIdx.x >= G / 2) {
            const int w = ((int)blockIdx.x - G / 2) * 8 + wave, nw = (G - G / 2) * 8;
            for (int it = 5120 + w; it < 128 * 64; it += nw) tr_item(a.in[I_WDOWN], DFF, DM, (bf16_t*)(ws + WS_WDOWN), 0, 0, nullptr, nullptr, 0, (LAS float*)(lds + wave * 16384), it, lane);
        }
        if (BOTH(4)) GRID_BAR();
    }

    if (IN(5)) {
        pg8::Gemm g{MG, (const bf16_t*)(ws + WS_WOUT), DM, DM, DM, 0}; pg8::StaticOrder S; S.init(MP / 256, DM / 256, G, (int)blockIdx.x);
        { float* RAT = (float*)(ws + WS_SMALL + SM_RAT); float* RSB = (float*)(ws + WS_SMALL + SM_RSB);
          pg8::Unit cu;
          for (int ui = -1; ui < 0 || S.next(ui, cu); ++ui)
              for (int i = tid; i < (ui < 0 ? MS : 256); i += 512) { const int row = ui < 0 ? MP + i : cu.pm * 256 + i;
                  const float va = ssb[SS_A * SS_STRIDE + row] * (1.f / DH) + EPS, vb = ssb[SS_B * SS_STRIDE + row] * (1.f / DH) + EPS; RAT[row] = sqrtf(vb / va); RSB[row] = rsqrtf(vb); }
          asm volatile("s_waitcnt vmcnt(0)" ::: "memory"); __syncthreads(); }
        EpiWrap<EOut> E{{ssb + SS_1 * SS_STRIDE, (const float*)(ws + WS_SMALL + SM_RAT), (const float*)(ws + WS_SMALL + SM_RSB), a.in[I_XP], a.in[I_XS], XO, AB}};
        pg8::gemm_phase<EpiWrap<EOut>, true>(lds, g, S, E);
        skinny_gemm<EOut, 4>(lds, MG + (size_t)MP * DM, DM, (const bf16_t*)(ws + WS_WOUT), DM, DM, DM, E.e);
        if (BOTH(5)) GRID_BAR();
    }

    if (IN(6)) {
        pg8::Gemm g{AB, (const bf16_t*)(ws + WS_WUP), DM, DM, DM, 0}; pg8::StaticOrder S; S.init(MP / 256, DFF / 256, G, (int)blockIdx.x);
        EpiWrap<EUp> E{{nullptr, ssb + SS_1 * SS_STRIDE, HUP}};
        pg8::gemm_phase<EpiWrap<EUp>, true>(lds, g, S, E);
        skinny_gemm<EUp, 8, 2>(lds, AB + (size_t)MP * DM, DM, (const bf16_t*)(ws + WS_WUP), DM, DFF, DM, E.e);
        if (BOTH(6)) GRID_BAR();
    }

    if (IN(7)) {
        pg8::Gemm g{HUP, (const bf16_t*)(ws + WS_WDOWN), DFF, DFF, DFF, 0}; pg8::StaticOrder S; S.init(MP / 256, DM / 256, G, (int)blockIdx.x);
        EpiWrap<EDown> E{{ssb + SS_2 * SS_STRIDE, XO, AB}};
        pg8::gemm_phase<EpiWrap<EDown>, true>(lds, g, S, E);
        skinny_gemm<EDown, 4>(lds, HUP + (size_t)MP * DFF, DFF, (const bf16_t*)(ws + WS_WDOWN), DFF, DM, DFF, E.e);
        if (BOTH(7)) GRID_BAR();
    }

    if (IN(8)) {
        { pg8::Gemm g{PB, (const bf16_t*)(ws + WS_WPLE), DPLE, DPLE, DPLE, 0}; pg8::StaticOrder S; S.init(MP / 256, DM / 256, G, (int)blockIdx.x);
          EpiWrap<EPw> E{{nullptr, PW}};
          pg8::gemm_phase<EpiWrap<EPw>, true>(lds, g, S, E);
          skinny_gemm<EPw, 4>(lds, PB + (size_t)MP * DPLE, DPLE, (const bf16_t*)(ws + WS_WPLE), DPLE, DM, DPLE, E.e); }
        asm volatile("s_waitcnt vmcnt(0)" ::: "memory"); __syncthreads();
        { pg8::Gemm g{AB, (const bf16_t*)(ws + WS_WGATE), DM, DM, DM, 0}; pg8::StaticOrder S; S.init(MP / 256, DM / 256, G, (int)blockIdx.x);
          EpiWrap<EGate> E{{ssb + SS_3 * SS_STRIDE, ssb + SS_2 * SS_STRIDE, PW, XO}};
          pg8::gemm_phase<EpiWrap<EGate>, true>(lds, g, S, E);
          skinny_gemm<EGate, 4>(lds, AB + (size_t)MP * DM, DM, (const bf16_t*)(ws + WS_WGATE), DM, DM, DM, E.e); }
        if (BOTH(8)) GRID_BAR();
    }

    if (IN(9)) {
        const float* ss3 = ssb + SS_3 * SS_STRIDE; const float* gf = a.in[I_GFIN];
        f32x4 gv[8];
#pragma unroll
        for (int j = 0; j < 8; ++j) gv[j] = ((const f32x4*)gf)[lane + 64 * j];
        for (int row = blockIdx.x * 8 + wave; row < MT; row += 2 * G * 8) {
            const int row2 = row + G * 8; const bool has2 = row2 < MT; const int r2 = has2 ? row2 : row;
            f32x4* xa = (f32x4*)(XO + (size_t)row * DM); f32x4* xb2 = (f32x4*)(XO + (size_t)r2 * DM);
            f32x4 va[8], vb[8];
#pragma unroll
            for (int j = 0; j < 8; ++j) { va[j] = xa[lane + 64 * j]; vb[j] = xb2[lane + 64 * j]; }
            const float rsa = rsqrtf(ss3[row] * (1.f / DM) + EPS), rsb2 = rsqrtf(ss3[r2] * (1.f / DM) + EPS);
#pragma unroll
            for (int j = 0; j < 8; ++j) __builtin_nontemporal_store(va[j] * rsa * gv[j], &xa[lane + 64 * j]);
            if (has2) {
#pragma unroll
                for (int j = 0; j < 8; ++j) __builtin_nontemporal_store(vb[j] * rsb2 * gv[j], &xb2[lane + 64 * j]);
            }
        }
    }
#if MK_LAUNCHES == 1
    if (lo > hi) cg::this_grid().sync();
#endif
}

#undef ssb
#undef AB
#undef Z
#undef YG
#undef MG
#undef HUP
#undef PW
#undef PB
#undef XO
extern "C" void kernel_launch(void* const* d_in, const int* in_sizes, int n_in, void* d_out, int out_size, void* d_ws, size_t ws_size, hipStream_t stream) {
    static int grid = 0;
    if (grid == 0) {
        int dev = 0, cus = 0;
        if (n_in != 37 || ws_size < WS_END) { fprintf(stderr, "kernel_launch: unexpected inputs (n_in %d, ws %zu)\n", n_in, ws_size); grid = -1; return; }
        if (hipGetDevice(&dev) != hipSuccess || hipDeviceGetAttribute(&cus, hipDeviceAttributeMultiprocessorCount, dev) != hipSuccess) { grid = -1; return; }
        if (hipFuncSetAttribute((const void*)fwd_kernel, hipFuncAttributeMaxDynamicSharedMemorySize, LDS_BYTES) != hipSuccess) { fprintf(stderr, "kernel_launch: hipFuncSetAttribute failed\n"); grid = -1; return; }
        int per_cu = 0;
        if (hipOccupancyMaxActiveBlocksPerMultiprocessor(&per_cu, (const void*)fwd_kernel, 512, LDS_BYTES) != hipSuccess || per_cu < 1) { fprintf(stderr, "kernel_launch: occupancy query %d\n", per_cu); }
        (void)hipGetLastError();
        grid = cus;
    }
    if (grid < 0) return;
    (void)hipMemsetAsync((char*)d_ws + WS_CTL, 0, CTL_ZERO_BYTES, stream);
    Args a{};
    for (int i = 0; i < 37; ++i) a.in[i] = (const float*)d_in[i];
    a.out = (float*)d_out; a.ws = (unsigned char*)d_ws;
#if MK_LAUNCHES == 1
    a.ph_lo = 0; a.ph_hi = NPHASE;
    void* args[] = {&a};
    hipError_t e = hipLaunchCooperativeKernel((const void*)fwd_kernel, dim3(grid), dim3(512), args, LDS_BYTES, stream);
    if (e != hipSuccess) fprintf(stderr, "cooperative launch failed: %s (grid %d)\n", hipGetErrorString(e), grid);
#else
    for (int ph = 0; ph < NPHASE; ++ph) {
        a.ph_lo = ph; a.ph_hi = ph + 1;
        hipLaunchKernelGGL(fwd_kernel, dim3(grid), dim3(512), LDS_BYTES, stream, a);
    }
#endif
}
```

```cpp
#include <hip/hip_runtime.h>
#include <hip/hip_cooperative_groups.h>
#include <cstdio>
#include <cstdint>
namespace cg = cooperative_groups;

#ifndef MK_LAUNCHES
#define MK_LAUNCHES 1
#endif

#define LAS __attribute__((address_space(3)))
typedef unsigned short bf16_t;
typedef short bf16x8 __attribute__((ext_vector_type(8)));
typedef float f32x4 __attribute__((ext_vector_type(4)));
typedef unsigned u32x4 __attribute__((ext_vector_type(4)));
typedef unsigned u32x2 __attribute__((ext_vector_type(2)));

constexpr int DM = 2048, SEQ = 2048, NB = 4, MP = 8192, MS = 128, MT = 8320;
constexpr int NZ = 3072, DFF = 8192, DPLE = 256, DH = 1024;
constexpr float EPS = 1e-6f;
constexpr int NPHASE = 10;

constexpr size_t MiB = 1u << 20;
constexpr size_t WS_CTL = 0, CTL_ZERO_BYTES = 1 * MiB;
constexpr int SS_STRIDE = 8448;
constexpr int SS_A = 0, SS_B = 1, SS_1 = 2, SS_2 = 3, SS_3 = 4;
constexpr int CW_BAR = 65536;
constexpr size_t WS_SMALL = 1 * MiB;
constexpr size_t SM_RS0 = 0, SM_AR = 65536, SM_AI = SM_AR + 16384, SM_A64R = SM_AI + 16384, SM_A64I = SM_A64R + 16384,
                 SM_BBB = SM_A64I + 16384  , SM_CMB = SM_BBB + 262144  , SM_SPL = SM_CMB + 262144  , SM_RAT = 663552  , SM_RSB = SM_RAT + 34816  ;
constexpr size_t WS_WUP = 2 * MiB, WS_WDOWN = 34 * MiB, WS_WGATE = 66 * MiB, WS_WPLE = 74 * MiB, WS_PB = 75 * MiB, WS_AB = 80 * MiB;
constexpr size_t WS_E = 113 * MiB;
constexpr size_t WS_HUP = WS_E, WS_PW = WS_E;
constexpr size_t WS_WIN = 113 * MiB, WS_WGLU = 125 * MiB, WS_WOUT = 127 * MiB, WS_WLRU = 135 * MiB, WS_Z = 136 * MiB,
                 WS_YG = 185 * MiB, WS_MERGED = 202 * MiB, WS_XC = 235 * MiB, WS_S5SUM = 251 * MiB, WS_END = 255 * MiB;
static_assert(WS_HUP + (size_t)MT * DFF * 2 <= 256 * MiB, "hup fits");
static_assert(WS_Z + (size_t)MT * NZ * 2 <= WS_YG && WS_YG + (size_t)MT * DH * 2 <= WS_MERGED && WS_MERGED + (size_t)MT * DM * 2 <= WS_XC, "map");
static_assert(WS_AB + (size_t)MT * DM * 2 <= WS_E && WS_PB + (size_t)MT * DPLE * 2 <= WS_AB, "map2");

constexpr size_t O_Y = 0, O_S5RP = 17039360, O_S5IP = 17055744, O_LRUP = 17072128, O_CONVP = 17076224,
                 O_S5RS = 17088512, O_S5IS = 17612800, O_LRUS = 18137088, O_CONVS = 18268160;

constexpr int RING_BYTES = 131072, MISC_OFF = RING_BYTES + 320, LDS_BYTES = 147456;

__device__ __forceinline__ unsigned cvt_pk_bf16(float lo, float hi) { unsigned r; asm("v_cvt_pk_bf16_f32 %0, %1, %2" : "=v"(r) : "v"(lo), "v"(hi)); return r; }
__device__ __forceinline__ float bf_lo(unsigned u) { return __uint_as_float(u << 16); }
__device__ __forceinline__ float bf_hi(unsigned u) { return __uint_as_float(u & 0xffff0000u); }
__device__ __forceinline__ float bf1(bf16_t u) { return __uint_as_float(((unsigned)u) << 16); }
__device__ __forceinline__ float sigm(float x) { return __builtin_amdgcn_rcpf(1.f + __expf(-x)); }
__device__ __forceinline__ float gelu_t(float x) { const float u = 1.5957691216057308f * (x + 0.044715f * x * x * x); return x * __builtin_amdgcn_rcpf(1.f + __expf(-u)); }
__device__ __forceinline__ float wave_sum(float v) {
#pragma unroll
    for (int o = 1; o < 64; o <<= 1) v += __shfl_xor(v, o);
    return v;
}
#define LDS_WAIT() asm volatile("s_waitcnt lgkmcnt(0)" ::: "memory")

namespace pg8 {
constexpr int BM = 256, BK = 64, HALF = 128, HTB = HALF * BK * 2, STAGE_BYTES = 8 * HTB, NXCD = 8, WGM = 8;
__host__ __device__ __forceinline__ int lds_byte(int r, int c) { const int st = (r >> 4) * 2 + (c >> 5), rr = r & 15, cc = c & 31, ob = rr * 64 + cc * 2; return st * 1024 + (ob ^ (((ob >> 9) & 1) << 5)); }
__host__ __device__ __forceinline__ void stage_rc(int b, int& R, int& C) { const int st = b / 1024, sb = b % 1024, swz = sb ^ (((sb >> 9) & 1) << 5); R = (st >> 1) * 16 + swz / 64; C = (st & 1) * 32 + (swz % 64) / 2; }
__host__ __device__ __forceinline__ int perm32(int rho) { const int n = rho >> 4, i = rho & 15; return 8 * (i >> 2) + 4 * n + (i & 3); }
struct Unit { int pm, pn; };
struct Gemm { const bf16_t* A; const bf16_t* Bt; int lda, ldb, K, akmode; };
struct StaticOrder {
    int nM, nN, nwg, G, c;
    __device__ __forceinline__ void init(int nM_, int nN_, int G_, int c_) { nM = nM_; nN = nN_; nwg = nM * nN; G = G_; c = c_; }
    __device__ __forceinline__ bool next(int i, Unit& u) const {
        const long L = (long)i * G + c; if (L >= nwg) return false;
        int wgid = (int)L; { const int q = nwg / NXCD, r = nwg % NXCD, xcd = wgid % NXCD, off = wgid / NXCD; wgid = (xcd < r ? xcd * (q + 1) : r * (q + 1) + (xcd - r) * q) + off; }
        const int nig = WGM * nN, gid = wgid / nig, fm = gid * WGM, gsz = (nM - fm) < WGM ? (nM - fm) : WGM;
        u.pm = fm + ((wgid % nig) % gsz); u.pn = (wgid % nig) / gsz; return true;
    }
};

template <class Epi, bool ALIGN_EPI>
__device__ __forceinline__ void gemm_phase(LAS unsigned char* lds, const Gemm g, const StaticOrder& S, const Epi& E) {
    const int tid = threadIdx.x, wid = __builtin_amdgcn_readfirstlane(tid >> 6), lane = tid & 63, wr = wid >> 2, wc = wid & 3, fr = lane & 15, fq = lane >> 4;
    int K = g.K; asm volatile("" : "+s"(K));
    const int nt = K / BK;
    unsigned voffA[2], voffB[2];
#pragma unroll
    for (int i = 0; i < 2; ++i) { int R, C; stage_rc(tid * 16 + i * 8192, R, C);
        const int Rb = Epi::PERM ? ((R & ~31) + perm32(R & 31)) : R;
        voffA[i] = (unsigned)(R * g.lda + C) * 2u; voffB[i] = (unsigned)(Rb * g.ldb + C) * 2u; }
    const size_t kstep = (size_t)(BK * 2);
    const size_t hstepA = (size_t)HALF * g.lda * 2, hstepB = (size_t)HALF * g.ldb * 2;
    const size_t tstepA = 2 * hstepA, tstepB = 2 * hstepB;
    const unsigned ldsw = (unsigned)wid * 1024u;
    const int aoff = lds_byte(wr * 64 + fr, fq * 8), boff = lds_byte(wc * 32 + fr, fq * 8);
#define PG8_SA(b, h) (((b) * 2 + (h)) * HTB)
#define PG8_SB(b, h) ((4 + (b) * 2 + (h)) * HTB)
#define PG8_STAGE(bufoff, gbase, voff) do { _Pragma("unroll") for (int _i = 0; _i < 2; ++_i) \
        __builtin_amdgcn_global_load_lds((const unsigned*)((const char*)(gbase) + (voff)[_i]), (LAS unsigned*)(lds + (bufoff) + ldsw + _i * 8192), 16, 0, 0); } while (0)
#define PG8_LDA(dst, b, h) do { _Pragma("unroll") for (int m = 0; m < 4; ++m) _Pragma("unroll") for (int k = 0; k < 2; ++k) dst[m][k] = *(const LAS bf16x8*)(lds + PG8_SA(b, h) + aoff + m * 2048 + k * 1024); } while (0)
#define PG8_LDB(dst, b, h) do { _Pragma("unroll") for (int n = 0; n < 2; ++n) _Pragma("unroll") for (int k = 0; k < 2; ++k) dst[n][k] = *(const LAS bf16x8*)(lds + PG8_SB(b, h) + boff + n * 2048 + k * 1024); } while (0)
#define PG8_MMA(ai, bj, At, Bt) do { __builtin_amdgcn_s_setprio(1); _Pragma("unroll") for (int m = 0; m < 4; ++m) _Pragma("unroll") for (int n = 0; n < 2; ++n) _Pragma("unroll") for (int k = 0; k < 2; ++k) \
        acc[ai][bj][m][n] = __builtin_amdgcn_mfma_f32_16x16x32_bf16(Bt[n][k], At[m][k], acc[ai][bj][m][n], 0, 0, 0); __builtin_amdgcn_s_setprio(0); } while (0)
#define PG8_WAIT_V(n) asm volatile("s_waitcnt vmcnt(" #n ")" ::: "memory")
#define PG8_WAIT_L(n) asm volatile("s_waitcnt lgkmcnt(" #n ")" ::: "memory")
#define PG8_BAR __builtin_amdgcn_s_barrier()
#define PG8_SCHED __builtin_amdgcn_sched_barrier(0)
    Unit cur, nxt; int ui = 0;
    if (!S.next(0, cur)) return;
    f32x4 acc[2][2][4][2];
#pragma unroll
    for (int a = 0; a < 2; ++a)
#pragma unroll
        for (int b = 0; b < 2; ++b)
#pragma unroll
            for (int m = 0; m < 4; ++m)
#pragma unroll
                for (int n = 0; n < 2; ++n) acc[a][b][m][n] = (f32x4){0.f, 0.f, 0.f, 0.f};
    bf16x8 At[4][2], B0[2][2], B1[2][2];
    const char* cA = (const char*)g.A + (size_t)cur.pm * tstepA + (g.akmode ? (size_t)(cur.pn >> 1) * 512 : 0);
    const char* cB = (const char*)g.Bt + (size_t)cur.pn * tstepB;
    PG8_STAGE(PG8_SB(0, 0), cB, voffB); PG8_STAGE(PG8_SB(0, 1), cB + hstepB, voffB); PG8_STAGE(PG8_SA(0, 0), cA, voffA); PG8_STAGE(PG8_SA(0, 1), cA + hstepA, voffA);
    if (wr == 1) PG8_BAR;
    PG8_WAIT_V(2); PG8_BAR;
    PG8_STAGE(PG8_SB(1, 0), cB + kstep, voffB); PG8_STAGE(PG8_SA(1, 0), cA + kstep, voffA); PG8_STAGE(PG8_SB(1, 1), cB + hstepB + kstep, voffB);
    PG8_WAIT_V(6); PG8_BAR;
    for (;;) {
        const bool has_next = S.next(ui + 1, nxt);
        const char* nA = has_next ? (const char*)g.A + (size_t)nxt.pm * tstepA + (g.akmode ? (size_t)(nxt.pn >> 1) * 512 : 0) : cA;
        const char* nB = has_next ? (const char*)g.Bt + (size_t)nxt.pn * tstepB : cB;
        for (int t = 0; t < nt; t += 2) {
            const bool last = (t == nt - 2);
            const char* a1 = cA + (size_t)(t + 1) * kstep;
            const char* a2 = last ? nA : cA + (size_t)(t + 2) * kstep; const char* b2 = last ? nB : cB + (size_t)(t + 2) * kstep;
            const char* a3 = a2 + kstep; const char* b3 = b2 + kstep;
            if constexpr (Epi::MID) { if (t == (nt >> 1)) E.mid(acc, cur, wr, fr); }
            PG8_LDB(B0, 0, 0); PG8_LDB(B1, 0, 1); PG8_SCHED; PG8_LDA(At, 0, 0); PG8_STAGE(PG8_SA(1, 1), a1 + hstepA, voffA);
            PG8_WAIT_V(8); PG8_WAIT_L(0); PG8_BAR; PG8_MMA(0, 0, At, B0); PG8_MMA(0, 1, At, B1); PG8_BAR; PG8_SCHED;
            PG8_LDA(At, 0, 1); PG8_STAGE(PG8_SB(0, 0), b2, voffB); PG8_STAGE(PG8_SB(0, 1), b2 + hstepB, voffB); PG8_STAGE(PG8_SA(0, 0), a2, voffA);
            PG8_WAIT_V(8); PG8_WAIT_L(0); PG8_BAR; PG8_MMA(1, 0, At, B0); PG8_MMA(1, 1, At, B1); PG8_BAR; PG8_SCHED;
            PG8_LDB(B0, 1, 0); PG8_LDB(B1, 1, 1); PG8_SCHED; PG8_LDA(At, 1, 0); PG8_STAGE(PG8_SA(0, 1), a2 + hstepA, voffA);
            PG8_WAIT_V(8); PG8_WAIT_L(0); PG8_BAR; PG8_MMA(0, 0, At, B0); PG8_MMA(0, 1, At, B1); PG8_BAR; PG8_SCHED;
            PG8_LDA(At, 1, 1); PG8_STAGE(PG8_SB(1, 0), b3, voffB); PG8_STAGE(PG8_SB(1, 1), b3 + hstepB, voffB); PG8_STAGE(PG8_SA(1, 0), a3, voffA);
            PG8_WAIT_V(8); PG8_WAIT_L(0); PG8_BAR; PG8_MMA(1, 0, At, B0); PG8_MMA(1, 1, At, B1); PG8_BAR; PG8_SCHED;
        }
        if constexpr (ALIGN_EPI) { if (wr == 0) PG8_BAR; }
        E(acc, cur, wr, wc, fr, fq);
        if (!has_next) break;
#pragma unroll
        for (int a = 0; a < 2; ++a)
#pragma unroll
            for (int b = 0; b < 2; ++b)
#pragma unroll
                for (int m = 0; m < 4; ++m)
#pragma unroll
                    for (int n = 0; n < 2; ++n) acc[a][b][m][n] = (f32x4){0.f, 0.f, 0.f, 0.f};
        cur = nxt; cA = nA; cB = nB; ++ui;
        if constexpr (ALIGN_EPI) { if (wr == 1) PG8_BAR; }
    }
    PG8_WAIT_V(0);
    if constexpr (!ALIGN_EPI) { if (wr == 0) PG8_BAR; }
    PG8_BAR;
#undef PG8_SA
#undef PG8_SB
#undef PG8_STAGE
#undef PG8_LDA
#undef PG8_LDB
#undef PG8_MMA
#undef PG8_WAIT_V
#undef PG8_WAIT_L
#undef PG8_BAR
#undef PG8_SCHED
}
}

template <class E> struct EpiWrap {
    E e; static constexpr bool MID = E::MID, PERM = E::PERM;
    __device__ __forceinline__ void operator()(const f32x4 (&acc)[2][2][4][2], const pg8::Unit& u, int wr, int wc, int fr, int fq) const {
        if constexpr (E::HAS_RES) {
            f32x4 rc[2][2], rn[2][2];
            { const int row = u.pm * 256 + wr * 64 + fr;
#pragma unroll
              for (int bj = 0; bj < 2; ++bj)
#pragma unroll
                  for (int n = 0; n < 2; ++n) rc[bj][n] = e.res(row, u.pn * 256 + bj * 128 + wc * 32 + 8 * fq + 4 * n); }
#pragma unroll
            for (int idx = 0; idx < 8; ++idx) {
                const int ai = idx >> 2, m = idx & 3;
                const int row = u.pm * 256 + ai * 128 + wr * 64 + m * 16 + fr; const float rv = e.rowval(row); float s = 0.f;
                if (idx < 7) { const int rown = u.pm * 256 + ((idx + 1) >> 2) * 128 + wr * 64 + ((idx + 1) & 3) * 16 + fr;
#pragma unroll
                    for (int bj = 0; bj < 2; ++bj)
#pragma unroll
                        for (int n = 0; n < 2; ++n) rn[bj][n] = e.res(rown, u.pn * 256 + bj * 128 + wc * 32 + 8 * fq + 4 * n); }
#pragma unroll
                for (int bj = 0; bj < 2; ++bj) s += e.applyr8(row, u.pn * 256 + bj * 128 + wc * 32 + 8 * fq, acc[ai][bj][m][0], acc[ai][bj][m][1], rv, rc[bj][0], rc[bj][1]);
                if constexpr (E::HAS_SS) { s += __shfl_xor(s, 16); s += __shfl_xor(s, 32); if (fq == 0) atomicAdd(e.ss + row, s); }
                asm volatile("" ::: "memory");
#pragma unroll
                for (int bj = 0; bj < 2; ++bj)
#pragma unroll
                    for (int n = 0; n < 2; ++n) rc[bj][n] = rn[bj][n];
            }
            return;
        }
        if constexpr (E::PERM && !E::HAS_RES) {
#pragma unroll
            for (int ai = 0; ai < 2; ++ai)
#pragma unroll
                for (int m = 0; m < 4; ++m) {
                    const int row = u.pm * 256 + ai * 128 + wr * 64 + m * 16 + fr; const float rv = e.rowval(row); float s = 0.f;
#pragma unroll
                    for (int bj = 0; bj < 2; ++bj) s += e.apply8(row, u.pn * 256 + bj * 128 + wc * 32 + 8 * fq, acc[ai][bj][m][0], acc[ai][bj][m][1], rv);
                    if constexpr (E::HAS_SS) { s += __shfl_xor(s, 16); s += __shfl_xor(s, 32); if (fq == 0) atomicAdd(e.ss + row, s); }
                    asm volatile("" ::: "memory");
                }
            return;
        }
#pragma unroll
        for (int ai = 0; ai < 2; ++ai)
#pragma unroll
            for (int m = 0; m < 4; ++m) {
                const int row = u.pm * 256 + ai * 128 + wr * 64 + m * 16 + fr; const float rv = e.rowval(row); float s = 0.f;
#pragma unroll
                for (int bj = 0; bj < 2; ++bj)
#pragma unroll
                    for (int n = 0; n < 2; ++n) s += e.apply(row, u.pn * 256 + bj * 128 + wc * 32 + n * 16 + 4 * fq, acc[ai][bj][m][n], rv);
                if constexpr (E::HAS_SS) { s += __shfl_xor(s, 16); s += __shfl_xor(s, 32); if (fq == 0) atomicAdd(e.ss + row, s); }
                asm volatile("" ::: "memory");
            }
    }
    __device__ __forceinline__ void mid(f32x4 (&acc)[2][2][4][2], const pg8::Unit& u, int wr, int fr) const {
#pragma unroll
        for (int ai = 0; ai < 2; ++ai)
#pragma unroll
            for (int m = 0; m < 4; ++m) { const float r = e.kscale(u.pm * 256 + ai * 128 + wr * 64 + m * 16 + fr, 0);
#pragma unroll
                for (int bj = 0; bj < 2; ++bj)
#pragma unroll
                    for (int n = 0; n < 2; ++n) acc[ai][bj][m][n] = acc[ai][bj][m][n] * r; }
    }
};
__device__ __forceinline__ u32x2 pk4(f32x4 v) { u32x2 w; w.x = cvt_pk_bf16(v[0], v[1]); w.y = cvt_pk_bf16(v[2], v[3]); return w; }
__device__ __forceinline__ f32x4 up4(u32x2 w) { return (f32x4){bf_lo(w.x), bf_hi(w.x), bf_lo(w.y), bf_hi(w.y)}; }
__device__ __forceinline__ float ssq4(f32x4 v) { return (v[0] * v[0] + v[1] * v[1]) + (v[2] * v[2] + v[3] * v[3]); }

struct EIn {
    static constexpr bool HAS_RES = false, PERM = true; static constexpr bool MID = false, HAS_SS = false; float* ss; const float* rs0; bf16_t* Z;
    __device__ __forceinline__ float rowval(int row) const { return rs0[row]; }
    __device__ __forceinline__ float kscale(int, int) const { return 1.f; }
    __device__ __forceinline__ float apply(int row, int col, f32x4 v, float rv) const { *(u32x2*)(Z + (size_t)row * NZ + col) = pk4(v * rv); return 0.f; }
    __device__ __forceinline__ float apply8(int row, int col, f32x4 v0, f32x4 v1, float rv) const { u32x4 w; { const u32x2 a0 = pk4(v0 * rv), a1 = pk4(v1 * rv); w.x = a0.x; w.y = a0.y; w.z = a1.x; w.w = a1.y; } *(u32x4*)(Z + (size_t)row * NZ + col) = w; return 0.f; }
};
struct EGlu {
    static constexpr bool HAS_RES = false, PERM = true; static constexpr bool MID = false, HAS_SS = true; float* ss; const float* bglu; const bf16_t* YG; bf16_t* MG;
    __device__ __forceinline__ float rowval(int) const { return 0.f; }
    __device__ __forceinline__ float kscale(int, int) const { return 1.f; }
    __device__ __forceinline__ float apply(int row, int col, f32x4 v, float) const {
        const f32x4 b = *(const f32x4*)(bglu + col); const f32x4 yg = up4(*(const u32x2*)(YG + (size_t)row * DH + col)); f32x4 o;
#pragma unroll
        for (int j = 0; j < 4; ++j) o[j] = yg[j] * sigm(v[j] + b[j]);
        *(u32x2*)(MG + (size_t)row * DM + col) = pk4(o); return ssq4(o);
    }
    __device__ __forceinline__ float apply8(int row, int col, f32x4 v0, f32x4 v1, float) const {
        const f32x4 b0 = *(const f32x4*)(bglu + col), b1 = *(const f32x4*)(bglu + col + 4); const u32x4 yr = *(const u32x4*)(YG + (size_t)row * DH + col);
        const f32x4 y0 = up4((u32x2){yr.x, yr.y}), y1 = up4((u32x2){yr.z, yr.w}); f32x4 o0, o1;
#pragma unroll
        for (int j = 0; j < 4; ++j) { o0[j] = y0[j] * sigm(v0[j] + b0[j]); o1[j] = y1[j] * sigm(v1[j] + b1[j]); }
        u32x4 w; { const u32x2 a0 = pk4(o0), a1 = pk4(o1); w.x = a0.x; w.y = a0.y; w.z = a1.x; w.w = a1.y; } *(u32x4*)(MG + (size_t)row * DM + col) = w; return ssq4(o0) + ssq4(o1);
    }
};
struct EOut {
    static constexpr bool MID = true, HAS_SS = true; float* ss; const float* rat; const float* rsb; const float* xp; const float* xs; float* XO; bf16_t* AB;
    __device__ __forceinline__ float rowval(int row) const { return rsb[row]; }
    __device__ __forceinline__ float kscale(int row, int w) const { return w < 4 ? rat[row] : 1.f; }
    static constexpr bool HAS_RES = true, PERM = true;
    __device__ __forceinline__ f32x4 res(int row, int col) const { return __builtin_nontemporal_load((const f32x4*)(xp + (size_t)row * DM + col)); }
    __device__ __forceinline__ float applyr8(int row, int col, f32x4 v0, f32x4 v1, float rv, f32x4 r0, f32x4 r1) const {
        const f32x4 o0 = r0 + v0 * rv, o1 = r1 + v1 * rv; float* p = XO + (size_t)row * DM + col; *(f32x4*)p = o0; *(f32x4*)(p + 4) = o1;
        u32x4 w; { const u32x2 a0 = pk4(o0), a1 = pk4(o1); w.x = a0.x; w.y = a0.y; w.z = a1.x; w.w = a1.y; } *(u32x4*)(AB + (size_t)row * DM + col) = w; return ssq4(o0) + ssq4(o1); }
    __device__ __forceinline__ float applyr(int row, int col, f32x4 v, float rv, f32x4 r) const {
        const f32x4 o = r + v * rv;
        *(f32x4*)(XO + (size_t)row * DM + col) = o; *(u32x2*)(AB + (size_t)row * DM + col) = pk4(o); return ssq4(o); }
    __device__ __forceinline__ float apply(int row, int col, f32x4 v, float rv) const {
        const float* xr = row < MP ? xp + (size_t)row * DM : xs + (size_t)(row - MP) * DM;
        const f32x4 o = *(const f32x4*)(xr + col) + v * rv;
        *(f32x4*)(XO + (size_t)row * DM + col) = o; *(u32x2*)(AB + (size_t)row * DM + col) = pk4(o); return ssq4(o);
    }
};
struct EUp {
    static constexpr bool HAS_RES = false, PERM = true; static constexpr bool MID = false, HAS_SS = false; float* ss; const float* ss1; bf16_t* HUP;
    __device__ __forceinline__ float rowval(int row) const { return rsqrtf(ss1[row] * (1.f / DM) + EPS); }
    __device__ __forceinline__ float kscale(int, int) const { return 1.f; }
    __device__ __forceinline__ float apply(int row, int col, f32x4 v, float rv) const { f32x4 o;
#pragma unroll
        for (int j = 0; j < 4; ++j) { const float r = fmaxf(v[j] * rv, 0.f); o[j] = r * r; }
        *(u32x2*)(HUP + (size_t)row * DFF + col) = pk4(o); return 0.f; }
    __device__ __forceinline__ float apply8(int row, int col, f32x4 v0, f32x4 v1, float rv) const { f32x4 o0, o1;
#pragma unroll
        for (int j = 0; j < 4; ++j) { const float r0 = fmaxf(v0[j] * rv, 0.f), r1 = fmaxf(v1[j] * rv, 0.f); o0[j] = r0 * r0; o1[j] = r1 * r1; }
        u32x4 w; { const u32x2 a0 = pk4(o0), a1 = pk4(o1); w.x = a0.x; w.y = a0.y; w.z = a1.x; w.w = a1.y; } *(u32x4*)(HUP + (size_t)row * DFF + col) = w; return 0.f; }
};
struct EDown {
    static constexpr bool MID = false, HAS_SS = true; float* ss; float* XO; bf16_t* AB;
    __device__ __forceinline__ float rowval(int) const { return 0.f; }
    __device__ __forceinline__ float kscale(int, int) const { return 1.f; }
    static constexpr bool HAS_RES = true, PERM = true;
    __device__ __forceinline__ f32x4 res(int row, int col) const { return *(const f32x4*)(XO + (size_t)row * DM + col); }
    __device__ __forceinline__ float applyr8(int row, int col, f32x4 v0, f32x4 v1, float, f32x4 r0, f32x4 r1) const {
        const f32x4 o0 = r0 + v0, o1 = r1 + v1; float* p = XO + (size_t)row * DM + col; *(f32x4*)p = o0; *(f32x4*)(p + 4) = o1;
        u32x4 w; { const u32x2 a0 = pk4(o0), a1 = pk4(o1); w.x = a0.x; w.y = a0.y; w.z = a1.x; w.w = a1.y; } *(u32x4*)(AB + (size_t)row * DM + col) = w; return ssq4(o0) + ssq4(o1); }
    __device__ __forceinline__ float applyr(int row, int col, f32x4 v, float, f32x4 r) const {
        const f32x4 o = r + v; *(f32x4*)(XO + (size_t)row * DM + col) = o; *(u32x2*)(AB + (size_t)row * DM + col) = pk4(o); return ssq4(o); }
    __device__ __forceinline__ float apply(int row, int col, f32x4 v, float) const {
        float* p = XO + (size_t)row * DM + col; const f32x4 o = *(const f32x4*)p + v; *(f32x4*)p = o; *(u32x2*)(AB + (size_t)row * DM + col) = pk4(o); return ssq4(o); }
};
struct EPw {
    static constexpr bool HAS_RES = false, PERM = true; static constexpr bool MID = false, HAS_SS = false; float* ss; bf16_t* PW;
    __device__ __forceinline__ float rowval(int) const { return 0.f; }
    __device__ __forceinline__ float kscale(int, int) const { return 1.f; }
    __device__ __forceinline__ float apply(int row, int col, f32x4 v, float) const { *(u32x2*)(PW + (size_t)row * DM + col) = pk4(v); return 0.f; }
    __device__ __forceinline__ float apply8(int row, int col, f32x4 v0, f32x4 v1, float) const { u32x4 w; { const u32x2 a0 = pk4(v0), a1 = pk4(v1); w.x = a0.x; w.y = a0.y; w.z = a1.x; w.w = a1.y; } *(u32x4*)(PW + (size_t)row * DM + col) = w; return 0.f; }
};
struct EGate {
    static constexpr bool MID = false, HAS_SS = true; float* ss; const float* ss2; const bf16_t* PW; float* XO;
    __device__ __forceinline__ float rowval(int row) const { return rsqrtf(ss2[row] * (1.f / DM) + EPS); }
    __device__ __forceinline__ float kscale(int, int) const { return 1.f; }
    static constexpr bool HAS_RES = true, PERM = true;
    __device__ __forceinline__ f32x4 res(int row, int col) const { return *(const f32x4*)(XO + (size_t)row * DM + col); }
    __device__ __forceinline__ float applyr8(int row, int col, f32x4 v0, f32x4 v1, float rv, f32x4 r0, f32x4 r1) const {
        const u32x4 pr = *(const u32x4*)(PW + (size_t)row * DM + col); const f32x4 p0 = up4((u32x2){pr.x, pr.y}), p1 = up4((u32x2){pr.z, pr.w}); f32x4 o0 = r0, o1 = r1;
#pragma unroll
        for (int j = 0; j < 4; ++j) { o0[j] += p0[j] * sigm(v0[j] * rv); o1[j] += p1[j] * sigm(v1[j] * rv); }
        float* p = XO + (size_t)row * DM + col; *(f32x4*)p = o0; *(f32x4*)(p + 4) = o1; return ssq4(o0) + ssq4(o1); }
    __device__ __forceinline__ float applyr(int row, int col, f32x4 v, float rv, f32x4 r) const {
        f32x4 o = r; const f32x4 pw = up4(*(const u32x2*)(PW + (size_t)row * DM + col));
#pragma unroll
        for (int j = 0; j < 4; ++j) o[j] += pw[j] * sigm(v[j] * rv);
        *(f32x4*)(XO + (size_t)row * DM + col) = o; return ssq4(o); }
    __device__ __forceinline__ float apply(int row, int col, f32x4 v, float rv) const {
        float* p = XO + (size_t)row * DM + col; f32x4 o = *(const f32x4*)p; const f32x4 pw = up4(*(const u32x2*)(PW + (size_t)row * DM + col));
#pragma unroll
        for (int j = 0; j < 4; ++j) o[j] += pw[j] * sigm(v[j] * rv);
        *(f32x4*)p = o; return ssq4(o); }
};
__device__ __forceinline__ float em1(float x) {
    float p = x * (1.f + x * (0.5f + x * (0.16666667f + x * (0.041666668f + x * (0.0083333338f + x * (0.0013888889f + x * 0.0001984127f))))));
    if (__builtin_expect(__any(fabsf(x) >= 0.5f), 0)) p = fabsf(x) < 0.5f ? p : __expf(x) - 1.f;
    return p;
}
struct ELru {
    static constexpr bool MID = false, PERM = false; const bf16_t* XC; const float* ba; const float* bi; const float* spl; float* Ao; float* Bo;
    __device__ __forceinline__ void mid(f32x4 (&)[2][2][4][2], const pg8::Unit&, int, int) const {}
    __device__ __forceinline__ void operator()(const f32x4 (&acc)[2][2][4][2], const pg8::Unit& u, int wr, int wc, int fr, int fq) const {
#pragma unroll
        for (int n = 0; n < 2; ++n) {
            const int ch = (u.pn >> 1) * 256 + (u.pn & 1) * 128 + wc * 32 + n * 16 + 4 * fq;
            const f32x4 bav = *(const f32x4*)(ba + ch), biv = *(const f32x4*)(bi + ch), sp = *(const f32x4*)(spl + ch);
#pragma unroll
            for (int ai = 0; ai < 2; ++ai)
#pragma unroll
                for (int m = 0; m < 4; ++m) {
                    const int row = u.pm * 256 + ai * 128 + wr * 64 + m * 16 + fr;
                    const f32x4 xc = up4(*(const u32x2*)(XC + (size_t)row * DH + ch)); f32x4 av, bv;
#pragma unroll
                    for (int j = 0; j < 4; ++j) { const float r = sigm(acc[ai][0][m][n][j] + bav[j]), ig = sigm(acc[ai][1][m][n][j] + biv[j]);
                        const float la = r * sp[j]; av[j] = 1.f + em1(la); bv[j] = __builtin_amdgcn_sqrtf(fmaxf(-em1(2.f * la), 0.f)) * ig * xc[j]; }
                    *(f32x4*)(Ao + (size_t)row * DH + ch) = av; *(f32x4*)(Bo + (size_t)row * DH + ch) = bv;
                    asm volatile("" ::: "memory");
                }
        }
    }
};

template <class E, int MT = 8, int NG = 1>
__device__ __forceinline__ void skinny_gemm(LAS unsigned char* lds, const bf16_t* A, int lda, const bf16_t* Bt, int ldb, int N, int K, const E& e, int nb = 0) {
    const int tid = threadIdx.x, wid = __builtin_amdgcn_readfirstlane(tid >> 6), lane = tid & 63, fr = lane & 15, fq = lane >> 4;
    LAS f32x4* red = (LAS f32x4*)lds;
    constexpr int NH = 8 / MT;
    const int kw = K >> 3, k0w = wid * kw, nks = kw >> 5, nit = ((N >> 4) / NG) * NH, G = gridDim.x, NBk = nb ? nb : G;
    for (int iti = G - 1 - (int)blockIdx.x; iti < nit && (G - 1 - (int)blockIdx.x) < NBk; iti += NBk) {
        const int n0 = (iti / NH) * (16 * NG), r0 = (iti % NH) * (MT * 16);
        f32x4 acc[NG][MT];
#pragma unroll
        for (int q = 0; q < NG; ++q)
#pragma unroll
            for (int m = 0; m < MT; ++m) acc[q][m] = (f32x4){0.f, 0.f, 0.f, 0.f};
        const bf16_t* bp = Bt + (size_t)(n0 + fr) * ldb + k0w + 8 * fq;
        const bf16_t* ap = A + (size_t)(r0 + fr) * lda + k0w + 8 * fq;
        {
            bf16x8 bc[NG], ac[MT];
#pragma unroll
            for (int q = 0; q < NG; ++q) bc[q] = *(const bf16x8*)(bp + (size_t)(16 * q) * ldb);
#pragma unroll
            for (int m = 0; m < MT; ++m) ac[m] = *(const bf16x8*)(ap + (size_t)(16 * m) * lda);
            for (int ks = 0; ks < nks; ++ks) {
                const int kn = ks + 1 < nks ? ks + 1 : ks;
                bf16x8 bn[NG], an[MT];
#pragma unroll
                for (int q = 0; q < NG; ++q) bn[q] = *(const bf16x8*)(bp + (size_t)(16 * q) * ldb + 32 * kn);
#pragma unroll
                for (int m = 0; m < MT; ++m) an[m] = *(const bf16x8*)(ap + (size_t)(16 * m) * lda + 32 * kn);
#pragma unroll
                for (int q = 0; q < NG; ++q)
#pragma unroll
                    for (int m = 0; m < MT; ++m) acc[q][m] = __builtin_amdgcn_mfma_f32_16x16x32_bf16(bc[q], ac[m], acc[q][m], 0, 0, 0);
#pragma unroll
                for (int q = 0; q < NG; ++q) bc[q] = bn[q];
#pragma unroll
                for (int m = 0; m < MT; ++m) ac[m] = an[m];
            }
        }
#pragma unroll
        for (int q = 0; q < NG; ++q)
#pragma unroll
            for (int m = 0; m < MT; ++m) red[((wid * NG + q) * MT + m) * 64 + lane] = acc[q][m];
        __syncthreads();
        if (wid < MT) {
            const int row = MP + r0 + 16 * wid + fr; const float rv = e.rowval(row);
#pragma unroll
            for (int q = 0; q < NG; ++q) {
                f32x4 v = (f32x4){0.f, 0.f, 0.f, 0.f};
#pragma unroll
                for (int w = 0; w < 8; ++w) { f32x4 p = red[((w * NG + q) * MT + wid) * 64 + lane]; if constexpr (E::MID) p = p * e.kscale(row, w); v += p; }
                float s = e.apply(row, n0 + 16 * q + 4 * fq, v, rv);
                if constexpr (E::HAS_SS) { s += __shfl_xor(s, 16); s += __shfl_xor(s, 32); if (fq == 0) atomicAdd(e.ss + row, s); }
            }
        }
        __syncthreads();
    }
}

struct Args { const float* in[37]; float* out; unsigned char* ws; int ph_lo, ph_hi; };
enum { I_XP = 0, I_XS, I_S5RE, I_S5IM, I_LRUH, I_CONV, I_PP, I_PS, I_GMIX, I_WIN, I_LAMRE, I_LAMIM, I_LOGSTEP, I_BRE, I_BIM, I_CRE, I_CIM, I_S5D,
       I_WGLU, I_BGLU, I_CONVW, I_CONVB, I_WA, I_BA, I_WI, I_BI, I_LAM, I_GMA, I_GMB, I_WOUT, I_GMLP, I_WUP, I_WDOWN, I_GPLE, I_WGATE, I_WPLE, I_GFIN };

__device__ __forceinline__ void tr_item(const float* W, int K, int N, bf16_t* WT, int rbase, int lru, const float* g1, const float* g2, int gsplit,
                                        LAS float* scr, int item, int lane) {
    const int nblk = N / 32, kb = item / nblk, nb = item % nblk, k0 = 64 * kb, n0 = 32 * nb;
    f32x4 wv[8];
#pragma unroll
    for (int i = 0; i < 8; ++i) wv[i] = __builtin_nontemporal_load((const f32x4*)(W + (size_t)(k0 + 8 * i + (lane >> 3)) * N + n0 + 4 * (lane & 7)));
#pragma unroll
    for (int i = 0; i < 8; ++i) { const int kk = 8 * i + (lane >> 3), k = k0 + kk; const float gv = g1 ? (k < gsplit ? g1[k] : g2[k - gsplit]) : 1.f;
        LAS float* d = scr + kk * 33 + 4 * (lane & 7); d[0] = wv[i][0] * gv; d[1] = wv[i][1] * gv; d[2] = wv[i][2] * gv; d[3] = wv[i][3] * gv; }
    LDS_WAIT();
    const int c = lane & 7;
#pragma unroll
    for (int j = 0; j < 4; ++j) { const int n = (lane >> 3) + 8 * j, nn = n0 + n; const int drow = lru ? rbase + (nn >> 7) * 256 + (nn & 127) : rbase + nn;
        const LAS float* s = scr + (8 * c) * 33 + n;
        u32x4 o; o.x = cvt_pk_bf16(s[0 * 33], s[1 * 33]); o.y = cvt_pk_bf16(s[2 * 33], s[3 * 33]); o.z = cvt_pk_bf16(s[4 * 33], s[5 * 33]); o.w = cvt_pk_bf16(s[6 * 33], s[7 * 33]);
        *(u32x4*)(WT + (size_t)drow * K + k0 + 8 * c) = o; }
    LDS_WAIT();
}

__device__ __forceinline__ void phase0(const Args& a, LAS unsigned char* lds) {
    const int tid = threadIdx.x, wave = __builtin_amdgcn_readfirstlane(tid >> 6), lane = tid & 63, G = gridDim.x;
    unsigned char* ws = a.ws;
    LAS float* scr = (LAS float*)(lds + wave * 16384);
    const int gw = blockIdx.x * 8 + wave, NGW = G * 8;
    constexpr int I_IN = 32 * 96, I_UP = 32 * 256, I_DOWN = 5120  , I_LRU = 8 * 32;
    constexpr int NITEMS = I_IN + I_UP + I_DOWN + I_LRU;
    for (int it = gw; it < NITEMS; it += NGW) {
        int r = it;
        if (r < I_UP) { tr_item(a.in[I_WUP], DM, DFF, (bf16_t*)(ws + WS_WUP), 0, 0, a.in[I_GMLP], a.in[I_GMLP], 1 << 30, scr, r, lane); continue; } r -= I_UP;
        if (r < I_DOWN) { tr_item(a.in[I_WDOWN], DFF, DM, (bf16_t*)(ws + WS_WDOWN), 0, 0, nullptr, nullptr, 0, scr, r, lane); continue; } r -= I_DOWN;
        if (r < I_IN) { tr_item(a.in[I_WIN], DM, NZ, (bf16_t*)(ws + WS_WIN), 0, 0, a.in[I_GMIX], a.in[I_GMIX], 1 << 30, scr, r, lane); continue; } r -= I_IN;
        { const int mat = r >> 5, h = mat >> 1, bj = mat & 1;
          tr_item((bj ? a.in[I_WI] : a.in[I_WA]) + (size_t)h * 65536, 256, 256, (bf16_t*)(ws + WS_WLRU), h * 512 + bj * 128, 1, nullptr, nullptr, 0, scr, r & 31, lane); }
    }
    float* rs0 = (float*)(ws + WS_SMALL + SM_RS0); bf16_t* XB = (bf16_t*)(ws + WS_AB); bf16_t* PB = (bf16_t*)(ws + WS_PB);
    for (int row = gw; row < MT; row += NGW) {
        const float* xr = row < MP ? a.in[I_XP] + (size_t)row * DM : a.in[I_XS] + (size_t)(row - MP) * DM;
        f32x4 v[8]; float s = 0.f;
#pragma unroll
        for (int j = 0; j < 8; ++j) { v[j] = __builtin_nontemporal_load((const f32x4*)xr + lane + 64 * j); s += ssq4(v[j]); }
        s = wave_sum(s); if (lane == 0) rs0[row] = rsqrtf(s * (1.f / DM) + EPS);
#pragma unroll
        for (int j = 0; j < 8; ++j) ((u32x2*)(XB + (size_t)row * DM))[lane + 64 * j] = pk4(v[j]);
        const float* pr = row < MP ? a.in[I_PP] + (size_t)row * DPLE : a.in[I_PS] + (size_t)(row - MP) * DPLE;
        ((u32x2*)(PB + (size_t)row * DPLE))[lane] = pk4(__builtin_nontemporal_load((const f32x4*)pr + lane));
    }
    { float* SPL = (float*)(ws + WS_SMALL + SM_SPL);
      for (int i = blockIdx.x * 512 + tid; i < DH; i += G * 512) { const float xl = -a.in[I_LAM][i]; SPL[i] = -8.f * (fmaxf(xl, 0.f) + log1pf(expf(-fabsf(xl)))); } }
    float* AR = (float*)(ws + WS_SMALL + SM_AR); float* AI = (float*)(ws + WS_SMALL + SM_AI); float* A64R = (float*)(ws + WS_SMALL + SM_A64R); float* A64I = (float*)(ws + WS_SMALL + SM_A64I);
    bf16_t* BBB = (bf16_t*)(ws + WS_SMALL + SM_BBB); bf16_t* CMB = (bf16_t*)(ws + WS_SMALL + SM_CMB);
    for (int i = blockIdx.x * 512 + tid; i < 4096; i += G * 512) {
        const int g = i >> 6, p = i & 63;
        const float step = expf(a.in[I_LOGSTEP][g]), lr = a.in[I_LAMRE][i], li = a.in[I_LAMIM][i];
        const float mag = expf(lr * step); float sn, cs; sincosf(li * step, &sn, &cs);
        const float ar = mag * cs, ai = mag * sn, nr = ar - 1.f, ni = ai, den = lr * lr + li * li;
        const float cr = (nr * lr + ni * li) / den, ci = (ni * lr - nr * li) / den;
        AR[i] = ar; AI[i] = ai;
        float pr_ = ar, pi_ = ai;
#pragma unroll
        for (int q = 0; q < 6; ++q) { const float t0 = pr_ * pr_ - pi_ * pi_, t1 = 2.f * pr_ * pi_; pr_ = t0; pi_ = t1; }
        A64R[i] = pr_; A64I[i] = pi_;
        for (int c = 0; c < 16; ++c) {
            const float br = a.in[I_BRE][(size_t)i * 16 + c], bi = a.in[I_BIM][(size_t)i * 16 + c];
            BBB[((size_t)g * 128 + p) * 16 + c] = (bf16_t)(cvt_pk_bf16(cr * br - ci * bi, 0.f) & 0xffffu);
            BBB[((size_t)g * 128 + 64 + p) * 16 + c] = (bf16_t)(cvt_pk_bf16(cr * bi + ci * br, 0.f) & 0xffffu);
            CMB[((size_t)g * 16 + c) * 128 + p] = (bf16_t)(cvt_pk_bf16(a.in[I_CRE][((size_t)g * 16 + c) * 64 + p], 0.f) & 0xffffu);
            CMB[((size_t)g * 16 + c) * 128 + 64 + p] = (bf16_t)(cvt_pk_bf16(-a.in[I_CIM][((size_t)g * 16 + c) * 64 + p], 0.f) & 0xffffu);
        }
    }
}

__device__ __forceinline__ void s5_unit(const Args& a, LAS unsigned char* wl, int lane, int mode, int n, int g, int j) {
    unsigned char* ws = a.ws;
    const int fr = lane & 15, fq = lane >> 4;
    const float* AR = (const float*)(ws + WS_SMALL + SM_AR); const float* AI = (const float*)(ws + WS_SMALL + SM_AI);
    const bf16_t* BBB = (const bf16_t*)(ws + WS_SMALL + SM_BBB); const bf16_t* CMB = (const bf16_t*)(ws + WS_SMALL + SM_CMB);
    const bf16_t* Z = (const bf16_t*)(ws + WS_Z); bf16_t* YG = (bf16_t*)(ws + WS_YG); float* SUM = (float*)(ws + WS_S5SUM);
    LAS float* BuS = (LAS float*)wl; LAS bf16_t* Hs = (LAS bf16_t*)(wl + 8448);
    const float ar = AR[g * 64 + lane], ai = AI[g * 64 + lane];
    const bf16x8 zero8 = (bf16x8){0, 0, 0, 0, 0, 0, 0, 0};
    bf16x8 bb[8];
#pragma unroll
    for (int t = 0; t < 8; ++t) bb[t] = fq < 2 ? *(const bf16x8*)(BBB + ((size_t)g * 128 + 16 * t + fr) * 16 + 8 * fq) : zero8;
    bf16x8 cm[4];
#pragma unroll
    for (int kk = 0; kk < 4; ++kk) cm[kk] = *(const bf16x8*)(CMB + ((size_t)g * 16 + fr) * 128 + 32 * kk + 8 * fq);
    const f32x4 dsk = *(const f32x4*)(a.in[I_S5D] + 16 * g + 4 * fq);
    float hr = 0.f, hi = 0.f;
    if (mode == 1 && j > 0) {
        const float pr = ((const float*)(ws + WS_SMALL + SM_A64R))[g * 64 + lane], pi = ((const float*)(ws + WS_SMALL + SM_A64I))[g * 64 + lane];
        const float* sp = SUM + ((size_t)(n * 64 + g) * 32) * 128;
        for (int i = 0; i < j; ++i) { const float sr = sp[i * 128 + lane], si = sp[i * 128 + 64 + lane];
            const float t0 = pr * hr - pi * hi + sr, t1 = pr * hi + pi * hr + si; hr = t0; hi = t1; }
    }
    if (mode == 4 && j > 0) {
        float pr = ((const float*)(ws + WS_SMALL + SM_A64R))[g * 64 + lane], pi = ((const float*)(ws + WS_SMALL + SM_A64I))[g * 64 + lane];
#pragma unroll
        for (int q = 0; q < 2; ++q) { const float t0 = pr * pr - pi * pi, t1 = 2.f * pr * pi; pr = t0; pi = t1; }
        for (int v = 0; v < j; ++v) { const LAS float* ps = (const LAS float*)(wl + (v - j) * 16384 + 12800); const float sr = ps[lane], si = ps[64 + lane];
            const float t0 = pr * hr - pi * hi + sr, t1 = pr * hi + pi * hr + si; hr = t0; hi = t1; }
    }
    const int row0 = mode == 2 ? MP + 16 * j : ((mode == 3 || mode == 4) ? n * SEQ + 256 * j : n * SEQ + 64 * j);
    const int nblk = mode == 2 ? 1 : ((mode == 3 || mode == 1 || mode == 4) ? 16 : 4);
    for (int blk = 0; blk < nblk; ++blk) {
        const int r0 = row0 + 16 * blk;
        const bf16x8 ua = fq < 2 ? *(const bf16x8*)(Z + (size_t)(r0 + fr) * NZ + 16 * g + 8 * fq) : zero8;
        u32x2 u4raw = (u32x2){0u, 0u}; if (mode == 1 || mode == 2 || mode == 4) u4raw = *(const u32x2*)(Z + (size_t)(r0 + fr) * NZ + 16 * g + 4 * fq);
#pragma unroll
        for (int t = 0; t < 8; ++t) {
            const f32x4 c = __builtin_amdgcn_mfma_f32_16x16x32_bf16(ua, bb[t], (f32x4){0.f, 0.f, 0.f, 0.f}, 0, 0, 0);
#pragma unroll
            for (int jj = 0; jj < 4; ++jj) BuS[(4 * fq + jj) * 132 + 16 * t + fr] = c[jj];
        }
        LDS_WAIT();
        float burv[16], buiv[16];
#pragma unroll
        for (int t = 0; t < 16; ++t) { burv[t] = BuS[t * 132 + lane]; buiv[t] = BuS[t * 132 + 64 + lane]; }
#pragma unroll
        for (int t = 0; t < 16; ++t) {
            const float bur = burv[t], bui = buiv[t];
            if (mode == 2) { const size_t si = ((size_t)(r0 - MP + t) * 64 + g) * 64 + lane; hr = a.in[I_S5RE][si]; hi = a.in[I_S5IM][si]; }
            const float t0 = ar * hr - ai * hi + bur, t1 = ar * hi + ai * hr + bui; hr = t0; hi = t1;
            if (mode == 2) { const size_t si = ((size_t)(r0 - MP + t) * 64 + g) * 64 + lane; a.out[O_S5RS + si] = hr; a.out[O_S5IS + si] = hi; }
            if (mode == 1 || mode == 2 || mode == 4) { const unsigned w = cvt_pk_bf16(hr, hi); Hs[t * 136 + lane] = (bf16_t)(w & 0xffffu); Hs[t * 136 + 64 + lane] = (bf16_t)(w >> 16); }
        }
        if (mode == 1 || mode == 2 || mode == 4) {
            LDS_WAIT();
            f32x4 y = (f32x4){0.f, 0.f, 0.f, 0.f};
#pragma unroll
            for (int kk = 0; kk < 4; ++kk) { const bf16x8 hb = *(const LAS bf16x8*)(Hs + fr * 136 + 32 * kk + 8 * fq);
                y = __builtin_amdgcn_mfma_f32_16x16x32_bf16(cm[kk], hb, y, 0, 0, 0); }
            const f32x4 u4 = up4(u4raw); f32x4 o;
#pragma unroll
            for (int jj = 0; jj < 4; ++jj) o[jj] = gelu_t(y[jj] + dsk[jj] * u4[jj]);
            *(u32x2*)(YG + (size_t)(r0 + fr) * DH + 16 * g + 4 * fq) = pk4(o);
            LDS_WAIT();
        }
    }
    if (mode == 0) { float* sp = SUM + ((size_t)(n * 64 + g) * 32 + j) * 128; sp[lane] = hr; sp[64 + lane] = hi; }
    if (mode == 3) { LAS float* ps = (LAS float*)(wl + 12800); ps[lane] = hr; ps[64 + lane] = hi; }
    if (mode == 4 && j == 7) { a.out[O_S5RP + (size_t)(n * 64 + g) * 64 + lane] = hr; a.out[O_S5IP + (size_t)(n * 64 + g) * 64 + lane] = hi; }
}

__device__ __forceinline__ void conv_prompt(const Args& a) {
    unsigned char* ws = a.ws; const bf16_t* Z = (const bf16_t*)(ws + WS_Z); bf16_t* XC = (bf16_t*)(ws + WS_XC);
    const float* cw = a.in[I_CONVW]; const float* cb = a.in[I_CONVB];
    const int G = gridDim.x;
    for (int it = blockIdx.x * 512 + threadIdx.x; it < MP * 128; it += G * 512) {
        const int row = it >> 7, c = (it & 127) * 8, t = row & (SEQ - 1);
        float acc[8];
#pragma unroll
        for (int q = 0; q < 8; ++q) acc[q] = cb[c + q];
#pragma unroll
        for (int k = 0; k < 4; ++k) {
            if (t - 3 + k >= 0) {
                const u32x4 z = *(const u32x4*)(Z + (size_t)(row - 3 + k) * NZ + DH + c);
                const float x[8] = {bf_lo(z.x), bf_hi(z.x), bf_lo(z.y), bf_hi(z.y), bf_lo(z.z), bf_hi(z.z), bf_lo(z.w), bf_hi(z.w)};
#pragma unroll
                for (int q = 0; q < 8; ++q) acc[q] += cw[k * DH + c + q] * x[q];
                if (k == 3 && t >= SEQ - 3) {
                    float* o = a.out + O_CONVP + ((size_t)(row >> 11) * 3 + (t - (SEQ - 3))) * DH + c;
#pragma unroll
                    for (int q = 0; q < 8; ++q) o[q] = x[q];
                }
            }
        }
        u32x4 o; o.x = cvt_pk_bf16(acc[0], acc[1]); o.y = cvt_pk_bf16(acc[2], acc[3]); o.z = cvt_pk_bf16(acc[4], acc[5]); o.w = cvt_pk_bf16(acc[6], acc[7]);
        *(u32x4*)(XC + (size_t)row * DH + c) = o;
    }
}

__device__ __forceinline__ void conv_tile(const Args& a, int pm, int h) {
    unsigned char* ws = a.ws; const bf16_t* Z = (const bf16_t*)(ws + WS_Z); bf16_t* XC = (bf16_t*)(ws + WS_XC);
    const int tid = threadIdx.x, c = h * 256 + (tid & 31) * 8;
    float cwv[4][8], cbv[8];
#pragma unroll
    for (int q = 0; q < 8; ++q) { cbv[q] = a.in[I_CONVB][c + q];
#pragma unroll
        for (int k = 0; k < 4; ++k) cwv[k][q] = a.in[I_CONVW][k * DH + c + q]; }
#pragma unroll 1
    for (int r4 = 0; r4 < 16; r4 += 4) {
        u32x4 z[4][4];
#pragma unroll
        for (int rr = 0; rr < 4; ++rr) { const int row = pm * 256 + (tid >> 5) + 16 * (r4 + rr), t = row & (SEQ - 1);
#pragma unroll
            for (int k = 0; k < 4; ++k) z[rr][k] = (t - 3 + k >= 0) ? *(const u32x4*)(Z + (size_t)(row - 3 + k) * NZ + DH + c) : (u32x4){0u, 0u, 0u, 0u}; }
#pragma unroll
        for (int rr = 0; rr < 4; ++rr) { const int row = pm * 256 + (tid >> 5) + 16 * (r4 + rr), t = row & (SEQ - 1);
            float acc[8];
#pragma unroll
            for (int q = 0; q < 8; ++q) acc[q] = cbv[q];
#pragma unroll
            for (int k = 0; k < 4; ++k) { const u32x4 zz = z[rr][k];
                const float x[8] = {bf_lo(zz.x), bf_hi(zz.x), bf_lo(zz.y), bf_hi(zz.y), bf_lo(zz.z), bf_hi(zz.z), bf_lo(zz.w), bf_hi(zz.w)};
#pragma unroll
                for (int q = 0; q < 8; ++q) acc[q] += cwv[k][q] * x[q];
                if (k == 3 && t >= SEQ - 3) { float* o = a.out + O_CONVP + ((size_t)(row >> 11) * 3 + (t - (SEQ - 3))) * DH + c;
#pragma unroll
                    for (int q = 0; q < 8; ++q) o[q] = x[q]; } }
            u32x4 o; o.x = cvt_pk_bf16(acc[0], acc[1]); o.y = cvt_pk_bf16(acc[2], acc[3]); o.z = cvt_pk_bf16(acc[4], acc[5]); o.w = cvt_pk_bf16(acc[6], acc[7]);
            *(u32x4*)(XC + (size_t)row * DH + c) = o; }
    }
}

__device__ __forceinline__ void lru_sample(const Args& a, LAS unsigned char* lds, int unit) {
    unsigned char* ws = a.ws; const bf16_t* Z = (const bf16_t*)(ws + WS_Z); bf16_t* MG = (bf16_t*)(ws + WS_MERGED); float* ssB = (float*)(ws + WS_CTL) + SS_B * SS_STRIDE;
    LAS float* sxc = (LAS float*)lds;
    const int tid = threadIdx.x, s = unit >> 1, half = unit & 1, row = MP + s;
    const float* cw = a.in[I_CONVW]; const float* cs = a.in[I_CONV] + (size_t)s * 3 * DH;
    for (int c = tid; c < DH; c += 512) {
        const float xb = bf1(Z[(size_t)row * NZ + DH + c]);
        sxc[c] = a.in[I_CONVB][c] + cw[c] * cs[c] + cw[DH + c] * cs[DH + c] + cw[2 * DH + c] * cs[2 * DH + c] + cw[3 * DH + c] * xb;
        if ((c >> 9) == half) { float* o = a.out + O_CONVS + (size_t)s * 3 * DH; o[c] = cs[DH + c]; o[DH + c] = cs[2 * DH + c]; o[2 * DH + c] = xb; }
    }
    __syncthreads();
    float sq = 0.f;
    {
        const int c = half * 512 + tid, h = c >> 8, jj = c & 255;
        const float* wa = a.in[I_WA] + (size_t)h * 65536 + jj; const float* wi = a.in[I_WI] + (size_t)h * 65536 + jj;
        float ra = a.in[I_BA][c], ri = a.in[I_BI][c];
#pragma unroll 1
        for (int k0 = 0; k0 < 256; k0 += 32) {
            float wav[32], wiv[32];
#pragma unroll
            for (int q = 0; q < 32; ++q) { wav[q] = wa[(size_t)(k0 + q) * 256]; wiv[q] = wi[(size_t)(k0 + q) * 256]; }
#pragma unroll
            for (int q = 0; q < 32; ++q) { const float x = sxc[h * 256 + k0 + q]; ra += x * wav[q]; ri += x * wiv[q]; }
        }
        const float r = sigm(ra), ig = sigm(ri); const float xl = -a.in[I_LAM][c]; const float sp = fmaxf(xl, 0.f) + log1pf(expf(-fabsf(xl)));
        const float la = -8.f * r * sp, av = expf(la), bv = sqrtf(-expm1f(2.f * la)) * ig * sxc[c];
        const float hn = av * a.in[I_LRUH][(size_t)s * DH + c] + bv;
        a.out[O_LRUS + (size_t)s * DH + c] = hn;
        const float o = hn * gelu_t(bf1(Z[(size_t)row * NZ + 2 * DH + c]));
        MG[(size_t)row * DM + DH + c] = (bf16_t)(cvt_pk_bf16(o, 0.f) & 0xffffu);
        sq = o * o;
    }
    sq = wave_sum(sq);
    if ((tid & 63) == 0) atomicAdd(ssB + row, sq);
    __syncthreads();
}

__device__ __forceinline__ void lru_scan_unit(const Args& a, LAS unsigned char* lds, int unit) {
    unsigned char* ws = a.ws; const bf16_t* Z = (const bf16_t*)(ws + WS_Z); bf16_t* MG = (bf16_t*)(ws + WS_MERGED); float* ssB = (float*)(ws + WS_CTL) + SS_B * SS_STRIDE;
    const float* Ao = a.out; const float* Bo = a.out + (size_t)MP * DH;
    LAS float* sP = (LAS float*)lds; LAS float* sH = sP + 512; LAS float* rsum = sH + 512;
    const int tid = threadIdx.x, n = unit >> 6, ch = (unit & 63) * 16 + (tid & 15), j = tid >> 4;
    const size_t r0 = (size_t)n * SEQ + 64 * j;
    float P = 1.f, h = 0.f;
#pragma unroll 1
    for (int tb = 0; tb < 64; tb += 16) {
        float av[16], bv[16];
#pragma unroll
        for (int q = 0; q < 16; ++q) { av[q] = Ao[(r0 + tb + q) * DH + ch]; bv[q] = Bo[(r0 + tb + q) * DH + ch]; }
#pragma unroll
        for (int q = 0; q < 16; ++q) { h = av[q] * h + bv[q]; P *= av[q]; }
    }
    sP[tid] = P; sH[tid] = h;
    __syncthreads();
    float H = 0.f;
    for (int i = 0; i < j; ++i) H = sP[i * 16 + (tid & 15)] * H + sH[i * 16 + (tid & 15)];
    h = H;
#pragma unroll 1
    for (int tb = 0; tb < 64; tb += 16) {
        float av[16], bv[16]; bf16_t gz[16];
#pragma unroll
        for (int q = 0; q < 16; ++q) { const size_t row = r0 + tb + q; av[q] = Ao[row * DH + ch]; bv[q] = Bo[row * DH + ch]; gz[q] = Z[row * NZ + 2 * DH + ch]; }
#pragma unroll
        for (int q = 0; q < 16; ++q) {
            const size_t row = r0 + tb + q;
            h = av[q] * h + bv[q];
            const float o = h * gelu_t(bf1(gz[q]));
            MG[row * DM + DH + ch] = (bf16_t)(cvt_pk_bf16(o, 0.f) & 0xffffu);
            float s = o * o; s += __shfl_xor(s, 1); s += __shfl_xor(s, 2); s += __shfl_xor(s, 4); s += __shfl_xor(s, 8);
            if ((tid & 15) == 0) rsum[64 * j + tb + q] = s;
        }
    }
    __syncthreads();
    for (int r = tid; r < SEQ; r += 512) atomicAdd(ssB + (size_t)n * SEQ + r, rsum[r]);
    if (j == 31) a.out[O_LRUP + (size_t)n * DH + ch] = h;
    __syncthreads();
}

#define XB_TMO      128
#define XB_XCNT(j)  (256  + 64 * (j))
#define XB_XSUB(j)  (1280 + 64 * (j))
#define XB_XGEN(j)  (2304 + 64 * (j))
#define XB_TOP      3328
#define XB_TOPGEN   3392
#define XB_SPIN_CAP (1u << 18)
__device__ __forceinline__ unsigned xb_ld(unsigned* p)              { return __hip_atomic_load(p, __ATOMIC_RELAXED, __HIP_MEMORY_SCOPE_AGENT); }
__device__ __forceinline__ unsigned xb_add(unsigned* p, unsigned v) { return __hip_atomic_fetch_add(p, v, __ATOMIC_RELAXED, __HIP_MEMORY_SCOPE_AGENT); }
__device__ __forceinline__ unsigned xb_xcc_id() { return (unsigned)__builtin_amdgcn_s_getreg((3 << 11) | 20) & 0xFu; }
#define XB_SPIN(cond, bar) do { unsigned _sp = 0; while (cond) { __builtin_amdgcn_s_sleep(1); \
    if ((++_sp & 255u) == 0u) { if (xb_ld(&(bar)[XB_TMO])) break; if (_sp > XB_SPIN_CAP) { atomicAdd(&(bar)[XB_TMO], 1u); break; } } } } while (0)
struct XcdBarrier { unsigned* bar; unsigned x; volatile LAS unsigned* st; };
__device__ __forceinline__ XcdBarrier xcd_barrier_post(unsigned* bar, volatile LAS unsigned* st) {
    XcdBarrier b; b.bar = bar; b.x = xb_xcc_id(); b.st = st;
    if (threadIdx.x == 0) (void)xb_add(&bar[XB_XCNT(b.x)], 1u);
    return b;
}
__device__ __forceinline__ void xcd_barrier_complete(unsigned* bar, unsigned x, unsigned& nloc, unsigned& nx) {
    const unsigned G = gridDim.x * gridDim.y * gridDim.z;
    unsigned sum, cnt, mine, sp = 0u;
    for (;;) {
        sum = 0u; cnt = 0u; mine = 0u;
#pragma unroll
        for (unsigned j = 0; j < 16; ++j) { const unsigned c = xb_ld(&bar[XB_XCNT(j)]); sum += c; cnt += (c > 0u) ? 1u : 0u; mine = (j == x) ? c : mine; }
        if (sum == G) break;
        __builtin_amdgcn_s_sleep(1);
        if ((++sp & 255u) == 0u) { if (xb_ld(&bar[XB_TMO])) break; if (sp > XB_SPIN_CAP) { atomicAdd(&bar[XB_TMO], 1u); break; } }
    }
    nloc = mine > 0u ? mine : 1u; nx = cnt > 0u ? cnt : 1u;
}
__device__ __forceinline__ void xcd_barrier(const XcdBarrier& b) {
    asm volatile("s_waitcnt vmcnt(0)" ::: "memory");
    __syncthreads();
    if (threadIdx.x == 0) {
        unsigned* bar = b.bar;
        __builtin_amdgcn_s_waitcnt(0);
        unsigned nloc = b.st[0], nx = b.st[1];
        if (nloc == 0u) { xcd_barrier_complete(bar, b.x, nloc, nx); b.st[0] = nloc; b.st[1] = nx; }
        const unsigned old = xb_add(&bar[XB_XSUB(b.x)], 1u);
        const unsigned gen = old / nloc;
        if (old + 1u == (gen + 1u) * nloc) {
            __builtin_amdgcn_fence(__ATOMIC_RELEASE, "agent");
            asm volatile("s_waitcnt vmcnt(0)" ::: "memory");
            const unsigned og = xb_add(&bar[XB_TOP], 1u);
            const unsigned tg = og / nx;
            if (og + 1u == (tg + 1u) * nx) xb_add(&bar[XB_TOPGEN], 1u);
            else XB_SPIN(xb_ld(&bar[XB_TOPGEN]) == tg, bar);
            __builtin_amdgcn_fence(__ATOMIC_ACQUIRE, "agent");
            xb_add(&bar[XB_XGEN(b.x)], 1u);
            asm volatile("s_waitcnt vmcnt(0)" ::: "memory");
        } else {
            XB_SPIN(xb_ld(&bar[XB_XGEN(b.x)]) == gen, bar);
            __builtin_amdgcn_fence(__ATOMIC_ACQUIRE, "agent");
            asm volatile("s_waitcnt vmcnt(0)" ::: "memory");
        }
    }
    __syncthreads();
}

__global__ void __launch_bounds__(512, 2) fwd_kernel(Args a) {
    extern __shared__ __attribute__((aligned(16))) unsigned char lds_raw[];
    LAS unsigned char* lds = (LAS unsigned char*)lds_raw;
    const int tid = threadIdx.x, wave = __builtin_amdgcn_readfirstlane(tid >> 6), lane = tid & 63, G = gridDim.x;
    unsigned char* ws = a.ws;
    const int lo = a.ph_lo, hi = a.ph_hi;
    volatile LAS unsigned* MISC = (volatile LAS unsigned*)(lds + MISC_OFF);
    for (int u = tid; u < (LDS_BYTES - RING_BYTES) / 4; u += 512) ((LAS unsigned*)(lds + RING_BYTES))[u] = 0u;
    __syncthreads();
#if MK_LAUNCHES == 1
    XcdBarrier bar = xcd_barrier_post((unsigned*)(ws + WS_CTL) + CW_BAR, MISC + 8);
#define GRID_BAR() xcd_barrier(bar)
#else
#define GRID_BAR() do {} while (0)
#endif
#define IN(k) (lo <= (k) && (k) < hi)
#define BOTH(k) (IN(k) && IN((k) + 1))
#define ssb ((float*)(ws + WS_CTL))
#define AB ((bf16_t*)(ws + WS_AB))
#define Z ((bf16_t*)(ws + WS_Z))
#define YG ((bf16_t*)(ws + WS_YG))
#define MG ((bf16_t*)(ws + WS_MERGED))
#define HUP ((bf16_t*)(ws + WS_HUP))
#define PW ((bf16_t*)(ws + WS_PW))
#define PB ((bf16_t*)(ws + WS_PB))
#define XO (a.out + O_Y)

    if (IN(0)) { phase0(a, lds); if (BOTH(0)) GRID_BAR(); }

    if (IN(1)) {
        pg8::Gemm g{AB, (const bf16_t*)(ws + WS_WIN), DM, DM, DM, 0}; pg8::StaticOrder S; S.init(MP / 256, NZ / 256, G, (int)blockIdx.x);
        EpiWrap<EIn> E{{nullptr, (const float*)(ws + WS_SMALL + SM_RS0), Z}};
        pg8::gemm_phase<EpiWrap<EIn>, true>(lds, g, S, E);
        skinny_gemm<EIn, 8, 2>(lds, AB + (size_t)MP * DM, DM, (const bf16_t*)(ws + WS_WIN), DM, NZ, DM, E.e, G / 2);
        if ((int)blockIdx.x >= G / 2) {
            const int w = ((int)blockIdx.x - G / 2) * 8 + wave, nw = (G - G / 2) * 8; LAS float* scr = (LAS float*)(lds + wave * 16384);
            constexpr int J_OUT = 32 * 64, J_GATE = 32 * 64, J_GLU = 16 * 32, J_PLE = 4 * 64;
            for (int it = w; it < J_OUT + J_GATE + J_GLU + J_PLE; it += nw) {
                int r = it;
                if (r < J_OUT) { tr_item(a.in[I_WOUT], DM, DM, (bf16_t*)(ws + WS_WOUT), 0, 0, a.in[I_GMA], a.in[I_GMB], DH, scr, r, lane); continue; } r -= J_OUT;
                if (r < J_GATE) { tr_item(a.in[I_WGATE], DM, DM, (bf16_t*)(ws + WS_WGATE), 0, 0, a.in[I_GPLE], a.in[I_GPLE], 1 << 30, scr, r, lane); continue; } r -= J_GATE;
                if (r < J_GLU) { tr_item(a.in[I_WGLU], DH, DH, (bf16_t*)(ws + WS_WGLU), 0, 0, nullptr, nullptr, 0, scr, r, lane); continue; } r -= J_GLU;
                tr_item(a.in[I_WPLE], DPLE, DM, (bf16_t*)(ws + WS_WPLE), 0, 0, nullptr, nullptr, 0, scr, r, lane);
            }
        }
        if (BOTH(1)) GRID_BAR();
    }

    if (IN(3)) {
        pg8::Gemm g{(const bf16_t*)(ws + WS_XC), (const bf16_t*)(ws + WS_WLRU), DH, 256, 256, 1}; pg8::StaticOrder S; S.init(MP / 256, 8, G, (int)blockIdx.x);
        { pg8::Unit cu; for (int i = 0; S.next(i, cu); ++i) conv_tile(a, cu.pm, cu.pn >> 1); }
        asm volatile("s_waitcnt vmcnt(0)" ::: "memory"); __syncthreads();
        ELru E{(const bf16_t*)(ws + WS_XC), a.in[I_BA], a.in[I_BI], (const float*)(ws + WS_SMALL + SM_SPL), a.out, a.out + (size_t)MP * DH};
        pg8::gemm_phase<ELru, true>(lds, g, S, E);
        for (int s = G - 1 - (int)blockIdx.x; s < 2 * MS; s += G) lru_sample(a, lds, s);
        for (int u = blockIdx.x; u < NB * 64; u += G) {
            const int n = u >> 6, g2 = u & 63;
            s5_unit(a, lds + wave * 16384, lane, 3, n, g2, wave);
            __syncthreads();
            s5_unit(a, lds + wave * 16384, lane, 4, n, g2, wave);
            __syncthreads();
        }
        for (int u = blockIdx.x * 8 + wave; u < 512; u += G * 8) s5_unit(a, lds + wave * 16384, lane, 2, 0, u >> 3, u & 7);
        if (BOTH(3)) GRID_BAR();
    }

    if (IN(4)) {
        pg8::Gemm g{YG, (const bf16_t*)(ws + WS_WGLU), DH, DH, DH, 0}; pg8::StaticOrder S; S.init(MP / 256, DH / 256, G, (int)blockIdx.x);
        EpiWrap<EGlu> E{{ssb + SS_A * SS_STRIDE, a.in[I_BGLU], YG, MG}};
        pg8::gemm_phase<EpiWrap<EGlu>, true>(lds, g, S, E);
        skinny_gemm<EGlu, 4>(lds, YG + (size_t)MP * DH, DH, (const bf16_t*)(ws + WS_WGLU), DH, DH, DH, E.e);
        for (int u = G - 1 - (int)blockIdx.x; u < NB * 64; u += G) lru_scan_unit(a, lds, u);
        if ((int)blockIdx.x >= G / 2) {
            const int w = ((int)blockIdx.x - G / 2) * 8 + wave, nw = (G - G / 2) * 8;
            for (int it = 5120 + w; it < 128 * 64; it += nw) tr_item(a.in[I_WDOWN], DFF, DM, (bf16_t*)(ws + WS_WDOWN), 0, 0, nullptr, nullptr, 0, (LAS float*)(lds + wave * 16384), it, lane);
        }
        if (BOTH(4)) GRID_BAR();
    }

    if (IN(5)) {
        pg8::Gemm g{MG, (const bf16_t*)(ws + WS_WOUT), DM, DM, DM, 0}; pg8::StaticOrder S; S.init(MP / 256, DM / 256, G, (int)blockIdx.x);
        { float* RAT = (float*)(ws + WS_SMALL + SM_RAT); float* RSB = (float*)(ws + WS_SMALL + SM_RSB);
          pg8::Unit cu;
          for (int ui = -1; ui < 0 || S.next(ui, cu); ++ui)
              for (int i = tid; i < (ui < 0 ? MS : 256); i += 512) { const int row = ui < 0 ? MP + i : cu.pm * 256 + i;
                  const float va = ssb[SS_A * SS_STRIDE + row] * (1.f / DH) + EPS, vb = ssb[SS_B * SS_STRIDE + row] * (1.f / DH) + EPS; RAT[row] = sqrtf(vb / va); RSB[row] = rsqrtf(vb); }
          asm volatile("s_waitcnt vmcnt(0)" ::: "memory"); __syncthreads(); }
        EpiWrap<EOut> E{{ssb + SS_1 * SS_STRIDE, (const float*)(ws + WS_SMALL + SM_RAT), (const float*)(ws + WS_SMALL + SM_RSB), a.in[I_XP], a.in[I_XS], XO, AB}};
        pg8::gemm_phase<EpiWrap<EOut>, true>(lds, g, S, E);
        skinny_gemm<EOut, 4>(lds, MG + (size_t)MP * DM, DM, (const bf16_t*)(ws + WS_WOUT), DM, DM, DM, E.e);
        if (BOTH(5)) GRID_BAR();
    }

    if (IN(6)) {
        pg8::Gemm g{AB, (const bf16_t*)(ws + WS_WUP), DM, DM, DM, 0}; pg8::StaticOrder S; S.init(MP / 256, DFF / 256, G, (int)blockIdx.x);
        EpiWrap<EUp> E{{nullptr, ssb + SS_1 * SS_STRIDE, HUP}};
        pg8::gemm_phase<EpiWrap<EUp>, true>(lds, g, S, E);
        skinny_gemm<EUp, 8, 2>(lds, AB + (size_t)MP * DM, DM, (const bf16_t*)(ws + WS_WUP), DM, DFF, DM, E.e);
        if (BOTH(6)) GRID_BAR();
    }

    if (IN(7)) {
        pg8::Gemm g{HUP, (const bf16_t*)(ws + WS_WDOWN), DFF, DFF, DFF, 0}; pg8::StaticOrder S; S.init(MP / 256, DM / 256, G, (int)blockIdx.x);
        EpiWrap<EDown> E{{ssb + SS_2 * SS_STRIDE, XO, AB}};
        pg8::gemm_phase<EpiWrap<EDown>, true>(lds, g, S, E);
        skinny_gemm<EDown, 4>(lds, HUP + (size_t)MP * DFF, DFF, (const bf16_t*)(ws + WS_WDOWN), DFF, DM, DFF, E.e);
        if (BOTH(7)) GRID_BAR();
    }

    if (IN(8)) {
        { pg8::Gemm g{PB, (const bf16_t*)(ws + WS_WPLE), DPLE, DPLE, DPLE, 0}; pg8::StaticOrder S; S.init(MP / 256, DM / 256, G, (int)blockIdx.x);
          EpiWrap<EPw> E{{nullptr, PW}};
          pg8::gemm_phase<EpiWrap<EPw>, true>(lds, g, S, E);
          skinny_gemm<EPw, 4>(lds, PB + (size_t)MP * DPLE, DPLE, (const bf16_t*)(ws + WS_WPLE), DPLE, DM, DPLE, E.e); }
        asm volatile("s_waitcnt vmcnt(0)" ::: "memory"); __syncthreads();
        { pg8::Gemm g{AB, (const bf16_t*)(ws + WS_WGATE), DM, DM, DM, 0}; pg8::StaticOrder S; S.init(MP / 256, DM / 256, G, (int)blockIdx.x);
          EpiWrap<EGate> E{{ssb + SS_3 * SS_STRIDE, ssb + SS_2 * SS_STRIDE, PW, XO}};
          pg8::gemm_phase<EpiWrap<EGate>, true>(lds, g, S, E);
          skinny_gemm<EGate, 4>(lds, AB + (size_t)MP * DM, DM, (const bf16_t*)(ws + WS_WGATE), DM, DM, DM, E.e); }
        if (BOTH(8)) GRID_BAR();
    }

    if (IN(9)) {
        const float* ss3 = ssb + SS_3 * SS_STRIDE; const float* gf = a.in[I_GFIN];
        f32x4 gv[8];
#pragma unroll
        for (int j = 0; j < 8; ++j) gv[j] = ((const f32x4*)gf)[lane + 64 * j];
        for (int row = blockIdx.x * 8 + wave; row < MT; row += 2 * G * 8) {
            const int row2 = row + G * 8; const bool has2 = row2 < MT; const int r2 = has2 ? row2 : row;
            f32x4* xa = (f32x4*)(XO + (size_t)row * DM); f32x4* xb2 = (f32x4*)(XO + (size_t)r2 * DM);
            f32x4 va[8], vb[8];
#pragma unroll
            for (int j = 0; j < 8; ++j) { va[j] = __builtin_nontemporal_load(&xa[lane + 64 * j]); vb[j] = __builtin_nontemporal_load(&xb2[lane + 64 * j]); }
            const float rsa = rsqrtf(ss3[row] * (1.f / DM) + EPS), rsb2 = rsqrtf(ss3[r2] * (1.f / DM) + EPS);
#pragma unroll
            for (int j = 0; j < 8; ++j) __builtin_nontemporal_store(va[j] * rsa * gv[j], &xa[lane + 64 * j]);
            if (has2) {
#pragma unroll
                for (int j = 0; j < 8; ++j) __builtin_nontemporal_store(vb[j] * rsb2 * gv[j], &xb2[lane + 64 * j]);
            }
        }
    }
#if MK_LAUNCHES == 1
    if (lo > hi) cg::this_grid().sync();
#endif
}

#undef ssb
#undef AB
#undef Z
#undef YG
#undef MG
#undef HUP
#undef PW
#undef PB
#undef XO
extern "C" void kernel_launch(void* const* d_in, const int* in_sizes, int n_in, void* d_out, int out_size, void* d_ws, size_t ws_size, hipStream_t stream) {
    static int grid = 0;
    if (grid == 0) {
        int dev = 0, cus = 0;
        if (n_in != 37 || ws_size < WS_END) { fprintf(stderr, "kernel_launch: unexpected inputs (n_in %d, ws %zu)\n", n_in, ws_size); grid = -1; return; }
        if (hipGetDevice(&dev) != hipSuccess || hipDeviceGetAttribute(&cus, hipDeviceAttributeMultiprocessorCount, dev) != hipSuccess) { grid = -1; return; }
        if (hipFuncSetAttribute((const void*)fwd_kernel, hipFuncAttributeMaxDynamicSharedMemorySize, LDS_BYTES) != hipSuccess) { fprintf(stderr, "kernel_launch: hipFuncSetAttribute failed\n"); grid = -1; return; }
        int per_cu = 0;
        if (hipOccupancyMaxActiveBlocksPerMultiprocessor(&per_cu, (const void*)fwd_kernel, 512, LDS_BYTES) != hipSuccess || per_cu < 1) { fprintf(stderr, "kernel_launch: occupancy query %d\n", per_cu); }
        (void)hipGetLastError();
        grid = cus;
    }
    if (grid < 0) return;
    (void)hipMemsetAsync((char*)d_ws + WS_CTL, 0, CTL_ZERO_BYTES, stream);
    Args a{};
    for (int i = 0; i < 37; ++i) a.in[i] = (const float*)d_in[i];
    a.out = (float*)d_out; a.ws = (unsigned char*)d_ws;
#if MK_LAUNCHES == 1
    a.ph_lo = 0; a.ph_hi = NPHASE;
    void* args[] = {&a};
    hipError_t e = hipLaunchCooperativeKernel((const void*)fwd_kernel, dim3(grid), dim3(512), args, LDS_BYTES, stream);
    if (e != hipSuccess) fprintf(stderr, "cooperative launch failed: %s (grid %d)\n", hipGetErrorString(e), grid);
#else
    for (int ph = 0; ph < NPHASE; ++ph) {
        a.ph_lo = ph; a.ph_hi = ph + 1;
        hipLaunchKernelGGL(fwd_kernel, dim3(grid), dim3(512), LDS_BYTES, stream, a);
    }
#endif
}
```

```cpp
#include <hip/hip_runtime.h>
#include <hip/hip_cooperative_groups.h>
#include <cstdio>
#include <cstdint>
namespace cg = cooperative_groups;

#ifndef MK_LAUNCHES
#define MK_LAUNCHES 1
#endif

#define LAS __attribute__((address_space(3)))
typedef unsigned short bf16_t;
typedef short bf16x8 __attribute__((ext_vector_type(8)));
typedef float f32x4 __attribute__((ext_vector_type(4)));
typedef unsigned u32x4 __attribute__((ext_vector_type(4)));
typedef unsigned u32x2 __attribute__((ext_vector_type(2)));

constexpr int DM = 2048, SEQ = 2048, NB = 4, MP = 8192, MS = 128, MT = 8320;
constexpr int NZ = 3072, DFF = 8192, DPLE = 256, DH = 1024;
constexpr float EPS = 1e-6f;
constexpr int NPHASE = 10;

constexpr size_t MiB = 1u << 20;
constexpr size_t WS_CTL = 0, CTL_ZERO_BYTES = 1 * MiB;
constexpr int SS_STRIDE = 8448;
constexpr int SS_A = 0, SS_B = 1, SS_1 = 2, SS_2 = 3, SS_3 = 4;
constexpr int CW_BAR = 65536;
constexpr size_t WS_SMALL = 1 * MiB;
constexpr size_t SM_RS0 = 0, SM_AR = 65536, SM_AI = SM_AR + 16384, SM_A64R = SM_AI + 16384, SM_A64I = SM_A64R + 16384,
                 SM_BBB = SM_A64I + 16384  , SM_CMB = SM_BBB + 262144  , SM_SPL = SM_CMB + 262144  , SM_RAT = 663552  , SM_RSB = SM_RAT + 34816  ;
constexpr size_t WS_WUP = 2 * MiB, WS_WDOWN = 34 * MiB, WS_WGATE = 66 * MiB, WS_WPLE = 74 * MiB, WS_PB = 75 * MiB, WS_AB = 80 * MiB;
constexpr size_t WS_E = 113 * MiB;
constexpr size_t WS_HUP = WS_E, WS_PW = WS_E;
constexpr size_t WS_WIN = 113 * MiB, WS_WGLU = 125 * MiB, WS_WOUT = 127 * MiB, WS_WLRU = 135 * MiB, WS_Z = 136 * MiB,
                 WS_YG = 185 * MiB, WS_MERGED = 202 * MiB, WS_XC = 235 * MiB, WS_S5SUM = 251 * MiB, WS_END = 255 * MiB;
static_assert(WS_HUP + (size_t)MT * DFF * 2 <= 256 * MiB, "hup fits");
static_assert(WS_Z + (size_t)MT * NZ * 2 <= WS_YG && WS_YG + (size_t)MT * DH * 2 <= WS_MERGED && WS_MERGED + (size_t)MT * DM * 2 <= WS_XC, "map");
static_assert(WS_AB + (size_t)MT * DM * 2 <= WS_E && WS_PB + (size_t)MT * DPLE * 2 <= WS_AB, "map2");

constexpr size_t O_Y = 0, O_S5RP = 17039360, O_S5IP = 17055744, O_LRUP = 17072128, O_CONVP = 17076224,
                 O_S5RS = 17088512, O_S5IS = 17612800, O_LRUS = 18137088, O_CONVS = 18268160;

constexpr int RING_BYTES = 131072, MISC_OFF = RING_BYTES + 320, LDS_BYTES = 147456;

__device__ __forceinline__ unsigned cvt_pk_bf16(float lo, float hi) { unsigned r; asm("v_cvt_pk_bf16_f32 %0, %1, %2" : "=v"(r) : "v"(lo), "v"(hi)); return r; }
__device__ __forceinline__ float bf_lo(unsigned u) { return __uint_as_float(u << 16); }
__device__ __forceinline__ float bf_hi(unsigned u) { return __uint_as_float(u & 0xffff0000u); }
__device__ __forceinline__ float bf1(bf16_t u) { return __uint_as_float(((unsigned)u) << 16); }
__device__ __forceinline__ float sigm(float x) { return __builtin_amdgcn_rcpf(1.f + __expf(-x)); }
__device__ __forceinline__ float gelu_t(float x) { const float u = 1.5957691216057308f * (x + 0.044715f * x * x * x); return x * __builtin_amdgcn_rcpf(1.f + __expf(-u)); }
__device__ __forceinline__ float wave_sum(float v) {
#pragma unroll
    for (int o = 1; o < 64; o <<= 1) v += __shfl_xor(v, o);
    return v;
}
#define LDS_WAIT() asm volatile("s_waitcnt lgkmcnt(0)" ::: "memory")

namespace pg8 {
constexpr int BM = 256, BK = 64, HALF = 128, HTB = HALF * BK * 2, STAGE_BYTES = 8 * HTB, NXCD = 8, WGM = 8;
__host__ __device__ __forceinline__ int lds_byte(int r, int c) { const int st = (r >> 4) * 2 + (c >> 5), rr = r & 15, cc = c & 31, ob = rr * 64 + cc * 2; return st * 1024 + (ob ^ (((ob >> 9) & 1) << 5)); }
__host__ __device__ __forceinline__ void stage_rc(int b, int& R, int& C) { const int st = b / 1024, sb = b % 1024, swz = sb ^ (((sb >> 9) & 1) << 5); R = (st >> 1) * 16 + swz / 64; C = (st & 1) * 32 + (swz % 64) / 2; }
__host__ __device__ __forceinline__ int perm32(int rho) { const int n = rho >> 4, i = rho & 15; return 8 * (i >> 2) + 4 * n + (i & 3); }
struct Unit { int pm, pn; };
struct Gemm { const bf16_t* A; const bf16_t* Bt; int lda, ldb, K, akmode; };
struct StaticOrder {
    int nM, nN, nwg, G, c;
    __device__ __forceinline__ void init(int nM_, int nN_, int G_, int c_) { nM = nM_; nN = nN_; nwg = nM * nN; G = G_; c = c_; }
    __device__ __forceinline__ bool next(int i, Unit& u) const {
        const long L = (long)i * G + c; if (L >= nwg) return false;
        int wgid = (int)L; { const int q = nwg / NXCD, r = nwg % NXCD, xcd = wgid % NXCD, off = wgid / NXCD; wgid = (xcd < r ? xcd * (q + 1) : r * (q + 1) + (xcd - r) * q) + off; }
        const int nig = WGM * nN, gid = wgid / nig, fm = gid * WGM, gsz = (nM - fm) < WGM ? (nM - fm) : WGM;
        u.pm = fm + ((wgid % nig) % gsz); u.pn = (wgid % nig) / gsz; return true;
    }
};

template <class Epi, bool ALIGN_EPI>
__device__ __forceinline__ void gemm_phase(LAS unsigned char* lds, const Gemm g, const StaticOrder& S, const Epi& E) {
    const int tid = threadIdx.x, wid = __builtin_amdgcn_readfirstlane(tid >> 6), lane = tid & 63, wr = wid >> 2, wc = wid & 3, fr = lane & 15, fq = lane >> 4;
    int K = g.K; asm volatile("" : "+s"(K));
    const int nt = K / BK;
    unsigned voffA[2], voffB[2];
#pragma unroll
    for (int i = 0; i < 2; ++i) { int R, C; stage_rc(tid * 16 + i * 8192, R, C);
        const int Rb = Epi::PERM ? ((R & ~31) + perm32(R & 31)) : R;
        voffA[i] = (unsigned)(R * g.lda + C) * 2u; voffB[i] = (unsigned)(Rb * g.ldb + C) * 2u; }
    const size_t kstep = (size_t)(BK * 2);
    const size_t hstepA = (size_t)HALF * g.lda * 2, hstepB = (size_t)HALF * g.ldb * 2;
    const size_t tstepA = 2 * hstepA, tstepB = 2 * hstepB;
    const unsigned ldsw = (unsigned)wid * 1024u;
    const int aoff = lds_byte(wr * 64 + fr, fq * 8), boff = lds_byte(wc * 32 + fr, fq * 8);
#define PG8_SA(b, h) (((b) * 2 + (h)) * HTB)
#define PG8_SB(b, h) ((4 + (b) * 2 + (h)) * HTB)
#define PG8_STAGE(bufoff, gbase, voff) do { _Pragma("unroll") for (int _i = 0; _i < 2; ++_i) \
        __builtin_amdgcn_global_load_lds((const unsigned*)((const char*)(gbase) + (voff)[_i]), (LAS unsigned*)(lds + (bufoff) + ldsw + _i * 8192), 16, 0, 0); } while (0)
#define PG8_LDA(dst, b, h) do { _Pragma("unroll") for (int m = 0; m < 4; ++m) _Pragma("unroll") for (int k = 0; k < 2; ++k) dst[m][k] = *(const LAS bf16x8*)(lds + PG8_SA(b, h) + aoff + m * 2048 + k * 1024); } while (0)
#define PG8_LDB(dst, b, h) do { _Pragma("unroll") for (int n = 0; n < 2; ++n) _Pragma("unroll") for (int k = 0; k < 2; ++k) dst[n][k] = *(const LAS bf16x8*)(lds + PG8_SB(b, h) + boff + n * 2048 + k * 1024); } while (0)
#define PG8_MMA(ai, bj, At, Bt) do { __builtin_amdgcn_s_setprio(1); _Pragma("unroll") for (int m = 0; m < 4; ++m) _Pragma("unroll") for (int n = 0; n < 2; ++n) _Pragma("unroll") for (int k = 0; k < 2; ++k) \
        acc[ai][bj][m][n] = __builtin_amdgcn_mfma_f32_16x16x32_bf16(Bt[n][k], At[m][k], acc[ai][bj][m][n], 0, 0, 0); __builtin_amdgcn_s_setprio(0); } while (0)
#define PG8_WAIT_V(n) asm volatile("s_waitcnt vmcnt(" #n ")" ::: "memory")
#define PG8_WAIT_L(n) asm volatile("s_waitcnt lgkmcnt(" #n ")" ::: "memory")
#define PG8_BAR __builtin_amdgcn_s_barrier()
#define PG8_SCHED __builtin_amdgcn_sched_barrier(0)
    Unit cur, nxt; int ui = 0;
    if (!S.next(0, cur)) return;
    f32x4 acc[2][2][4][2];
#pragma unroll
    for (int a = 0; a < 2; ++a)
#pragma unroll
        for (int b = 0; b < 2; ++b)
#pragma unroll
            for (int m = 0; m < 4; ++m)
#pragma unroll
                for (int n = 0; n < 2; ++n) acc[a][b][m][n] = (f32x4){0.f, 0.f, 0.f, 0.f};
    bf16x8 At[4][2], B0[2][2], B1[2][2];
    const char* cA = (const char*)g.A + (size_t)cur.pm * tstepA + (g.akmode ? (size_t)(cur.pn >> 1) * 512 : 0);
    const char* cB = (const char*)g.Bt + (size_t)cur.pn * tstepB;
    PG8_STAGE(PG8_SB(0, 0), cB, voffB); PG8_STAGE(PG8_SB(0, 1), cB + hstepB, voffB); PG8_STAGE(PG8_SA(0, 0), cA, voffA); PG8_STAGE(PG8_SA(0, 1), cA + hstepA, voffA);
    if (wr == 1) PG8_BAR;
    PG8_WAIT_V(2); PG8_BAR;
    PG8_STAGE(PG8_SB(1, 0), cB + kstep, voffB); PG8_STAGE(PG8_SA(1, 0), cA + kstep, voffA); PG8_STAGE(PG8_SB(1, 1), cB + hstepB + kstep, voffB);
    PG8_WAIT_V(6); PG8_BAR;
    for (;;) {
        const bool has_next = S.next(ui + 1, nxt);
        const char* nA = has_next ? (const char*)g.A + (size_t)nxt.pm * tstepA + (g.akmode ? (size_t)(nxt.pn >> 1) * 512 : 0) : cA;
        const char* nB = has_next ? (const char*)g.Bt + (size_t)nxt.pn * tstepB : cB;
        for (int t = 0; t < nt; t += 2) {
            const bool last = (t == nt - 2);
            const char* a1 = cA + (size_t)(t + 1) * kstep;
            const char* a2 = last ? nA : cA + (size_t)(t + 2) * kstep; const char* b2 = last ? nB : cB + (size_t)(t + 2) * kstep;
            const char* a3 = a2 + kstep; const char* b3 = b2 + kstep;
            if constexpr (Epi::MID) { if (t == (nt >> 1)) E.mid(acc, cur, wr, fr); }
            PG8_LDB(B0, 0, 0); PG8_LDB(B1, 0, 1); PG8_SCHED; PG8_LDA(At, 0, 0); PG8_STAGE(PG8_SA(1, 1), a1 + hstepA, voffA);
            PG8_WAIT_V(8); PG8_WAIT_L(0); PG8_BAR; PG8_MMA(0, 0, At, B0); PG8_MMA(0, 1, At, B1); PG8_BAR; PG8_SCHED;
            PG8_LDA(At, 0, 1); PG8_STAGE(PG8_SB(0, 0), b2, voffB); PG8_STAGE(PG8_SB(0, 1), b2 + hstepB, voffB); PG8_STAGE(PG8_SA(0, 0), a2, voffA);
            PG8_WAIT_V(8); PG8_WAIT_L(0); PG8_BAR; PG8_MMA(1, 0, At, B0); PG8_MMA(1, 1, At, B1); PG8_BAR; PG8_SCHED;
            PG8_LDB(B0, 1, 0); PG8_LDB(B1, 1, 1); PG8_SCHED; PG8_LDA(At, 1, 0); PG8_STAGE(PG8_SA(0, 1), a2 + hstepA, voffA);
            PG8_WAIT_V(8); PG8_WAIT_L(0); PG8_BAR; PG8_MMA(0, 0, At, B0); PG8_MMA(0, 1, At, B1); PG8_BAR; PG8_SCHED;
            PG8_LDA(At, 1, 1); PG8_STAGE(PG8_SB(1, 0), b3, voffB); PG8_STAGE(PG8_SB(1, 1), b3 + hstepB, voffB); PG8_STAGE(PG8_SA(1, 0), a3, voffA);
            PG8_WAIT_V(8); PG8_WAIT_L(0); PG8_BAR; PG8_MMA(1, 0, At, B0); PG8_MMA(1, 1, At, B1); PG8_BAR; PG8_SCHED;
        }
        if constexpr (ALIGN_EPI) { if (wr == 0) PG8_BAR; }
        E(acc, cur, wr, wc, fr, fq);
        if (!has_next) break;
#pragma unroll
        for (int a = 0; a < 2; ++a)
#pragma unroll
            for (int b = 0; b < 2; ++b)
#pragma unroll
                for (int m = 0; m < 4; ++m)
#pragma unroll
                    for (int n = 0; n < 2; ++n) acc[a][b][m][n] = (f32x4){0.f, 0.f, 0.f, 0.f};
        cur = nxt; cA = nA; cB = nB; ++ui;
        if constexpr (ALIGN_EPI) { if (wr == 1) PG8_BAR; }
    }
    PG8_WAIT_V(0);
    if constexpr (!ALIGN_EPI) { if (wr == 0) PG8_BAR; }
    PG8_BAR;
#undef PG8_SA
#undef PG8_SB
#undef PG8_STAGE
#undef PG8_LDA
#undef PG8_LDB
#undef PG8_MMA
#undef PG8_WAIT_V
#undef PG8_WAIT_L
#undef PG8_BAR
#undef PG8_SCHED
}
}

template <class E> struct EpiWrap {
    E e; static constexpr bool MID = E::MID, PERM = E::PERM;
    __device__ __forceinline__ void operator()(const f32x4 (&acc)[2][2][4][2], const pg8::Unit& u, int wr, int wc, int fr, int fq) const {
        if constexpr (E::HAS_RES) {
            f32x4 rc[2][2], rn[2][2];
            { const int row = u.pm * 256 + wr * 64 + fr;
#pragma unroll
              for (int bj = 0; bj < 2; ++bj)
#pragma unroll
                  for (int n = 0; n < 2; ++n) rc[bj][n] = e.res(row, u.pn * 256 + bj * 128 + wc * 32 + 8 * fq + 4 * n); }
#pragma unroll
            for (int idx = 0; idx < 8; ++idx) {
                const int ai = idx >> 2, m = idx & 3;
                const int row = u.pm * 256 + ai * 128 + wr * 64 + m * 16 + fr; const float rv = e.rowval(row); float s = 0.f;
                if (idx < 7) { const int rown = u.pm * 256 + ((idx + 1) >> 2) * 128 + wr * 64 + ((idx + 1) & 3) * 16 + fr;
#pragma unroll
                    for (int bj = 0; bj < 2; ++bj)
#pragma unroll
                        for (int n = 0; n < 2; ++n) rn[bj][n] = e.res(rown, u.pn * 256 + bj * 128 + wc * 32 + 8 * fq + 4 * n); }
#pragma unroll
                for (int bj = 0; bj < 2; ++bj) s += e.applyr8(row, u.pn * 256 + bj * 128 + wc * 32 + 8 * fq, acc[ai][bj][m][0], acc[ai][bj][m][1], rv, rc[bj][0], rc[bj][1]);
                if constexpr (E::HAS_SS) { s += __shfl_xor(s, 16); s += __shfl_xor(s, 32); if (fq == 0) atomicAdd(e.ss + row, s); }
                asm volatile("" ::: "memory");
#pragma unroll
                for (int bj = 0; bj < 2; ++bj)
#pragma unroll
                    for (int n = 0; n < 2; ++n) rc[bj][n] = rn[bj][n];
            }
            return;
        }
        if constexpr (E::PERM && !E::HAS_RES) {
#pragma unroll
            for (int ai = 0; ai < 2; ++ai)
#pragma unroll
                for (int m = 0; m < 4; ++m) {
                    const int row = u.pm * 256 + ai * 128 + wr * 64 + m * 16 + fr; const float rv = e.rowval(row); float s = 0.f;
#pragma unroll
                    for (int bj = 0; bj < 2; ++bj) s += e.apply8(row, u.pn * 256 + bj * 128 + wc * 32 + 8 * fq, acc[ai][bj][m][0], acc[ai][bj][m][1], rv);
                    if constexpr (E::HAS_SS) { s += __shfl_xor(s, 16); s += __shfl_xor(s, 32); if (fq == 0) atomicAdd(e.ss + row, s); }
                    asm volatile("" ::: "memory");
                }
            return;
        }
#pragma unroll
        for (int ai = 0; ai < 2; ++ai)
#pragma unroll
            for (int m = 0; m < 4; ++m) {
                const int row = u.pm * 256 + ai * 128 + wr * 64 + m * 16 + fr; const float rv = e.rowval(row); float s = 0.f;
#pragma unroll
                for (int bj = 0; bj < 2; ++bj)
#pragma unroll
                    for (int n = 0; n < 2; ++n) s += e.apply(row, u.pn * 256 + bj * 128 + wc * 32 + n * 16 + 4 * fq, acc[ai][bj][m][n], rv);
                if constexpr (E::HAS_SS) { s += __shfl_xor(s, 16); s += __shfl_xor(s, 32); if (fq == 0) atomicAdd(e.ss + row, s); }
                asm volatile("" ::: "memory");
            }
    }
    __device__ __forceinline__ void mid(f32x4 (&acc)[2][2][4][2], const pg8::Unit& u, int wr, int fr) const {
#pragma unroll
        for (int ai = 0; ai < 2; ++ai)
#pragma unroll
            for (int m = 0; m < 4; ++m) { const float r = e.kscale(u.pm * 256 + ai * 128 + wr * 64 + m * 16 + fr, 0);
#pragma unroll
                for (int bj = 0; bj < 2; ++bj)
#pragma unroll
                    for (int n = 0; n < 2; ++n) acc[ai][bj][m][n] = acc[ai][bj][m][n] * r; }
    }
};
__device__ __forceinline__ u32x2 pk4(f32x4 v) { u32x2 w; w.x = cvt_pk_bf16(v[0], v[1]); w.y = cvt_pk_bf16(v[2], v[3]); return w; }
__device__ __forceinline__ f32x4 up4(u32x2 w) { return (f32x4){bf_lo(w.x), bf_hi(w.x), bf_lo(w.y), bf_hi(w.y)}; }
__device__ __forceinline__ float ssq4(f32x4 v) { return (v[0] * v[0] + v[1] * v[1]) + (v[2] * v[2] + v[3] * v[3]); }

struct EIn {
    static constexpr bool HAS_RES = false, PERM = true; static constexpr bool MID = false, HAS_SS = false; float* ss; const float* rs0; bf16_t* Z;
    __device__ __forceinline__ float rowval(int row) const { return rs0[row]; }
    __device__ __forceinline__ float kscale(int, int) const { return 1.f; }
    __device__ __forceinline__ float apply(int row, int col, f32x4 v, float rv) const { *(u32x2*)(Z + (size_t)row * NZ + col) = pk4(v * rv); return 0.f; }
    __device__ __forceinline__ float apply8(int row, int col, f32x4 v0, f32x4 v1, float rv) const { u32x4 w; { const u32x2 a0 = pk4(v0 * rv), a1 = pk4(v1 * rv); w.x = a0.x; w.y = a0.y; w.z = a1.x; w.w = a1.y; } *(u32x4*)(Z + (size_t)row * NZ + col) = w; return 0.f; }
};
struct EGlu {
    static constexpr bool HAS_RES = false, PERM = true; static constexpr bool MID = false, HAS_SS = true; float* ss; const float* bglu; const bf16_t* YG; bf16_t* MG;
    __device__ __forceinline__ float rowval(int) const { return 0.f; }
    __device__ __forceinline__ float kscale(int, int) const { return 1.f; }
    __device__ __forceinline__ float apply(int row, int col, f32x4 v, float) const {
        const f32x4 b = *(const f32x4*)(bglu + col); const f32x4 yg = up4(*(const u32x2*)(YG + (size_t)row * DH + col)); f32x4 o;
#pragma unroll
        for (int j = 0; j < 4; ++j) o[j] = yg[j] * sigm(v[j] + b[j]);
        *(u32x2*)(MG + (size_t)row * DM + col) = pk4(o); return ssq4(o);
    }
    __device__ __forceinline__ float apply8(int row, int col, f32x4 v0, f32x4 v1, float) const {
        const f32x4 b0 = *(const f32x4*)(bglu + col), b1 = *(const f32x4*)(bglu + col + 4); const u32x4 yr = *(const u32x4*)(YG + (size_t)row * DH + col);
        const f32x4 y0 = up4((u32x2){yr.x, yr.y}), y1 = up4((u32x2){yr.z, yr.w}); f32x4 o0, o1;
#pragma unroll
        for (int j = 0; j < 4; ++j) { o0[j] = y0[j] * sigm(v0[j] + b0[j]); o1[j] = y1[j] * sigm(v1[j] + b1[j]); }
        u32x4 w; { const u32x2 a0 = pk4(o0), a1 = pk4(o1); w.x = a0.x; w.y = a0.y; w.z = a1.x; w.w = a1.y; } *(u32x4*)(MG + (size_t)row * DM + col) = w; return ssq4(o0) + ssq4(o1);
    }
};
struct EOut {
    static constexpr bool MID = true, HAS_SS = true; float* ss; const float* rat; const float* rsb; const float* xp; const float* xs; float* XO; bf16_t* AB;
    __device__ __forceinline__ float rowval(int row) const { return rsb[row]; }
    __device__ __forceinline__ float kscale(int row, int w) const { return w < 4 ? rat[row] : 1.f; }
    static constexpr bool HAS_RES = true, PERM = true;
    __device__ __forceinline__ f32x4 res(int row, int col) const { return __builtin_nontemporal_load((const f32x4*)(xp + (size_t)row * DM + col)); }
    __device__ __forceinline__ float applyr8(int row, int col, f32x4 v0, f32x4 v1, float rv, f32x4 r0, f32x4 r1) const {
        const f32x4 o0 = r0 + v0 * rv, o1 = r1 + v1 * rv; float* p = XO + (size_t)row * DM + col; *(f32x4*)p = o0; *(f32x4*)(p + 4) = o1;
        u32x4 w; { const u32x2 a0 = pk4(o0), a1 = pk4(o1); w.x = a0.x; w.y = a0.y; w.z = a1.x; w.w = a1.y; } *(u32x4*)(AB + (size_t)row * DM + col) = w; return ssq4(o0) + ssq4(o1); }
    __device__ __forceinline__ float applyr(int row, int col, f32x4 v, float rv, f32x4 r) const {
        const f32x4 o = r + v * rv;
        *(f32x4*)(XO + (size_t)row * DM + col) = o; *(u32x2*)(AB + (size_t)row * DM + col) = pk4(o); return ssq4(o); }
    __device__ __forceinline__ float apply(int row, int col, f32x4 v, float rv) const {
        const float* xr = row < MP ? xp + (size_t)row * DM : xs + (size_t)(row - MP) * DM;
        const f32x4 o = *(const f32x4*)(xr + col) + v * rv;
        *(f32x4*)(XO + (size_t)row * DM + col) = o; *(u32x2*)(AB + (size_t)row * DM + col) = pk4(o); return ssq4(o);
    }
};
struct EUp {
    static constexpr bool HAS_RES = false, PERM = true; static constexpr bool MID = false, HAS_SS = false; float* ss; const float* ss1; bf16_t* HUP;
    __device__ __forceinline__ float rowval(int row) const { return rsqrtf(ss1[row] * (1.f / DM) + EPS); }
    __device__ __forceinline__ float kscale(int, int) const { return 1.f; }
    __device__ __forceinline__ float apply(int row, int col, f32x4 v, float rv) const { f32x4 o;
#pragma unroll
        for (int j = 0; j < 4; ++j) { const float r = fmaxf(v[j] * rv, 0.f); o[j] = r * r; }
        *(u32x2*)(HUP + (size_t)row * DFF + col) = pk4(o); return 0.f; }
    __device__ __forceinline__ float apply8(int row, int col, f32x4 v0, f32x4 v1, float rv) const { f32x4 o0, o1;
#pragma unroll
        for (int j = 0; j < 4; ++j) { const float r0 = fmaxf(v0[j] * rv, 0.f), r1 = fmaxf(v1[j] * rv, 0.f); o0[j] = r0 * r0; o1[j] = r1 * r1; }
        u32x4 w; { const u32x2 a0 = pk4(o0), a1 = pk4(o1); w.x = a0.x; w.y = a0.y; w.z = a1.x; w.w = a1.y; } *(u32x4*)(HUP + (size_t)row * DFF + col) = w; return 0.f; }
};
struct EDown {
    static constexpr bool MID = false, HAS_SS = true; float* ss; float* XO; bf16_t* AB;
    __device__ __forceinline__ float rowval(int) const { return 0.f; }
    __device__ __forceinline__ float kscale(int, int) const { return 1.f; }
    static constexpr bool HAS_RES = true, PERM = true;
    __device__ __forceinline__ f32x4 res(int row, int col) const { return *(const f32x4*)(XO + (size_t)row * DM + col); }
    __device__ __forceinline__ float applyr8(int row, int col, f32x4 v0, f32x4 v1, float, f32x4 r0, f32x4 r1) const {
        const f32x4 o0 = r0 + v0, o1 = r1 + v1; float* p = XO + (size_t)row * DM + col; *(f32x4*)p = o0; *(f32x4*)(p + 4) = o1;
        u32x4 w; { const u32x2 a0 = pk4(o0), a1 = pk4(o1); w.x = a0.x; w.y = a0.y; w.z = a1.x; w.w = a1.y; } *(u32x4*)(AB + (size_t)row * DM + col) = w; return ssq4(o0) + ssq4(o1); }
    __device__ __forceinline__ float applyr(int row, int col, f32x4 v, float, f32x4 r) const {
        const f32x4 o = r + v; *(f32x4*)(XO + (size_t)row * DM + col) = o; *(u32x2*)(AB + (size_t)row * DM + col) = pk4(o); return ssq4(o); }
    __device__ __forceinline__ float apply(int row, int col, f32x4 v, float) const {
        float* p = XO + (size_t)row * DM + col; const f32x4 o = *(const f32x4*)p + v; *(f32x4*)p = o; *(u32x2*)(AB + (size_t)row * DM + col) = pk4(o); return ssq4(o); }
};
struct EPw {
    static constexpr bool HAS_RES = false, PERM = true; static constexpr bool MID = false, HAS_SS = false; float* ss; bf16_t* PW;
    __device__ __forceinline__ float rowval(int) const { return 0.f; }
    __device__ __forceinline__ float kscale(int, int) const { return 1.f; }
    __device__ __forceinline__ float apply(int row, int col, f32x4 v, float) const { *(u32x2*)(PW + (size_t)row * DM + col) = pk4(v); return 0.f; }
    __device__ __forceinline__ float apply8(int row, int col, f32x4 v0, f32x4 v1, float) const { u32x4 w; { const u32x2 a0 = pk4(v0), a1 = pk4(v1); w.x = a0.x; w.y = a0.y; w.z = a1.x; w.w = a1.y; } *(u32x4*)(PW + (size_t)row * DM + col) = w; return 0.f; }
};
struct EGate {
    static constexpr bool MID = false, HAS_SS = true; float* ss; const float* ss2; const bf16_t* PW; float* XO;
    __device__ __forceinline__ float rowval(int row) const { return rsqrtf(ss2[row] * (1.f / DM) + EPS); }
    __device__ __forceinline__ float kscale(int, int) const { return 1.f; }
    static constexpr bool HAS_RES = true, PERM = true;
    __device__ __forceinline__ f32x4 res(int row, int col) const { return *(const f32x4*)(XO + (size_t)row * DM + col); }
    __device__ __forceinline__ float applyr8(int row, int col, f32x4 v0, f32x4 v1, float rv, f32x4 r0, f32x4 r1) const {
        const u32x4 pr = *(const u32x4*)(PW + (size_t)row * DM + col); const f32x4 p0 = up4((u32x2){pr.x, pr.y}), p1 = up4((u32x2){pr.z, pr.w}); f32x4 o0 = r0, o1 = r1;
#pragma unroll
        for (int j = 0; j < 4; ++j) { o0[j] += p0[j] * sigm(v0[j] * rv); o1[j] += p1[j] * sigm(v1[j] * rv); }
        float* p = XO + (size_t)row * DM + col; *(f32x4*)p = o0; *(f32x4*)(p + 4) = o1; return ssq4(o0) + ssq4(o1); }
    __device__ __forceinline__ float applyr(int row, int col, f32x4 v, float rv, f32x4 r) const {
        f32x4 o = r; const f32x4 pw = up4(*(const u32x2*)(PW + (size_t)row * DM + col));
#pragma unroll
        for (int j = 0; j < 4; ++j) o[j] += pw[j] * sigm(v[j] * rv);
        *(f32x4*)(XO + (size_t)row * DM + col) = o; return ssq4(o); }
    __device__ __forceinline__ float apply(int row, int col, f32x4 v, float rv) const {
        float* p = XO + (size_t)row * DM + col; f32x4 o = *(const f32x4*)p; const f32x4 pw = up4(*(const u32x2*)(PW + (size_t)row * DM + col));
#pragma unroll
        for (int j = 0; j < 4; ++j) o[j] += pw[j] * sigm(v[j] * rv);
        *(f32x4*)p = o; return ssq4(o); }
};
__device__ __forceinline__ float em1(float x) {
    float p = x * (1.f + x * (0.5f + x * (0.16666667f + x * (0.041666668f + x * (0.0083333338f + x * (0.0013888889f + x * 0.0001984127f))))));
    if (__builtin_expect(__any(fabsf(x) >= 0.5f), 0)) p = fabsf(x) < 0.5f ? p : __expf(x) - 1.f;
    return p;
}
struct ELru {
    static constexpr bool MID = false, PERM = false; const bf16_t* XC; const float* ba; const float* bi; const float* spl; float* Ao; float* Bo;
    __device__ __forceinline__ void mid(f32x4 (&)[2][2][4][2], const pg8::Unit&, int, int) const {}
    __device__ __forceinline__ void operator()(const f32x4 (&acc)[2][2][4][2], const pg8::Unit& u, int wr, int wc, int fr, int fq) const {
#pragma unroll
        for (int n = 0; n < 2; ++n) {
            const int ch = (u.pn >> 1) * 256 + (u.pn & 1) * 128 + wc * 32 + n * 16 + 4 * fq;
            const f32x4 bav = *(const f32x4*)(ba + ch), biv = *(const f32x4*)(bi + ch), sp = *(const f32x4*)(spl + ch);
#pragma unroll
            for (int ai = 0; ai < 2; ++ai)
#pragma unroll
                for (int m = 0; m < 4; ++m) {
                    const int row = u.pm * 256 + ai * 128 + wr * 64 + m * 16 + fr;
                    const f32x4 xc = up4(*(const u32x2*)(XC + (size_t)row * DH + ch)); f32x4 av, bv;
#pragma unroll
                    for (int j = 0; j < 4; ++j) { const float r = sigm(acc[ai][0][m][n][j] + bav[j]), ig = sigm(acc[ai][1][m][n][j] + biv[j]);
                        const float la = r * sp[j]; av[j] = 1.f + em1(la); bv[j] = __builtin_amdgcn_sqrtf(fmaxf(-em1(2.f * la), 0.f)) * ig * xc[j]; }
                    *(f32x4*)(Ao + (size_t)row * DH + ch) = av; *(f32x4*)(Bo + (size_t)row * DH + ch) = bv;
                    asm volatile("" ::: "memory");
                }
        }
    }
};

template <class E, int MT = 8, int NG = 1>
__device__ __forceinline__ void skinny_gemm(LAS unsigned char* lds, const bf16_t* A, int lda, const bf16_t* Bt, int ldb, int N, int K, const E& e, int nb = 0) {
    const int tid = threadIdx.x, wid = __builtin_amdgcn_readfirstlane(tid >> 6), lane = tid & 63, fr = lane & 15, fq = lane >> 4;
    LAS f32x4* red = (LAS f32x4*)lds;
    constexpr int NH = 8 / MT;
    const int kw = K >> 3, k0w = wid * kw, nks = kw >> 5, nit = ((N >> 4) / NG) * NH, G = gridDim.x, NBk = nb ? nb : G;
    for (int iti = G - 1 - (int)blockIdx.x; iti < nit && (G - 1 - (int)blockIdx.x) < NBk; iti += NBk) {
        const int n0 = (iti / NH) * (16 * NG), r0 = (iti % NH) * (MT * 16);
        f32x4 acc[NG][MT];
#pragma unroll
        for (int q = 0; q < NG; ++q)
#pragma unroll
            for (int m = 0; m < MT; ++m) acc[q][m] = (f32x4){0.f, 0.f, 0.f, 0.f};
        const bf16_t* bp = Bt + (size_t)(n0 + fr) * ldb + k0w + 8 * fq;
        const bf16_t* ap = A + (size_t)(r0 + fr) * lda + k0w + 8 * fq;
        {
            bf16x8 bc[NG], ac[MT];
#pragma unroll
            for (int q = 0; q < NG; ++q) bc[q] = *(const bf16x8*)(bp + (size_t)(16 * q) * ldb);
#pragma unroll
            for (int m = 0; m < MT; ++m) ac[m] = *(const bf16x8*)(ap + (size_t)(16 * m) * lda);
            for (int ks = 0; ks < nks; ++ks) {
                const int kn = ks + 1 < nks ? ks + 1 : ks;
                bf16x8 bn[NG], an[MT];
#pragma unroll
                for (int q = 0; q < NG; ++q) bn[q] = *(const bf16x8*)(bp + (size_t)(16 * q) * ldb + 32 * kn);
#pragma unroll
                for (int m = 0; m < MT; ++m) an[m] = *(const bf16x8*)(ap + (size_t)(16 * m) * lda + 32 * kn);
#pragma unroll
                for (int q = 0; q < NG; ++q)
#pragma unroll
                    for (int m = 0; m < MT; ++m) acc[q][m] = __builtin_amdgcn_mfma_f32_16x16x32_bf16(bc[q], ac[m], acc[q][m], 0, 0, 0);
#pragma unroll
                for (int q = 0; q < NG; ++q) bc[q] = bn[q];
#pragma unroll
                for (int m = 0; m < MT; ++m) ac[m] = an[m];
            }
        }
#pragma unroll
        for (int q = 0; q < NG; ++q)
#pragma unroll
            for (int m = 0; m < MT; ++m) red[((wid * NG + q) * MT + m) * 64 + lane] = acc[q][m];
        __syncthreads();
        if (wid < MT) {
            const int row = MP + r0 + 16 * wid + fr; const float rv = e.rowval(row);
#pragma unroll
            for (int q = 0; q < NG; ++q) {
                f32x4 v = (f32x4){0.f, 0.f, 0.f, 0.f};
#pragma unroll
                for (int w = 0; w < 8; ++w) { f32x4 p = red[((w * NG + q) * MT + wid) * 64 + lane]; if constexpr (E::MID) p = p * e.kscale(row, w); v += p; }
                float s = e.apply(row, n0 + 16 * q + 4 * fq, v, rv);
                if constexpr (E::HAS_SS) { s += __shfl_xor(s, 16); s += __shfl_xor(s, 32); if (fq == 0) atomicAdd(e.ss + row, s); }
            }
        }
        __syncthreads();
    }
}

struct Args { const float* in[37]; float* out; unsigned char* ws; int ph_lo, ph_hi; };
enum { I_XP = 0, I_XS, I_S5RE, I_S5IM, I_LRUH, I_CONV, I_PP, I_PS, I_GMIX, I_WIN, I_LAMRE, I_LAMIM, I_LOGSTEP, I_BRE, I_BIM, I_CRE, I_CIM, I_S5D,
       I_WGLU, I_BGLU, I_CONVW, I_CONVB, I_WA, I_BA, I_WI, I_BI, I_LAM, I_GMA, I_GMB, I_WOUT, I_GMLP, I_WUP, I_WDOWN, I_GPLE, I_WGATE, I_WPLE, I_GFIN };

__device__ __forceinline__ void tr_item(const float* W, int K, int N, bf16_t* WT, int rbase, int lru, const float* g1, const float* g2, int gsplit,
                                        LAS float* scr, int item, int lane) {
    const int nblk = N / 32, kb = item / nblk, nb = item % nblk, k0 = 64 * kb, n0 = 32 * nb;
    f32x4 wv[8];
#pragma unroll
    for (int i = 0; i < 8; ++i) wv[i] = __builtin_nontemporal_load((const f32x4*)(W + (size_t)(k0 + 8 * i + (lane >> 3)) * N + n0 + 4 * (lane & 7)));
#pragma unroll
    for (int i = 0; i < 8; ++i) { const int kk = 8 * i + (lane >> 3), k = k0 + kk; const float gv = g1 ? (k < gsplit ? g1[k] : g2[k - gsplit]) : 1.f;
        LAS float* d = scr + kk * 33 + 4 * (lane & 7); d[0] = wv[i][0] * gv; d[1] = wv[i][1] * gv; d[2] = wv[i][2] * gv; d[3] = wv[i][3] * gv; }
    LDS_WAIT();
    const int c = lane & 7;
#pragma unroll
    for (int j = 0; j < 4; ++j) { const int n = (lane >> 3) + 8 * j, nn = n0 + n; const int drow = lru ? rbase + (nn >> 7) * 256 + (nn & 127) : rbase + nn;
        const LAS float* s = scr + (8 * c) * 33 + n;
        u32x4 o; o.x = cvt_pk_bf16(s[0 * 33], s[1 * 33]); o.y = cvt_pk_bf16(s[2 * 33], s[3 * 33]); o.z = cvt_pk_bf16(s[4 * 33], s[5 * 33]); o.w = cvt_pk_bf16(s[6 * 33], s[7 * 33]);
        *(u32x4*)(WT + (size_t)drow * K + k0 + 8 * c) = o; }
    LDS_WAIT();
}

__device__ __forceinline__ void phase0(const Args& a, LAS unsigned char* lds) {
    const int tid = threadIdx.x, wave = __builtin_amdgcn_readfirstlane(tid >> 6), lane = tid & 63, G = gridDim.x;
    unsigned char* ws = a.ws;
    LAS float* scr = (LAS float*)(lds + wave * 16384);
    const int gw = blockIdx.x * 8 + wave, NGW = G * 8;
    constexpr int I_IN = 32 * 96, I_UP = 32 * 256, I_DOWN = 4096  , I_LRU = 8 * 32;
    constexpr int NITEMS = I_IN + I_UP + I_DOWN + I_LRU;
    for (int it = gw; it < NITEMS; it += NGW) {
        int r = it;
        if (r < I_UP) { tr_item(a.in[I_WUP], DM, DFF, (bf16_t*)(ws + WS_WUP), 0, 0, a.in[I_GMLP], a.in[I_GMLP], 1 << 30, scr, r, lane); continue; } r -= I_UP;
        if (r < I_DOWN) { tr_item(a.in[I_WDOWN], DFF, DM, (bf16_t*)(ws + WS_WDOWN), 0, 0, nullptr, nullptr, 0, scr, r, lane); continue; } r -= I_DOWN;
        if (r < I_IN) { tr_item(a.in[I_WIN], DM, NZ, (bf16_t*)(ws + WS_WIN), 0, 0, a.in[I_GMIX], a.in[I_GMIX], 1 << 30, scr, r, lane); continue; } r -= I_IN;
        { const int mat = r >> 5, h = mat >> 1, bj = mat & 1;
          tr_item((bj ? a.in[I_WI] : a.in[I_WA]) + (size_t)h * 65536, 256, 256, (bf16_t*)(ws + WS_WLRU), h * 512 + bj * 128, 1, nullptr, nullptr, 0, scr, r & 31, lane); }
    }
    float* rs0 = (float*)(ws + WS_SMALL + SM_RS0); bf16_t* XB = (bf16_t*)(ws + WS_AB); bf16_t* PB = (bf16_t*)(ws + WS_PB);
    for (int row = gw; row < MT; row += NGW) {
        const float* xr = row < MP ? a.in[I_XP] + (size_t)row * DM : a.in[I_XS] + (size_t)(row - MP) * DM;
        f32x4 v[8]; float s = 0.f;
#pragma unroll
        for (int j = 0; j < 8; ++j) { v[j] = __builtin_nontemporal_load((const f32x4*)xr + lane + 64 * j); s += ssq4(v[j]); }
        s = wave_sum(s); if (lane == 0) rs0[row] = rsqrtf(s * (1.f / DM) + EPS);
#pragma unroll
        for (int j = 0; j < 8; ++j) ((u32x2*)(XB + (size_t)row * DM))[lane + 64 * j] = pk4(v[j]);
        const float* pr = row < MP ? a.in[I_PP] + (size_t)row * DPLE : a.in[I_PS] + (size_t)(row - MP) * DPLE;
        ((u32x2*)(PB + (size_t)row * DPLE))[lane] = pk4(__builtin_nontemporal_load((const f32x4*)pr + lane));
    }
    { float* SPL = (float*)(ws + WS_SMALL + SM_SPL);
      for (int i = blockIdx.x * 512 + tid; i < DH; i += G * 512) { const float xl = -a.in[I_LAM][i]; SPL[i] = -8.f * (fmaxf(xl, 0.f) + log1pf(expf(-fabsf(xl)))); } }
    float* AR = (float*)(ws + WS_SMALL + SM_AR); float* AI = (float*)(ws + WS_SMALL + SM_AI); float* A64R = (float*)(ws + WS_SMALL + SM_A64R); float* A64I = (float*)(ws + WS_SMALL + SM_A64I);
    bf16_t* BBB = (bf16_t*)(ws + WS_SMALL + SM_BBB); bf16_t* CMB = (bf16_t*)(ws + WS_SMALL + SM_CMB);
    for (int i = blockIdx.x * 512 + tid; i < 4096; i += G * 512) {
        const int g = i >> 6, p = i & 63;
        const float step = expf(a.in[I_LOGSTEP][g]), lr = a.in[I_LAMRE][i], li = a.in[I_LAMIM][i];
        const float mag = expf(lr * step); float sn, cs; sincosf(li * step, &sn, &cs);
        const float ar = mag * cs, ai = mag * sn, nr = ar - 1.f, ni = ai, den = lr * lr + li * li;
        const float cr = (nr * lr + ni * li) / den, ci = (ni * lr - nr * li) / den;
        AR[i] = ar; AI[i] = ai;
        float pr_ = ar, pi_ = ai;
#pragma unroll
        for (int q = 0; q < 6; ++q) { const float t0 = pr_ * pr_ - pi_ * pi_, t1 = 2.f * pr_ * pi_; pr_ = t0; pi_ = t1; }
        A64R[i] = pr_; A64I[i] = pi_;
        for (int c = 0; c < 16; ++c) {
            const float br = a.in[I_BRE][(size_t)i * 16 + c], bi = a.in[I_BIM][(size_t)i * 16 + c];
            BBB[((size_t)g * 128 + p) * 16 + c] = (bf16_t)(cvt_pk_bf16(cr * br - ci * bi, 0.f) & 0xffffu);
            BBB[((size_t)g * 128 + 64 + p) * 16 + c] = (bf16_t)(cvt_pk_bf16(cr * bi + ci * br, 0.f) & 0xffffu);
            CMB[((size_t)g * 16 + c) * 128 + p] = (bf16_t)(cvt_pk_bf16(a.in[I_CRE][((size_t)g * 16 + c) * 64 + p], 0.f) & 0xffffu);
            CMB[((size_t)g * 16 + c) * 128 + 64 + p] = (bf16_t)(cvt_pk_bf16(-a.in[I_CIM][((size_t)g * 16 + c) * 64 + p], 0.f) & 0xffffu);
        }
    }
}

__device__ __forceinline__ void s5_unit(const Args& a, LAS unsigned char* wl, int lane, int mode, int n, int g, int j) {
    unsigned char* ws = a.ws;
    const int fr = lane & 15, fq = lane >> 4;
    const float* AR = (const float*)(ws + WS_SMALL + SM_AR); const float* AI = (const float*)(ws + WS_SMALL + SM_AI);
    const bf16_t* BBB = (const bf16_t*)(ws + WS_SMALL + SM_BBB); const bf16_t* CMB = (const bf16_t*)(ws + WS_SMALL + SM_CMB);
    const bf16_t* Z = (const bf16_t*)(ws + WS_Z); bf16_t* YG = (bf16_t*)(ws + WS_YG); float* SUM = (float*)(ws + WS_S5SUM);
    LAS float* BuS = (LAS float*)wl; LAS bf16_t* Hs = (LAS bf16_t*)(wl + 8448);
    const float ar = AR[g * 64 + lane], ai = AI[g * 64 + lane];
    const bf16x8 zero8 = (bf16x8){0, 0, 0, 0, 0, 0, 0, 0};
    bf16x8 bb[8];
#pragma unroll
    for (int t = 0; t < 8; ++t) bb[t] = fq < 2 ? *(const bf16x8*)(BBB + ((size_t)g * 128 + 16 * t + fr) * 16 + 8 * fq) : zero8;
    bf16x8 cm[4];
#pragma unroll
    for (int kk = 0; kk < 4; ++kk) cm[kk] = *(const bf16x8*)(CMB + ((size_t)g * 16 + fr) * 128 + 32 * kk + 8 * fq);
    const f32x4 dsk = *(const f32x4*)(a.in[I_S5D] + 16 * g + 4 * fq);
    float hr = 0.f, hi = 0.f;
    if (mode == 1 && j > 0) {
        const float pr = ((const float*)(ws + WS_SMALL + SM_A64R))[g * 64 + lane], pi = ((const float*)(ws + WS_SMALL + SM_A64I))[g * 64 + lane];
        const float* sp = SUM + ((size_t)(n * 64 + g) * 32) * 128;
        for (int i = 0; i < j; ++i) { const float sr = sp[i * 128 + lane], si = sp[i * 128 + 64 + lane];
            const float t0 = pr * hr - pi * hi + sr, t1 = pr * hi + pi * hr + si; hr = t0; hi = t1; }
    }
    if (mode == 4 && j > 0) {
        float pr = ((const float*)(ws + WS_SMALL + SM_A64R))[g * 64 + lane], pi = ((const float*)(ws + WS_SMALL + SM_A64I))[g * 64 + lane];
#pragma unroll
        for (int q = 0; q < 2; ++q) { const float t0 = pr * pr - pi * pi, t1 = 2.f * pr * pi; pr = t0; pi = t1; }
        for (int v = 0; v < j; ++v) { const LAS float* ps = (const LAS float*)(wl + (v - j) * 16384 + 12800); const float sr = ps[lane], si = ps[64 + lane];
            const float t0 = pr * hr - pi * hi + sr, t1 = pr * hi + pi * hr + si; hr = t0; hi = t1; }
    }
    const int row0 = mode == 2 ? MP + 16 * j : ((mode == 3 || mode == 4) ? n * SEQ + 256 * j : n * SEQ + 64 * j);
    const int nblk = mode == 2 ? 1 : ((mode == 3 || mode == 1 || mode == 4) ? 16 : 4);
    for (int blk = 0; blk < nblk; ++blk) {
        const int r0 = row0 + 16 * blk;
        const bf16x8 ua = fq < 2 ? *(const bf16x8*)(Z + (size_t)(r0 + fr) * NZ + 16 * g + 8 * fq) : zero8;
        u32x2 u4raw = (u32x2){0u, 0u}; if (mode == 1 || mode == 2 || mode == 4) u4raw = *(const u32x2*)(Z + (size_t)(r0 + fr) * NZ + 16 * g + 4 * fq);
#pragma unroll
        for (int t = 0; t < 8; ++t) {
            const f32x4 c = __builtin_amdgcn_mfma_f32_16x16x32_bf16(ua, bb[t], (f32x4){0.f, 0.f, 0.f, 0.f}, 0, 0, 0);
#pragma unroll
            for (int jj = 0; jj < 4; ++jj) BuS[(4 * fq + jj) * 132 + 16 * t + fr] = c[jj];
        }
        LDS_WAIT();
        float burv[16], buiv[16];
#pragma unroll
        for (int t = 0; t < 16; ++t) { burv[t] = BuS[t * 132 + lane]; buiv[t] = BuS[t * 132 + 64 + lane]; }
#pragma unroll
        for (int t = 0; t < 16; ++t) {
            const float bur = burv[t], bui = buiv[t];
            if (mode == 2) { const size_t si = ((size_t)(r0 - MP + t) * 64 + g) * 64 + lane; hr = a.in[I_S5RE][si]; hi = a.in[I_S5IM][si]; }
            const float t0 = ar * hr - ai * hi + bur, t1 = ar * hi + ai * hr + bui; hr = t0; hi = t1;
            if (mode == 2) { const size_t si = ((size_t)(r0 - MP + t) * 64 + g) * 64 + lane; a.out[O_S5RS + si] = hr; a.out[O_S5IS + si] = hi; }
            if (mode == 1 || mode == 2 || mode == 4) { const unsigned w = cvt_pk_bf16(hr, hi); Hs[t * 136 + lane] = (bf16_t)(w & 0xffffu); Hs[t * 136 + 64 + lane] = (bf16_t)(w >> 16); }
        }
        if (mode == 1 || mode == 2 || mode == 4) {
            LDS_WAIT();
            f32x4 y = (f32x4){0.f, 0.f, 0.f, 0.f};
#pragma unroll
            for (int kk = 0; kk < 4; ++kk) { const bf16x8 hb = *(const LAS bf16x8*)(Hs + fr * 136 + 32 * kk + 8 * fq);
                y = __builtin_amdgcn_mfma_f32_16x16x32_bf16(cm[kk], hb, y, 0, 0, 0); }
            const f32x4 u4 = up4(u4raw); f32x4 o;
#pragma unroll
            for (int jj = 0; jj < 4; ++jj) o[jj] = gelu_t(y[jj] + dsk[jj] * u4[jj]);
            *(u32x2*)(YG + (size_t)(r0 + fr) * DH + 16 * g + 4 * fq) = pk4(o);
            LDS_WAIT();
        }
    }
    if (mode == 0) { float* sp = SUM + ((size_t)(n * 64 + g) * 32 + j) * 128; sp[lane] = hr; sp[64 + lane] = hi; }
    if (mode == 3) { LAS float* ps = (LAS float*)(wl + 12800); ps[lane] = hr; ps[64 + lane] = hi; }
    if (mode == 4 && j == 7) { a.out[O_S5RP + (size_t)(n * 64 + g) * 64 + lane] = hr; a.out[O_S5IP + (size_t)(n * 64 + g) * 64 + lane] = hi; }
}

__device__ __forceinline__ void conv_prompt(const Args& a) {
    unsigned char* ws = a.ws; const bf16_t* Z = (const bf16_t*)(ws + WS_Z); bf16_t* XC = (bf16_t*)(ws + WS_XC);
    const float* cw = a.in[I_CONVW]; const float* cb = a.in[I_CONVB];
    const int G = gridDim.x;
    for (int it = blockIdx.x * 512 + threadIdx.x; it < MP * 128; it += G * 512) {
        const int row = it >> 7, c = (it & 127) * 8, t = row & (SEQ - 1);
        float acc[8];
#pragma unroll
        for (int q = 0; q < 8; ++q) acc[q] = cb[c + q];
#pragma unroll
        for (int k = 0; k < 4; ++k) {
            if (t - 3 + k >= 0) {
                const u32x4 z = *(const u32x4*)(Z + (size_t)(row - 3 + k) * NZ + DH + c);
                const float x[8] = {bf_lo(z.x), bf_hi(z.x), bf_lo(z.y), bf_hi(z.y), bf_lo(z.z), bf_hi(z.z), bf_lo(z.w), bf_hi(z.w)};
#pragma unroll
                for (int q = 0; q < 8; ++q) acc[q] += cw[k * DH + c + q] * x[q];
                if (k == 3 && t >= SEQ - 3) {
                    float* o = a.out + O_CONVP + ((size_t)(row >> 11) * 3 + (t - (SEQ - 3))) * DH + c;
#pragma unroll
                    for (int q = 0; q < 8; ++q) o[q] = x[q];
                }
            }
        }
        u32x4 o; o.x = cvt_pk_bf16(acc[0], acc[1]); o.y = cvt_pk_bf16(acc[2], acc[3]); o.z = cvt_pk_bf16(acc[4], acc[5]); o.w = cvt_pk_bf16(acc[6], acc[7]);
        *(u32x4*)(XC + (size_t)row * DH + c) = o;
    }
}

__device__ __forceinline__ void conv_tile(const Args& a, int pm, int h) {
    unsigned char* ws = a.ws; const bf16_t* Z = (const bf16_t*)(ws + WS_Z); bf16_t* XC = (bf16_t*)(ws + WS_XC);
    const int tid = threadIdx.x, c = h * 256 + (tid & 31) * 8;
    float cwv[4][8], cbv[8];
#pragma unroll
    for (int q = 0; q < 8; ++q) { cbv[q] = a.in[I_CONVB][c + q];
#pragma unroll
        for (int k = 0; k < 4; ++k) cwv[k][q] = a.in[I_CONVW][k * DH + c + q]; }
#pragma unroll 1
    for (int r4 = 0; r4 < 16; r4 += 4) {
        u32x4 z[4][4];
#pragma unroll
        for (int rr = 0; rr < 4; ++rr) { const int row = pm * 256 + (tid >> 5) + 16 * (r4 + rr), t = row & (SEQ - 1);
#pragma unroll
            for (int k = 0; k < 4; ++k) z[rr][k] = (t - 3 + k >= 0) ? *(const u32x4*)(Z + (size_t)(row - 3 + k) * NZ + DH + c) : (u32x4){0u, 0u, 0u, 0u}; }
#pragma unroll
        for (int rr = 0; rr < 4; ++rr) { const int row = pm * 256 + (tid >> 5) + 16 * (r4 + rr), t = row & (SEQ - 1);
            float acc[8];
#pragma unroll
            for (int q = 0; q < 8; ++q) acc[q] = cbv[q];
#pragma unroll
            for (int k = 0; k < 4; ++k) { const u32x4 zz = z[rr][k];
                const float x[8] = {bf_lo(zz.x), bf_hi(zz.x), bf_lo(zz.y), bf_hi(zz.y), bf_lo(zz.z), bf_hi(zz.z), bf_lo(zz.w), bf_hi(zz.w)};
#pragma unroll
                for (int q = 0; q < 8; ++q) acc[q] += cwv[k][q] * x[q];
                if (k == 3 && t >= SEQ - 3) { float* o = a.out + O_CONVP + ((size_t)(row >> 11) * 3 + (t - (SEQ - 3))) * DH + c;
#pragma unroll
                    for (int q = 0; q < 8; ++q) o[q] = x[q]; } }
            u32x4 o; o.x = cvt_pk_bf16(acc[0], acc[1]); o.y = cvt_pk_bf16(acc[2], acc[3]); o.z = cvt_pk_bf16(acc[4], acc[5]); o.w = cvt_pk_bf16(acc[6], acc[7]);
            *(u32x4*)(XC + (size_t)row * DH + c) = o; }
    }
}

__device__ __forceinline__ void lru_sample(const Args& a, LAS unsigned char* lds, int unit) {
    unsigned char* ws = a.ws; const bf16_t* Z = (const bf16_t*)(ws + WS_Z); bf16_t* MG = (bf16_t*)(ws + WS_MERGED); float* ssB = (float*)(ws + WS_CTL) + SS_B * SS_STRIDE;
    LAS float* sxc = (LAS float*)lds;
    const int tid = threadIdx.x, s = unit >> 1, half = unit & 1, row = MP + s;
    const float* cw = a.in[I_CONVW]; const float* cs = a.in[I_CONV] + (size_t)s * 3 * DH;
    for (int c = tid; c < DH; c += 512) {
        const float xb = bf1(Z[(size_t)row * NZ + DH + c]);
        sxc[c] = a.in[I_CONVB][c] + cw[c] * cs[c] + cw[DH + c] * cs[DH + c] + cw[2 * DH + c] * cs[2 * DH + c] + cw[3 * DH + c] * xb;
        if ((c >> 9) == half) { float* o = a.out + O_CONVS + (size_t)s * 3 * DH; o[c] = cs[DH + c]; o[DH + c] = cs[2 * DH + c]; o[2 * DH + c] = xb; }
    }
    __syncthreads();
    float sq = 0.f;
    {
        const int c = half * 512 + tid, h = c >> 8, jj = c & 255;
        const float* wa = a.in[I_WA] + (size_t)h * 65536 + jj; const float* wi = a.in[I_WI] + (size_t)h * 65536 + jj;
        float ra = a.in[I_BA][c], ri = a.in[I_BI][c];
#pragma unroll 1
        for (int k0 = 0; k0 < 256; k0 += 32) {
            float wav[32], wiv[32];
#pragma unroll
            for (int q = 0; q < 32; ++q) { wav[q] = wa[(size_t)(k0 + q) * 256]; wiv[q] = wi[(size_t)(k0 + q) * 256]; }
#pragma unroll
            for (int q = 0; q < 32; ++q) { const float x = sxc[h * 256 + k0 + q]; ra += x * wav[q]; ri += x * wiv[q]; }
        }
        const float r = sigm(ra), ig = sigm(ri); const float xl = -a.in[I_LAM][c]; const float sp = fmaxf(xl, 0.f) + log1pf(expf(-fabsf(xl)));
        const float la = -8.f * r * sp, av = expf(la), bv = sqrtf(-expm1f(2.f * la)) * ig * sxc[c];
        const float hn = av * a.in[I_LRUH][(size_t)s * DH + c] + bv;
        a.out[O_LRUS + (size_t)s * DH + c] = hn;
        const float o = hn * gelu_t(bf1(Z[(size_t)row * NZ + 2 * DH + c]));
        MG[(size_t)row * DM + DH + c] = (bf16_t)(cvt_pk_bf16(o, 0.f) & 0xffffu);
        sq = o * o;
    }
    sq = wave_sum(sq);
    if ((tid & 63) == 0) atomicAdd(ssB + row, sq);
    __syncthreads();
}

__device__ __forceinline__ void lru_scan_unit(const Args& a, LAS unsigned char* lds, int unit) {
    unsigned char* ws = a.ws; const bf16_t* Z = (const bf16_t*)(ws + WS_Z); bf16_t* MG = (bf16_t*)(ws + WS_MERGED); float* ssB = (float*)(ws + WS_CTL) + SS_B * SS_STRIDE;
    const float* Ao = a.out; const float* Bo = a.out + (size_t)MP * DH;
    LAS float* sP = (LAS float*)lds; LAS float* sH = sP + 512; LAS float* rsum = sH + 512;
    const int tid = threadIdx.x, n = unit >> 6, ch = (unit & 63) * 16 + (tid & 15), j = tid >> 4;
    const size_t r0 = (size_t)n * SEQ + 64 * j;
    float P = 1.f, h = 0.f;
#pragma unroll 1
    for (int tb = 0; tb < 64; tb += 16) {
        float av[16], bv[16];
#pragma unroll
        for (int q = 0; q < 16; ++q) { av[q] = Ao[(r0 + tb + q) * DH + ch]; bv[q] = Bo[(r0 + tb + q) * DH + ch]; }
#pragma unroll
        for (int q = 0; q < 16; ++q) { h = av[q] * h + bv[q]; P *= av[q]; }
    }
    sP[tid] = P; sH[tid] = h;
    __syncthreads();
    float H = 0.f;
    for (int i = 0; i < j; ++i) H = sP[i * 16 + (tid & 15)] * H + sH[i * 16 + (tid & 15)];
    h = H;
#pragma unroll 1
    for (int tb = 0; tb < 64; tb += 16) {
        float av[16], bv[16]; bf16_t gz[16];
#pragma unroll
        for (int q = 0; q < 16; ++q) { const size_t row = r0 + tb + q; av[q] = Ao[row * DH + ch]; bv[q] = Bo[row * DH + ch]; gz[q] = Z[row * NZ + 2 * DH + ch]; }
#pragma unroll
        for (int q = 0; q < 16; ++q) {
            const size_t row = r0 + tb + q;
            h = av[q] * h + bv[q];
            const float o = h * gelu_t(bf1(gz[q]));
            MG[row * DM + DH + ch] = (bf16_t)(cvt_pk_bf16(o, 0.f) & 0xffffu);
            float s = o * o; s += __shfl_xor(s, 1); s += __shfl_xor(s, 2); s += __shfl_xor(s, 4); s += __shfl_xor(s, 8);
            if ((tid & 15) == 0) rsum[64 * j + tb + q] = s;
        }
    }
    __syncthreads();
    for (int r = tid; r < SEQ; r += 512) atomicAdd(ssB + (size_t)n * SEQ + r, rsum[r]);
    if (j == 31) a.out[O_LRUP + (size_t)n * DH + ch] = h;
    __syncthreads();
}

#define XB_TMO      128
#define XB_XCNT(j)  (256  + 64 * (j))
#define XB_XSUB(j)  (1280 + 64 * (j))
#define XB_XGEN(j)  (2304 + 64 * (j))
#define XB_TOP      3328
#define XB_TOPGEN   3392
#define XB_SPIN_CAP (1u << 18)
__device__ __forceinline__ unsigned xb_ld(unsigned* p)              { return __hip_atomic_load(p, __ATOMIC_RELAXED, __HIP_MEMORY_SCOPE_AGENT); }
__device__ __forceinline__ unsigned xb_add(unsigned* p, unsigned v) { return __hip_atomic_fetch_add(p, v, __ATOMIC_RELAXED, __HIP_MEMORY_SCOPE_AGENT); }
__device__ __forceinline__ unsigned xb_xcc_id() { return (unsigned)__builtin_amdgcn_s_getreg((3 << 11) | 20) & 0xFu; }
#define XB_SPIN(cond, bar) do { unsigned _sp = 0; while (cond) { __builtin_amdgcn_s_sleep(1); \
    if ((++_sp & 255u) == 0u) { if (xb_ld(&(bar)[XB_TMO])) break; if (_sp > XB_SPIN_CAP) { atomicAdd(&(bar)[XB_TMO], 1u); break; } } } } while (0)
struct XcdBarrier { unsigned* bar; unsigned x; volatile LAS unsigned* st; };
__device__ __forceinline__ XcdBarrier xcd_barrier_post(unsigned* bar, volatile LAS unsigned* st) {
    XcdBarrier b; b.bar = bar; b.x = xb_xcc_id(); b.st = st;
    if (threadIdx.x == 0) (void)xb_add(&bar[XB_XCNT(b.x)], 1u);
    return b;
}
__device__ __forceinline__ void xcd_barrier_complete(unsigned* bar, unsigned x, unsigned& nloc, unsigned& nx) {
    const unsigned G = gridDim.x * gridDim.y * gridDim.z;
    unsigned sum, cnt, mine, sp = 0u;
    for (;;) {
        sum = 0u; cnt = 0u; mine = 0u;
#pragma unroll
        for (unsigned j = 0; j < 16; ++j) { const unsigned c = xb_ld(&bar[XB_XCNT(j)]); sum += c; cnt += (c > 0u) ? 1u : 0u; mine = (j == x) ? c : mine; }
        if (sum == G) break;
        __builtin_amdgcn_s_sleep(1);
        if ((++sp & 255u) == 0u) { if (xb_ld(&bar[XB_TMO])) break; if (sp > XB_SPIN_CAP) { atomicAdd(&bar[XB_TMO], 1u); break; } }
    }
    nloc = mine > 0u ? mine : 1u; nx = cnt > 0u ? cnt : 1u;
}
__device__ __forceinline__ void xcd_barrier(const XcdBarrier& b) {
    asm volatile("s_waitcnt vmcnt(0)" ::: "memory");
    __syncthreads();
    if (threadIdx.x == 0) {
        unsigned* bar = b.bar;
        __builtin_amdgcn_s_waitcnt(0);
        unsigned nloc = b.st[0], nx = b.st[1];
        if (nloc == 0u) { xcd_barrier_complete(bar, b.x, nloc, nx); b.st[0] = nloc; b.st[1] = nx; }
        const unsigned old = xb_add(&bar[XB_XSUB(b.x)], 1u);
        const unsigned gen = old / nloc;
        if (old + 1u == (gen + 1u) * nloc) {
            __builtin_amdgcn_fence(__ATOMIC_RELEASE, "agent");
            asm volatile("s_waitcnt vmcnt(0)" ::: "memory");
            const unsigned og = xb_add(&bar[XB_TOP], 1u);
            const unsigned tg = og / nx;
            if (og + 1u == (tg + 1u) * nx) xb_add(&bar[XB_TOPGEN], 1u);
            else XB_SPIN(xb_ld(&bar[XB_TOPGEN]) == tg, bar);
            __builtin_amdgcn_fence(__ATOMIC_ACQUIRE, "agent");
            xb_add(&bar[XB_XGEN(b.x)], 1u);
            asm volatile("s_waitcnt vmcnt(0)" ::: "memory");
        } else {
            XB_SPIN(xb_ld(&bar[XB_XGEN(b.x)]) == gen, bar);
            __builtin_amdgcn_fence(__ATOMIC_ACQUIRE, "agent");
            asm volatile("s_waitcnt vmcnt(0)" ::: "memory");
        }
    }
    __syncthreads();
}

__global__ void __launch_bounds__(512, 2) fwd_kernel(Args a) {
    extern __shared__ __attribute__((aligned(16))) unsigned char lds_raw[];
    LAS unsigned char* lds = (LAS unsigned char*)lds_raw;
    const int tid = threadIdx.x, wave = __builtin_amdgcn_readfirstlane(tid >> 6), lane = tid & 63, G = gridDim.x;
    unsigned char* ws = a.ws;
    const int lo = a.ph_lo, hi = a.ph_hi;
    volatile LAS unsigned* MISC = (volatile LAS unsigned*)(lds + MISC_OFF);
    for (int u = tid; u < (LDS_BYTES - RING_BYTES) / 4; u += 512) ((LAS unsigned*)(lds + RING_BYTES))[u] = 0u;
    __syncthreads();
#if MK_LAUNCHES == 1
    XcdBarrier bar = xcd_barrier_post((unsigned*)(ws + WS_CTL) + CW_BAR, MISC + 8);
#define GRID_BAR() xcd_barrier(bar)
#else
#define GRID_BAR() do {} while (0)
#endif
#define IN(k) (lo <= (k) && (k) < hi)
#define BOTH(k) (IN(k) && IN((k) + 1))
#define ssb ((float*)(ws + WS_CTL))
#define AB ((bf16_t*)(ws + WS_AB))
#define Z ((bf16_t*)(ws + WS_Z))
#define YG ((bf16_t*)(ws + WS_YG))
#define MG ((bf16_t*)(ws + WS_MERGED))
#define HUP ((bf16_t*)(ws + WS_HUP))
#define PW ((bf16_t*)(ws + WS_PW))
#define PB ((bf16_t*)(ws + WS_PB))
#define XO (a.out + O_Y)

    if (IN(0)) { phase0(a, lds); if (BOTH(0)) GRID_BAR(); }

    if (IN(1)) {
        pg8::Gemm g{AB, (const bf16_t*)(ws + WS_WIN), DM, DM, DM, 0}; pg8::StaticOrder S; S.init(MP / 256, NZ / 256, G, (int)blockIdx.x);
        EpiWrap<EIn> E{{nullptr, (const float*)(ws + WS_SMALL + SM_RS0), Z}};
        pg8::gemm_phase<EpiWrap<EIn>, true>(lds, g, S, E);
        skinny_gemm<EIn, 8, 2>(lds, AB + (size_t)MP * DM, DM, (const bf16_t*)(ws + WS_WIN), DM, NZ, DM, E.e, G / 2);
        if ((int)blockIdx.x >= G / 2) {
            const int w = ((int)blockIdx.x - G / 2) * 8 + wave, nw = (G - G / 2) * 8; LAS float* scr = (LAS float*)(lds + wave * 16384);
            constexpr int J_OUT = 32 * 64, J_GATE = 32 * 64, J_GLU = 16 * 32, J_PLE = 4 * 64;
            for (int it = w; it < J_OUT + J_GATE + J_GLU + J_PLE; it += nw) {
                int r = it;
                if (r < J_OUT) { tr_item(a.in[I_WOUT], DM, DM, (bf16_t*)(ws + WS_WOUT), 0, 0, a.in[I_GMA], a.in[I_GMB], DH, scr, r, lane); continue; } r -= J_OUT;
                if (r < J_GATE) { tr_item(a.in[I_WGATE], DM, DM, (bf16_t*)(ws + WS_WGATE), 0, 0, a.in[I_GPLE], a.in[I_GPLE], 1 << 30, scr, r, lane); continue; } r -= J_GATE;
                if (r < J_GLU) { tr_item(a.in[I_WGLU], DH, DH, (bf16_t*)(ws + WS_WGLU), 0, 0, nullptr, nullptr, 0, scr, r, lane); continue; } r -= J_GLU;
                tr_item(a.in[I_WPLE], DPLE, DM, (bf16_t*)(ws + WS_WPLE), 0, 0, nullptr, nullptr, 0, scr, r, lane);
            }
        }
        if (BOTH(1)) GRID_BAR();
    }

    if (IN(3)) {
        pg8::Gemm g{(const bf16_t*)(ws + WS_XC), (const bf16_t*)(ws + WS_WLRU), DH, 256, 256, 1}; pg8::StaticOrder S; S.init(MP / 256, 8, G, (int)blockIdx.x);
        { pg8::Unit cu; for (int i = 0; S.next(i, cu); ++i) conv_tile(a, cu.pm, cu.pn >> 1); }
        asm volatile("s_waitcnt vmcnt(0)" ::: "memory"); __syncthreads();
        ELru E{(const bf16_t*)(ws + WS_XC), a.in[I_BA], a.in[I_BI], (const float*)(ws + WS_SMALL + SM_SPL), a.out, a.out + (size_t)MP * DH};
        pg8::gemm_phase<ELru, true>(lds, g, S, E);
        for (int s = G - 1 - (int)blockIdx.x; s < 2 * MS; s += G) lru_sample(a, lds, s);
        for (int u = blockIdx.x; u < NB * 64; u += G) {
            const int n = u >> 6, g2 = u & 63;
            s5_unit(a, lds + wave * 16384, lane, 3, n, g2, wave);
            __syncthreads();
            s5_unit(a, lds + wave * 16384, lane, 4, n, g2, wave);
            __syncthreads();
        }
        for (int u = blockIdx.x * 8 + wave; u < 512; u += G * 8) s5_unit(a, lds + wave * 16384, lane, 2, 0, u >> 3, u & 7);
        if (BOTH(3)) GRID_BAR();
    }

    if (IN(4)) {
        pg8::Gemm g{YG, (const bf16_t*)(ws + WS_WGLU), DH, DH, DH, 0}; pg8::StaticOrder S; S.init(MP / 256, DH / 256, G, (int)blockIdx.x);
        EpiWrap<EGlu> E{{ssb + SS_A * SS_STRIDE, a.in[I_BGLU], YG, MG}};
        pg8::gemm_phase<EpiWrap<EGlu>, true>(lds, g, S, E);
        skinny_gemm<EGlu, 4>(lds, YG + (size_t)MP * DH, DH, (const bf16_t*)(ws + WS_WGLU), DH, DH, DH, E.e);
        for (int u = G - 1 - (int)blockIdx.x; u < NB * 64; u += G) lru_scan_unit(a, lds, u);
        if ((int)blockIdx.x >= G / 2) {
            const int w = ((int)blockIdx.x - G / 2) * 8 + wave, nw = (G - G / 2) * 8;
            for (int it = 4096 + w; it < 128 * 64; it += nw) tr_item(a.in[I_WDOWN], DFF, DM, (bf16_t*)(ws + WS_WDOWN), 0, 0, nullptr, nullptr, 0, (LAS float*)(lds + wave * 16384), it, lane);
        }
        if (BOTH(4)) GRID_BAR();
    }

    if (IN(5)) {
        pg8::Gemm g{MG, (const bf16_t*)(ws + WS_WOUT), DM, DM, DM, 0}; pg8::StaticOrder S; S.init(MP / 256, DM / 256, G, (int)blockIdx.x);
        { float* RAT = (float*)(ws + WS_SMALL + SM_RAT); float* RSB = (float*)(ws + WS_SMALL + SM_RSB);
          pg8::Unit cu;
          for (int ui = -1; ui < 0 || S.next(ui, cu); ++ui)
              for (int i = tid; i < (ui < 0 ? MS : 256); i += 512) { const int row = ui < 0 ? MP + i : cu.pm * 256 + i;
                  const float va = ssb[SS_A * SS_STRIDE + row] * (1.f / DH) + EPS, vb = ssb[SS_B * SS_STRIDE + row] * (1.f / DH) + EPS; RAT[row] = sqrtf(vb / va); RSB[row] = rsqrtf(vb); }
          asm volatile("s_waitcnt vmcnt(0)" ::: "memory"); __syncthreads(); }
        EpiWrap<EOut> E{{ssb + SS_1 * SS_STRIDE, (const float*)(ws + WS_SMALL + SM_RAT), (const float*)(ws + WS_SMALL + SM_RSB), a.in[I_XP], a.in[I_XS], XO, AB}};
        pg8::gemm_phase<EpiWrap<EOut>, true>(lds, g, S, E);
        skinny_gemm<EOut, 4>(lds, MG + (size_t)MP * DM, DM, (const bf16_t*)(ws + WS_WOUT), DM, DM, DM, E.e);
        if (BOTH(5)) GRID_BAR();
    }

    if (IN(6)) {
        pg8::Gemm g{AB, (const bf16_t*)(ws + WS_WUP), DM, DM, DM, 0}; pg8::StaticOrder S; S.init(MP / 256, DFF / 256, G, (int)blockIdx.x);
        EpiWrap<EUp> E{{nullptr, ssb + SS_1 * SS_STRIDE, HUP}};
        pg8::gemm_phase<EpiWrap<EUp>, true>(lds, g, S, E);
        skinny_gemm<EUp, 8, 2>(lds, AB + (size_t)MP * DM, DM, (const bf16_t*)(ws + WS_WUP), DM, DFF, DM, E.e);
        if (BOTH(6)) GRID_BAR();
    }

    if (IN(7)) {
        pg8::Gemm g{HUP, (const bf16_t*)(ws + WS_WDOWN), DFF, DFF, DFF, 0}; pg8::StaticOrder S; S.init(MP / 256, DM / 256, G, (int)blockIdx.x);
        EpiWrap<EDown> E{{ssb + SS_2 * SS_STRIDE, XO, AB}};
        pg8::gemm_phase<EpiWrap<EDown>, true>(lds, g, S, E);
        skinny_gemm<EDown, 4>(lds, HUP + (size_t)MP * DFF, DFF, (const bf16_t*)(ws + WS_WDOWN), DFF, DM, DFF, E.e);
        if (BOTH(7)) GRID_BAR();
    }

    if (IN(8)) {
        { pg8::Gemm g{PB, (const bf16_t*)(ws + WS_WPLE), DPLE, DPLE, DPLE, 0}; pg8::StaticOrder S; S.init(MP / 256, DM / 256, G, (int)blockIdx.x);
          EpiWrap<EPw> E{{nullptr, PW}};
          pg8::gemm_phase<EpiWrap<EPw>, true>(lds, g, S, E);
          skinny_gemm<EPw, 4>(lds, PB + (size_t)MP * DPLE, DPLE, (const bf16_t*)(ws + WS_WPLE), DPLE, DM, DPLE, E.e); }
        asm volatile("s_waitcnt vmcnt(0)" ::: "memory"); __syncthreads();
        { pg8::Gemm g{AB, (const bf16_t*)(ws + WS_WGATE), DM, DM, DM, 0}; pg8::StaticOrder S; S.init(MP / 256, DM / 256, G, (int)blockIdx.x);
          EpiWrap<EGate> E{{ssb + SS_3 * SS_STRIDE, ssb + SS_2 * SS_STRIDE, PW, XO}};
          pg8::gemm_phase<EpiWrap<EGate>, true>(lds, g, S, E);
          skinny_gemm<EGate, 4>(lds, AB + (size_t)MP * DM, DM, (const bf16_t*)(ws + WS_WGATE), DM, DM, DM, E.e); }
        if (BOTH(8)) GRID_BAR();
    }

    if (IN(9)) {
        const float* ss3 = ssb + SS_3 * SS_STRIDE; const float* gf = a.in[I_GFIN];
        f32x4 gv[8];
#pragma unroll
        for (int j = 0; j < 8; ++j) gv[j] = ((const f32x4*)gf)[lane + 64 * j];
        for (int row = blockIdx.x * 8 + wave; row < MT; row += 2 * G * 8) {
            const int row2 = row + G * 8; const bool has2 = row2 < MT; const int r2 = has2 ? row2 : row;
            f32x4* xa = (f32x4*)(XO + (size_t)row * DM); f32x4* xb2 = (f32x4*)(XO + (size_t)r2 * DM);
            f32x4 va[8], vb[8];
#pragma unroll
            for (int j = 0; j < 8; ++j) { va[j] = __builtin_nontemporal_load(&xa[lane + 64 * j]); vb[j] = __builtin_nontemporal_load(&xb2[lane + 64 * j]); }
            const float rsa = rsqrtf(ss3[row] * (1.f / DM) + EPS), rsb2 = rsqrtf(ss3[r2] * (1.f / DM) + EPS);
#pragma unroll
            for (int j = 0; j < 8; ++j) __builtin_nontemporal_store(va[j] * rsa * gv[j], &xa[lane + 64 * j]);
            if (has2) {
#pragma unroll
                for (int j = 0; j < 8; ++j) __builtin_nontemporal_store(vb[j] * rsb2 * gv[j], &xb2[lane + 64 * j]);
            }
        }
    }
#if MK_LAUNCHES == 1
    if (lo > hi) cg::this_grid().sync();
#endif
}

#undef ssb
#undef AB
#undef Z
#undef YG
#undef MG
#undef HUP
#undef PW
#undef PB
#undef XO
extern "C" void kernel_launch(void* const* d_in, const int* in_sizes, int n_in, void* d_out, int out_size, void* d_ws, size_t ws_size, hipStream_t stream) {
    static int grid = 0;
    if (grid == 0) {
        int dev = 0, cus = 0;
        if (n_in != 37 || ws_size < WS_END) { fprintf(stderr, "kernel_launch: unexpected inputs (n_in %d, ws %zu)\n", n_in, ws_size); grid = -1; return; }
        if (hipGetDevice(&dev) != hipSuccess || hipDeviceGetAttribute(&cus, hipDeviceAttributeMultiprocessorCount, dev) != hipSuccess) { grid = -1; return; }
        if (hipFuncSetAttribute((const void*)fwd_kernel, hipFuncAttributeMaxDynamicSharedMemorySize, LDS_BYTES) != hipSuccess) { fprintf(stderr, "kernel_launch: hipFuncSetAttribute failed\n"); grid = -1; return; }
        int per_cu = 0;
        if (hipOccupancyMaxActiveBlocksPerMultiprocessor(&per_cu, (const void*)fwd_kernel, 512, LDS_BYTES) != hipSuccess || per_cu < 1) { fprintf(stderr, "kernel_launch: occupancy query %d\n", per_cu); }
        (void)hipGetLastError();
        grid = cus;
    }
    if (grid < 0) return;
    (void)hipMemsetAsync((char*)d_ws + WS_CTL, 0, CTL_ZERO_BYTES, stream);
    Args a{};
    for (int i = 0; i < 37; ++i) a.in[i] = (const float*)d_in[i];
    a.out = (float*)d_out; a.ws = (unsigned char*)d_ws;
#if MK_LAUNCHES == 1
    a.ph_lo = 0; a.ph_hi = NPHASE;
    void* args[] = {&a};
    hipError_t e = hipLaunchCooperativeKernel((const void*)fwd_kernel, dim3(grid), dim3(512), args, LDS_BYTES, stream);
    if (e != hipSuccess) fprintf(stderr, "cooperative launch failed: %s (grid %d)\n", hipGetErrorString(e), grid);
#else
    for (int ph = 0; ph < NPHASE; ++ph) {
        a.ph_lo = ph; a.ph_hi = ph + 1;
        hipLaunchKernelGGL(fwd_kernel, dim3(grid), dim3(512), LDS_BYTES, stream, a);
    }
#endif
}
```

```cpp
#include <hip/hip_runtime.h>
#include <hip/hip_cooperative_groups.h>
#include <cstdio>
#include <cstdint>
namespace cg = cooperative_groups;

#ifndef MK_LAUNCHES
#define MK_LAUNCHES 1
#endif

#define LAS __attribute__((address_space(3)))
typedef unsigned short bf16_t;
typedef short bf16x8 __attribute__((ext_vector_type(8)));
typedef float f32x4 __attribute__((ext_vector_type(4)));
typedef unsigned u32x4 __attribute__((ext_vector_type(4)));
typedef unsigned u32x2 __attribute__((ext_vector_type(2)));

constexpr int DM = 2048, SEQ = 2048, NB = 4, MP = 8192, MS = 128, MT = 8320;
constexpr int NZ = 3072, DFF = 8192, DPLE = 256, DH = 1024;
constexpr float EPS = 1e-6f;
constexpr int NPHASE = 10;

constexpr size_t MiB = 1u << 20;
constexpr size_t WS_CTL = 0, CTL_ZERO_BYTES = 1 * MiB;
constexpr int SS_STRIDE = 8448;
constexpr int SS_A = 0, SS_B = 1, SS_1 = 2, SS_2 = 3, SS_3 = 4;
constexpr int CW_BAR = 65536;
constexpr size_t WS_SMALL = 1 * MiB;
constexpr size_t SM_RS0 = 0, SM_AR = 65536, SM_AI = SM_AR + 16384, SM_A64R = SM_AI + 16384, SM_A64I = SM_A64R + 16384,
                 SM_BBB = SM_A64I + 16384  , SM_CMB = SM_BBB + 262144  , SM_SPL = SM_CMB + 262144  , SM_RAT = 663552  , SM_RSB = SM_RAT + 34816  ;
constexpr size_t WS_WUP = 2 * MiB, WS_WDOWN = 34 * MiB, WS_WGATE = 66 * MiB, WS_WPLE = 74 * MiB, WS_PB = 75 * MiB, WS_AB = 80 * MiB;
constexpr size_t WS_E = 113 * MiB;
constexpr size_t WS_HUP = WS_E, WS_PW = WS_E;
constexpr size_t WS_WIN = 113 * MiB, WS_WGLU = 125 * MiB, WS_WOUT = 127 * MiB, WS_WLRU = 135 * MiB, WS_Z = 136 * MiB,
                 WS_YG = 185 * MiB, WS_MERGED = 202 * MiB, WS_XC = 235 * MiB, WS_S5SUM = 251 * MiB, WS_END = 255 * MiB;
static_assert(WS_HUP + (size_t)MT * DFF * 2 <= 256 * MiB, "hup fits");
static_assert(WS_Z + (size_t)MT * NZ * 2 <= WS_YG && WS_YG + (size_t)MT * DH * 2 <= WS_MERGED && WS_MERGED + (size_t)MT * DM * 2 <= WS_XC, "map");
static_assert(WS_AB + (size_t)MT * DM * 2 <= WS_E && WS_PB + (size_t)MT * DPLE * 2 <= WS_AB, "map2");

constexpr size_t O_Y = 0, O_S5RP = 17039360, O_S5IP = 17055744, O_LRUP = 17072128, O_CONVP = 17076224,
                 O_S5RS = 17088512, O_S5IS = 17612800, O_LRUS = 18137088, O_CONVS = 18268160;

constexpr int RING_BYTES = 131072, MISC_OFF = RING_BYTES + 320, LDS_BYTES = 147456;

__device__ __forceinline__ unsigned cvt_pk_bf16(float lo, float hi) { unsigned r; asm("v_cvt_pk_bf16_f32 %0, %1, %2" : "=v"(r) : "v"(lo), "v"(hi)); return r; }
__device__ __forceinline__ float bf_lo(unsigned u) { return __uint_as_float(u << 16); }
__device__ __forceinline__ float bf_hi(unsigned u) { return __uint_as_float(u & 0xffff0000u); }
__device__ __forceinline__ float bf1(bf16_t u) { return __uint_as_float(((unsigned)u) << 16); }
__device__ __forceinline__ float sigm(float x) { return __builtin_amdgcn_rcpf(1.f + __expf(-x)); }
__device__ __forceinline__ float gelu_t(float x) { const float u = 1.5957691216057308f * (x + 0.044715f * x * x * x); return x * __builtin_amdgcn_rcpf(1.f + __expf(-u)); }
__device__ __forceinline__ float wave_sum(float v) {
#pragma unroll
    for (int o = 1; o < 64; o <<= 1) v += __shfl_xor(v, o);
    return v;
}
#define LDS_WAIT() asm volatile("s_waitcnt lgkmcnt(0)" ::: "memory")

namespace pg8 {
constexpr int BM = 256, BK = 64, HALF = 128, HTB = HALF * BK * 2, STAGE_BYTES = 8 * HTB, NXCD = 8, WGM = 8;
__host__ __device__ __forceinline__ int lds_byte(int r, int c) { const int st = (r >> 4) * 2 + (c >> 5), rr = r & 15, cc = c & 31, ob = rr * 64 + cc * 2; return st * 1024 + (ob ^ (((ob >> 9) & 1) << 5)); }
__host__ __device__ __forceinline__ void stage_rc(int b, int& R, int& C) { const int st = b / 1024, sb = b % 1024, swz = sb ^ (((sb >> 9) & 1) << 5); R = (st >> 1) * 16 + swz / 64; C = (st & 1) * 32 + (swz % 64) / 2; }
__host__ __device__ __forceinline__ int perm32(int rho) { const int n = rho >> 4, i = rho & 15; return 8 * (i >> 2) + 4 * n + (i & 3); }
struct Unit { int pm, pn; };
struct Gemm { const bf16_t* A; const bf16_t* Bt; int lda, ldb, K, akmode; };
struct StaticOrder {
    int nM, nN, nwg, G, c;
    __device__ __forceinline__ void init(int nM_, int nN_, int G_, int c_) { nM = nM_; nN = nN_; nwg = nM * nN; G = G_; c = c_; }
    __device__ __forceinline__ bool next(int i, Unit& u) const {
        const long L = (long)i * G + c; if (L >= nwg) return false;
        int wgid = (int)L; { const int q = nwg / NXCD, r = nwg % NXCD, xcd = wgid % NXCD, off = wgid / NXCD; wgid = (xcd < r ? xcd * (q + 1) : r * (q + 1) + (xcd - r) * q) + off; }
        const int nig = WGM * nN, gid = wgid / nig, fm = gid * WGM, gsz = (nM - fm) < WGM ? (nM - fm) : WGM;
        u.pm = fm + ((wgid % nig) % gsz); u.pn = (wgid % nig) / gsz; return true;
    }
};

template <class Epi, bool ALIGN_EPI>
__device__ __forceinline__ void gemm_phase(LAS unsigned char* lds, const Gemm g, const StaticOrder& S, const Epi& E) {
    const int tid = threadIdx.x, wid = __builtin_amdgcn_readfirstlane(tid >> 6), lane = tid & 63, wr = wid >> 2, wc = wid & 3, fr = lane & 15, fq = lane >> 4;
    int K = g.K; asm volatile("" : "+s"(K));
    const int nt = K / BK;
    unsigned voffA[2], voffB[2];
#pragma unroll
    for (int i = 0; i < 2; ++i) { int R, C; stage_rc(tid * 16 + i * 8192, R, C);
        const int Rb = Epi::PERM ? ((R & ~31) + perm32(R & 31)) : R;
        voffA[i] = (unsigned)(R * g.lda + C) * 2u; voffB[i] = (unsigned)(Rb * g.ldb + C) * 2u; }
    const size_t kstep = (size_t)(BK * 2);
    const size_t hstepA = (size_t)HALF * g.lda * 2, hstepB = (size_t)HALF * g.ldb * 2;
    const size_t tstepA = 2 * hstepA, tstepB = 2 * hstepB;
    const unsigned ldsw = (unsigned)wid * 1024u;
    const int aoff = lds_byte(wr * 64 + fr, fq * 8), boff = lds_byte(wc * 32 + fr, fq * 8);
#define PG8_SA(b, h) (((b) * 2 + (h)) * HTB)
#define PG8_SB(b, h) ((4 + (b) * 2 + (h)) * HTB)
#define PG8_STAGE(bufoff, gbase, voff) do { _Pragma("unroll") for (int _i = 0; _i < 2; ++_i) \
        __builtin_amdgcn_global_load_lds((const unsigned*)((const char*)(gbase) + (voff)[_i]), (LAS unsigned*)(lds + (bufoff) + ldsw + _i * 8192), 16, 0, 0); } while (0)
#define PG8_LDA(dst, b, h) do { _Pragma("unroll") for (int m = 0; m < 4; ++m) _Pragma("unroll") for (int k = 0; k < 2; ++k) dst[m][k] = *(const LAS bf16x8*)(lds + PG8_SA(b, h) + aoff + m * 2048 + k * 1024); } while (0)
#define PG8_LDB(dst, b, h) do { _Pragma("unroll") for (int n = 0; n < 2; ++n) _Pragma("unroll") for (int k = 0; k < 2; ++k) dst[n][k] = *(const LAS bf16x8*)(lds + PG8_SB(b, h) + boff + n * 2048 + k * 1024); } while (0)
#define PG8_MMA(ai, bj, At, Bt) do { __builtin_amdgcn_s_setprio(1); _Pragma("unroll") for (int m = 0; m < 4; ++m) _Pragma("unroll") for (int n = 0; n < 2; ++n) _Pragma("unroll") for (int k = 0; k < 2; ++k) \
        acc[ai][bj][m][n] = __builtin_amdgcn_mfma_f32_16x16x32_bf16(Bt[n][k], At[m][k], acc[ai][bj][m][n], 0, 0, 0); __builtin_amdgcn_s_setprio(0); } while (0)
#define PG8_WAIT_V(n) asm volatile("s_waitcnt vmcnt(" #n ")" ::: "memory")
#define PG8_WAIT_L(n) asm volatile("s_waitcnt lgkmcnt(" #n ")" ::: "memory")
#define PG8_BAR __builtin_amdgcn_s_barrier()
#define PG8_SCHED __builtin_amdgcn_sched_barrier(0)
    Unit cur, nxt; int ui = 0;
    if (!S.next(0, cur)) return;
    f32x4 acc[2][2][4][2];
#pragma unroll
    for (int a = 0; a < 2; ++a)
#pragma unroll
        for (int b = 0; b < 2; ++b)
#pragma unroll
            for (int m = 0; m < 4; ++m)
#pragma unroll
                for (int n = 0; n < 2; ++n) acc[a][b][m][n] = (f32x4){0.f, 0.f, 0.f, 0.f};
    bf16x8 At[4][2], B0[2][2], B1[2][2];
    const char* cA = (const char*)g.A + (size_t)cur.pm * tstepA + (g.akmode ? (size_t)(cur.pn >> 1) * 512 : 0);
    const char* cB = (const char*)g.Bt + (size_t)cur.pn * tstepB;
    PG8_STAGE(PG8_SB(0, 0), cB, voffB); PG8_STAGE(PG8_SB(0, 1), cB + hstepB, voffB); PG8_STAGE(PG8_SA(0, 0), cA, voffA); PG8_STAGE(PG8_SA(0, 1), cA + hstepA, voffA);
    if (wr == 1) PG8_BAR;
    PG8_WAIT_V(2); PG8_BAR;
    PG8_STAGE(PG8_SB(1, 0), cB + kstep, voffB); PG8_STAGE(PG8_SA(1, 0), cA + kstep, voffA); PG8_STAGE(PG8_SB(1, 1), cB + hstepB + kstep, voffB);
    PG8_WAIT_V(6); PG8_BAR;
    for (;;) {
        const bool has_next = S.next(ui + 1, nxt);
        const char* nA = has_next ? (const char*)g.A + (size_t)nxt.pm * tstepA + (g.akmode ? (size_t)(nxt.pn >> 1) * 512 : 0) : cA;
        const char* nB = has_next ? (const char*)g.Bt + (size_t)nxt.pn * tstepB : cB;
        for (int t = 0; t < nt; t += 2) {
            const bool last = (t == nt - 2);
            const char* a1 = cA + (size_t)(t + 1) * kstep;
            const char* a2 = last ? nA : cA + (size_t)(t + 2) * kstep; const char* b2 = last ? nB : cB + (size_t)(t + 2) * kstep;
            const char* a3 = a2 + kstep; const char* b3 = b2 + kstep;
            if constexpr (Epi::MID) { if (t == (nt >> 1)) E.mid(acc, cur, wr, fr); }
            PG8_LDB(B0, 0, 0); PG8_LDB(B1, 0, 1); PG8_SCHED; PG8_LDA(At, 0, 0); PG8_STAGE(PG8_SA(1, 1), a1 + hstepA, voffA);
            PG8_WAIT_V(8); PG8_WAIT_L(0); PG8_BAR; PG8_MMA(0, 0, At, B0); PG8_MMA(0, 1, At, B1); PG8_BAR; PG8_SCHED;
            PG8_LDA(At, 0, 1); PG8_STAGE(PG8_SB(0, 0), b2, voffB); PG8_STAGE(PG8_SB(0, 1), b2 + hstepB, voffB); PG8_STAGE(PG8_SA(0, 0), a2, voffA);
            PG8_WAIT_V(8); PG8_WAIT_L(0); PG8_BAR; PG8_MMA(1, 0, At, B0); PG8_MMA(1, 1, At, B1); PG8_BAR; PG8_SCHED;
            PG8_LDB(B0, 1, 0); PG8_LDB(B1, 1, 1); PG8_SCHED; PG8_LDA(At, 1, 0); PG8_STAGE(PG8_SA(0, 1), a2 + hstepA, voffA);
            PG8_WAIT_V(8); PG8_WAIT_L(0); PG8_BAR; PG8_MMA(0, 0, At, B0); PG8_MMA(0, 1, At, B1); PG8_BAR; PG8_SCHED;
            PG8_LDA(At, 1, 1); PG8_STAGE(PG8_SB(1, 0), b3, voffB); PG8_STAGE(PG8_SB(1, 1), b3 + hstepB, voffB); PG8_STAGE(PG8_SA(1, 0), a3, voffA);
            PG8_WAIT_V(8); PG8_WAIT_L(0); PG8_BAR; PG8_MMA(1, 0, At, B0); PG8_MMA(1, 1, At, B1); PG8_BAR; PG8_SCHED;
        }
        if constexpr (ALIGN_EPI) { if (wr == 0) PG8_BAR; }
        E(acc, cur, wr, wc, fr, fq);
        if (!has_next) break;
#pragma unroll
        for (int a = 0; a < 2; ++a)
#pragma unroll
            for (int b = 0; b < 2; ++b)
#pragma unroll
                for (int m = 0; m < 4; ++m)
#pragma unroll
                    for (int n = 0; n < 2; ++n) acc[a][b][m][n] = (f32x4){0.f, 0.f, 0.f, 0.f};
        cur = nxt; cA = nA; cB = nB; ++ui;
        if constexpr (ALIGN_EPI) { if (wr == 1) PG8_BAR; }
    }
    PG8_WAIT_V(0);
    if constexpr (!ALIGN_EPI) { if (wr == 0) PG8_BAR; }
    PG8_BAR;
#undef PG8_SA
#undef PG8_SB
#undef PG8_STAGE
#undef PG8_LDA
#undef PG8_LDB
#undef PG8_MMA
#undef PG8_WAIT_V
#undef PG8_WAIT_L
#undef PG8_BAR
#undef PG8_SCHED
}
}

template <class E> struct EpiWrap {
    E e; static constexpr bool MID = E::MID, PERM = E::PERM;
    __device__ __forceinline__ void operator()(const f32x4 (&acc)[2][2][4][2], const pg8::Unit& u, int wr, int wc, int fr, int fq) const {
        if constexpr (E::HAS_RES) {
            f32x4 rc[2][2], rn[2][2];
            { const int row = u.pm * 256 + wr * 64 + fr;
#pragma unroll
              for (int bj = 0; bj < 2; ++bj)
#pragma unroll
                  for (int n = 0; n < 2; ++n) rc[bj][n] = e.res(row, u.pn * 256 + bj * 128 + wc * 32 + 8 * fq + 4 * n); }
#pragma unroll
            for (int idx = 0; idx < 8; ++idx) {
                const int ai = idx >> 2, m = idx & 3;
                const int row = u.pm * 256 + ai * 128 + wr * 64 + m * 16 + fr; const float rv = e.rowval(row); float s = 0.f;
                if (idx < 7) { const int rown = u.pm * 256 + ((idx + 1) >> 2) * 128 + wr * 64 + ((idx + 1) & 3) * 16 + fr;
#pragma unroll
                    for (int bj = 0; bj < 2; ++bj)
#pragma unroll
                        for (int n = 0; n < 2; ++n) rn[bj][n] = e.res(rown, u.pn * 256 + bj * 128 + wc * 32 + 8 * fq + 4 * n); }
#pragma unroll
                for (int bj = 0; bj < 2; ++bj) s += e.applyr8(row, u.pn * 256 + bj * 128 + wc * 32 + 8 * fq, acc[ai][bj][m][0], acc[ai][bj][m][1], rv, rc[bj][0], rc[bj][1]);
                if constexpr (E::HAS_SS) { s += __shfl_xor(s, 16); s += __shfl_xor(s, 32); if (fq == 0) atomicAdd(e.ss + row, s); }
                asm volatile("" ::: "memory");
#pragma unroll
                for (int bj = 0; bj < 2; ++bj)
#pragma unroll
                    for (int n = 0; n < 2; ++n) rc[bj][n] = rn[bj][n];
            }
            return;
        }
        if constexpr (E::PERM && !E::HAS_RES) {
#pragma unroll
            for (int ai = 0; ai < 2; ++ai)
#pragma unroll
                for (int m = 0; m < 4; ++m) {
                    const int row = u.pm * 256 + ai * 128 + wr * 64 + m * 16 + fr; const float rv = e.rowval(row); float s = 0.f;
#pragma unroll
                    for (int bj = 0; bj < 2; ++bj) s += e.apply8(row, u.pn * 256 + bj * 128 + wc * 32 + 8 * fq, acc[ai][bj][m][0], acc[ai][bj][m][1], rv);
                    if constexpr (E::HAS_SS) { s += __shfl_xor(s, 16); s += __shfl_xor(s, 32); if (fq == 0) atomicAdd(e.ss + row, s); }
                    asm volatile("" ::: "memory");
                }
            return;
        }
#pragma unroll
        for (int ai = 0; ai < 2; ++ai)
#pragma unroll
            for (int m = 0; m < 4; ++m) {
                const int row = u.pm * 256 + ai * 128 + wr * 64 + m * 16 + fr; const float rv = e.rowval(row); float s = 0.f;
#pragma unroll
                for (int bj = 0; bj < 2; ++bj)
#pragma unroll
                    for (int n = 0; n < 2; ++n) s += e.apply(row, u.pn * 256 + bj * 128 + wc * 32 + n * 16 + 4 * fq, acc[ai][bj][m][n], rv);
                if constexpr (E::HAS_SS) { s += __shfl_xor(s, 16); s += __shfl_xor(s, 32); if (fq == 0) atomicAdd(e.ss + row, s); }
                asm volatile("" ::: "memory");
            }
    }
    __device__ __forceinline__ void mid(f32x4 (&acc)[2][2][4][2], const pg8::Unit& u, int wr, int fr) const {
#pragma unroll
        for (int ai = 0; ai < 2; ++ai)
#pragma unroll
            for (int m = 0; m < 4; ++m) { const float r = e.kscale(u.pm * 256 + ai * 128 + wr * 64 + m * 16 + fr, 0);
#pragma unroll
                for (int bj = 0; bj < 2; ++bj)
#pragma unroll
                    for (int n = 0; n < 2; ++n) acc[ai][bj][m][n] = acc[ai][bj][m][n] * r; }
    }
};
__device__ __forceinline__ u32x2 pk4(f32x4 v) { u32x2 w; w.x = cvt_pk_bf16(v[0], v[1]); w.y = cvt_pk_bf16(v[2], v[3]); return w; }
__device__ __forceinline__ f32x4 up4(u32x2 w) { return (f32x4){bf_lo(w.x), bf_hi(w.x), bf_lo(w.y), bf_hi(w.y)}; }
__device__ __forceinline__ float ssq4(f32x4 v) { return (v[0] * v[0] + v[1] * v[1]) + (v[2] * v[2] + v[3] * v[3]); }

struct EIn {
    static constexpr bool HAS_RES = false, PERM = true; static constexpr bool MID = false, HAS_SS = false; float* ss; const float* rs0; bf16_t* Z;
    __device__ __forceinline__ float rowval(int row) const { return rs0[row]; }
    __device__ __forceinline__ float kscale(int, int) const { return 1.f; }
    __device__ __forceinline__ float apply(int row, int col, f32x4 v, float rv) const { *(u32x2*)(Z + (size_t)row * NZ + col) = pk4(v * rv); return 0.f; }
    __device__ __forceinline__ float apply8(int row, int col, f32x4 v0, f32x4 v1, float rv) const { u32x4 w; { const u32x2 a0 = pk4(v0 * rv), a1 = pk4(v1 * rv); w.x = a0.x; w.y = a0.y; w.z = a1.x; w.w = a1.y; } *(u32x4*)(Z + (size_t)row * NZ + col) = w; return 0.f; }
};
struct EGlu {
    static constexpr bool HAS_RES = false, PERM = true; static constexpr bool MID = false, HAS_SS = true; float* ss; const float* bglu; const bf16_t* YG; bf16_t* MG;
    __device__ __forceinline__ float rowval(int) const { return 0.f; }
    __device__ __forceinline__ float kscale(int, int) const { return 1.f; }
    __device__ __forceinline__ float apply(int row, int col, f32x4 v, float) const {
        const f32x4 b = *(const f32x4*)(bglu + col); const f32x4 yg = up4(*(const u32x2*)(YG + (size_t)row * DH + col)); f32x4 o;
#pragma unroll
        for (int j = 0; j < 4; ++j) o[j] = yg[j] * sigm(v[j] + b[j]);
        *(u32x2*)(MG + (size_t)row * DM + col) = pk4(o); return ssq4(o);
    }
    __device__ __forceinline__ float apply8(int row, int col, f32x4 v0, f32x4 v1, float) const {
        const f32x4 b0 = *(const f32x4*)(bglu + col), b1 = *(const f32x4*)(bglu + col + 4); const u32x4 yr = *(const u32x4*)(YG + (size_t)row * DH + col);
        const f32x4 y0 = up4((u32x2){yr.x, yr.y}), y1 = up4((u32x2){yr.z, yr.w}); f32x4 o0, o1;
#pragma unroll
        for (int j = 0; j < 4; ++j) { o0[j] = y0[j] * sigm(v0[j] + b0[j]); o1[j] = y1[j] * sigm(v1[j] + b1[j]); }
        u32x4 w; { const u32x2 a0 = pk4(o0), a1 = pk4(o1); w.x = a0.x; w.y = a0.y; w.z = a1.x; w.w = a1.y; } *(u32x4*)(MG + (size_t)row * DM + col) = w; return ssq4(o0) + ssq4(o1);
    }
};
struct EOut {
    static constexpr bool MID = true, HAS_SS = true; float* ss; const float* rat; const float* rsb; const float* xp; const float* xs; float* XO; bf16_t* AB;
    __device__ __forceinline__ float rowval(int row) const { return rsb[row]; }
    __device__ __forceinline__ float kscale(int row, int w) const { return w < 4 ? rat[row] : 1.f; }
    static constexpr bool HAS_RES = true, PERM = true;
    __device__ __forceinline__ f32x4 res(int row, int col) const { return __builtin_nontemporal_load((const f32x4*)(xp + (size_t)row * DM + col)); }
    __device__ __forceinline__ float applyr8(int row, int col, f32x4 v0, f32x4 v1, float rv, f32x4 r0, f32x4 r1) const {
        const f32x4 o0 = r0 + v0 * rv, o1 = r1 + v1 * rv; float* p = XO + (size_t)row * DM + col; *(f32x4*)p = o0; *(f32x4*)(p + 4) = o1;
        u32x4 w; { const u32x2 a0 = pk4(o0), a1 = pk4(o1); w.x = a0.x; w.y = a0.y; w.z = a1.x; w.w = a1.y; } *(u32x4*)(AB + (size_t)row * DM + col) = w; return ssq4(o0) + ssq4(o1); }
    __device__ __forceinline__ float applyr(int row, int col, f32x4 v, float rv, f32x4 r) const {
        const f32x4 o = r + v * rv;
        *(f32x4*)(XO + (size_t)row * DM + col) = o; *(u32x2*)(AB + (size_t)row * DM + col) = pk4(o); return ssq4(o); }
    __device__ __forceinline__ float apply(int row, int col, f32x4 v, float rv) const {
        const float* xr = row < MP ? xp + (size_t)row * DM : xs + (size_t)(row - MP) * DM;
        const f32x4 o = *(const f32x4*)(xr + col) + v * rv;
        *(f32x4*)(XO + (size_t)row * DM + col) = o; *(u32x2*)(AB + (size_t)row * DM + col) = pk4(o); return ssq4(o);
    }
};
struct EUp {
    static constexpr bool HAS_RES = false, PERM = true; static constexpr bool MID = false, HAS_SS = false; float* ss; const float* ss1; bf16_t* HUP;
    __device__ __forceinline__ float rowval(int row) const { return rsqrtf(ss1[row] * (1.f / DM) + EPS); }
    __device__ __forceinline__ float kscale(int, int) const { return 1.f; }
    __device__ __forceinline__ float apply(int row, int col, f32x4 v, float rv) const { f32x4 o;
#pragma unroll
        for (int j = 0; j < 4; ++j) { const float r = fmaxf(v[j] * rv, 0.f); o[j] = r * r; }
        *(u32x2*)(HUP + (size_t)row * DFF + col) = pk4(o); return 0.f; }
    __device__ __forceinline__ float apply8(int row, int col, f32x4 v0, f32x4 v1, float rv) const { f32x4 o0, o1;
#pragma unroll
        for (int j = 0; j < 4; ++j) { const float r0 = fmaxf(v0[j] * rv, 0.f), r1 = fmaxf(v1[j] * rv, 0.f); o0[j] = r0 * r0; o1[j] = r1 * r1; }
        u32x4 w; { const u32x2 a0 = pk4(o0), a1 = pk4(o1); w.x = a0.x; w.y = a0.y; w.z = a1.x; w.w = a1.y; } *(u32x4*)(HUP + (size_t)row * DFF + col) = w; return 0.f; }
};
struct EDown {
    static constexpr bool MID = false, HAS_SS = true; float* ss; float* XO; bf16_t* AB;
    __device__ __forceinline__ float rowval(int) const { return 0.f; }
    __device__ __forceinline__ float kscale(int, int) const { return 1.f; }
    static constexpr bool HAS_RES = true, PERM = true;
    __device__ __forceinline__ f32x4 res(int row, int col) const { return *(const f32x4*)(XO + (size_t)row * DM + col); }
    __device__ __forceinline__ float applyr8(int row, int col, f32x4 v0, f32x4 v1, float, f32x4 r0, f32x4 r1) const {
        const f32x4 o0 = r0 + v0, o1 = r1 + v1; float* p = XO + (size_t)row * DM + col; *(f32x4*)p = o0; *(f32x4*)(p + 4) = o1;
        u32x4 w; { const u32x2 a0 = pk4(o0), a1 = pk4(o1); w.x = a0.x; w.y = a0.y; w.z = a1.x; w.w = a1.y; } *(u32x4*)(AB + (size_t)row * DM + col) = w; return ssq4(o0) + ssq4(o1); }
    __device__ __forceinline__ float applyr(int row, int col, f32x4 v, float, f32x4 r) const {
        const f32x4 o = r + v; *(f32x4*)(XO + (size_t)row * DM + col) = o; *(u32x2*)(AB + (size_t)row * DM + col) = pk4(o); return ssq4(o); }
    __device__ __forceinline__ float apply(int row, int col, f32x4 v, float) const {
        float* p = XO + (size_t)row * DM + col; const f32x4 o = *(const f32x4*)p + v; *(f32x4*)p = o; *(u32x2*)(AB + (size_t)row * DM + col) = pk4(o); return ssq4(o); }
};
struct EPw {
    static constexpr bool HAS_RES = false, PERM = true; static constexpr bool MID = false, HAS_SS = false; float* ss; bf16_t* PW;
    __device__ __forceinline__ float rowval(int) const { return 0.f; }
    __device__ __forceinline__ float kscale(int, int) const { return 1.f; }
    __device__ __forceinline__ float apply(int row, int col, f32x4 v, float) const { *(u32x2*)(PW + (size_t)row * DM + col) = pk4(v); return 0.f; }
    __device__ __forceinline__ float apply8(int row, int col, f32x4 v0, f32x4 v1, float) const { u32x4 w; { const u32x2 a0 = pk4(v0), a1 = pk4(v1); w.x = a0.x; w.y = a0.y; w.z = a1.x; w.w = a1.y; } *(u32x4*)(PW + (size_t)row * DM + col) = w; return 0.f; }
};
struct EGate {
    static constexpr bool MID = false, HAS_SS = true; float* ss; const float* ss2; const bf16_t* PW; float* XO;
    __device__ __forceinline__ float rowval(int row) const { return rsqrtf(ss2[row] * (1.f / DM) + EPS); }
    __device__ __forceinline__ float kscale(int, int) const { return 1.f; }
    static constexpr bool HAS_RES = true, PERM = true;
    __device__ __forceinline__ f32x4 res(int row, int col) const { return *(const f32x4*)(XO + (size_t)row * DM + col); }
    __device__ __forceinline__ float applyr8(int row, int col, f32x4 v0, f32x4 v1, float rv, f32x4 r0, f32x4 r1) const {
        const u32x4 pr = *(const u32x4*)(PW + (size_t)row * DM + col); const f32x4 p0 = up4((u32x2){pr.x, pr.y}), p1 = up4((u32x2){pr.z, pr.w}); f32x4 o0 = r0, o1 = r1;
#pragma unroll
        for (int j = 0; j < 4; ++j) { o0[j] += p0[j] * sigm(v0[j] * rv); o1[j] += p1[j] * sigm(v1[j] * rv); }
        float* p = XO + (size_t)row * DM + col; *(f32x4*)p = o0; *(f32x4*)(p + 4) = o1; return ssq4(o0) + ssq4(o1); }
    __device__ __forceinline__ float applyr(int row, int col, f32x4 v, float rv, f32x4 r) const {
        f32x4 o = r; const f32x4 pw = up4(*(const u32x2*)(PW + (size_t)row * DM + col));
#pragma unroll
        for (int j = 0; j < 4; ++j) o[j] += pw[j] * sigm(v[j] * rv);
        *(f32x4*)(XO + (size_t)row * DM + col) = o; return ssq4(o); }
    __device__ __forceinline__ float apply(int row, int col, f32x4 v, float rv) const {
        float* p = XO + (size_t)row * DM + col; f32x4 o = *(const f32x4*)p; const f32x4 pw = up4(*(const u32x2*)(PW + (size_t)row * DM + col));
#pragma unroll
        for (int j = 0; j < 4; ++j) o[j] += pw[j] * sigm(v[j] * rv);
        *(f32x4*)p = o; return ssq4(o); }
};
__device__ __forceinline__ float em1(float x) {
    float p = x * (1.f + x * (0.5f + x * (0.16666667f + x * (0.041666668f + x * (0.0083333338f + x * (0.0013888889f + x * 0.0001984127f))))));
    if (__builtin_expect(__any(fabsf(x) >= 0.5f), 0)) p = fabsf(x) < 0.5f ? p : __expf(x) - 1.f;
    return p;
}
struct ELru {
    static constexpr bool MID = false, PERM = false; const bf16_t* XC; const float* ba; const float* bi; const float* spl; float* Ao; float* Bo;
    __device__ __forceinline__ void mid(f32x4 (&)[2][2][4][2], const pg8::Unit&, int, int) const {}
    __device__ __forceinline__ void operator()(const f32x4 (&acc)[2][2][4][2], const pg8::Unit& u, int wr, int wc, int fr, int fq) const {
#pragma unroll
        for (int n = 0; n < 2; ++n) {
            const int ch = (u.pn >> 1) * 256 + (u.pn & 1) * 128 + wc * 32 + n * 16 + 4 * fq;
            const f32x4 bav = *(const f32x4*)(ba + ch), biv = *(const f32x4*)(bi + ch), sp = *(const f32x4*)(spl + ch);
#pragma unroll
            for (int ai = 0; ai < 2; ++ai)
#pragma unroll
                for (int m = 0; m < 4; ++m) {
                    const int row = u.pm * 256 + ai * 128 + wr * 64 + m * 16 + fr;
                    const f32x4 xc = up4(*(const u32x2*)(XC + (size_t)row * DH + ch)); f32x4 av, bv;
#pragma unroll
                    for (int j = 0; j < 4; ++j) { const float r = sigm(acc[ai][0][m][n][j] + bav[j]), ig = sigm(acc[ai][1][m][n][j] + biv[j]);
                        const float la = r * sp[j]; av[j] = 1.f + em1(la); bv[j] = __builtin_amdgcn_sqrtf(fmaxf(-em1(2.f * la), 0.f)) * ig * xc[j]; }
                    *(f32x4*)(Ao + (size_t)row * DH + ch) = av; *(f32x4*)(Bo + (size_t)row * DH + ch) = bv;
                    asm volatile("" ::: "memory");
                }
        }
    }
};

template <class E, int MT = 8, int NG = 1>
__device__ __forceinline__ void skinny_gemm(LAS unsigned char* lds, const bf16_t* A, int lda, const bf16_t* Bt, int ldb, int N, int K, const E& e, int nb = 0) {
    const int tid = threadIdx.x, wid = __builtin_amdgcn_readfirstlane(tid >> 6), lane = tid & 63, fr = lane & 15, fq = lane >> 4;
    LAS f32x4* red = (LAS f32x4*)lds;
    constexpr int NH = 8 / MT;
    const int kw = K >> 3, k0w = wid * kw, nks = kw >> 5, nit = ((N >> 4) / NG) * NH, G = gridDim.x, NBk = nb ? nb : G;
    for (int iti = G - 1 - (int)blockIdx.x; iti < nit && (G - 1 - (int)blockIdx.x) < NBk; iti += NBk) {
        const int n0 = (iti / NH) * (16 * NG), r0 = (iti % NH) * (MT * 16);
        f32x4 acc[NG][MT];
#pragma unroll
        for (int q = 0; q < NG; ++q)
#pragma unroll
            for (int m = 0; m < MT; ++m) acc[q][m] = (f32x4){0.f, 0.f, 0.f, 0.f};
        const bf16_t* bp = Bt + (size_t)(n0 + fr) * ldb + k0w + 8 * fq;
        const bf16_t* ap = A + (size_t)(r0 + fr) * lda + k0w + 8 * fq;
        {
            bf16x8 bc[NG], ac[MT];
#pragma unroll
            for (int q = 0; q < NG; ++q) bc[q] = *(const bf16x8*)(bp + (size_t)(16 * q) * ldb);
#pragma unroll
            for (int m = 0; m < MT; ++m) ac[m] = *(const bf16x8*)(ap + (size_t)(16 * m) * lda);
            for (int ks = 0; ks < nks; ++ks) {
                const int kn = ks + 1 < nks ? ks + 1 : ks;
                bf16x8 bn[NG], an[MT];
#pragma unroll
                for (int q = 0; q < NG; ++q) bn[q] = *(const bf16x8*)(bp + (size_t)(16 * q) * ldb + 32 * kn);
#pragma unroll
                for (int m = 0; m < MT; ++m) an[m] = *(const bf16x8*)(ap + (size_t)(16 * m) * lda + 32 * kn);
#pragma unroll
                for (int q = 0; q < NG; ++q)
#pragma unroll
                    for (int m = 0; m < MT; ++m) acc[q][m] = __builtin_amdgcn_mfma_f32_16x16x32_bf16(bc[q], ac[m], acc[q][m], 0, 0, 0);
#pragma unroll
                for (int q = 0; q < NG; ++q) bc[q] = bn[q];
#pragma unroll
                for (int m = 0; m < MT; ++m) ac[m] = an[m];
            }
        }
#pragma unroll
        for (int q = 0; q < NG; ++q)
#pragma unroll
            for (int m = 0; m < MT; ++m) red[((wid * NG + q) * MT + m) * 64 + lane] = acc[q][m];
        __syncthreads();
        if (wid < MT) {
            const int row = MP + r0 + 16 * wid + fr; const float rv = e.rowval(row);
#pragma unroll
            for (int q = 0; q < NG; ++q) {
                f32x4 v = (f32x4){0.f, 0.f, 0.f, 0.f};
#pragma unroll
                for (int w = 0; w < 8; ++w) { f32x4 p = red[((w * NG + q) * MT + wid) * 64 + lane]; if constexpr (E::MID) p = p * e.kscale(row, w); v += p; }
                float s = e.apply(row, n0 + 16 * q + 4 * fq, v, rv);
                if constexpr (E::HAS_SS) { s += __shfl_xor(s, 16); s += __shfl_xor(s, 32); if (fq == 0) atomicAdd(e.ss + row, s); }
            }
        }
        __syncthreads();
    }
}

struct Args { const float* in[37]; float* out; unsigned char* ws; int ph_lo, ph_hi; };
enum { I_XP = 0, I_XS, I_S5RE, I_S5IM, I_LRUH, I_CONV, I_PP, I_PS, I_GMIX, I_WIN, I_LAMRE, I_LAMIM, I_LOGSTEP, I_BRE, I_BIM, I_CRE, I_CIM, I_S5D,
       I_WGLU, I_BGLU, I_CONVW, I_CONVB, I_WA, I_BA, I_WI, I_BI, I_LAM, I_GMA, I_GMB, I_WOUT, I_GMLP, I_WUP, I_WDOWN, I_GPLE, I_WGATE, I_WPLE, I_GFIN };

__device__ __forceinline__ void tr_item(const float* W, int K, int N, bf16_t* WT, int rbase, int lru, const float* g1, const float* g2, int gsplit,
                                        LAS float* scr, int item, int lane) {
    const int nblk = N / 32, kb = item / nblk, nb = item % nblk, k0 = 64 * kb, n0 = 32 * nb;
    f32x4 wv[8];
#pragma unroll
    for (int i = 0; i < 8; ++i) wv[i] = __builtin_nontemporal_load((const f32x4*)(W + (size_t)(k0 + 8 * i + (lane >> 3)) * N + n0 + 4 * (lane & 7)));
#pragma unroll
    for (int i = 0; i < 8; ++i) { const int kk = 8 * i + (lane >> 3), k = k0 + kk; const float gv = g1 ? (k < gsplit ? g1[k] : g2[k - gsplit]) : 1.f;
        LAS float* d = scr + kk * 33 + 4 * (lane & 7); d[0] = wv[i][0] * gv; d[1] = wv[i][1] * gv; d[2] = wv[i][2] * gv; d[3] = wv[i][3] * gv; }
    LDS_WAIT();
    const int c = lane & 7;
#pragma unroll
    for (int j = 0; j < 4; ++j) { const int n = (lane >> 3) + 8 * j, nn = n0 + n; const int drow = lru ? rbase + (nn >> 7) * 256 + (nn & 127) : rbase + nn;
        const LAS float* s = scr + (8 * c) * 33 + n;
        u32x4 o; o.x = cvt_pk_bf16(s[0 * 33], s[1 * 33]); o.y = cvt_pk_bf16(s[2 * 33], s[3 * 33]); o.z = cvt_pk_bf16(s[4 * 33], s[5 * 33]); o.w = cvt_pk_bf16(s[6 * 33], s[7 * 33]);
        *(u32x4*)(WT + (size_t)drow * K + k0 + 8 * c) = o; }
    LDS_WAIT();
}

__device__ __forceinline__ void phase0(const Args& a, LAS unsigned char* lds) {
    const int tid = threadIdx.x, wave = __builtin_amdgcn_readfirstlane(tid >> 6), lane = tid & 63, G = gridDim.x;
    unsigned char* ws = a.ws;
    LAS float* scr = (LAS float*)(lds + wave * 16384);
    const int gw = blockIdx.x * 8 + wave, NGW = G * 8;
    constexpr int I_IN = 32 * 96, I_UP = 32 * 256, I_DOWN = 4096  , I_LRU = 8 * 32;
    constexpr int NITEMS = I_IN + I_UP + I_DOWN + I_LRU;
    for (int it = gw; it < NITEMS; it += NGW) {
        int r = it;
        if (r < I_UP) { tr_item(a.in[I_WUP], DM, DFF, (bf16_t*)(ws + WS_WUP), 0, 0, a.in[I_GMLP], a.in[I_GMLP], 1 << 30, scr, r, lane); continue; } r -= I_UP;
        if (r < I_DOWN) { tr_item(a.in[I_WDOWN], DFF, DM, (bf16_t*)(ws + WS_WDOWN), 0, 0, nullptr, nullptr, 0, scr, r, lane); continue; } r -= I_DOWN;
        if (r < I_IN) { tr_item(a.in[I_WIN], DM, NZ, (bf16_t*)(ws + WS_WIN), 0, 0, a.in[I_GMIX], a.in[I_GMIX], 1 << 30, scr, r, lane); continue; } r -= I_IN;
        { const int mat = r >> 5, h = mat >> 1, bj = mat & 1;
          tr_item((bj ? a.in[I_WI] : a.in[I_WA]) + (size_t)h * 65536, 256, 256, (bf16_t*)(ws + WS_WLRU), h * 512 + bj * 128, 1, nullptr, nullptr, 0, scr, r & 31, lane); }
    }
    float* rs0 = (float*)(ws + WS_SMALL + SM_RS0); bf16_t* XB = (bf16_t*)(ws + WS_AB); bf16_t* PB = (bf16_t*)(ws + WS_PB);
    for (int row = gw; row < MT; row += NGW) {
        const float* xr = row < MP ? a.in[I_XP] + (size_t)row * DM : a.in[I_XS] + (size_t)(row - MP) * DM;
        f32x4 v[8]; float s = 0.f;
#pragma unroll
        for (int j = 0; j < 8; ++j) { v[j] = __builtin_nontemporal_load((const f32x4*)xr + lane + 64 * j); s += ssq4(v[j]); }
        s = wave_sum(s); if (lane == 0) rs0[row] = rsqrtf(s * (1.f / DM) + EPS);
#pragma unroll
        for (int j = 0; j < 8; ++j) ((u32x2*)(XB + (size_t)row * DM))[lane + 64 * j] = pk4(v[j]);
        const float* pr = row < MP ? a.in[I_PP] + (size_t)row * DPLE : a.in[I_PS] + (size_t)(row - MP) * DPLE;
        ((u32x2*)(PB + (size_t)row * DPLE))[lane] = pk4(__builtin_nontemporal_load((const f32x4*)pr + lane));
    }
    { float* SPL = (float*)(ws + WS_SMALL + SM_SPL);
      for (int i = blockIdx.x * 512 + tid; i < DH; i += G * 512) { const float xl = -a.in[I_LAM][i]; SPL[i] = -8.f * (fmaxf(xl, 0.f) + log1pf(expf(-fabsf(xl)))); } }
    float* AR = (float*)(ws + WS_SMALL + SM_AR); float* AI = (float*)(ws + WS_SMALL + SM_AI); float* A64R = (float*)(ws + WS_SMALL + SM_A64R); float* A64I = (float*)(ws + WS_SMALL + SM_A64I);
    bf16_t* BBB = (bf16_t*)(ws + WS_SMALL + SM_BBB); bf16_t* CMB = (bf16_t*)(ws + WS_SMALL + SM_CMB);
    for (int i = blockIdx.x * 512 + tid; i < 4096; i += G * 512) {
        const int g = i >> 6, p = i & 63;
        const float step = expf(a.in[I_LOGSTEP][g]), lr = a.in[I_LAMRE][i], li = a.in[I_LAMIM][i];
        const float mag = expf(lr * step); float sn, cs; sincosf(li * step, &sn, &cs);
        const float ar = mag * cs, ai = mag * sn, nr = ar - 1.f, ni = ai, den = lr * lr + li * li;
        const float cr = (nr * lr + ni * li) / den, ci = (ni * lr - nr * li) / den;
        AR[i] = ar; AI[i] = ai;
        float pr_ = ar, pi_ = ai;
#pragma unroll
        for (int q = 0; q < 6; ++q) { const float t0 = pr_ * pr_ - pi_ * pi_, t1 = 2.f * pr_ * pi_; pr_ = t0; pi_ = t1; }
        A64R[i] = pr_; A64I[i] = pi_;
        for (int c = 0; c < 16; ++c) {
            const float br = a.in[I_BRE][(size_t)i * 16 + c], bi = a.in[I_BIM][(size_t)i * 16 + c];
            BBB[((size_t)g * 128 + p) * 16 + c] = (bf16_t)(cvt_pk_bf16(cr * br - ci * bi, 0.f) & 0xffffu);
            BBB[((size_t)g * 128 + 64 + p) * 16 + c] = (bf16_t)(cvt_pk_bf16(cr * bi + ci * br, 0.f) & 0xffffu);
            CMB[((size_t)g * 16 + c) * 128 + p] = (bf16_t)(cvt_pk_bf16(a.in[I_CRE][((size_t)g * 16 + c) * 64 + p], 0.f) & 0xffffu);
            CMB[((size_t)g * 16 + c) * 128 + 64 + p] = (bf16_t)(cvt_pk_bf16(-a.in[I_CIM][((size_t)g * 16 + c) * 64 + p], 0.f) & 0xffffu);
        }
    }
}

__device__ __forceinline__ void s5_unit(const Args& a, LAS unsigned char* wl, int lane, int mode, int n, int g, int j) {
    unsigned char* ws = a.ws;
    const int fr = lane & 15, fq = lane >> 4;
    const float* AR = (const float*)(ws + WS_SMALL + SM_AR); const float* AI = (const float*)(ws + WS_SMALL + SM_AI);
    const bf16_t* BBB = (const bf16_t*)(ws + WS_SMALL + SM_BBB); const bf16_t* CMB = (const bf16_t*)(ws + WS_SMALL + SM_CMB);
    const bf16_t* Z = (const bf16_t*)(ws + WS_Z); bf16_t* YG = (bf16_t*)(ws + WS_YG); float* SUM = (float*)(ws + WS_S5SUM);
    LAS float* BuS = (LAS float*)wl; LAS bf16_t* Hs = (LAS bf16_t*)(wl + 8448);
    const float ar = AR[g * 64 + lane], ai = AI[g * 64 + lane];
    const bf16x8 zero8 = (bf16x8){0, 0, 0, 0, 0, 0, 0, 0};
    bf16x8 bb[8];
#pragma unroll
    for (int t = 0; t < 8; ++t) bb[t] = fq < 2 ? *(const bf16x8*)(BBB + ((size_t)g * 128 + 16 * t + fr) * 16 + 8 * fq) : zero8;
    bf16x8 cm[4];
#pragma unroll
    for (int kk = 0; kk < 4; ++kk) cm[kk] = *(const bf16x8*)(CMB + ((size_t)g * 16 + fr) * 128 + 32 * kk + 8 * fq);
    const f32x4 dsk = *(const f32x4*)(a.in[I_S5D] + 16 * g + 4 * fq);
    float hr = 0.f, hi = 0.f;
    if (mode == 1 && j > 0) {
        const float pr = ((const float*)(ws + WS_SMALL + SM_A64R))[g * 64 + lane], pi = ((const float*)(ws + WS_SMALL + SM_A64I))[g * 64 + lane];
        const float* sp = SUM + ((size_t)(n * 64 + g) * 32) * 128;
        for (int i = 0; i < j; ++i) { const float sr = sp[i * 128 + lane], si = sp[i * 128 + 64 + lane];
            const float t0 = pr * hr - pi * hi + sr, t1 = pr * hi + pi * hr + si; hr = t0; hi = t1; }
    }
    if (mode == 4 && j > 0) {
        float pr = ((const float*)(ws + WS_SMALL + SM_A64R))[g * 64 + lane], pi = ((const float*)(ws + WS_SMALL + SM_A64I))[g * 64 + lane];
#pragma unroll
        for (int q = 0; q < 2; ++q) { const float t0 = pr * pr - pi * pi, t1 = 2.f * pr * pi; pr = t0; pi = t1; }
        for (int v = 0; v < j; ++v) { const LAS float* ps = (const LAS float*)(wl + (v - j) * 16384 + 12800); const float sr = ps[lane], si = ps[64 + lane];
            const float t0 = pr * hr - pi * hi + sr, t1 = pr * hi + pi * hr + si; hr = t0; hi = t1; }
    }
    const int row0 = mode == 2 ? MP + 16 * j : ((mode == 3 || mode == 4) ? n * SEQ + 256 * j : n * SEQ + 64 * j);
    const int nblk = mode == 2 ? 1 : ((mode == 3 || mode == 1 || mode == 4) ? 16 : 4);
    for (int blk = 0; blk < nblk; ++blk) {
        const int r0 = row0 + 16 * blk;
        const bf16x8 ua = fq < 2 ? *(const bf16x8*)(Z + (size_t)(r0 + fr) * NZ + 16 * g + 8 * fq) : zero8;
        u32x2 u4raw = (u32x2){0u, 0u}; if (mode == 1 || mode == 2 || mode == 4) u4raw = *(const u32x2*)(Z + (size_t)(r0 + fr) * NZ + 16 * g + 4 * fq);
#pragma unroll
        for (int t = 0; t < 8; ++t) {
            const f32x4 c = __builtin_amdgcn_mfma_f32_16x16x32_bf16(ua, bb[t], (f32x4){0.f, 0.f, 0.f, 0.f}, 0, 0, 0);
#pragma unroll
            for (int jj = 0; jj < 4; ++jj) BuS[(4 * fq + jj) * 132 + 16 * t + fr] = c[jj];
        }
        LDS_WAIT();
        float burv[16], buiv[16];
#pragma unroll
        for (int t = 0; t < 16; ++t) { burv[t] = BuS[t * 132 + lane]; buiv[t] = BuS[t * 132 + 64 + lane]; }
#pragma unroll
        for (int t = 0; t < 16; ++t) {
            const float bur = burv[t], bui = buiv[t];
            if (mode == 2) { const size_t si = ((size_t)(r0 - MP + t) * 64 + g) * 64 + lane; hr = a.in[I_S5RE][si]; hi = a.in[I_S5IM][si]; }
            const float t0 = ar * hr - ai * hi + bur, t1 = ar * hi + ai * hr + bui; hr = t0; hi = t1;
            if (mode == 2) { const size_t si = ((size_t)(r0 - MP + t) * 64 + g) * 64 + lane; a.out[O_S5RS + si] = hr; a.out[O_S5IS + si] = hi; }
            if (mode == 1 || mode == 2 || mode == 4) { const unsigned w = cvt_pk_bf16(hr, hi); Hs[t * 136 + lane] = (bf16_t)(w & 0xffffu); Hs[t * 136 + 64 + lane] = (bf16_t)(w >> 16); }
        }
        if (mode == 1 || mode == 2 || mode == 4) {
            LDS_WAIT();
            f32x4 y = (f32x4){0.f, 0.f, 0.f, 0.f};
#pragma unroll
            for (int kk = 0; kk < 4; ++kk) { const bf16x8 hb = *(const LAS bf16x8*)(Hs + fr * 136 + 32 * kk + 8 * fq);
                y = __builtin_amdgcn_mfma_f32_16x16x32_bf16(cm[kk], hb, y, 0, 0, 0); }
            const f32x4 u4 = up4(u4raw); f32x4 o;
#pragma unroll
            for (int jj = 0; jj < 4; ++jj) o[jj] = gelu_t(y[jj] + dsk[jj] * u4[jj]);
            *(u32x2*)(YG + (size_t)(r0 + fr) * DH + 16 * g + 4 * fq) = pk4(o);
            LDS_WAIT();
        }
    }
    if (mode == 0) { float* sp = SUM + ((size_t)(n * 64 + g) * 32 + j) * 128; sp[lane] = hr; sp[64 + lane] = hi; }
    if (mode == 3) { LAS float* ps = (LAS float*)(wl + 12800); ps[lane] = hr; ps[64 + lane] = hi; }
    if (mode == 4 && j == 7) { a.out[O_S5RP + (size_t)(n * 64 + g) * 64 + lane] = hr; a.out[O_S5IP + (size_t)(n * 64 + g) * 64 + lane] = hi; }
}

__device__ __forceinline__ void conv_prompt(const Args& a) {
    unsigned char* ws = a.ws; const bf16_t* Z = (const bf16_t*)(ws + WS_Z); bf16_t* XC = (bf16_t*)(ws + WS_XC);
    const float* cw = a.in[I_CONVW]; const float* cb = a.in[I_CONVB];
    const int G = gridDim.x;
    for (int it = blockIdx.x * 512 + threadIdx.x; it < MP * 128; it += G * 512) {
        const int row = it >> 7, c = (it & 127) * 8, t = row & (SEQ - 1);
        float acc[8];
#pragma unroll
        for (int q = 0; q < 8; ++q) acc[q] = cb[c + q];
#pragma unroll
        for (int k = 0; k < 4; ++k) {
            if (t - 3 + k >= 0) {
                const u32x4 z = *(const u32x4*)(Z + (size_t)(row - 3 + k) * NZ + DH + c);
                const float x[8] = {bf_lo(z.x), bf_hi(z.x), bf_lo(z.y), bf_hi(z.y), bf_lo(z.z), bf_hi(z.z), bf_lo(z.w), bf_hi(z.w)};
#pragma unroll
                for (int q = 0; q < 8; ++q) acc[q] += cw[k * DH + c + q] * x[q];
                if (k == 3 && t >= SEQ - 3) {
                    float* o = a.out + O_CONVP + ((size_t)(row >> 11) * 3 + (t - (SEQ - 3))) * DH + c;
#pragma unroll
                    for (int q = 0; q < 8; ++q) o[q] = x[q];
                }
            }
        }
        u32x4 o; o.x = cvt_pk_bf16(acc[0], acc[1]); o.y = cvt_pk_bf16(acc[2], acc[3]); o.z = cvt_pk_bf16(acc[4], acc[5]); o.w = cvt_pk_bf16(acc[6], acc[7]);
        *(u32x4*)(XC + (size_t)row * DH + c) = o;
    }
}

__device__ __forceinline__ void conv_tile(const Args& a, int pm, int h) {
    unsigned char* ws = a.ws; const bf16_t* Z = (const bf16_t*)(ws + WS_Z); bf16_t* XC = (bf16_t*)(ws + WS_XC);
    const int tid = threadIdx.x, c = h * 256 + (tid & 31) * 8;
    float cwv[4][8], cbv[8];
#pragma unroll
    for (int q = 0; q < 8; ++q) { cbv[q] = a.in[I_CONVB][c + q];
#pragma unroll
        for (int k = 0; k < 4; ++k) cwv[k][q] = a.in[I_CONVW][k * DH + c + q]; }
#pragma unroll 1
    for (int r4 = 0; r4 < 16; r4 += 4) {
        u32x4 z[4][4];
#pragma unroll
        for (int rr = 0; rr < 4; ++rr) { const int row = pm * 256 + (tid >> 5) + 16 * (r4 + rr), t = row & (SEQ - 1);
#pragma unroll
            for (int k = 0; k < 4; ++k) z[rr][k] = (t - 3 + k >= 0) ? *(const u32x4*)(Z + (size_t)(row - 3 + k) * NZ + DH + c) : (u32x4){0u, 0u, 0u, 0u}; }
#pragma unroll
        for (int rr = 0; rr < 4; ++rr) { const int row = pm * 256 + (tid >> 5) + 16 * (r4 + rr), t = row & (SEQ - 1);
            float acc[8];
#pragma unroll
            for (int q = 0; q < 8; ++q) acc[q] = cbv[q];
#pragma unroll
            for (int k = 0; k < 4; ++k) { const u32x4 zz = z[rr][k];
                const float x[8] = {bf_lo(zz.x), bf_hi(zz.x), bf_lo(zz.y), bf_hi(zz.y), bf_lo(zz.z), bf_hi(zz.z), bf_lo(zz.w), bf_hi(zz.w)};
#pragma unroll
                for (int q = 0; q < 8; ++q) acc[q] += cwv[k][q] * x[q];
                if (k == 3 && t >= SEQ - 3) { float* o = a.out + O_CONVP + ((size_t)(row >> 11) * 3 + (t - (SEQ - 3))) * DH + c;
#pragma unroll
                    for (int q = 0; q < 8; ++q) o[q] = x[q]; } }
            u32x4 o; o.x = cvt_pk_bf16(acc[0], acc[1]); o.y = cvt_pk_bf16(acc[2], acc[3]); o.z = cvt_pk_bf16(acc[4], acc[5]); o.w = cvt_pk_bf16(acc[6], acc[7]);
            *(u32x4*)(XC + (size_t)row * DH + c) = o; }
    }
}

__device__ __forceinline__ void lru_sample(const Args& a, LAS unsigned char* lds, int unit) {
    unsigned char* ws = a.ws; const bf16_t* Z = (const bf16_t*)(ws + WS_Z); bf16_t* MG = (bf16_t*)(ws + WS_MERGED); float* ssB = (float*)(ws + WS_CTL) + SS_B * SS_STRIDE;
    LAS float* sxc = (LAS float*)lds;
    const int tid = threadIdx.x, s = unit >> 1, half = unit & 1, row = MP + s;
    const float* cw = a.in[I_CONVW]; const float* cs = a.in[I_CONV] + (size_t)s * 3 * DH;
    for (int c = tid; c < DH; c += 512) {
        const float xb = bf1(Z[(size_t)row * NZ + DH + c]);
        sxc[c] = a.in[I_CONVB][c] + cw[c] * cs[c] + cw[DH + c] * cs[DH + c] + cw[2 * DH + c] * cs[2 * DH + c] + cw[3 * DH + c] * xb;
        if ((c >> 9) == half) { float* o = a.out + O_CONVS + (size_t)s * 3 * DH; o[c] = cs[DH + c]; o[DH + c] = cs[2 * DH + c]; o[2 * DH + c] = xb; }
    }
    __syncthreads();
    float sq = 0.f;
    {
        const int c = half * 512 + tid, h = c >> 8, jj = c & 255;
        const float* wa = a.in[I_WA] + (size_t)h * 65536 + jj; const float* wi = a.in[I_WI] + (size_t)h * 65536 + jj;
        float ra = a.in[I_BA][c], ri = a.in[I_BI][c];
#pragma unroll 1
        for (int k0 = 0; k0 < 256; k0 += 32) {
            float wav[32], wiv[32];
#pragma unroll
            for (int q = 0; q < 32; ++q) { wav[q] = wa[(size_t)(k0 + q) * 256]; wiv[q] = wi[(size_t)(k0 + q) * 256]; }
#pragma unroll
            for (int q = 0; q < 32; ++q) { const float x = sxc[h * 256 + k0 + q]; ra += x * wav[q]; ri += x * wiv[q]; }
        }
        const float r = sigm(ra), ig = sigm(ri); const float xl = -a.in[I_LAM][c]; const float sp = fmaxf(xl, 0.f) + log1pf(expf(-fabsf(xl)));
        const float la = -8.f * r * sp, av = expf(la), bv = sqrtf(-expm1f(2.f * la)) * ig * sxc[c];
        const float hn = av * a.in[I_LRUH][(size_t)s * DH + c] + bv;
        a.out[O_LRUS + (size_t)s * DH + c] = hn;
        const float o = hn * gelu_t(bf1(Z[(size_t)row * NZ + 2 * DH + c]));
        MG[(size_t)row * DM + DH + c] = (bf16_t)(cvt_pk_bf16(o, 0.f) & 0xffffu);
        sq = o * o;
    }
    sq = wave_sum(sq);
    if ((tid & 63) == 0) atomicAdd(ssB + row, sq);
    __syncthreads();
}

__device__ __forceinline__ void lru_scan_unit(const Args& a, LAS unsigned char* lds, int unit) {
    unsigned char* ws = a.ws; const bf16_t* Z = (const bf16_t*)(ws + WS_Z); bf16_t* MG = (bf16_t*)(ws + WS_MERGED); float* ssB = (float*)(ws + WS_CTL) + SS_B * SS_STRIDE;
    const float* Ao = a.out; const float* Bo = a.out + (size_t)MP * DH;
    LAS float* sP = (LAS float*)lds; LAS float* sH = sP + 512; LAS float* rsum = sH + 512;
    const int tid = threadIdx.x, n = unit >> 6, ch = (unit & 63) * 16 + (tid & 15), j = tid >> 4;
    const size_t r0 = (size_t)n * SEQ + 64 * j;
    float P = 1.f, h = 0.f;
#pragma unroll 1
    for (int tb = 0; tb < 64; tb += 16) {
        float av[16], bv[16];
#pragma unroll
        for (int q = 0; q < 16; ++q) { av[q] = Ao[(r0 + tb + q) * DH + ch]; bv[q] = Bo[(r0 + tb + q) * DH + ch]; }
#pragma unroll
        for (int q = 0; q < 16; ++q) { h = av[q] * h + bv[q]; P *= av[q]; }
    }
    sP[tid] = P; sH[tid] = h;
    __syncthreads();
    float H = 0.f;
    for (int i = 0; i < j; ++i) H = sP[i * 16 + (tid & 15)] * H + sH[i * 16 + (tid & 15)];
    h = H;
#pragma unroll 1
    for (int tb = 0; tb < 64; tb += 16) {
        float av[16], bv[16]; bf16_t gz[16];
#pragma unroll
        for (int q = 0; q < 16; ++q) { const size_t row = r0 + tb + q; av[q] = Ao[row * DH + ch]; bv[q] = Bo[row * DH + ch]; gz[q] = Z[row * NZ + 2 * DH + ch]; }
#pragma unroll
        for (int q = 0; q < 16; ++q) {
            const size_t row = r0 + tb + q;
            h = av[q] * h + bv[q];
            const float o = h * gelu_t(bf1(gz[q]));
            MG[row * DM + DH + ch] = (bf16_t)(cvt_pk_bf16(o, 0.f) & 0xffffu);
            float s = o * o; s += __shfl_xor(s, 1); s += __shfl_xor(s, 2); s += __shfl_xor(s, 4); s += __shfl_xor(s, 8);
            if ((tid & 15) == 0) rsum[64 * j + tb + q] = s;
        }
    }
    __syncthreads();
    for (int r = tid; r < SEQ; r += 512) atomicAdd(ssB + (size_t)n * SEQ + r, rsum[r]);
    if (j == 31) a.out[O_LRUP + (size_t)n * DH + ch] = h;
    __syncthreads();
}

#define XB_TMO      128
#define XB_XCNT(j)  (256  + 64 * (j))
#define XB_XSUB(j)  (1280 + 64 * (j))
#define XB_XGEN(j)  (2304 + 64 * (j))
#define XB_TOP      3328
#define XB_TOPGEN   3392
#define XB_SPIN_CAP (1u << 18)
__device__ __forceinline__ unsigned xb_ld(unsigned* p)              { return __hip_atomic_load(p, __ATOMIC_RELAXED, __HIP_MEMORY_SCOPE_AGENT); }
__device__ __forceinline__ unsigned xb_add(unsigned* p, unsigned v) { return __hip_atomic_fetch_add(p, v, __ATOMIC_RELAXED, __HIP_MEMORY_SCOPE_AGENT); }
__device__ __forceinline__ unsigned xb_xcc_id() { return (unsigned)__builtin_amdgcn_s_getreg((3 << 11) | 20) & 0xFu; }
#define XB_SPIN(cond, bar) do { unsigned _sp = 0; while (cond) { __builtin_amdgcn_s_sleep(1); \
    if ((++_sp & 255u) == 0u) { if (xb_ld(&(bar)[XB_TMO])) break; if (_sp > XB_SPIN_CAP) { atomicAdd(&(bar)[XB_TMO], 1u); break; } } } } while (0)
struct XcdBarrier { unsigned* bar; unsigned x; volatile LAS unsigned* st; };
__device__ __forceinline__ XcdBarrier xcd_barrier_post(unsigned* bar, volatile LAS unsigned* st) {
    XcdBarrier b; b.bar = bar; b.x = xb_xcc_id(); b.st = st;
    if (threadIdx.x == 0) (void)xb_add(&bar[XB_XCNT(b.x)], 1u);
    return b;
}
__device__ __forceinline__ void xcd_barrier_complete(unsigned* bar, unsigned x, unsigned& nloc, unsigned& nx) {
    const unsigned G = gridDim.x * gridDim.y * gridDim.z;
    unsigned sum, cnt, mine, sp = 0u;
    for (;;) {
        sum = 0u; cnt = 0u; mine = 0u;
#pragma unroll
        for (unsigned j = 0; j < 16; ++j) { const unsigned c = xb_ld(&bar[XB_XCNT(j)]); sum += c; cnt += (c > 0u) ? 1u : 0u; mine = (j == x) ? c : mine; }
        if (sum == G) break;
        __builtin_amdgcn_s_sleep(1);
        if ((++sp & 255u) == 0u) { if (xb_ld(&bar[XB_TMO])) break; if (sp > XB_SPIN_CAP) { atomicAdd(&bar[XB_TMO], 1u); break; } }
    }
    nloc = mine > 0u ? mine : 1u; nx = cnt > 0u ? cnt : 1u;
}
__device__ __forceinline__ void xcd_barrier(const XcdBarrier& b) {
    asm volatile("s_waitcnt vmcnt(0)" ::: "memory");
    __syncthreads();
    if (threadIdx.x == 0) {
        unsigned* bar = b.bar;
        __builtin_amdgcn_s_waitcnt(0);
        unsigned nloc = b.st[0], nx = b.st[1];
        if (nloc == 0u) { xcd_barrier_complete(bar, b.x, nloc, nx); b.st[0] = nloc; b.st[1] = nx; }
        const unsigned old = xb_add(&bar[XB_XSUB(b.x)], 1u);
        const unsigned gen = old / nloc;
        if (old + 1u == (gen + 1u) * nloc) {
            __builtin_amdgcn_fence(__ATOMIC_RELEASE, "agent");
            asm volatile("s_waitcnt vmcnt(0)" ::: "memory");
            const unsigned og = xb_add(&bar[XB_TOP], 1u);
            const unsigned tg = og / nx;
            if (og + 1u == (tg + 1u) * nx) xb_add(&bar[XB_TOPGEN], 1u);
            else XB_SPIN(xb_ld(&bar[XB_TOPGEN]) == tg, bar);
            __builtin_amdgcn_fence(__ATOMIC_ACQUIRE, "agent");
            xb_add(&bar[XB_XGEN(b.x)], 1u);
            asm volatile("s_waitcnt vmcnt(0)" ::: "memory");
        } else {
            XB_SPIN(xb_ld(&bar[XB_XGEN(b.x)]) == gen, bar);
            __builtin_amdgcn_fence(__ATOMIC_ACQUIRE, "agent");
            asm volatile("s_waitcnt vmcnt(0)" ::: "memory");
        }
    }
    __syncthreads();
}

__global__ void __launch_bounds__(512, 2) fwd_kernel(Args a) {
    extern __shared__ __attribute__((aligned(16))) unsigned char lds_raw[];
    LAS unsigned char* lds = (LAS unsigned char*)lds_raw;
    const int tid = threadIdx.x, wave = __builtin_amdgcn_readfirstlane(tid >> 6), lane = tid & 63, G = gridDim.x;
    unsigned char* ws = a.ws;
    const int lo = a.ph_lo, hi = a.ph_hi;
    volatile LAS unsigned* MISC = (volatile LAS unsigned*)(lds + MISC_OFF);
    for (int u = tid; u < (LDS_BYTES - RING_BYTES) / 4; u += 512) ((LAS unsigned*)(lds + RING_BYTES))[u] = 0u;
    __syncthreads();
#if MK_LAUNCHES == 1
    XcdBarrier bar = xcd_barrier_post((unsigned*)(ws + WS_CTL) + CW_BAR, MISC + 8);
#define GRID_BAR() xcd_barrier(bar)
#else
#define GRID_BAR() do {} while (0)
#endif
#define IN(k) (lo <= (k) && (k) < hi)
#define BOTH(k) (IN(k) && IN((k) + 1))
#define ssb ((float*)(ws + WS_CTL))
#define AB ((bf16_t*)(ws + WS_AB))
#define Z ((bf16_t*)(ws + WS_Z))
#define YG ((bf16_t*)(ws + WS_YG))
#define MG ((bf16_t*)(ws + WS_MERGED))
#define HUP ((bf16_t*)(ws + WS_HUP))
#define PW ((bf16_t*)(ws + WS_PW))
#define PB ((bf16_t*)(ws + WS_PB))
#define XO (a.out + O_Y)

    if (IN(0)) { phase0(a, lds); if (BOTH(0)) GRID_BAR(); }

    if (IN(1)) {
        pg8::Gemm g{AB, (const bf16_t*)(ws + WS_WIN), DM, DM, DM, 0}; pg8::StaticOrder S; S.init(MP / 256, NZ / 256, G, (int)blockIdx.x);
        EpiWrap<EIn> E{{nullptr, (const float*)(ws + WS_SMALL + SM_RS0), Z}};
        pg8::gemm_phase<EpiWrap<EIn>, true>(lds, g, S, E);
        skinny_gemm<EIn, 8, 2>(lds, AB + (size_t)MP * DM, DM, (const bf16_t*)(ws + WS_WIN), DM, NZ, DM, E.e, G / 2);
        if ((int)blockIdx.x >= G / 2) {
            const int w = ((int)blockIdx.x - G / 2) * 8 + wave, nw = (G - G / 2) * 8; LAS float* scr = (LAS float*)(lds + wave * 16384);
            constexpr int J_OUT = 32 * 64, J_GATE = 32 * 64, J_GLU = 16 * 32, J_PLE = 4 * 64;
            for (int it = w; it < J_OUT + J_GATE + J_GLU + J_PLE; it += nw) {
                int r = it;
                if (r < J_OUT) { tr_item(a.in[I_WOUT], DM, DM, (bf16_t*)(ws + WS_WOUT), 0, 0, a.in[I_GMA], a.in[I_GMB], DH, scr, r, lane); continue; } r -= J_OUT;
                if (r < J_GATE) { tr_item(a.in[I_WGATE], DM, DM, (bf16_t*)(ws + WS_WGATE), 0, 0, a.in[I_GPLE], a.in[I_GPLE], 1 << 30, scr, r, lane); continue; } r -= J_GATE;
                if (r < J_GLU) { tr_item(a.in[I_WGLU], DH, DH, (bf16_t*)(ws + WS_WGLU), 0, 0, nullptr, nullptr, 0, scr, r, lane); continue; } r -= J_GLU;
                tr_item(a.in[I_WPLE], DPLE, DM, (bf16_t*)(ws + WS_WPLE), 0, 0, nullptr, nullptr, 0, scr, r, lane);
            }
        }
        if (BOTH(1)) GRID_BAR();
    }

    if (IN(3)) {
        pg8::Gemm g{(const bf16_t*)(ws + WS_XC), (const bf16_t*)(ws + WS_WLRU), DH, 256, 256, 1}; pg8::StaticOrder S; S.init(MP / 256, 8, G, (int)blockIdx.x);
        { pg8::Unit cu; for (int i = 0; S.next(i, cu); ++i) conv_tile(a, cu.pm, cu.pn >> 1); }
        asm volatile("s_waitcnt vmcnt(0)" ::: "memory"); __syncthreads();
        ELru E{(const bf16_t*)(ws + WS_XC), a.in[I_BA], a.in[I_BI], (const float*)(ws + WS_SMALL + SM_SPL), a.out, a.out + (size_t)MP * DH};
        pg8::gemm_phase<ELru, true>(lds, g, S, E);
        for (int s = G - 1 - (int)blockIdx.x; s < 2 * MS; s += G) lru_sample(a, lds, s);
        for (int u = blockIdx.x; u < NB * 64; u += G) {
            const int n = u >> 6, g2 = u & 63;
            s5_unit(a, lds + wave * 16384, lane, 3, n, g2, wave);
            __syncthreads();
            s5_unit(a, lds + wave * 16384, lane, 4, n, g2, wave);
            __syncthreads();
        }
        for (int u = blockIdx.x * 8 + wave; u < 512; u += G * 8) s5_unit(a, lds + wave * 16384, lane, 2, 0, u >> 3, u & 7);
        if (BOTH(3)) GRID_BAR();
    }

    if (IN(4)) {
        pg8::Gemm g{YG, (const bf16_t*)(ws + WS_WGLU), DH, DH, DH, 0}; pg8::StaticOrder S; S.init(MP / 256, DH / 256, G, (int)blockIdx.x);
        EpiWrap<EGlu> E{{ssb + SS_A * SS_STRIDE, a.in[I_BGLU], YG, MG}};
        pg8::gemm_phase<EpiWrap<EGlu>, true>(lds, g, S, E);
        skinny_gemm<EGlu, 4>(lds, YG + (size_t)MP * DH, DH, (const bf16_t*)(ws + WS_WGLU), DH, DH, DH, E.e);
        {
            const int vb = G - 1 - (int)blockIdx.x, vs = (G % 8 == 0) ? (vb % 8) * (G / 8) + vb / 8 : vb;
            for (int u = vs; u < NB * 64; u += G) lru_scan_unit(a, lds, u);
        }
        if ((int)blockIdx.x >= G / 2) {
            const int w = ((int)blockIdx.x - G / 2) * 8 + wave, nw = (G - G / 2) * 8;
            for (int it = 4096 + w; it < 128 * 64; it += nw) tr_item(a.in[I_WDOWN], DFF, DM, (bf16_t*)(ws + WS_WDOWN), 0, 0, nullptr, nullptr, 0, (LAS float*)(lds + wave * 16384), it, lane);
        }
        if (BOTH(4)) GRID_BAR();
    }

    if (IN(5)) {
        pg8::Gemm g{MG, (const bf16_t*)(ws + WS_WOUT), DM, DM, DM, 0}; pg8::StaticOrder S; S.init(MP / 256, DM / 256, G, (int)blockIdx.x);
        { float* RAT = (float*)(ws + WS_SMALL + SM_RAT); float* RSB = (float*)(ws + WS_SMALL + SM_RSB);
          pg8::Unit cu;
          for (int ui = -1; ui < 0 || S.next(ui, cu); ++ui)
              for (int i = tid; i < (ui < 0 ? MS : 256); i += 512) { const int row = ui < 0 ? MP + i : cu.pm * 256 + i;
                  const float va = ssb[SS_A * SS_STRIDE + row] * (1.f / DH) + EPS, vb = ssb[SS_B * SS_STRIDE + row] * (1.f / DH) + EPS; RAT[row] = sqrtf(vb / va); RSB[row] = rsqrtf(vb); }
          asm volatile("s_waitcnt vmcnt(0)" ::: "memory"); __syncthreads(); }
        EpiWrap<EOut> E{{ssb + SS_1 * SS_STRIDE, (const float*)(ws + WS_SMALL + SM_RAT), (const float*)(ws + WS_SMALL + SM_RSB), a.in[I_XP], a.in[I_XS], XO, AB}};
        pg8::gemm_phase<EpiWrap<EOut>, true>(lds, g, S, E);
        skinny_gemm<EOut, 4>(lds, MG + (size_t)MP * DM, DM, (const bf16_t*)(ws + WS_WOUT), DM, DM, DM, E.e);
        if (BOTH(5)) GRID_BAR();
    }

    if (IN(6)) {
        pg8::Gemm g{AB, (const bf16_t*)(ws + WS_WUP), DM, DM, DM, 0}; pg8::StaticOrder S; S.init(MP / 256, DFF / 256, G, (int)blockIdx.x);
        EpiWrap<EUp> E{{nullptr, ssb + SS_1 * SS_STRIDE, HUP}};
        pg8::gemm_phase<EpiWrap<EUp>, true>(lds, g, S, E);
        skinny_gemm<EUp, 8, 2>(lds, AB + (size_t)MP * DM, DM, (const bf16_t*)(ws + WS_WUP), DM, DFF, DM, E.e);
        if (BOTH(6)) GRID_BAR();
    }

    if (IN(7)) {
        pg8::Gemm g{HUP, (const bf16_t*)(ws + WS_WDOWN), DFF, DFF, DFF, 0}; pg8::StaticOrder S; S.init(MP / 256, DM / 256, G, (int)blockIdx.x);
        EpiWrap<EDown> E{{ssb + SS_2 * SS_STRIDE, XO, AB}};
        pg8::gemm_phase<EpiWrap<EDown>, true>(lds, g, S, E);
        skinny_gemm<EDown, 4>(lds, HUP + (size_t)MP * DFF, DFF, (const bf16_t*)(ws + WS_WDOWN), DFF, DM, DFF, E.e);
        if (BOTH(7)) GRID_BAR();
    }

    if (IN(8)) {
        { pg8::Gemm g{PB, (const bf16_t*)(ws + WS_WPLE), DPLE, DPLE, DPLE, 0}; pg8::StaticOrder S; S.init(MP / 256, DM / 256, G, (int)blockIdx.x);
          EpiWrap<EPw> E{{nullptr, PW}};
          pg8::gemm_phase<EpiWrap<EPw>, true>(lds, g, S, E);
          skinny_gemm<EPw, 4>(lds, PB + (size_t)MP * DPLE, DPLE, (const bf16_t*)(ws + WS_WPLE), DPLE, DM, DPLE, E.e); }
        asm volatile("s_waitcnt vmcnt(0)" ::: "memory"); __syncthreads();
        { pg8::Gemm g{AB, (const bf16_t*)(ws + WS_WGATE), DM, DM, DM, 0}; pg8::StaticOrder S; S.init(MP / 256, DM / 256, G, (int)blockIdx.x);
          EpiWrap<EGate> E{{ssb + SS_3 * SS_STRIDE, ssb + SS_2 * SS_STRIDE, PW, XO}};
          pg8::gemm_phase<EpiWrap<EGate>, true>(lds, g, S, E);
          skinny_gemm<EGate, 4>(lds, AB + (size_t)MP * DM, DM, (const bf16_t*)(ws + WS_WGATE), DM, DM, DM, E.e); }
        if (BOTH(8)) GRID_BAR();
    }

    if (IN(9)) {
        const float* ss3 = ssb + SS_3 * SS_STRIDE; const float* gf = a.in[I_GFIN];
        f32x4 gv[8];
#pragma unroll
        for (int j = 0; j < 8; ++j) gv[j] = ((const f32x4*)gf)[lane + 64 * j];
        for (int row = blockIdx.x * 8 + wave; row < MT; row += 2 * G * 8) {
            const int row2 = row + G * 8; const bool has2 = row2 < MT; const int r2 = has2 ? row2 : row;
            f32x4* xa = (f32x4*)(XO + (size_t)row * DM); f32x4* xb2 = (f32x4*)(XO + (size_t)r2 * DM);
            f32x4 va[8], vb[8];
#pragma unroll
            for (int j = 0; j < 8; ++j) { va[j] = __builtin_nontemporal_load(&xa[lane + 64 * j]); vb[j] = __builtin_nontemporal_load(&xb2[lane + 64 * j]); }
            const float rsa = rsqrtf(ss3[row] * (1.f / DM) + EPS), rsb2 = rsqrtf(ss3[r2] * (1.f / DM) + EPS);
#pragma unroll
            for (int j = 0; j < 8; ++j) __builtin_nontemporal_store(va[j] * rsa * gv[j], &xa[lane + 64 * j]);
            if (has2) {
#pragma unroll
                for (int j = 0; j < 8; ++j) __builtin_nontemporal_store(vb[j] * rsb2 * gv[j], &xb2[lane + 64 * j]);
            }
        }
    }
#if MK_LAUNCHES == 1
    if (lo > hi) cg::this_grid().sync();
#endif
}

#undef ssb
#undef AB
#undef Z
#undef YG
#undef MG
#undef HUP
#undef PW
#undef PB
#undef XO
extern "C" void kernel_launch(void* const* d_in, const int* in_sizes, int n_in, void* d_out, int out_size, void* d_ws, size_t ws_size, hipStream_t stream) {
    static int grid = 0;
    if (grid == 0) {
        int dev = 0, cus = 0;
        if (n_in != 37 || ws_size < WS_END) { fprintf(stderr, "kernel_launch: unexpected inputs (n_in %d, ws %zu)\n", n_in, ws_size); grid = -1; return; }
        if (hipGetDevice(&dev) != hipSuccess || hipDeviceGetAttribute(&cus, hipDeviceAttributeMultiprocessorCount, dev) != hipSuccess) { grid = -1; return; }
        if (hipFuncSetAttribute((const void*)fwd_kernel, hipFuncAttributeMaxDynamicSharedMemorySize, LDS_BYTES) != hipSuccess) { fprintf(stderr, "kernel_launch: hipFuncSetAttribute failed\n"); grid = -1; return; }
        int per_cu = 0;
        if (hipOccupancyMaxActiveBlocksPerMultiprocessor(&per_cu, (const void*)fwd_kernel, 512, LDS_BYTES) != hipSuccess || per_cu < 1) { fprintf(stderr, "kernel_launch: occupancy query %d\n", per_cu); }
        (void)hipGetLastError();
        grid = cus;
    }
    if (grid < 0) return;
    (void)hipMemsetAsync((char*)d_ws + WS_CTL, 0, CTL_ZERO_BYTES, stream);
    Args a{};
    for (int i = 0; i < 37; ++i) a.in[i] = (const float*)d_in[i];
    a.out = (float*)d_out; a.ws = (unsigned char*)d_ws;
#if MK_LAUNCHES == 1
    a.ph_lo = 0; a.ph_hi = NPHASE;
    void* args[] = {&a};
    hipError_t e = hipLaunchCooperativeKernel((const void*)fwd_kernel, dim3(grid), dim3(512), args, LDS_BYTES, stream);
    if (e != hipSuccess) fprintf(stderr, "cooperative launch failed: %s (grid %d)\n", hipGetErrorString(e), grid);
#else
    for (int ph = 0; ph < NPHASE; ++ph) {
        a.ph_lo = ph; a.ph_hi = ph + 1;
        hipLaunchKernelGGL(fwd_kernel, dim3(grid), dim3(512), LDS_BYTES, stream, a);
    }
#endif
}
```

```cpp
#include <hip/hip_runtime.h>
#include <hip/hip_cooperative_groups.h>
#include <cstdio>
#include <cstdint>
namespace cg = cooperative_groups;

#ifndef MK_LAUNCHES
#define MK_LAUNCHES 1
#endif

#define LAS __attribute__((address_space(3)))
typedef unsigned short bf16_t;
typedef short bf16x8 __attribute__((ext_vector_type(8)));
typedef float f32x4 __attribute__((ext_vector_type(4)));
typedef unsigned u32x4 __attribute__((ext_vector_type(4)));
typedef unsigned u32x2 __attribute__((ext_vector_type(2)));

constexpr int DM = 2048, SEQ = 2048, NB = 4, MP = 8192, MS = 128, MT = 8320;
constexpr int NZ = 3072, DFF = 8192, DPLE = 256, DH = 1024;
constexpr float EPS = 1e-6f;
constexpr int NPHASE = 10;

constexpr size_t MiB = 1u << 20;
constexpr size_t WS_CTL = 0, CTL_ZERO_BYTES = 1 * MiB;
constexpr int SS_STRIDE = 8448;
constexpr int SS_A = 0, SS_B = 1, SS_1 = 2, SS_2 = 3, SS_3 = 4;
constexpr int CW_BAR = 65536;
constexpr size_t WS_SMALL = 1 * MiB;
constexpr size_t SM_RS0 = 0, SM_AR = 65536, SM_AI = SM_AR + 16384, SM_A64R = SM_AI + 16384, SM_A64I = SM_A64R + 16384,
                 SM_BBB = SM_A64I + 16384  , SM_CMB = SM_BBB + 262144  , SM_SPL = SM_CMB + 262144  , SM_RAT = 663552  , SM_RSB = SM_RAT + 34816  ;
constexpr size_t WS_WUP = 2 * MiB, WS_WDOWN = 34 * MiB, WS_WGATE = 66 * MiB, WS_WPLE = 74 * MiB, WS_PB = 75 * MiB, WS_AB = 80 * MiB;
constexpr size_t WS_E = 113 * MiB;
constexpr size_t WS_HUP = WS_E, WS_PW = WS_E;
constexpr size_t WS_WIN = 113 * MiB, WS_WGLU = 125 * MiB, WS_WOUT = 127 * MiB, WS_WLRU = 135 * MiB, WS_Z = 136 * MiB,
                 WS_YG = 185 * MiB, WS_MERGED = 202 * MiB, WS_XC = 235 * MiB, WS_S5SUM = 251 * MiB, WS_END = 255 * MiB;
static_assert(WS_HUP + (size_t)MT * DFF * 2 <= 256 * MiB, "hup fits");
static_assert(WS_Z + (size_t)MT * NZ * 2 <= WS_YG && WS_YG + (size_t)MT * DH * 2 <= WS_MERGED && WS_MERGED + (size_t)MT * DM * 2 <= WS_XC, "map");
static_assert(WS_AB + (size_t)MT * DM * 2 <= WS_E && WS_PB + (size_t)MT * DPLE * 2 <= WS_AB, "map2");

constexpr size_t O_Y = 0, O_S5RP = 17039360, O_S5IP = 17055744, O_LRUP = 17072128, O_CONVP = 17076224,
                 O_S5RS = 17088512, O_S5IS = 17612800, O_LRUS = 18137088, O_CONVS = 18268160;

constexpr int RING_BYTES = 131072, MISC_OFF = RING_BYTES + 320, LDS_BYTES = 147456;

__device__ __forceinline__ unsigned cvt_pk_bf16(float lo, float hi) { unsigned r; asm("v_cvt_pk_bf16_f32 %0, %1, %2" : "=v"(r) : "v"(lo), "v"(hi)); return r; }
__device__ __forceinline__ float bf_lo(unsigned u) { return __uint_as_float(u << 16); }
__device__ __forceinline__ float bf_hi(unsigned u) { return __uint_as_float(u & 0xffff0000u); }
__device__ __forceinline__ float bf1(bf16_t u) { return __uint_as_float(((unsigned)u) << 16); }
__device__ __forceinline__ float sigm(float x) { return __builtin_amdgcn_rcpf(1.f + __expf(-x)); }
__device__ __forceinline__ float gelu_t(float x) { const float u = 1.5957691216057308f * (x + 0.044715f * x * x * x); return x * __builtin_amdgcn_rcpf(1.f + __expf(-u)); }
__device__ __forceinline__ float wave_sum(float v) {
#pragma unroll
    for (int o = 1; o < 64; o <<= 1) v += __shfl_xor(v, o);
    return v;
}
#define LDS_WAIT() asm volatile("s_waitcnt lgkmcnt(0)" ::: "memory")

namespace pg8 {
constexpr int BM = 256, BK = 64, HALF = 128, HTB = HALF * BK * 2, STAGE_BYTES = 8 * HTB, NXCD = 8, WGM = 8;
__host__ __device__ __forceinline__ int lds_byte(int r, int c) { const int st = (r >> 4) * 2 + (c >> 5), rr = r & 15, cc = c & 31, ob = rr * 64 + cc * 2; return st * 1024 + (ob ^ (((ob >> 9) & 1) << 5)); }
__host__ __device__ __forceinline__ void stage_rc(int b, int& R, int& C) { const int st = b / 1024, sb = b % 1024, swz = sb ^ (((sb >> 9) & 1) << 5); R = (st >> 1) * 16 + swz / 64; C = (st & 1) * 32 + (swz % 64) / 2; }
__host__ __device__ __forceinline__ int perm32(int rho) { const int n = rho >> 4, i = rho & 15; return 8 * (i >> 2) + 4 * n + (i & 3); }
struct Unit { int pm, pn; };
struct Gemm { const bf16_t* A; const bf16_t* Bt; int lda, ldb, K, akmode; };
struct StaticOrder {
    int nM, nN, nwg, G, c;
    __device__ __forceinline__ void init(int nM_, int nN_, int G_, int c_) { nM = nM_; nN = nN_; nwg = nM * nN; G = G_; c = c_; }
    __device__ __forceinline__ bool next(int i, Unit& u) const {
        const long L = (long)i * G + c; if (L >= nwg) return false;
        int wgid = (int)L; { const int q = nwg / NXCD, r = nwg % NXCD, xcd = wgid % NXCD, off = wgid / NXCD; wgid = (xcd < r ? xcd * (q + 1) : r * (q + 1) + (xcd - r) * q) + off; }
        const int nig = WGM * nN, gid = wgid / nig, fm = gid * WGM, gsz = (nM - fm) < WGM ? (nM - fm) : WGM;
        u.pm = fm + ((wgid % nig) % gsz); u.pn = (wgid % nig) / gsz; return true;
    }
};

template <class Epi, bool ALIGN_EPI>
__device__ __forceinline__ void gemm_phase(LAS unsigned char* lds, const Gemm g, const StaticOrder& S, const Epi& E) {
    const int tid = threadIdx.x, wid = __builtin_amdgcn_readfirstlane(tid >> 6), lane = tid & 63, wr = wid >> 2, wc = wid & 3, fr = lane & 15, fq = lane >> 4;
    int K = g.K; asm volatile("" : "+s"(K));
    const int nt = K / BK;
    unsigned voffA[2], voffB[2];
#pragma unroll
    for (int i = 0; i < 2; ++i) { int R, C; stage_rc(tid * 16 + i * 8192, R, C);
        const int Rb = Epi::PERM ? ((R & ~31) + perm32(R & 31)) : R;
        voffA[i] = (unsigned)(R * g.lda + C) * 2u; voffB[i] = (unsigned)(Rb * g.ldb + C) * 2u; }
    const size_t kstep = (size_t)(BK * 2);
    const size_t hstepA = (size_t)HALF * g.lda * 2, hstepB = (size_t)HALF * g.ldb * 2;
    const size_t tstepA = 2 * hstepA, tstepB = 2 * hstepB;
    const unsigned ldsw = (unsigned)wid * 1024u;
    const int aoff = lds_byte(wr * 64 + fr, fq * 8), boff = lds_byte(wc * 32 + fr, fq * 8);
#define PG8_SA(b, h) (((b) * 2 + (h)) * HTB)
#define PG8_SB(b, h) ((4 + (b) * 2 + (h)) * HTB)
#define PG8_STAGE(bufoff, gbase, voff) do { _Pragma("unroll") for (int _i = 0; _i < 2; ++_i) \
        __builtin_amdgcn_global_load_lds((const unsigned*)((const char*)(gbase) + (voff)[_i]), (LAS unsigned*)(lds + (bufoff) + ldsw + _i * 8192), 16, 0, 0); } while (0)
#define PG8_LDA(dst, b, h) do { _Pragma("unroll") for (int m = 0; m < 4; ++m) _Pragma("unroll") for (int k = 0; k < 2; ++k) dst[m][k] = *(const LAS bf16x8*)(lds + PG8_SA(b, h) + aoff + m * 2048 + k * 1024); } while (0)
#define PG8_LDB(dst, b, h) do { _Pragma("unroll") for (int n = 0; n < 2; ++n) _Pragma("unroll") for (int k = 0; k < 2; ++k) dst[n][k] = *(const LAS bf16x8*)(lds + PG8_SB(b, h) + boff + n * 2048 + k * 1024); } while (0)
#define PG8_MMA(ai, bj, At, Bt) do { __builtin_amdgcn_s_setprio(1); _Pragma("unroll") for (int m = 0; m < 4; ++m) _Pragma("unroll") for (int n = 0; n < 2; ++n) _Pragma("unroll") for (int k = 0; k < 2; ++k) \
        acc[ai][bj][m][n] = __builtin_amdgcn_mfma_f32_16x16x32_bf16(Bt[n][k], At[m][k], acc[ai][bj][m][n], 0, 0, 0); __builtin_amdgcn_s_setprio(0); } while (0)
#define PG8_WAIT_V(n) asm volatile("s_waitcnt vmcnt(" #n ")" ::: "memory")
#define PG8_WAIT_L(n) asm volatile("s_waitcnt lgkmcnt(" #n ")" ::: "memory")
#define PG8_BAR __builtin_amdgcn_s_barrier()
#define PG8_SCHED __builtin_amdgcn_sched_barrier(0)
    Unit cur, nxt; int ui = 0;
    if (!S.next(0, cur)) return;
    f32x4 acc[2][2][4][2];
#pragma unroll
    for (int a = 0; a < 2; ++a)
#pragma unroll
        for (int b = 0; b < 2; ++b)
#pragma unroll
            for (int m = 0; m < 4; ++m)
#pragma unroll
                for (int n = 0; n < 2; ++n) acc[a][b][m][n] = (f32x4){0.f, 0.f, 0.f, 0.f};
    bf16x8 At[4][2], B0[2][2], B1[2][2];
    const char* cA = (const char*)g.A + (size_t)cur.pm * tstepA + (g.akmode ? (size_t)(cur.pn >> 1) * 512 : 0);
    const char* cB = (const char*)g.Bt + (size_t)cur.pn * tstepB;
    PG8_STAGE(PG8_SB(0, 0), cB, voffB); PG8_STAGE(PG8_SB(0, 1), cB + hstepB, voffB); PG8_STAGE(PG8_SA(0, 0), cA, voffA); PG8_STAGE(PG8_SA(0, 1), cA + hstepA, voffA);
    if (wr == 1) PG8_BAR;
    PG8_WAIT_V(2); PG8_BAR;
    PG8_STAGE(PG8_SB(1, 0), cB + kstep, voffB); PG8_STAGE(PG8_SA(1, 0), cA + kstep, voffA); PG8_STAGE(PG8_SB(1, 1), cB + hstepB + kstep, voffB);
    PG8_WAIT_V(6); PG8_BAR;
    for (;;) {
        const bool has_next = S.next(ui + 1, nxt);
        const char* nA = has_next ? (const char*)g.A + (size_t)nxt.pm * tstepA + (g.akmode ? (size_t)(nxt.pn >> 1) * 512 : 0) : cA;
        const char* nB = has_next ? (const char*)g.Bt + (size_t)nxt.pn * tstepB : cB;
        for (int t = 0; t < nt; t += 2) {
            const bool last = (t == nt - 2);
            const char* a1 = cA + (size_t)(t + 1) * kstep;
            const char* a2 = last ? nA : cA + (size_t)(t + 2) * kstep; const char* b2 = last ? nB : cB + (size_t)(t + 2) * kstep;
            const char* a3 = a2 + kstep; const char* b3 = b2 + kstep;
            if constexpr (Epi::MID) { if (t == (nt >> 1)) E.mid(acc, cur, wr, fr); }
            PG8_LDB(B0, 0, 0); PG8_LDB(B1, 0, 1); PG8_SCHED; PG8_LDA(At, 0, 0); PG8_STAGE(PG8_SA(1, 1), a1 + hstepA, voffA);
            PG8_WAIT_V(8); PG8_WAIT_L(0); PG8_BAR; PG8_MMA(0, 0, At, B0); PG8_MMA(0, 1, At, B1); PG8_BAR; PG8_SCHED;
            PG8_LDA(At, 0, 1); PG8_STAGE(PG8_SB(0, 0), b2, voffB); PG8_STAGE(PG8_SB(0, 1), b2 + hstepB, voffB); PG8_STAGE(PG8_SA(0, 0), a2, voffA);
            PG8_WAIT_V(8); PG8_WAIT_L(0); PG8_BAR; PG8_MMA(1, 0, At, B0); PG8_MMA(1, 1, At, B1); PG8_BAR; PG8_SCHED;
            PG8_LDB(B0, 1, 0); PG8_LDB(B1, 1, 1); PG8_SCHED; PG8_LDA(At, 1, 0); PG8_STAGE(PG8_SA(0, 1), a2 + hstepA, voffA);
            PG8_WAIT_V(8); PG8_WAIT_L(0); PG8_BAR; PG8_MMA(0, 0, At, B0); PG8_MMA(0, 1, At, B1); PG8_BAR; PG8_SCHED;
            PG8_LDA(At, 1, 1); PG8_STAGE(PG8_SB(1, 0), b3, voffB); PG8_STAGE(PG8_SB(1, 1), b3 + hstepB, voffB); PG8_STAGE(PG8_SA(1, 0), a3, voffA);
            PG8_WAIT_V(8); PG8_WAIT_L(0); PG8_BAR; PG8_MMA(1, 0, At, B0); PG8_MMA(1, 1, At, B1); PG8_BAR; PG8_SCHED;
        }
        if constexpr (ALIGN_EPI) { if (wr == 0) PG8_BAR; }
        E(acc, cur, wr, wc, fr, fq);
        if (!has_next) break;
#pragma unroll
        for (int a = 0; a < 2; ++a)
#pragma unroll
            for (int b = 0; b < 2; ++b)
#pragma unroll
                for (int m = 0; m < 4; ++m)
#pragma unroll
                    for (int n = 0; n < 2; ++n) acc[a][b][m][n] = (f32x4){0.f, 0.f, 0.f, 0.f};
        cur = nxt; cA = nA; cB = nB; ++ui;
        if constexpr (ALIGN_EPI) { if (wr == 1) PG8_BAR; }
    }
    PG8_WAIT_V(0);
    if constexpr (!ALIGN_EPI) { if (wr == 0) PG8_BAR; }
    PG8_BAR;
#undef PG8_SA
#undef PG8_SB
#undef PG8_STAGE
#undef PG8_LDA
#undef PG8_LDB
#undef PG8_MMA
#undef PG8_WAIT_V
#undef PG8_WAIT_L
#undef PG8_BAR
#undef PG8_SCHED
}
}

template <class E> struct EpiWrap {
    E e; static constexpr bool MID = E::MID, PERM = E::PERM;
    __device__ __forceinline__ void operator()(const f32x4 (&acc)[2][2][4][2], const pg8::Unit& u, int wr, int wc, int fr, int fq) const {
        if constexpr (E::HAS_RES) {
            f32x4 rc[2][2], rn[2][2];
            { const int row = u.pm * 256 + wr * 64 + fr;
#pragma unroll
              for (int bj = 0; bj < 2; ++bj)
#pragma unroll
                  for (int n = 0; n < 2; ++n) rc[bj][n] = e.res(row, u.pn * 256 + bj * 128 + wc * 32 + 8 * fq + 4 * n); }
#pragma unroll
            for (int idx = 0; idx < 8; ++idx) {
                const int ai = idx >> 2, m = idx & 3;
                const int row = u.pm * 256 + ai * 128 + wr * 64 + m * 16 + fr; const float rv = e.rowval(row); float s = 0.f;
                if (idx < 7) { const int rown = u.pm * 256 + ((idx + 1) >> 2) * 128 + wr * 64 + ((idx + 1) & 3) * 16 + fr;
#pragma unroll
                    for (int bj = 0; bj < 2; ++bj)
#pragma unroll
                        for (int n = 0; n < 2; ++n) rn[bj][n] = e.res(rown, u.pn * 256 + bj * 128 + wc * 32 + 8 * fq + 4 * n); }
#pragma unroll
                for (int bj = 0; bj < 2; ++bj) s += e.applyr8(row, u.pn * 256 + bj * 128 + wc * 32 + 8 * fq, acc[ai][bj][m][0], acc[ai][bj][m][1], rv, rc[bj][0], rc[bj][1]);
                if constexpr (E::HAS_SS) { s += __shfl_xor(s, 16); s += __shfl_xor(s, 32); if (fq == 0) atomicAdd(e.ss + row, s); }
                asm volatile("" ::: "memory");
#pragma unroll
                for (int bj = 0; bj < 2; ++bj)
#pragma unroll
                    for (int n = 0; n < 2; ++n) rc[bj][n] = rn[bj][n];
            }
            return;
        }
        if constexpr (E::PERM && !E::HAS_RES) {
#pragma unroll
            for (int ai = 0; ai < 2; ++ai)
#pragma unroll
                for (int m = 0; m < 4; ++m) {
                    const int row = u.pm * 256 + ai * 128 + wr * 64 + m * 16 + fr; const float rv = e.rowval(row); float s = 0.f;
#pragma unroll
                    for (int bj = 0; bj < 2; ++bj) s += e.apply8(row, u.pn * 256 + bj * 128 + wc * 32 + 8 * fq, acc[ai][bj][m][0], acc[ai][bj][m][1], rv);
                    if constexpr (E::HAS_SS) { s += __shfl_xor(s, 16); s += __shfl_xor(s, 32); if (fq == 0) atomicAdd(e.ss + row, s); }
                    asm volatile("" ::: "memory");
                }
            return;
        }
#pragma unroll
        for (int ai = 0; ai < 2; ++ai)
#pragma unroll
            for (int m = 0; m < 4; ++m) {
                const int row = u.pm * 256 + ai * 128 + wr * 64 + m * 16 + fr; const float rv = e.rowval(row); float s = 0.f;
#pragma unroll
                for (int bj = 0; bj < 2; ++bj)
#pragma unroll
                    for (int n = 0; n < 2; ++n) s += e.apply(row, u.pn * 256 + bj * 128 + wc * 32 + n * 16 + 4 * fq, acc[ai][bj][m][n], rv);
                if constexpr (E::HAS_SS) { s += __shfl_xor(s, 16); s += __shfl_xor(s, 32); if (fq == 0) atomicAdd(e.ss + row, s); }
                asm volatile("" ::: "memory");
            }
    }
    __device__ __forceinline__ void mid(f32x4 (&acc)[2][2][4][2], const pg8::Unit& u, int wr, int fr) const {
#pragma unroll
        for (int ai = 0; ai < 2; ++ai)
#pragma unroll
            for (int m = 0; m < 4; ++m) { const float r = e.kscale(u.pm * 256 + ai * 128 + wr * 64 + m * 16 + fr, 0);
#pragma unroll
                for (int bj = 0; bj < 2; ++bj)
#pragma unroll
                    for (int n = 0; n < 2; ++n) acc[ai][bj][m][n] = acc[ai][bj][m][n] * r; }
    }
};
__device__ __forceinline__ u32x2 pk4(f32x4 v) { u32x2 w; w.x = cvt_pk_bf16(v[0], v[1]); w.y = cvt_pk_bf16(v[2], v[3]); return w; }
__device__ __forceinline__ f32x4 up4(u32x2 w) { return (f32x4){bf_lo(w.x), bf_hi(w.x), bf_lo(w.y), bf_hi(w.y)}; }
__device__ __forceinline__ float ssq4(f32x4 v) { return (v[0] * v[0] + v[1] * v[1]) + (v[2] * v[2] + v[3] * v[3]); }

struct EIn {
    static constexpr bool HAS_RES = false, PERM = true; static constexpr bool MID = false, HAS_SS = false; float* ss; const float* rs0; bf16_t* Z;
    __device__ __forceinline__ float rowval(int row) const { return rs0[row]; }
    __device__ __forceinline__ float kscale(int, int) const { return 1.f; }
    __device__ __forceinline__ float apply(int row, int col, f32x4 v, float rv) const { *(u32x2*)(Z + (size_t)row * NZ + col) = pk4(v * rv); return 0.f; }
    __device__ __forceinline__ float apply8(int row, int col, f32x4 v0, f32x4 v1, float rv) const { u32x4 w; { const u32x2 a0 = pk4(v0 * rv), a1 = pk4(v1 * rv); w.x = a0.x; w.y = a0.y; w.z = a1.x; w.w = a1.y; } *(u32x4*)(Z + (size_t)row * NZ + col) = w; return 0.f; }
};
struct EGlu {
    static constexpr bool HAS_RES = false, PERM = true; static constexpr bool MID = false, HAS_SS = true; float* ss; const float* bglu; const bf16_t* YG; bf16_t* MG;
    __device__ __forceinline__ float rowval(int) const { return 0.f; }
    __device__ __forceinline__ float kscale(int, int) const { return 1.f; }
    __device__ __forceinline__ float apply(int row, int col, f32x4 v, float) const {
        const f32x4 b = *(const f32x4*)(bglu + col); const f32x4 yg = up4(*(const u32x2*)(YG + (size_t)row * DH + col)); f32x4 o;
#pragma unroll
        for (int j = 0; j < 4; ++j) o[j] = yg[j] * sigm(v[j] + b[j]);
        *(u32x2*)(MG + (size_t)row * DM + col) = pk4(o); return ssq4(o);
    }
    __device__ __forceinline__ float apply8(int row, int col, f32x4 v0, f32x4 v1, float) const {
        const f32x4 b0 = *(const f32x4*)(bglu + col), b1 = *(const f32x4*)(bglu + col + 4); const u32x4 yr = *(const u32x4*)(YG + (size_t)row * DH + col);
        const f32x4 y0 = up4((u32x2){yr.x, yr.y}), y1 = up4((u32x2){yr.z, yr.w}); f32x4 o0, o1;
#pragma unroll
        for (int j = 0; j < 4; ++j) { o0[j] = y0[j] * sigm(v0[j] + b0[j]); o1[j] = y1[j] * sigm(v1[j] + b1[j]); }
        u32x4 w; { const u32x2 a0 = pk4(o0), a1 = pk4(o1); w.x = a0.x; w.y = a0.y; w.z = a1.x; w.w = a1.y; } *(u32x4*)(MG + (size_t)row * DM + col) = w; return ssq4(o0) + ssq4(o1);
    }
};
struct EOut {
    static constexpr bool MID = true, HAS_SS = true; float* ss; const float* rat; const float* rsb; const float* xp; const float* xs; float* XO; bf16_t* AB;
    __device__ __forceinline__ float rowval(int row) const { return rsb[row]; }
    __device__ __forceinline__ float kscale(int row, int w) const { return w < 4 ? rat[row] : 1.f; }
    static constexpr bool HAS_RES = true, PERM = true;
    __device__ __forceinline__ f32x4 res(int row, int col) const { return __builtin_nontemporal_load((const f32x4*)(xp + (size_t)row * DM + col)); }
    __device__ __forceinline__ float applyr8(int row, int col, f32x4 v0, f32x4 v1, float rv, f32x4 r0, f32x4 r1) const {
        const f32x4 o0 = r0 + v0 * rv, o1 = r1 + v1 * rv; float* p = XO + (size_t)row * DM + col; *(f32x4*)p = o0; *(f32x4*)(p + 4) = o1;
        u32x4 w; { const u32x2 a0 = pk4(o0), a1 = pk4(o1); w.x = a0.x; w.y = a0.y; w.z = a1.x; w.w = a1.y; } *(u32x4*)(AB + (size_t)row * DM + col) = w; return ssq4(o0) + ssq4(o1); }
    __device__ __forceinline__ float applyr(int row, int col, f32x4 v, float rv, f32x4 r) const {
        const f32x4 o = r + v * rv;
        *(f32x4*)(XO + (size_t)row * DM + col) = o; *(u32x2*)(AB + (size_t)row * DM + col) = pk4(o); return ssq4(o); }
    __device__ __forceinline__ float apply(int row, int col, f32x4 v, float rv) const {
        const float* xr = row < MP ? xp + (size_t)row * DM : xs + (size_t)(row - MP) * DM;
        const f32x4 o = *(const f32x4*)(xr + col) + v * rv;
        *(f32x4*)(XO + (size_t)row * DM + col) = o; *(u32x2*)(AB + (size_t)row * DM + col) = pk4(o); return ssq4(o);
    }
};
struct EUp {
    static constexpr bool HAS_RES = false, PERM = true; static constexpr bool MID = false, HAS_SS = false; float* ss; const float* ss1; bf16_t* HUP;
    __device__ __forceinline__ float rowval(int row) const { return rsqrtf(ss1[row] * (1.f / DM) + EPS); }
    __device__ __forceinline__ float kscale(int, int) const { return 1.f; }
    __device__ __forceinline__ float apply(int row, int col, f32x4 v, float rv) const { f32x4 o;
#pragma unroll
        for (int j = 0; j < 4; ++j) { const float r = fmaxf(v[j] * rv, 0.f); o[j] = r * r; }
        *(u32x2*)(HUP + (size_t)row * DFF + col) = pk4(o); return 0.f; }
    __device__ __forceinline__ float apply8(int row, int col, f32x4 v0, f32x4 v1, float rv) const { f32x4 o0, o1;
#pragma unroll
        for (int j = 0; j < 4; ++j) { const float r0 = fmaxf(v0[j] * rv, 0.f), r1 = fmaxf(v1[j] * rv, 0.f); o0[j] = r0 * r0; o1[j] = r1 * r1; }
        u32x4 w; { const u32x2 a0 = pk4(o0), a1 = pk4(o1); w.x = a0.x; w.y = a0.y; w.z = a1.x; w.w = a1.y; } *(u32x4*)(HUP + (size_t)row * DFF + col) = w; return 0.f; }
};
struct EDown {
    static constexpr bool MID = false, HAS_SS = true; float* ss; float* XO; bf16_t* AB;
    __device__ __forceinline__ float rowval(int) const { return 0.f; }
    __device__ __forceinline__ float kscale(int, int) const { return 1.f; }
    static constexpr bool HAS_RES = true, PERM = true;
    __device__ __forceinline__ f32x4 res(int row, int col) const { return *(const f32x4*)(XO + (size_t)row * DM + col); }
    __device__ __forceinline__ float applyr8(int row, int col, f32x4 v0, f32x4 v1, float, f32x4 r0, f32x4 r1) const {
        const f32x4 o0 = r0 + v0, o1 = r1 + v1; float* p = XO + (size_t)row * DM + col; *(f32x4*)p = o0; *(f32x4*)(p + 4) = o1;
        u32x4 w; { const u32x2 a0 = pk4(o0), a1 = pk4(o1); w.x = a0.x; w.y = a0.y; w.z = a1.x; w.w = a1.y; } *(u32x4*)(AB + (size_t)row * DM + col) = w; return ssq4(o0) + ssq4(o1); }
    __device__ __forceinline__ float applyr(int row, int col, f32x4 v, float, f32x4 r) const {
        const f32x4 o = r + v; *(f32x4*)(XO + (size_t)row * DM + col) = o; *(u32x2*)(AB + (size_t)row * DM + col) = pk4(o); return ssq4(o); }
    __device__ __forceinline__ float apply(int row, int col, f32x4 v, float) const {
        float* p = XO + (size_t)row * DM + col; const f32x4 o = *(const f32x4*)p + v; *(f32x4*)p = o; *(u32x2*)(AB + (size_t)row * DM + col) = pk4(o); return ssq4(o); }
};
struct EPw {
    static constexpr bool HAS_RES = false, PERM = true; static constexpr bool MID = false, HAS_SS = false; float* ss; bf16_t* PW;
    __device__ __forceinline__ float rowval(int) const { return 0.f; }
    __device__ __forceinline__ float kscale(int, int) const { return 1.f; }
    __device__ __forceinline__ float apply(int row, int col, f32x4 v, float) const { *(u32x2*)(PW + (size_t)row * DM + col) = pk4(v); return 0.f; }
    __device__ __forceinline__ float apply8(int row, int col, f32x4 v0, f32x4 v1, float) const { u32x4 w; { const u32x2 a0 = pk4(v0), a1 = pk4(v1); w.x = a0.x; w.y = a0.y; w.z = a1.x; w.w = a1.y; } *(u32x4*)(PW + (size_t)row * DM + col) = w; return 0.f; }
};
struct EGate {
    static constexpr bool MID = false, HAS_SS = true; float* ss; const float* ss2; const bf16_t* PW; float* XO;
    __device__ __forceinline__ float rowval(int row) const { return rsqrtf(ss2[row] * (1.f / DM) + EPS); }
    __device__ __forceinline__ float kscale(int, int) const { return 1.f; }
    static constexpr bool HAS_RES = true, PERM = true;
    __device__ __forceinline__ f32x4 res(int row, int col) const { return *(const f32x4*)(XO + (size_t)row * DM + col); }
    __device__ __forceinline__ float applyr8(int row, int col, f32x4 v0, f32x4 v1, float rv, f32x4 r0, f32x4 r1) const {
        const u32x4 pr = *(const u32x4*)(PW + (size_t)row * DM + col); const f32x4 p0 = up4((u32x2){pr.x, pr.y}), p1 = up4((u32x2){pr.z, pr.w}); f32x4 o0 = r0, o1 = r1;
#pragma unroll
        for (int j = 0; j < 4; ++j) { o0[j] += p0[j] * sigm(v0[j] * rv); o1[j] += p1[j] * sigm(v1[j] * rv); }
        float* p = XO + (size_t)row * DM + col; *(f32x4*)p = o0; *(f32x4*)(p + 4) = o1; return ssq4(o0) + ssq4(o1); }
    __device__ __forceinline__ float applyr(int row, int col, f32x4 v, float rv, f32x4 r) const {
        f32x4 o = r; const f32x4 pw = up4(*(const u32x2*)(PW + (size_t)row * DM + col));
#pragma unroll
        for (int j = 0; j < 4; ++j) o[j] += pw[j] * sigm(v[j] * rv);
        *(f32x4*)(XO + (size_t)row * DM + col) = o; return ssq4(o); }
    __device__ __forceinline__ float apply(int row, int col, f32x4 v, float rv) const {
        float* p = XO + (size_t)row * DM + col; f32x4 o = *(const f32x4*)p; const f32x4 pw = up4(*(const u32x2*)(PW + (size_t)row * DM + col));
#pragma unroll
        for (int j = 0; j < 4; ++j) o[j] += pw[j] * sigm(v[j] * rv);
        *(f32x4*)p = o; return ssq4(o); }
};
__device__ __forceinline__ float em1(float x) {
    float p = x * (1.f + x * (0.5f + x * (0.16666667f + x * (0.041666668f + x * (0.0083333338f + x * (0.0013888889f + x * 0.0001984127f))))));
    if (__builtin_expect(__any(fabsf(x) >= 0.5f), 0)) p = fabsf(x) < 0.5f ? p : __expf(x) - 1.f;
    return p;
}
struct ELru {
    static constexpr bool MID = false, PERM = false; const bf16_t* XC; const float* ba; const float* bi; const float* spl; float* Ao; float* Bo;
    __device__ __forceinline__ void mid(f32x4 (&)[2][2][4][2], const pg8::Unit&, int, int) const {}
    __device__ __forceinline__ void operator()(const f32x4 (&acc)[2][2][4][2], const pg8::Unit& u, int wr, int wc, int fr, int fq) const {
#pragma unroll
        for (int n = 0; n < 2; ++n) {
            const int ch = (u.pn >> 1) * 256 + (u.pn & 1) * 128 + wc * 32 + n * 16 + 4 * fq;
            const f32x4 bav = *(const f32x4*)(ba + ch), biv = *(const f32x4*)(bi + ch), sp = *(const f32x4*)(spl + ch);
#pragma unroll
            for (int ai = 0; ai < 2; ++ai)
#pragma unroll
                for (int m = 0; m < 4; ++m) {
                    const int row = u.pm * 256 + ai * 128 + wr * 64 + m * 16 + fr;
                    const f32x4 xc = up4(*(const u32x2*)(XC + (size_t)row * DH + ch)); f32x4 av, bv;
#pragma unroll
                    for (int j = 0; j < 4; ++j) { const float r = sigm(acc[ai][0][m][n][j] + bav[j]), ig = sigm(acc[ai][1][m][n][j] + biv[j]);
                        const float la = r * sp[j]; av[j] = 1.f + em1(la); bv[j] = __builtin_amdgcn_sqrtf(fmaxf(-em1(2.f * la), 0.f)) * ig * xc[j]; }
                    *(f32x4*)(Ao + (size_t)row * DH + ch) = av; *(f32x4*)(Bo + (size_t)row * DH + ch) = bv;
                    asm volatile("" ::: "memory");
                }
        }
    }
};

template <class E, int MT = 8, int NG = 1>
__device__ __forceinline__ void skinny_gemm(LAS unsigned char* lds, const bf16_t* A, int lda, const bf16_t* Bt, int ldb, int N, int K, const E& e, int nb = 0) {
    const int tid = threadIdx.x, wid = __builtin_amdgcn_readfirstlane(tid >> 6), lane = tid & 63, fr = lane & 15, fq = lane >> 4;
    LAS f32x4* red = (LAS f32x4*)lds;
    constexpr int NH = 8 / MT;
    const int kw = K >> 3, k0w = wid * kw, nks = kw >> 5, nit = ((N >> 4) / NG) * NH, G = gridDim.x, NBk = nb ? nb : G;
    for (int iti = G - 1 - (int)blockIdx.x; iti < nit && (G - 1 - (int)blockIdx.x) < NBk; iti += NBk) {
        const int n0 = (iti / NH) * (16 * NG), r0 = (iti % NH) * (MT * 16);
        f32x4 acc[NG][MT];
#pragma unroll
        for (int q = 0; q < NG; ++q)
#pragma unroll
            for (int m = 0; m < MT; ++m) acc[q][m] = (f32x4){0.f, 0.f, 0.f, 0.f};
        const bf16_t* bp = Bt + (size_t)(n0 + fr) * ldb + k0w + 8 * fq;
        const bf16_t* ap = A + (size_t)(r0 + fr) * lda + k0w + 8 * fq;
        {
            bf16x8 bc[NG], ac[MT];
#pragma unroll
            for (int q = 0; q < NG; ++q) bc[q] = *(const bf16x8*)(bp + (size_t)(16 * q) * ldb);
#pragma unroll
            for (int m = 0; m < MT; ++m) ac[m] = *(const bf16x8*)(ap + (size_t)(16 * m) * lda);
            for (int ks = 0; ks < nks; ++ks) {
                const int kn = ks + 1 < nks ? ks + 1 : ks;
                bf16x8 bn[NG], an[MT];
#pragma unroll
                for (int q = 0; q < NG; ++q) bn[q] = *(const bf16x8*)(bp + (size_t)(16 * q) * ldb + 32 * kn);
#pragma unroll
                for (int m = 0; m < MT; ++m) an[m] = *(const bf16x8*)(ap + (size_t)(16 * m) * lda + 32 * kn);
#pragma unroll
                for (int q = 0; q < NG; ++q)
#pragma unroll
                    for (int m = 0; m < MT; ++m) acc[q][m] = __builtin_amdgcn_mfma_f32_16x16x32_bf16(bc[q], ac[m], acc[q][m], 0, 0, 0);
#pragma unroll
                for (int q = 0; q < NG; ++q) bc[q] = bn[q];
#pragma unroll
                for (int m = 0; m < MT; ++m) ac[m] = an[m];
            }
        }
#pragma unroll
        for (int q = 0; q < NG; ++q)
#pragma unroll
            for (int m = 0; m < MT; ++m) red[((wid * NG + q) * MT + m) * 64 + lane] = acc[q][m];
        __syncthreads();
        if (wid < MT) {
            const int row = MP + r0 + 16 * wid + fr; const float rv = e.rowval(row);
#pragma unroll
            for (int q = 0; q < NG; ++q) {
                f32x4 v = (f32x4){0.f, 0.f, 0.f, 0.f};
#pragma unroll
                for (int w = 0; w < 8; ++w) { f32x4 p = red[((w * NG + q) * MT + wid) * 64 + lane]; if constexpr (E::MID) p = p * e.kscale(row, w); v += p; }
                float s = e.apply(row, n0 + 16 * q + 4 * fq, v, rv);
                if constexpr (E::HAS_SS) { s += __shfl_xor(s, 16); s += __shfl_xor(s, 32); if (fq == 0) atomicAdd(e.ss + row, s); }
            }
        }
        __syncthreads();
    }
}

struct Args { const float* in[37]; float* out; unsigned char* ws; int ph_lo, ph_hi; };
enum { I_XP = 0, I_XS, I_S5RE, I_S5IM, I_LRUH, I_CONV, I_PP, I_PS, I_GMIX, I_WIN, I_LAMRE, I_LAMIM, I_LOGSTEP, I_BRE, I_BIM, I_CRE, I_CIM, I_S5D,
       I_WGLU, I_BGLU, I_CONVW, I_CONVB, I_WA, I_BA, I_WI, I_BI, I_LAM, I_GMA, I_GMB, I_WOUT, I_GMLP, I_WUP, I_WDOWN, I_GPLE, I_WGATE, I_WPLE, I_GFIN };

__device__ __forceinline__ void tr_item(const float* W, int K, int N, bf16_t* WT, int rbase, int lru, const float* g1, const float* g2, int gsplit,
                                        LAS float* scr, int item, int lane) {
    const int nblk = N / 32, kb = item / nblk, nb = item % nblk, k0 = 64 * kb, n0 = 32 * nb;
    f32x4 wv[8];
#pragma unroll
    for (int i = 0; i < 8; ++i) wv[i] = __builtin_nontemporal_load((const f32x4*)(W + (size_t)(k0 + 8 * i + (lane >> 3)) * N + n0 + 4 * (lane & 7)));
#pragma unroll
    for (int i = 0; i < 8; ++i) { const int kk = 8 * i + (lane >> 3), k = k0 + kk; const float gv = g1 ? (k < gsplit ? g1[k] : g2[k - gsplit]) : 1.f;
        LAS float* d = scr + kk * 33 + 4 * (lane & 7); d[0] = wv[i][0] * gv; d[1] = wv[i][1] * gv; d[2] = wv[i][2] * gv; d[3] = wv[i][3] * gv; }
    LDS_WAIT();
    const int c = lane & 7;
#pragma unroll
    for (int j = 0; j < 4; ++j) { const int n = (lane >> 3) + 8 * j, nn = n0 + n; const int drow = lru ? rbase + (nn >> 7) * 256 + (nn & 127) : rbase + nn;
        const LAS float* s = scr + (8 * c) * 33 + n;
        u32x4 o; o.x = cvt_pk_bf16(s[0 * 33], s[1 * 33]); o.y = cvt_pk_bf16(s[2 * 33], s[3 * 33]); o.z = cvt_pk_bf16(s[4 * 33], s[5 * 33]); o.w = cvt_pk_bf16(s[6 * 33], s[7 * 33]);
        *(u32x4*)(WT + (size_t)drow * K + k0 + 8 * c) = o; }
    LDS_WAIT();
}

__device__ __forceinline__ void phase0(const Args& a, LAS unsigned char* lds) {
    const int tid = threadIdx.x, wave = __builtin_amdgcn_readfirstlane(tid >> 6), lane = tid & 63, G = gridDim.x;
    unsigned char* ws = a.ws;
    LAS float* scr = (LAS float*)(lds + wave * 16384);
    const int gw = blockIdx.x * 8 + wave, NGW = G * 8;
    constexpr int I_IN = 32 * 96, I_UP = 32 * 256, I_DOWN = 4096  , I_LRU = 8 * 32;
    constexpr int NITEMS = I_IN + I_UP + I_DOWN + I_LRU;
    for (int it = gw; it < NITEMS; it += NGW) {
        int r = it;
        if (r < I_UP) { tr_item(a.in[I_WUP], DM, DFF, (bf16_t*)(ws + WS_WUP), 0, 0, a.in[I_GMLP], a.in[I_GMLP], 1 << 30, scr, r, lane); continue; } r -= I_UP;
        if (r < I_DOWN) { tr_item(a.in[I_WDOWN], DFF, DM, (bf16_t*)(ws + WS_WDOWN), 0, 0, nullptr, nullptr, 0, scr, r, lane); continue; } r -= I_DOWN;
        if (r < I_IN) { tr_item(a.in[I_WIN], DM, NZ, (bf16_t*)(ws + WS_WIN), 0, 0, a.in[I_GMIX], a.in[I_GMIX], 1 << 30, scr, r, lane); continue; } r -= I_IN;
        { const int mat = r >> 5, h = mat >> 1, bj = mat & 1;
          tr_item((bj ? a.in[I_WI] : a.in[I_WA]) + (size_t)h * 65536, 256, 256, (bf16_t*)(ws + WS_WLRU), h * 512 + bj * 128, 1, nullptr, nullptr, 0, scr, r & 31, lane); }
    }
    float* rs0 = (float*)(ws + WS_SMALL + SM_RS0); bf16_t* XB = (bf16_t*)(ws + WS_AB); bf16_t* PB = (bf16_t*)(ws + WS_PB);
    for (int row = gw; row < MT; row += NGW) {
        const float* xr = row < MP ? a.in[I_XP] + (size_t)row * DM : a.in[I_XS] + (size_t)(row - MP) * DM;
        f32x4 v[8]; float s = 0.f;
#pragma unroll
        for (int j = 0; j < 8; ++j) { v[j] = __builtin_nontemporal_load((const f32x4*)xr + lane + 64 * j); s += ssq4(v[j]); }
        s = wave_sum(s); if (lane == 0) rs0[row] = rsqrtf(s * (1.f / DM) + EPS);
#pragma unroll
        for (int j = 0; j < 8; ++j) ((u32x2*)(XB + (size_t)row * DM))[lane + 64 * j] = pk4(v[j]);
        const float* pr = row < MP ? a.in[I_PP] + (size_t)row * DPLE : a.in[I_PS] + (size_t)(row - MP) * DPLE;
        ((u32x2*)(PB + (size_t)row * DPLE))[lane] = pk4(__builtin_nontemporal_load((const f32x4*)pr + lane));
    }
    { float* SPL = (float*)(ws + WS_SMALL + SM_SPL);
      for (int i = blockIdx.x * 512 + tid; i < DH; i += G * 512) { const float xl = -a.in[I_LAM][i]; SPL[i] = -8.f * (fmaxf(xl, 0.f) + log1pf(expf(-fabsf(xl)))); } }
    float* AR = (float*)(ws + WS_SMALL + SM_AR); float* AI = (float*)(ws + WS_SMALL + SM_AI); float* A64R = (float*)(ws + WS_SMALL + SM_A64R); float* A64I = (float*)(ws + WS_SMALL + SM_A64I);
    bf16_t* BBB = (bf16_t*)(ws + WS_SMALL + SM_BBB); bf16_t* CMB = (bf16_t*)(ws + WS_SMALL + SM_CMB);
    for (int i = blockIdx.x * 512 + tid; i < 4096; i += G * 512) {
        const int g = i >> 6, p = i & 63;
        const float step = expf(a.in[I_LOGSTEP][g]), lr = a.in[I_LAMRE][i], li = a.in[I_LAMIM][i];
        const float mag = expf(lr * step); float sn, cs; sincosf(li * step, &sn, &cs);
        const float ar = mag * cs, ai = mag * sn, nr = ar - 1.f, ni = ai, den = lr * lr + li * li;
        const float cr = (nr * lr + ni * li) / den, ci = (ni * lr - nr * li) / den;
        AR[i] = ar; AI[i] = ai;
        float pr_ = ar, pi_ = ai;
#pragma unroll
        for (int q = 0; q < 6; ++q) { const float t0 = pr_ * pr_ - pi_ * pi_, t1 = 2.f * pr_ * pi_; pr_ = t0; pi_ = t1; }
        A64R[i] = pr_; A64I[i] = pi_;
        for (int c = 0; c < 16; ++c) {
            const float br = a.in[I_BRE][(size_t)i * 16 + c], bi = a.in[I_BIM][(size_t)i * 16 + c];
            BBB[((size_t)g * 128 + p) * 16 + c] = (bf16_t)(cvt_pk_bf16(cr * br - ci * bi, 0.f) & 0xffffu);
            BBB[((size_t)g * 128 + 64 + p) * 16 + c] = (bf16_t)(cvt_pk_bf16(cr * bi + ci * br, 0.f) & 0xffffu);
            CMB[((size_t)g * 16 + c) * 128 + p] = (bf16_t)(cvt_pk_bf16(a.in[I_CRE][((size_t)g * 16 + c) * 64 + p], 0.f) & 0xffffu);
            CMB[((size_t)g * 16 + c) * 128 + 64 + p] = (bf16_t)(cvt_pk_bf16(-a.in[I_CIM][((size_t)g * 16 + c) * 64 + p], 0.f) & 0xffffu);
        }
    }
}

__device__ __forceinline__ void s5_unit(const Args& a, LAS unsigned char* wl, int lane, int mode, int n, int g, int j) {
    unsigned char* ws = a.ws;
    const int fr = lane & 15, fq = lane >> 4;
    const float* AR = (const float*)(ws + WS_SMALL + SM_AR); const float* AI = (const float*)(ws + WS_SMALL + SM_AI);
    const bf16_t* BBB = (const bf16_t*)(ws + WS_SMALL + SM_BBB); const bf16_t* CMB = (const bf16_t*)(ws + WS_SMALL + SM_CMB);
    const bf16_t* Z = (const bf16_t*)(ws + WS_Z); bf16_t* YG = (bf16_t*)(ws + WS_YG); float* SUM = (float*)(ws + WS_S5SUM);
    LAS float* BuS = (LAS float*)wl; LAS bf16_t* Hs = (LAS bf16_t*)(wl + 8448);
    const float ar = AR[g * 64 + lane], ai = AI[g * 64 + lane];
    const bf16x8 zero8 = (bf16x8){0, 0, 0, 0, 0, 0, 0, 0};
    bf16x8 bb[8];
#pragma unroll
    for (int t = 0; t < 8; ++t) bb[t] = fq < 2 ? *(const bf16x8*)(BBB + ((size_t)g * 128 + 16 * t + fr) * 16 + 8 * fq) : zero8;
    bf16x8 cm[4];
#pragma unroll
    for (int kk = 0; kk < 4; ++kk) cm[kk] = *(const bf16x8*)(CMB + ((size_t)g * 16 + fr) * 128 + 32 * kk + 8 * fq);
    const f32x4 dsk = *(const f32x4*)(a.in[I_S5D] + 16 * g + 4 * fq);
    float hr = 0.f, hi = 0.f;
    if (mode == 1 && j > 0) {
        const float pr = ((const float*)(ws + WS_SMALL + SM_A64R))[g * 64 + lane], pi = ((const float*)(ws + WS_SMALL + SM_A64I))[g * 64 + lane];
        const float* sp = SUM + ((size_t)(n * 64 + g) * 32) * 128;
        for (int i = 0; i < j; ++i) { const float sr = sp[i * 128 + lane], si = sp[i * 128 + 64 + lane];
            const float t0 = pr * hr - pi * hi + sr, t1 = pr * hi + pi * hr + si; hr = t0; hi = t1; }
    }
    if (mode == 4 && j > 0) {
        float pr = ((const float*)(ws + WS_SMALL + SM_A64R))[g * 64 + lane], pi = ((const float*)(ws + WS_SMALL + SM_A64I))[g * 64 + lane];
#pragma unroll
        for (int q = 0; q < 2; ++q) { const float t0 = pr * pr - pi * pi, t1 = 2.f * pr * pi; pr = t0; pi = t1; }
        for (int v = 0; v < j; ++v) { const LAS float* ps = (const LAS float*)(wl + (v - j) * 16384 + 12800); const float sr = ps[lane], si = ps[64 + lane];
            const float t0 = pr * hr - pi * hi + sr, t1 = pr * hi + pi * hr + si; hr = t0; hi = t1; }
    }
    const int row0 = mode == 2 ? MP + 16 * j : ((mode == 3 || mode == 4) ? n * SEQ + 256 * j : n * SEQ + 64 * j);
    const int nblk = mode == 2 ? 1 : ((mode == 3 || mode == 1 || mode == 4) ? 16 : 4);
    for (int blk = 0; blk < nblk; ++blk) {
        const int r0 = row0 + 16 * blk;
        const bf16x8 ua = fq < 2 ? *(const bf16x8*)(Z + (size_t)(r0 + fr) * NZ + 16 * g + 8 * fq) : zero8;
        u32x2 u4raw = (u32x2){0u, 0u}; if (mode == 1 || mode == 2 || mode == 4) u4raw = *(const u32x2*)(Z + (size_t)(r0 + fr) * NZ + 16 * g + 4 * fq);
#pragma unroll
        for (int t = 0; t < 8; ++t) {
            const f32x4 c = __builtin_amdgcn_mfma_f32_16x16x32_bf16(ua, bb[t], (f32x4){0.f, 0.f, 0.f, 0.f}, 0, 0, 0);
#pragma unroll
            for (int jj = 0; jj < 4; ++jj) BuS[(4 * fq + jj) * 132 + 16 * t + fr] = c[jj];
        }
        LDS_WAIT();
        float burv[16], buiv[16];
#pragma unroll
        for (int t = 0; t < 16; ++t) { burv[t] = BuS[t * 132 + lane]; buiv[t] = BuS[t * 132 + 64 + lane]; }
#pragma unroll
        for (int t = 0; t < 16; ++t) {
            const float bur = burv[t], bui = buiv[t];
            if (mode == 2) { const size_t si = ((size_t)(r0 - MP + t) * 64 + g) * 64 + lane; hr = a.in[I_S5RE][si]; hi = a.in[I_S5IM][si]; }
            const float t0 = ar * hr - ai * hi + bur, t1 = ar * hi + ai * hr + bui; hr = t0; hi = t1;
            if (mode == 2) { const size_t si = ((size_t)(r0 - MP + t) * 64 + g) * 64 + lane; a.out[O_S5RS + si] = hr; a.out[O_S5IS + si] = hi; }
            if (mode == 1 || mode == 2 || mode == 4) { const unsigned w = cvt_pk_bf16(hr, hi); Hs[t * 136 + lane] = (bf16_t)(w & 0xffffu); Hs[t * 136 + 64 + lane] = (bf16_t)(w >> 16); }
        }
        if (mode == 1 || mode == 2 || mode == 4) {
            LDS_WAIT();
            f32x4 y = (f32x4){0.f, 0.f, 0.f, 0.f};
#pragma unroll
            for (int kk = 0; kk < 4; ++kk) { const bf16x8 hb = *(const LAS bf16x8*)(Hs + fr * 136 + 32 * kk + 8 * fq);
                y = __builtin_amdgcn_mfma_f32_16x16x32_bf16(cm[kk], hb, y, 0, 0, 0); }
            const f32x4 u4 = up4(u4raw); f32x4 o;
#pragma unroll
            for (int jj = 0; jj < 4; ++jj) o[jj] = gelu_t(y[jj] + dsk[jj] * u4[jj]);
            *(u32x2*)(YG + (size_t)(r0 + fr) * DH + 16 * g + 4 * fq) = pk4(o);
            LDS_WAIT();
        }
    }
    if (mode == 0) { float* sp = SUM + ((size_t)(n * 64 + g) * 32 + j) * 128; sp[lane] = hr; sp[64 + lane] = hi; }
    if (mode == 3) { LAS float* ps = (LAS float*)(wl + 12800); ps[lane] = hr; ps[64 + lane] = hi; }
    if (mode == 4 && j == 7) { a.out[O_S5RP + (size_t)(n * 64 + g) * 64 + lane] = hr; a.out[O_S5IP + (size_t)(n * 64 + g) * 64 + lane] = hi; }
}

__device__ __forceinline__ void conv_prompt(const Args& a) {
    unsigned char* ws = a.ws; const bf16_t* Z = (const bf16_t*)(ws + WS_Z); bf16_t* XC = (bf16_t*)(ws + WS_XC);
    const float* cw = a.in[I_CONVW]; const float* cb = a.in[I_CONVB];
    const int G = gridDim.x;
    for (int it = blockIdx.x * 512 + threadIdx.x; it < MP * 128; it += G * 512) {
        const int row = it >> 7, c = (it & 127) * 8, t = row & (SEQ - 1);
        float acc[8];
#pragma unroll
        for (int q = 0; q < 8; ++q) acc[q] = cb[c + q];
#pragma unroll
        for (int k = 0; k < 4; ++k) {
            if (t - 3 + k >= 0) {
                const u32x4 z = *(const u32x4*)(Z + (size_t)(row - 3 + k) * NZ + DH + c);
                const float x[8] = {bf_lo(z.x), bf_hi(z.x), bf_lo(z.y), bf_hi(z.y), bf_lo(z.z), bf_hi(z.z), bf_lo(z.w), bf_hi(z.w)};
#pragma unroll
                for (int q = 0; q < 8; ++q) acc[q] += cw[k * DH + c + q] * x[q];
                if (k == 3 && t >= SEQ - 3) {
                    float* o = a.out + O_CONVP + ((size_t)(row >> 11) * 3 + (t - (SEQ - 3))) * DH + c;
#pragma unroll
                    for (int q = 0; q < 8; ++q) o[q] = x[q];
                }
            }
        }
        u32x4 o; o.x = cvt_pk_bf16(acc[0], acc[1]); o.y = cvt_pk_bf16(acc[2], acc[3]); o.z = cvt_pk_bf16(acc[4], acc[5]); o.w = cvt_pk_bf16(acc[6], acc[7]);
        *(u32x4*)(XC + (size_t)row * DH + c) = o;
    }
}

__device__ __forceinline__ void conv_tile(const Args& a, int pm, int h) {
    unsigned char* ws = a.ws; const bf16_t* Z = (const bf16_t*)(ws + WS_Z); bf16_t* XC = (bf16_t*)(ws + WS_XC);
    const int tid = threadIdx.x, c = h * 256 + (tid & 31) * 8;
    float cwv[4][8], cbv[8];
#pragma unroll
    for (int q = 0; q < 8; ++q) { cbv[q] = a.in[I_CONVB][c + q];
#pragma unroll
        for (int k = 0; k < 4; ++k) cwv[k][q] = a.in[I_CONVW][k * DH + c + q]; }
#pragma unroll 1
    for (int r4 = 0; r4 < 16; r4 += 4) {
        u32x4 z[4][4];
#pragma unroll
        for (int rr = 0; rr < 4; ++rr) { const int row = pm * 256 + (tid >> 5) + 16 * (r4 + rr), t = row & (SEQ - 1);
#pragma unroll
            for (int k = 0; k < 4; ++k) z[rr][k] = (t - 3 + k >= 0) ? *(const u32x4*)(Z + (size_t)(row - 3 + k) * NZ + DH + c) : (u32x4){0u, 0u, 0u, 0u}; }
#pragma unroll
        for (int rr = 0; rr < 4; ++rr) { const int row = pm * 256 + (tid >> 5) + 16 * (r4 + rr), t = row & (SEQ - 1);
            float acc[8];
#pragma unroll
            for (int q = 0; q < 8; ++q) acc[q] = cbv[q];
#pragma unroll
            for (int k = 0; k < 4; ++k) { const u32x4 zz = z[rr][k];
                const float x[8] = {bf_lo(zz.x), bf_hi(zz.x), bf_lo(zz.y), bf_hi(zz.y), bf_lo(zz.z), bf_hi(zz.z), bf_lo(zz.w), bf_hi(zz.w)};
#pragma unroll
                for (int q = 0; q < 8; ++q) acc[q] += cwv[k][q] * x[q];
                if (k == 3 && t >= SEQ - 3) { float* o = a.out + O_CONVP + ((size_t)(row >> 11) * 3 + (t - (SEQ - 3))) * DH + c;
#pragma unroll
                    for (int q = 0; q < 8; ++q) o[q] = x[q]; } }
            u32x4 o; o.x = cvt_pk_bf16(acc[0], acc[1]); o.y = cvt_pk_bf16(acc[2], acc[3]); o.z = cvt_pk_bf16(acc[4], acc[5]); o.w = cvt_pk_bf16(acc[6], acc[7]);
            *(u32x4*)(XC + (size_t)row * DH + c) = o; }
    }
}

__device__ __forceinline__ void lru_sample(const Args& a, LAS unsigned char* lds, int unit) {
    unsigned char* ws = a.ws; const bf16_t* Z = (const bf16_t*)(ws + WS_Z); bf16_t* MG = (bf16_t*)(ws + WS_MERGED); float* ssB = (float*)(ws + WS_CTL) + SS_B * SS_STRIDE;
    LAS float* sxc = (LAS float*)lds;
    const int tid = threadIdx.x, s = unit >> 1, half = unit & 1, row = MP + s;
    const float* cw = a.in[I_CONVW]; const float* cs = a.in[I_CONV] + (size_t)s * 3 * DH;
    for (int c = tid; c < DH; c += 512) {
        const float xb = bf1(Z[(size_t)row * NZ + DH + c]);
        sxc[c] = a.in[I_CONVB][c] + cw[c] * cs[c] + cw[DH + c] * cs[DH + c] + cw[2 * DH + c] * cs[2 * DH + c] + cw[3 * DH + c] * xb;
        if ((c >> 9) == half) { float* o = a.out + O_CONVS + (size_t)s * 3 * DH; o[c] = cs[DH + c]; o[DH + c] = cs[2 * DH + c]; o[2 * DH + c] = xb; }
    }
    __syncthreads();
    float sq = 0.f;
    {
        const int c = half * 512 + tid, h = c >> 8, jj = c & 255;
        const float* wa = a.in[I_WA] + (size_t)h * 65536 + jj; const float* wi = a.in[I_WI] + (size_t)h * 65536 + jj;
        float ra = a.in[I_BA][c], ri = a.in[I_BI][c];
#pragma unroll 1
        for (int k0 = 0; k0 < 256; k0 += 32) {
            float wav[32], wiv[32];
#pragma unroll
            for (int q = 0; q < 32; ++q) { wav[q] = wa[(size_t)(k0 + q) * 256]; wiv[q] = wi[(size_t)(k0 + q) * 256]; }
#pragma unroll
            for (int q = 0; q < 32; ++q) { const float x = sxc[h * 256 + k0 + q]; ra += x * wav[q]; ri += x * wiv[q]; }
        }
        const float r = sigm(ra), ig = sigm(ri); const float xl = -a.in[I_LAM][c]; const float sp = fmaxf(xl, 0.f) + log1pf(expf(-fabsf(xl)));
        const float la = -8.f * r * sp, av = expf(la), bv = sqrtf(-expm1f(2.f * la)) * ig * sxc[c];
        const float hn = av * a.in[I_LRUH][(size_t)s * DH + c] + bv;
        a.out[O_LRUS + (size_t)s * DH + c] = hn;
        const float o = hn * gelu_t(bf1(Z[(size_t)row * NZ + 2 * DH + c]));
        MG[(size_t)row * DM + DH + c] = (bf16_t)(cvt_pk_bf16(o, 0.f) & 0xffffu);
        sq = o * o;
    }
    sq = wave_sum(sq);
    if ((tid & 63) == 0) atomicAdd(ssB + row, sq);
    __syncthreads();
}

__device__ __forceinline__ void lru_scan_unit(const Args& a, LAS unsigned char* lds, int unit) {
    unsigned char* ws = a.ws; const bf16_t* Z = (const bf16_t*)(ws + WS_Z); bf16_t* MG = (bf16_t*)(ws + WS_MERGED); float* ssB = (float*)(ws + WS_CTL) + SS_B * SS_STRIDE;
    const float* Ao = a.out; const float* Bo = a.out + (size_t)MP * DH;
    LAS float* sP = (LAS float*)lds; LAS float* sH = sP + 512; LAS float* rsum = sH + 512;
    const int tid = threadIdx.x, n = unit >> 6, ch = (unit & 63) * 16 + (tid & 15), j = tid >> 4;
    const size_t r0 = (size_t)n * SEQ + 64 * j;
    float P = 1.f, h = 0.f;
#pragma unroll 1
    for (int tb = 0; tb < 64; tb += 16) {
        float av[16], bv[16];
#pragma unroll
        for (int q = 0; q < 16; ++q) { av[q] = Ao[(r0 + tb + q) * DH + ch]; bv[q] = Bo[(r0 + tb + q) * DH + ch]; }
#pragma unroll
        for (int q = 0; q < 16; ++q) { h = av[q] * h + bv[q]; P *= av[q]; }
    }
    sP[tid] = P; sH[tid] = h;
    __syncthreads();
    float H = 0.f;
    for (int i = 0; i < j; ++i) H = sP[i * 16 + (tid & 15)] * H + sH[i * 16 + (tid & 15)];
    h = H;
#pragma unroll 1
    for (int tb = 0; tb < 64; tb += 16) {
        float av[16], bv[16]; bf16_t gz[16];
#pragma unroll
        for (int q = 0; q < 16; ++q) { const size_t row = r0 + tb + q; av[q] = Ao[row * DH + ch]; bv[q] = Bo[row * DH + ch]; gz[q] = Z[row * NZ + 2 * DH + ch]; }
#pragma unroll
        for (int q = 0; q < 16; ++q) {
            const size_t row = r0 + tb + q;
            h = av[q] * h + bv[q];
            const float o = h * gelu_t(bf1(gz[q]));
            MG[row * DM + DH + ch] = (bf16_t)(cvt_pk_bf16(o, 0.f) & 0xffffu);
            float s = o * o; s += __shfl_xor(s, 1); s += __shfl_xor(s, 2); s += __shfl_xor(s, 4); s += __shfl_xor(s, 8);
            if ((tid & 15) == 0) rsum[64 * j + tb + q] = s;
        }
    }
    __syncthreads();
    for (int r = tid; r < SEQ; r += 512) atomicAdd(ssB + (size_t)n * SEQ + r, rsum[r]);
    if (j == 31) a.out[O_LRUP + (size_t)n * DH + ch] = h;
    __syncthreads();
}

#define XB_TMO      128
#define XB_XCNT(j)  (256  + 64 * (j))
#define XB_XSUB(j)  (1280 + 64 * (j))
#define XB_XGEN(j)  (2304 + 64 * (j))
#define XB_TOP      3328
#define XB_TOPGEN   3392
#define XB_SPIN_CAP (1u << 18)
__device__ __forceinline__ unsigned xb_ld(unsigned* p)              { return __hip_atomic_load(p, __ATOMIC_RELAXED, __HIP_MEMORY_SCOPE_AGENT); }
__device__ __forceinline__ unsigned xb_add(unsigned* p, unsigned v) { return __hip_atomic_fetch_add(p, v, __ATOMIC_RELAXED, __HIP_MEMORY_SCOPE_AGENT); }
__device__ __forceinline__ unsigned xb_xcc_id() { return (unsigned)__builtin_amdgcn_s_getreg((3 << 11) | 20) & 0xFu; }
#define XB_SPIN(cond, bar) do { unsigned _sp = 0; while (cond) { __builtin_amdgcn_s_sleep(1); \
    if ((++_sp & 255u) == 0u) { if (xb_ld(&(bar)[XB_TMO])) break; if (_sp > XB_SPIN_CAP) { atomicAdd(&(bar)[XB_TMO], 1u); break; } } } } while (0)
struct XcdBarrier { unsigned* bar; unsigned x; volatile LAS unsigned* st; };
__device__ __forceinline__ XcdBarrier xcd_barrier_post(unsigned* bar, volatile LAS unsigned* st) {
    XcdBarrier b; b.bar = bar; b.x = xb_xcc_id(); b.st = st;
    if (threadIdx.x == 0) (void)xb_add(&bar[XB_XCNT(b.x)], 1u);
    return b;
}
__device__ __forceinline__ void xcd_barrier_complete(unsigned* bar, unsigned x, unsigned& nloc, unsigned& nx) {
    const unsigned G = gridDim.x * gridDim.y * gridDim.z;
    unsigned sum, cnt, mine, sp = 0u;
    for (;;) {
        sum = 0u; cnt = 0u; mine = 0u;
#pragma unroll
        for (unsigned j = 0; j < 16; ++j) { const unsigned c = xb_ld(&bar[XB_XCNT(j)]); sum += c; cnt += (c > 0u) ? 1u : 0u; mine = (j == x) ? c : mine; }
        if (sum == G) break;
        __builtin_amdgcn_s_sleep(1);
        if ((++sp & 255u) == 0u) { if (xb_ld(&bar[XB_TMO])) break; if (sp > XB_SPIN_CAP) { atomicAdd(&bar[XB_TMO], 1u); break; } }
    }
    nloc = mine > 0u ? mine : 1u; nx = cnt > 0u ? cnt : 1u;
}
__device__ __forceinline__ void xcd_barrier(const XcdBarrier& b) {
    asm volatile("s_waitcnt vmcnt(0)" ::: "memory");
    __syncthreads();
    if (threadIdx.x == 0) {
        unsigned* bar = b.bar;
        __builtin_amdgcn_s_waitcnt(0);
        unsigned nloc = b.st[0], nx = b.st[1];
        if (nloc == 0u) { xcd_barrier_complete(bar, b.x, nloc, nx); b.st[0] = nloc; b.st[1] = nx; }
        const unsigned old = xb_add(&bar[XB_XSUB(b.x)], 1u);
        const unsigned gen = old / nloc;
        if (old + 1u == (gen + 1u) * nloc) {
            __builtin_amdgcn_fence(__ATOMIC_RELEASE, "agent");
            asm volatile("s_waitcnt vmcnt(0)" ::: "memory");
            const unsigned og = xb_add(&bar[XB_TOP], 1u);
            const unsigned tg = og / nx;
            if (og + 1u == (tg + 1u) * nx) xb_add(&bar[XB_TOPGEN], 1u);
            else XB_SPIN(xb_ld(&bar[XB_TOPGEN]) == tg, bar);
            __builtin_amdgcn_fence(__ATOMIC_ACQUIRE, "agent");
            xb_add(&bar[XB_XGEN(b.x)], 1u);
            asm volatile("s_waitcnt vmcnt(0)" ::: "memory");
        } else {
            XB_SPIN(xb_ld(&bar[XB_XGEN(b.x)]) == gen, bar);
            __builtin_amdgcn_fence(__ATOMIC_ACQUIRE, "agent");
            asm volatile("s_waitcnt vmcnt(0)" ::: "memory");
        }
    }
    __syncthreads();
}

__global__ void __launch_bounds__(512, 2) fwd_kernel(Args a) {
    extern __shared__ __attribute__((aligned(16))) unsigned char lds_raw[];
    LAS unsigned char* lds = (LAS unsigned char*)lds_raw;
    const int tid = threadIdx.x, wave = __builtin_amdgcn_readfirstlane(tid >> 6), lane = tid & 63, G = gridDim.x;
    unsigned char* ws = a.ws;
    const int lo = a.ph_lo, hi = a.ph_hi;
    volatile LAS unsigned* MISC = (volatile LAS unsigned*)(lds + MISC_OFF);
    for (int u = tid; u < (LDS_BYTES - RING_BYTES) / 4; u += 512) ((LAS unsigned*)(lds + RING_BYTES))[u] = 0u;
    __syncthreads();
#if MK_LAUNCHES == 1
    XcdBarrier bar = xcd_barrier_post((unsigned*)(ws + WS_CTL) + CW_BAR, MISC + 8);
#define GRID_BAR() xcd_barrier(bar)
#else
#define GRID_BAR() do {} while (0)
#endif
#define IN(k) (lo <= (k) && (k) < hi)
#define BOTH(k) (IN(k) && IN((k) + 1))
#define ssb ((float*)(ws + WS_CTL))
#define AB ((bf16_t*)(ws + WS_AB))
#define Z ((bf16_t*)(ws + WS_Z))
#define YG ((bf16_t*)(ws + WS_YG))
#define MG ((bf16_t*)(ws + WS_MERGED))
#define HUP ((bf16_t*)(ws + WS_HUP))
#define PW ((bf16_t*)(ws + WS_PW))
#define PB ((bf16_t*)(ws + WS_PB))
#define XO (a.out + O_Y)

    if (IN(0)) { phase0(a, lds); if (BOTH(0)) GRID_BAR(); }

    if (IN(1)) {
        pg8::Gemm g{AB, (const bf16_t*)(ws + WS_WIN), DM, DM, DM, 0}; pg8::StaticOrder S; S.init(MP / 256, NZ / 256, G, (int)blockIdx.x);
        EpiWrap<EIn> E{{nullptr, (const float*)(ws + WS_SMALL + SM_RS0), Z}};
        pg8::gemm_phase<EpiWrap<EIn>, true>(lds, g, S, E);
        skinny_gemm<EIn, 8, 2>(lds, AB + (size_t)MP * DM, DM, (const bf16_t*)(ws + WS_WIN), DM, NZ, DM, E.e, G / 2);
        if ((int)blockIdx.x >= G / 2) {
            const int w = ((int)blockIdx.x - G / 2) * 8 + wave, nw = (G - G / 2) * 8; LAS float* scr = (LAS float*)(lds + wave * 16384);
            constexpr int J_OUT = 32 * 64, J_GATE = 32 * 64, J_GLU = 16 * 32, J_PLE = 4 * 64;
            for (int it = w; it < J_OUT + J_GATE + J_GLU + J_PLE; it += nw) {
                int r = it;
                if (r < J_OUT) { tr_item(a.in[I_WOUT], DM, DM, (bf16_t*)(ws + WS_WOUT), 0, 0, a.in[I_GMA], a.in[I_GMB], DH, scr, r, lane); continue; } r -= J_OUT;
                if (r < J_GATE) { tr_item(a.in[I_WGATE], DM, DM, (bf16_t*)(ws + WS_WGATE), 0, 0, a.in[I_GPLE], a.in[I_GPLE], 1 << 30, scr, r, lane); continue; } r -= J_GATE;
                if (r < J_GLU) { tr_item(a.in[I_WGLU], DH, DH, (bf16_t*)(ws + WS_WGLU), 0, 0, nullptr, nullptr, 0, scr, r, lane); continue; } r -= J_GLU;
                tr_item(a.in[I_WPLE], DPLE, DM, (bf16_t*)(ws + WS_WPLE), 0, 0, nullptr, nullptr, 0, scr, r, lane);
            }
        }
        if (BOTH(1)) GRID_BAR();
    }

    if (IN(3)) {
        pg8::Gemm g{(const bf16_t*)(ws + WS_XC), (const bf16_t*)(ws + WS_WLRU), DH, 256, 256, 1}; pg8::StaticOrder S; S.init(MP / 256, 8, G, (int)blockIdx.x);
        { pg8::Unit cu; for (int i = 0; S.next(i, cu); ++i) conv_tile(a, cu.pm, cu.pn >> 1); }
        asm volatile("s_waitcnt vmcnt(0)" ::: "memory"); __syncthreads();
        ELru E{(const bf16_t*)(ws + WS_XC), a.in[I_BA], a.in[I_BI], (const float*)(ws + WS_SMALL + SM_SPL), a.out, a.out + (size_t)MP * DH};
        pg8::gemm_phase<ELru, true>(lds, g, S, E);
        for (int s = G - 1 - (int)blockIdx.x; s < 2 * MS; s += G) lru_sample(a, lds, s);
        for (int u = (G % 8 == 0) ? ((int)blockIdx.x % 8) * (G / 8) + (int)blockIdx.x / 8 : (int)blockIdx.x; u < NB * 64; u += G) {
            const int n = u >> 6, g2 = u & 63;
            s5_unit(a, lds + wave * 16384, lane, 3, n, g2, wave);
            __syncthreads();
            s5_unit(a, lds + wave * 16384, lane, 4, n, g2, wave);
            __syncthreads();
        }
        for (int u = blockIdx.x * 8 + wave; u < 512; u += G * 8) s5_unit(a, lds + wave * 16384, lane, 2, 0, u >> 3, u & 7);
        if (BOTH(3)) GRID_BAR();
    }

    if (IN(4)) {
        pg8::Gemm g{YG, (const bf16_t*)(ws + WS_WGLU), DH, DH, DH, 0}; pg8::StaticOrder S; S.init(MP / 256, DH / 256, G, (int)blockIdx.x);
        EpiWrap<EGlu> E{{ssb + SS_A * SS_STRIDE, a.in[I_BGLU], YG, MG}};
        pg8::gemm_phase<EpiWrap<EGlu>, true>(lds, g, S, E);
        skinny_gemm<EGlu, 4>(lds, YG + (size_t)MP * DH, DH, (const bf16_t*)(ws + WS_WGLU), DH, DH, DH, E.e);
        {
            const int vb = G - 1 - (int)blockIdx.x, vs = (G % 8 == 0) ? (vb % 8) * (G / 8) + vb / 8 : vb;
            for (int u = vs; u < NB * 64; u += G) lru_scan_unit(a, lds, u);
        }
        if ((int)blockIdx.x >= G / 2) {
            const int w = ((int)blockIdx.x - G / 2) * 8 + wave, nw = (G - G / 2) * 8;
            for (int it = 4096 + w; it < 128 * 64; it += nw) tr_item(a.in[I_WDOWN], DFF, DM, (bf16_t*)(ws + WS_WDOWN), 0, 0, nullptr, nullptr, 0, (LAS float*)(lds + wave * 16384), it, lane);
        }
        if (BOTH(4)) GRID_BAR();
    }

    if (IN(5)) {
        pg8::Gemm g{MG, (const bf16_t*)(ws + WS_WOUT), DM, DM, DM, 0}; pg8::StaticOrder S; S.init(MP / 256, DM / 256, G, (int)blockIdx.x);
        { float* RAT = (float*)(ws + WS_SMALL + SM_RAT); float* RSB = (float*)(ws + WS_SMALL + SM_RSB);
          pg8::Unit cu;
          for (int ui = -1; ui < 0 || S.next(ui, cu); ++ui)
              for (int i = tid; i < (ui < 0 ? MS : 256); i += 512) { const int row = ui < 0 ? MP + i : cu.pm * 256 + i;
                  const float va = ssb[SS_A * SS_STRIDE + row] * (1.f / DH) + EPS, vb = ssb[SS_B * SS_STRIDE + row] * (1.f / DH) + EPS; RAT[row] = sqrtf(vb / va); RSB[row] = rsqrtf(vb); }
          asm volatile("s_waitcnt vmcnt(0)" ::: "memory"); __syncthreads(); }
        EpiWrap<EOut> E{{ssb + SS_1 * SS_STRIDE, (const float*)(ws + WS_SMALL + SM_RAT), (const float*)(ws + WS_SMALL + SM_RSB), a.in[I_XP], a.in[I_XS], XO, AB}};
        pg8::gemm_phase<EpiWrap<EOut>, true>(lds, g, S, E);
        skinny_gemm<EOut, 4>(lds, MG + (size_t)MP * DM, DM, (const bf16_t*)(ws + WS_WOUT), DM, DM, DM, E.e);
        if (BOTH(5)) GRID_BAR();
    }

    if (IN(6)) {
        pg8::Gemm g{AB, (const bf16_t*)(ws + WS_WUP), DM, DM, DM, 0}; pg8::StaticOrder S; S.init(MP / 256, DFF / 256, G, (int)blockIdx.x);
        EpiWrap<EUp> E{{nullptr, ssb + SS_1 * SS_STRIDE, HUP}};
        pg8::gemm_phase<EpiWrap<EUp>, true>(lds, g, S, E);
        skinny_gemm<EUp, 8, 2>(lds, AB + (size_t)MP * DM, DM, (const bf16_t*)(ws + WS_WUP), DM, DFF, DM, E.e);
        if (BOTH(6)) GRID_BAR();
    }

    if (IN(7)) {
        pg8::Gemm g{HUP, (const bf16_t*)(ws + WS_WDOWN), DFF, DFF, DFF, 0}; pg8::StaticOrder S; S.init(MP / 256, DM / 256, G, (int)blockIdx.x);
        EpiWrap<EDown> E{{ssb + SS_2 * SS_STRIDE, XO, AB}};
        pg8::gemm_phase<EpiWrap<EDown>, true>(lds, g, S, E);
        skinny_gemm<EDown, 4>(lds, HUP + (size_t)MP * DFF, DFF, (const bf16_t*)(ws + WS_WDOWN), DFF, DM, DFF, E.e);
        if (BOTH(7)) GRID_BAR();
    }

    if (IN(8)) {
        { pg8::Gemm g{PB, (const bf16_t*)(ws + WS_WPLE), DPLE, DPLE, DPLE, 0}; pg8::StaticOrder S; S.init(MP / 256, DM / 256, G, (int)blockIdx.x);
          EpiWrap<EPw> E{{nullptr, PW}};
          pg8::gemm_phase<EpiWrap<EPw>, true>(lds, g, S, E);
          skinny_gemm<EPw, 4>(lds, PB + (size_t)MP * DPLE, DPLE, (const bf16_t*)(ws + WS_WPLE), DPLE, DM, DPLE, E.e); }
        asm volatile("s_waitcnt vmcnt(0)" ::: "memory"); __syncthreads();
        { pg8::Gemm g{AB, (const bf16_t*)(ws + WS_WGATE), DM, DM, DM, 0}; pg8::StaticOrder S; S.init(MP / 256, DM / 256, G, (int)blockIdx.x);
          EpiWrap<EGate> E{{ssb + SS_3 * SS_STRIDE, ssb + SS_2 * SS_STRIDE, PW, XO}};
          pg8::gemm_phase<EpiWrap<EGate>, true>(lds, g, S, E);
          skinny_gemm<EGate, 4>(lds, AB + (size_t)MP * DM, DM, (const bf16_t*)(ws + WS_WGATE), DM, DM, DM, E.e); }
        if (BOTH(8)) GRID_BAR();
    }

    if (IN(9)) {
        const float* ss3 = ssb + SS_3 * SS_STRIDE; const float* gf = a.in[I_GFIN];
        f32x4 gv[8];
#pragma unroll
        for (int j = 0; j < 8; ++j) gv[j] = ((const f32x4*)gf)[lane + 64 * j];
        for (int row = blockIdx.x * 8 + wave; row < MT; row += 2 * G * 8) {
            const int row2 = row + G * 8; const bool has2 = row2 < MT; const int r2 = has2 ? row2 : row;
            f32x4* xa = (f32x4*)(XO + (size_t)row * DM); f32x4* xb2 = (f32x4*)(XO + (size_t)r2 * DM);
            f32x4 va[8], vb[8];
#pragma unroll
            for (int j = 0; j < 8; ++j) { va[j] = __builtin_nontemporal_load(&xa[lane + 64 * j]); vb[j] = __builtin_nontemporal_load(&xb2[lane + 64 * j]); }
            const float rsa = rsqrtf(ss3[row] * (1.f / DM) + EPS), rsb2 = rsqrtf(ss3[r2] * (1.f / DM) + EPS);
#pragma unroll
            for (int j = 0; j < 8; ++j) __builtin_nontemporal_store(va[j] * rsa * gv[j], &xa[lane + 64 * j]);
            if (has2) {
#pragma unroll
                for (int j = 0; j < 8; ++j) __builtin_nontemporal_store(vb[j] * rsb2 * gv[j], &xb2[lane + 64 * j]);
            }
        }
    }
#if MK_LAUNCHES == 1
    if (lo > hi) cg::this_grid().sync();
#endif
}

#undef ssb
#undef AB
#undef Z
#undef YG
#undef MG
#undef HUP
#undef PW
#undef PB
#undef XO
extern "C" void kernel_launch(void* const* d_in, const int* in_sizes, int n_in, void* d_out, int out_size, void* d_ws, size_t ws_size, hipStream_t stream) {
    static int grid = 0;
    if (grid == 0) {
        int dev = 0, cus = 0;
        if (n_in != 37 || ws_size < WS_END) { fprintf(stderr, "kernel_launch: unexpected inputs (n_in %d, ws %zu)\n", n_in, ws_size); grid = -1; return; }
        if (hipGetDevice(&dev) != hipSuccess || hipDeviceGetAttribute(&cus, hipDeviceAttributeMultiprocessorCount, dev) != hipSuccess) { grid = -1; return; }
        if (hipFuncSetAttribute((const void*)fwd_kernel, hipFuncAttributeMaxDynamicSharedMemorySize, LDS_BYTES) != hipSuccess) { fprintf(stderr, "kernel_launch: hipFuncSetAttribute failed\n"); grid = -1; return; }
        int per_cu = 0;
        if (hipOccupancyMaxActiveBlocksPerMultiprocessor(&per_cu, (const void*)fwd_kernel, 512, LDS_BYTES) != hipSuccess || per_cu < 1) { fprintf(stderr, "kernel_launch: occupancy query %d\n", per_cu); }
        (void)hipGetLastError();
        grid = cus;
    }
    if (grid < 0) return;
    (void)hipMemsetAsync((char*)d_ws + WS_CTL, 0, CTL_ZERO_BYTES, stream);
    Args a{};
    for (int i = 0; i < 37; ++i) a.in[i] = (const float*)d_in[i];
    a.out = (float*)d_out; a.ws = (unsigned char*)d_ws;
#if MK_LAUNCHES == 1
    a.ph_lo = 0; a.ph_hi = NPHASE;
    void* args[] = {&a};
    hipError_t e = hipLaunchCooperativeKernel((const void*)fwd_kernel, dim3(grid), dim3(512), args, LDS_BYTES, stream);
    if (e != hipSuccess) fprintf(stderr, "cooperative launch failed: %s (grid %d)\n", hipGetErrorString(e), grid);
#else
    for (int ph = 0; ph < NPHASE; ++ph) {
        a.ph_lo = ph; a.ph_hi = ph + 1;
        hipLaunchKernelGGL(fwd_kernel, dim3(grid), dim3(512), LDS_BYTES, stream, a);
    }
#endif
}
```
